# Optimizing an MI355X kernel written in HIP

```python
import math
import jax, jax.numpy as jnp
from jax import lax
import numpy as np

D_MODEL = 1024
BATCH = 4
SEQ = 8192
DEPTH = 1
DEC_BATCH = 32
DEC_SEQ = 64
PAST_LEN = 2048

CHUNK = 64
Q_BLOCK = 128
ATTN_WIDTH = D_MODEL // 2
LRU_WIDTH = D_MODEL - ATTN_WIDTH
HEAD_DIM = 64
N_ATTN_HEADS = ATTN_WIDTH // (2 * HEAD_DIM)
V_DIM = 2 * HEAD_DIM
LRU_BLOCKS = 8
LRU_BLOCK_W = LRU_WIDTH // LRU_BLOCKS
CONV_WIDTH = 4
LRU_C = 8.0
D_FF = 2816
NUM_BUCKETS = 32
MAX_DISTANCE = 128
IN_WIDTH = 3 * ATTN_WIDTH + 2 * LRU_WIDTH
EPS = 1e-6
NEG_INF = -1e30

kernel_name = "hymba_diffattn_rglru_macaron_stream"


def rms_norm(x, g):
    xf = x.astype(jnp.float32)
    y = xf * lax.rsqrt(jnp.mean(xf * xf, axis=-1, keepdims=True) + EPS)
    return (y * g.astype(jnp.float32)).astype(x.dtype)


def swiglu(x, w_gate, w_up, w_down):
    return (jax.nn.silu(x @ w_gate) * (x @ w_up)) @ w_down


def t5_bucket(rel):
    n = NUM_BUCKETS // 2
    max_exact = n // 2
    ret = jnp.where(rel > 0, n, 0)
    rel = jnp.abs(rel)
    relf = jnp.maximum(rel, 1).astype(jnp.float32)
    large = max_exact + (jnp.log(relf / max_exact) / math.log(MAX_DISTANCE / max_exact)
                         * (n - max_exact)).astype(jnp.int32)
    large = jnp.minimum(large, n - 1)
    return ret + jnp.where(rel < max_exact, rel, large)


def diff_attend(q, k, v, q_pos, k_pos, rel_table, lam):
    logits = jnp.einsum('bqhcd,bkhcd->bhcqk', q, k).astype(jnp.float32) * (HEAD_DIM ** -0.5)
    bias = rel_table.astype(jnp.float32)[t5_bucket(k_pos[None, :] - q_pos[:, None])]
    bias = jnp.transpose(bias, (2, 0, 1))[None, :, None]
    visible = (k_pos[None, :] // CHUNK) <= (q_pos[:, None] // CHUNK)
    logits = jnp.where(visible, logits + bias, NEG_INF)
    p = jax.nn.softmax(logits, axis=-1)
    attn = p[:, :, 0] - lam * p[:, :, 1]
    return jnp.einsum('bhqk,bkhe->bqhe', attn.astype(v.dtype), v)


def prompt_attention(q, k, v, rel_table, lam):
    B, S = q.shape[0], q.shape[1]
    nb = S // Q_BLOCK
    q_blocks = jnp.moveaxis(q.reshape(B, nb, Q_BLOCK, N_ATTN_HEADS, 2, HEAD_DIM), 1, 0)
    k_pos = jnp.arange(S, dtype=jnp.int32)

    def one_block(args):
        qb, start = args
        return diff_attend(qb, k, v, start + jnp.arange(Q_BLOCK, dtype=jnp.int32), k_pos, rel_table, lam)

    o = lax.map(one_block, (q_blocks, jnp.arange(nb, dtype=jnp.int32) * Q_BLOCK))
    return jnp.moveaxis(o, 0, 1).reshape(B, S, N_ATTN_HEADS, V_DIM)


def lru_combine(left, right):
    a1, b1 = left
    a2, b2 = right
    return a1 * a2, a2 * b1 + b2


def rglru_group(xr, xg, p, l, h0, conv0):
    B, S = xr.shape[0], xr.shape[1]
    xpad = jnp.concatenate([conv0.astype(xr.dtype), xr], axis=1)
    w = p['conv_w'][l]
    xc = p['conv_b'][l] + sum(xpad[:, j:j + S] * w[j] for j in range(CONV_WIDTH))
    conv_new = xpad[:, -(CONV_WIDTH - 1):]
    xb = xc.reshape(B, S, LRU_BLOCKS, LRU_BLOCK_W)
    r = jax.nn.sigmoid(jnp.einsum('bsnc,ncd->bsnd', xb, p['gate_a_w'][l]).reshape(B, S, LRU_WIDTH) + p['gate_a_b'][l])
    i = jax.nn.sigmoid(jnp.einsum('bsnc,ncd->bsnd', xb, p['gate_x_w'][l]).reshape(B, S, LRU_WIDTH) + p['gate_x_b'][l])
    log_a = -LRU_C * r.astype(jnp.float32) * jax.nn.softplus(-p['lru_L'][l].astype(jnp.float32))
    a = jnp.exp(log_a)
    b = jnp.sqrt(-jnp.expm1(2.0 * log_a)) * (i * xc).astype(jnp.float32)
    b = b.at[:, 0].add(a[:, 0] * h0.astype(jnp.float32))
    _, h = lax.associative_scan(lru_combine, (a, b), axis=1)
    out = h.astype(xr.dtype) * jax.nn.gelu(xg)
    out = rms_norm(out, p['lru_out_norm'][l])
    return out, h[:, -1].astype(h0.dtype), conv_new.astype(conv0.dtype)


def encoder_layer(x, p, l, rel_table, k_past, v_past, h0, conv0):
    B, S = x.shape[0], x.shape[1]
    x = x + 0.5 * swiglu(rms_norm(x, p['norm_ffn1'][l]), p['ffn1_gate'][l], p['ffn1_up'][l], p['ffn1_down'][l])
    hn = rms_norm(x, p['norm_mix'][l])
    proj = hn @ p['w_in'][l]
    q, k, v, xr, xg = jnp.split(proj, [ATTN_WIDTH, 2 * ATTN_WIDTH, 3 * ATTN_WIDTH, 3 * ATTN_WIDTH + LRU_WIDTH], axis=-1)
    q = rms_norm(q.reshape(B, S, N_ATTN_HEADS, 2, HEAD_DIM), p['q_norm'][l])
    k = rms_norm(k.reshape(B, S, N_ATTN_HEADS, 2, HEAD_DIM), p['k_norm'][l])
    v = v.reshape(B, S, N_ATTN_HEADS, V_DIM)
    lam_init = 0.8 - 0.6 * math.exp(-0.3 * l)
    lam = (jnp.exp(jnp.sum(p['lambda_q1'][l].astype(jnp.float32) * p['lambda_k1'][l].astype(jnp.float32)))
           - jnp.exp(jnp.sum(p['lambda_q2'][l].astype(jnp.float32) * p['lambda_k2'][l].astype(jnp.float32)))
           + lam_init)
    if k_past is None:
        o = prompt_attention(q, k, v, rel_table, lam)
    else:
        P = k_past.shape[1]
        k_all = jnp.concatenate([k_past.astype(k.dtype), k], axis=1)
        v_all = jnp.concatenate([v_past.astype(v.dtype), v], axis=1)
        q_pos = P + jnp.arange(S, dtype=jnp.int32)
        k_pos = jnp.arange(P + S, dtype=jnp.int32)
        o = diff_attend(q, k_all, v_all, q_pos, k_pos, rel_table, lam)
    o = (rms_norm(o, p['subln'][l]) * (1.0 - lam_init)).reshape(B, S, ATTN_WIDTH)
    r_out, h_last, conv_new = rglru_group(xr, xg, p, l, h0, conv0)
    x = x + jnp.concatenate([o, r_out], axis=-1) @ p['w_out'][l]
    x = x + 0.5 * swiglu(rms_norm(x, p['norm_ffn2'][l]), p['ffn2_gate'][l], p['ffn2_up'][l], p['ffn2_down'][l])
    return x, k, v, h_last, conv_new


def setup_inputs(seed: int = 0) -> dict:
    key = jax.random.key(seed)
    ks = jax.random.split(key, 40)

    def nrm(k, shape, scale):
        return jax.random.normal(k, shape, jnp.float32) * scale

    def gain(k, shape):
        return 1.0 + 0.01 * jax.random.normal(k, shape, jnp.float32)

    u = jax.random.uniform(ks[27], (DEPTH, LRU_WIDTH), jnp.float32, minval=0.9, maxval=0.999)
    a0 = u ** (1.0 / LRU_C)
    lru_L = jnp.log(a0) - jnp.log1p(-a0)
    return {
        "x_prompt": nrm(ks[0], (BATCH, SEQ, D_MODEL), 1.0),
        "x_sample": nrm(ks[1], (DEC_BATCH, DEC_SEQ, D_MODEL), 1.0),
        "cache_k": nrm(ks[2], (DEPTH, DEC_BATCH, PAST_LEN, N_ATTN_HEADS, 2, HEAD_DIM), 1.0),
        "cache_v": nrm(ks[3], (DEPTH, DEC_BATCH, PAST_LEN, N_ATTN_HEADS, V_DIM), 1.0),
        "state_lru": nrm(ks[4], (DEPTH, DEC_BATCH, LRU_WIDTH), 0.5),
        "state_conv": nrm(ks[5], (DEPTH, DEC_BATCH, CONV_WIDTH - 1, LRU_WIDTH), 1.0),
        "rel_bias": nrm(ks[6], (NUM_BUCKETS, N_ATTN_HEADS), 0.2),
        "norm_ffn1": gain(ks[7], (DEPTH, D_MODEL)),
        "ffn1_gate": nrm(ks[8], (DEPTH, D_MODEL, D_FF), D_MODEL ** -0.5),
        "ffn1_up": nrm(ks[9], (DEPTH, D_MODEL, D_FF), D_MODEL ** -0.5),
        "ffn1_down": nrm(ks[10], (DEPTH, D_FF, D_MODEL), D_FF ** -0.5),
        "norm_mix": gain(ks[11], (DEPTH, D_MODEL)),
        "w_in": nrm(ks[12], (DEPTH, D_MODEL, IN_WIDTH), D_MODEL ** -0.5),
        "q_norm": gain(ks[13], (DEPTH, HEAD_DIM)),
        "k_norm": gain(ks[14], (DEPTH, HEAD_DIM)),
        "lambda_q1": nrm(ks[15], (DEPTH, HEAD_DIM), 0.1),
        "lambda_k1": nrm(ks[16], (DEPTH, HEAD_DIM), 0.1),
        "lambda_q2": nrm(ks[17], (DEPTH, HEAD_DIM), 0.1),
        "lambda_k2": nrm(ks[18], (DEPTH, HEAD_DIM), 0.1),
        "subln": gain(ks[19], (DEPTH, V_DIM)),
        "conv_w": nrm(ks[20], (DEPTH, CONV_WIDTH, LRU_WIDTH), CONV_WIDTH ** -0.5),
        "conv_b": nrm(ks[21], (DEPTH, LRU_WIDTH), 0.01),
        "gate_a_w": nrm(ks[22], (DEPTH, LRU_BLOCKS, LRU_BLOCK_W, LRU_BLOCK_W), LRU_BLOCK_W ** -0.5),
        "gate_a_b": nrm(ks[23], (DEPTH, LRU_WIDTH), 0.01),
        "gate_x_w": nrm(ks[24], (DEPTH, LRU_BLOCKS, LRU_BLOCK_W, LRU_BLOCK_W), LRU_BLOCK_W ** -0.5),
        "gate_x_b": nrm(ks[25], (DEPTH, LRU_WIDTH), 0.01),
        "lru_L": lru_L,
        "lru_out_norm": gain(ks[26], (DEPTH, LRU_WIDTH)),
        "w_out": nrm(ks[28], (DEPTH, D_MODEL, D_MODEL), D_MODEL ** -0.5),
        "norm_ffn2": gain(ks[29], (DEPTH, D_MODEL)),
        "ffn2_gate": nrm(ks[30], (DEPTH, D_MODEL, D_FF), D_MODEL ** -0.5),
        "ffn2_up": nrm(ks[31], (DEPTH, D_MODEL, D_FF), D_MODEL ** -0.5),
        "ffn2_down": nrm(ks[32], (DEPTH, D_FF, D_MODEL), D_FF ** -0.5),
    }


def reference(x_prompt, x_sample, cache_k, cache_v, state_lru, state_conv, rel_bias,
              norm_ffn1, ffn1_gate, ffn1_up, ffn1_down, norm_mix, w_in, q_norm, k_norm,
              lambda_q1, lambda_k1, lambda_q2, lambda_k2, subln, conv_w, conv_b,
              gate_a_w, gate_a_b, gate_x_w, gate_x_b, lru_L, lru_out_norm, w_out,
              norm_ffn2, ffn2_gate, ffn2_up, ffn2_down):
    p = dict(norm_ffn1=norm_ffn1, ffn1_gate=ffn1_gate, ffn1_up=ffn1_up, ffn1_down=ffn1_down,
             norm_mix=norm_mix, w_in=w_in, q_norm=q_norm, k_norm=k_norm,
             lambda_q1=lambda_q1, lambda_k1=lambda_k1, lambda_q2=lambda_q2, lambda_k2=lambda_k2,
             subln=subln, conv_w=conv_w, conv_b=conv_b, gate_a_w=gate_a_w, gate_a_b=gate_a_b,
             gate_x_w=gate_x_w, gate_x_b=gate_x_b, lru_L=lru_L, lru_out_norm=lru_out_norm,
             w_out=w_out, norm_ffn2=norm_ffn2, ffn2_gate=ffn2_gate, ffn2_up=ffn2_up, ffn2_down=ffn2_down)
    B = x_prompt.shape[0]
    yp, ys = x_prompt, x_sample
    kp_l, vp_l, hp_l, cp_l, ks_l, vs_l, hs_l, cs_l = [], [], [], [], [], [], [], []
    for l in range(DEPTH):
        h0_p = jnp.zeros((B, LRU_WIDTH), state_lru.dtype)
        c0_p = jnp.zeros((B, CONV_WIDTH - 1, LRU_WIDTH), state_conv.dtype)
        yp, kp, vp, hp, cp = encoder_layer(yp, p, l, rel_bias, None, None, h0_p, c0_p)
        ys, kn, vn, hn, cn = encoder_layer(ys, p, l, rel_bias, cache_k[l], cache_v[l], state_lru[l], state_conv[l])
        kp_l.append(kp); vp_l.append(vp); hp_l.append(hp); cp_l.append(cp)
        ks_l.append(kn); vs_l.append(vn); hs_l.append(hn); cs_l.append(cn)
    new_k_prompt = jnp.stack(kp_l, axis=0)
    new_v_prompt = jnp.stack(vp_l, axis=0)
    new_lru_prompt = jnp.stack(hp_l, axis=0)
    new_conv_prompt = jnp.stack(cp_l, axis=0)
    new_k_sample = jnp.stack(ks_l, axis=0)
    new_v_sample = jnp.stack(vs_l, axis=0)
    new_lru_sample = jnp.stack(hs_l, axis=0)
    new_conv_sample = jnp.stack(cs_l, axis=0)
    return (yp, ys, new_k_prompt, new_v_prompt, new_lru_prompt, new_conv_prompt,
            new_k_sample, new_v_sample, new_lru_sample, new_conv_sample)
```

```cpp
#define ATT_TWICE 1
#include <hip/hip_runtime.h>
#include <hip/hip_cooperative_groups.h>
#include <hip/hip_bf16.h>
#include <cstdio>
#include <cstdint>
namespace cg = cooperative_groups;

constexpr int DM = 1024, NBP = 4, SEQ = 8192, NBS = 32, DSQ = 64, PAST = 2048;
constexpr int TP = NBP * SEQ, TS = NBS * DSQ, TT = TP + TS;
constexpr int FF = 2816, AW = 512, LW = 512, INW = 2560, NH = 4, HD = 64, VD = 128;
constexpr float EPS = 1e-6f;
constexpr float LOG2E = 1.4426950408889634f;
constexpr float QSCALE = 0.125f * LOG2E;
constexpr size_t O_Y = 0, O_KP = (size_t)TT * DM, O_VP = O_KP + (size_t)TP * 512, O_LP = O_VP + (size_t)TP * 512, O_CP = O_LP + NBP * 512,
                 O_KS = O_CP + NBP * 3 * 512, O_VS = O_KS + (size_t)TS * 512, O_LS = O_VS + (size_t)TS * 512, O_CS = O_LS + NBS * 512, O_END = O_CS + NBS * 3 * 512;
static_assert(O_END == 71376896, "output size");
constexpr size_t OFF_SSQ1 = 44u << 20, OFF_Q = 121u << 20, OFF_KVP = (121u + 34u) << 20, OFF_KVS = (121u + 98u) << 20, OFF_XR = (121u + 102u) << 20, OFF_XG = (121u + 136u) << 20;
namespace pg8 {
#define PG8_LAS __attribute__((address_space(3)))
typedef unsigned short bf16_t;
typedef short bf16x8 __attribute__((ext_vector_type(8)));
typedef float f32x4 __attribute__((ext_vector_type(4)));
typedef unsigned u32x4 __attribute__((ext_vector_type(4)));
constexpr int BM = 256, BK = 64, HALF = 128, HTB = HALF * BK * 2  , STAGE_BYTES = 8 * HTB, NXCD = 8, WGM = 8;

__host__ __device__ __forceinline__ int lds_byte(int r, int c) { const int st = (r >> 4) * 2 + (c >> 5), rr = r & 15, cc = c & 31, ob = rr * 64 + cc * 2; return st * 1024 + (ob ^ (((ob >> 9) & 1) << 5)); }
__host__ __device__ __forceinline__ void stage_rc(int b, int& R, int& C) { const int st = b / 1024, sb = b % 1024, swz = sb ^ (((sb >> 9) & 1) << 5); R = (st >> 1) * 16 + swz / 64; C = (st & 1) * 32 + (swz % 64) / 2; }
__host__ __device__ __forceinline__ int perm32(int rho) { const int n = rho >> 4, i = rho & 15; return 8 * (i >> 2) + 4 * n + (i & 3); }

struct Unit { int pm, pn, kt0, nkt, kind; };
struct Gemm { const bf16_t* A; const bf16_t* Bt; int M, N, K; };

struct StaticOrder {
    static constexpr bool SPLIT = false;
    int nM, nN, nwg, G, c;
    __host__ __device__ void init(int M, int N, int G_, int c_) { nM = M / BM; nN = N / BM; nwg = nM * nN; G = G_; c = c_; }
    __host__ __device__ bool next(int i, Unit& u) const {
        const long L = (long)i * G + c; if (L >= nwg) return false;
        int wgid = (int)L; { const int q = nwg / NXCD, r = nwg % NXCD, xcd = wgid % NXCD, off = wgid / NXCD; wgid = (xcd < r ? xcd * (q + 1) : r * (q + 1) + (xcd - r) * q) + off; }
        const int nig = WGM * nN, gid = wgid / nig, fm = gid * WGM, gsz = (nM - fm) < WGM ? (nM - fm) : WGM;
        u.pm = fm + ((wgid % nig) % gsz); u.pn = (wgid % nig) / gsz; u.kt0 = 0; u.nkt = nkt; u.kind = 0; return true;
    }
    int nkt;
    __device__ __forceinline__ void a_ready(const Unit&) const {}
    __device__ __forceinline__ void done(const Unit&) const {}
    __device__ __forceinline__ void put_partial(const f32x4 (&)[2][2][4][2], int, int) const {}
    __device__ __forceinline__ void load_partial(f32x4 (&)[2][2][4][2], int, int) const {}
};


template <bool SPLIT_> struct StreamK {
    static constexpr bool SPLIT = SPLIT_;
    int nM, nN, P, W, x, w, q, R1, Dq; long lo, hi; int v; float* slab; unsigned* flag;
    __device__ void init(int M, int N, int K, int G_, int bx, float* slab_, unsigned* flag_) { nM = M / BM; nN = N / BM; P = K / (2 * BK); W = G_ / NXCD; x = bx % NXCD; w = bx / NXCD;
        const int nwg = nM * nN; q = nwg / NXCD;
        if (!SPLIT) { R1 = (nwg + G_ - 1) / G_; Dq = q; } else { R1 = nwg / G_ - 1; Dq = R1 * W; }
        const long tot = (long)(q - Dq) * P; lo = tot * w / W; hi = tot * (w + 1) / W; v = x * W + w; slab = slab_; flag = flag_; }
    __device__ bool next(int i, Unit& u) const {
        int L;
        if (i < R1) { L = x * q + i * W + w; u.kt0 = 0; u.nkt = 2 * P; u.kind = 0; if (!SPLIT && i * W + w >= q) return false; }
        else if (!SPLIT) return false;
        else { const int k = i - R1; const long u0 = lo / P; const long base = (u0 + k) * P; const long start = (k == 0) ? lo - base : 0; if (base + start >= hi) return false;
            const long end = (hi - base) < P ? (hi - base) : P;
            L = x * q + Dq + (int)(u0 + k); u.kt0 = (int)(2 * start); u.nkt = (int)(2 * (end - start)); u.kind = start > 0 ? 1 : (end < P ? 2 : 0); }
        const int nig = WGM * nN, gid = L / nig, fm = gid * WGM, gsz = (nM - fm) < WGM ? (nM - fm) : WGM;
        u.pm = fm + ((L % nig) % gsz); u.pn = (L % nig) / gsz; return true;
    }
    __device__ __forceinline__ void a_ready(const Unit&) const {}
    __device__ __forceinline__ void done(const Unit&) const {}
    __device__ __forceinline__ void put_partial(const f32x4 (&acc)[2][2][4][2], int tid, int lane) const {
        f32x4* dst = (f32x4*)slab + (size_t)v * (32 * 512) + tid;
#pragma unroll
        for (int ai = 0; ai < 2; ++ai)
#pragma unroll
            for (int bj = 0; bj < 2; ++bj)
#pragma unroll
                for (int m = 0; m < 4; ++m)
#pragma unroll
                    for (int n = 0; n < 2; ++n) { const f32x4 val = acc[ai][bj][m][n];
                        asm volatile("global_store_dwordx4 %0, %1, off sc1\n\ts_nop 1" :: "v"(dst), "v"(val) : "memory");
                        dst += 512; asm volatile("" : "+v"(dst)); }
        asm volatile("s_waitcnt vmcnt(0)" ::: "memory");
        if (lane == 0) __hip_atomic_fetch_add(flag + v, 1u, __ATOMIC_RELAXED, __HIP_MEMORY_SCOPE_AGENT);
    }
    __device__ __forceinline__ void load_partial(f32x4 (&acc)[2][2][4][2], int tid, int lane) const {
        unsigned spins = 0;
        while ((unsigned)__builtin_amdgcn_readfirstlane(__hip_atomic_load(flag + v + 1, __ATOMIC_RELAXED, __HIP_MEMORY_SCOPE_AGENT)) < 8u) { __builtin_amdgcn_s_sleep(2); if (++spins > (1u << 22)) break; }
        __builtin_amdgcn_fence(__ATOMIC_ACQUIRE, "agent");
        const f32x4* src = (const f32x4*)slab + (size_t)(v + 1) * (32 * 512) + tid;
#pragma unroll
        for (int ai = 0; ai < 2; ++ai)
#pragma unroll
            for (int bj = 0; bj < 2; ++bj)
#pragma unroll
                for (int m = 0; m < 4; ++m)
#pragma unroll
                    for (int n = 0; n < 2; ++n) { acc[ai][bj][m][n] = *src; src += 512; asm volatile("" : "+v"(src)); }
    }
};

__device__ __forceinline__ unsigned cvt_pk_bf16(float lo, float hi) { unsigned r; asm volatile("v_cvt_pk_bf16_f32 %0, %1, %2" : "=v"(r) : "v"(lo), "v"(hi)); return r; }
__device__ __forceinline__ u32x4 pack8(const f32x4& a, const f32x4& b) { u32x4 w; w.x = cvt_pk_bf16(a[0], a[1]); w.y = cvt_pk_bf16(a[2], a[3]); w.z = cvt_pk_bf16(b[0], b[1]); w.w = cvt_pk_bf16(b[2], b[3]); return w; }
__device__ __forceinline__ float silu_f(float g) { return g * __builtin_amdgcn_rcpf(1.0f + __builtin_amdgcn_exp2f(-g * 1.4426950408889634f)); }
__device__ __forceinline__ float rstd_from_ssq(const float* ssq, int row, int fq) {
    const f32x4 p = *(const f32x4*)(ssq + (size_t)row * 16 + 4 * fq);
    float s = (p[0] + p[1]) + (p[2] + p[3]); s += __shfl_xor(s, 16); s += __shfl_xor(s, 32);
    return __builtin_amdgcn_rsqf(s * (1.0f / 1024.0f) + 1e-6f);
}
#ifndef EPI_TWICE
#define EPI_TWICE 0
#endif
template <int RSMODE  > struct EpiSwiGLU {
    static constexpr bool PERM = true, AFTER_DRAIN = false, TWICE_OK = (EPI_TWICE == 1);
    bf16_t* H; const float* rs;
    __device__ __forceinline__ void operator()(const f32x4 (&acc)[2][2][4][2], const Unit& u, int wr, int wc, int fr, int fq) const {
        const int row0 = u.pm * BM + wr * 64 + fr, col0 = u.pn * 128 + wc * 32 + 8 * fq;
#pragma unroll
        for (int ai = 0; ai < 2; ++ai)
#pragma unroll
            for (int m = 0; m < 4; ++m) { const int row = row0 + ai * HALF + m * 16;
                const float s = RSMODE == 0 ? rs[row] : rstd_from_ssq(rs, row, fq);
                f32x4 h0, h1;
#pragma unroll
                for (int e = 0; e < 4; ++e) { h0[e] = silu_f(acc[ai][0][m][0][e] * s) * (acc[ai][1][m][0][e] * s); h1[e] = silu_f(acc[ai][0][m][1][e] * s) * (acc[ai][1][m][1][e] * s); }
                *(u32x4*)(H + (size_t)row * 2816 + col0) = pack8(h0, h1); }
    }
};
__device__ __forceinline__ f32x4 bf4lo(const u32x4& w) { f32x4 r; r[0] = __builtin_bit_cast(float, w.x << 16); r[1] = __builtin_bit_cast(float, w.x & 0xffff0000u); r[2] = __builtin_bit_cast(float, w.y << 16); r[3] = __builtin_bit_cast(float, w.y & 0xffff0000u); return r; }
__device__ __forceinline__ f32x4 bf4hi(const u32x4& w) { f32x4 r; r[0] = __builtin_bit_cast(float, w.z << 16); r[1] = __builtin_bit_cast(float, w.z & 0xffff0000u); r[2] = __builtin_bit_cast(float, w.w << 16); r[3] = __builtin_bit_cast(float, w.w & 0xffff0000u); return r; }
template <int KIND> struct EpiResid {
    static constexpr bool PERM = true, AFTER_DRAIN = false, TWICE_OK = (EPI_TWICE == 3 && KIND == 2);
    bf16_t* xb; float* out; float* ssq;
    __device__ __forceinline__ void operator()(const f32x4 (&acc)[2][2][4][2], const Unit& u, int wr, int wc, int fr, int fq) const {
        const int row0 = u.pm * BM + wr * 64 + fr, col0 = u.pn * BM + wc * 32 + 8 * fq;
        const float sc = KIND == 1 ? 1.0f : 0.5f;
        u32x4 r0 = *(const u32x4*)(xb + (size_t)row0 * 1024 + col0), r1 = *(const u32x4*)(xb + (size_t)row0 * 1024 + col0 + HALF);
#pragma unroll
        for (int ai = 0; ai < 2; ++ai)
#pragma unroll
            for (int m = 0; m < 4; ++m) { const int row = row0 + ai * HALF + m * 16;
                const u32x4 c0 = r0, c1 = r1;
                if (ai * 4 + m < 7) { const int nrow = row0 + ((ai * 4 + m + 1) >> 2) * HALF + ((ai * 4 + m + 1) & 3) * 16;
                    r0 = *(const u32x4*)(xb + (size_t)nrow * 1024 + col0); r1 = *(const u32x4*)(xb + (size_t)nrow * 1024 + col0 + HALF); }
                const f32x4 v00 = bf4lo(c0) + acc[ai][0][m][0] * sc, v01 = bf4hi(c0) + acc[ai][0][m][1] * sc, v10 = bf4lo(c1) + acc[ai][1][m][0] * sc, v11 = bf4hi(c1) + acc[ai][1][m][1] * sc;
                if (KIND < 2) {
                    *(u32x4*)(xb + (size_t)row * 1024 + col0) = pack8(v00, v01); *(u32x4*)(xb + (size_t)row * 1024 + col0 + HALF) = pack8(v10, v11);
                    float ss = (v00[0] * v00[0] + v00[1] * v00[1]) + (v00[2] * v00[2] + v00[3] * v00[3]) + (v01[0] * v01[0] + v01[1] * v01[1]) + (v01[2] * v01[2] + v01[3] * v01[3]);
                    ss += (v10[0] * v10[0] + v10[1] * v10[1]) + (v10[2] * v10[2] + v10[3] * v10[3]) + (v11[0] * v11[0] + v11[1] * v11[1]) + (v11[2] * v11[2] + v11[3] * v11[3]);
                    ss += __shfl_xor(ss, 16); ss += __shfl_xor(ss, 32); if (fq == 0) ssq[(size_t)row * 16 + u.pn * 4 + wc] = ss;
                } else { float* orow = out + (size_t)row * 1024 + col0;
                    *(f32x4*)orow = v00; *(f32x4*)(orow + 4) = v01; *(f32x4*)(orow + HALF) = v10; *(f32x4*)(orow + HALF + 4) = v11; } }
    }
};
struct EpiWinPtrs { const float* ssq1; bf16_t* Q; unsigned char *KVP, *KVS; bf16_t *XR, *XG; float* out; const float *gq, *gk; };
__device__ __forceinline__ unsigned char* tile_of(const EpiWinPtrs& P, int row, int h, int& key) {
    if (row < 32768) { const int pos = row & 8191; key = pos & 63; return P.KVP + (size_t)((((row >> 13) * 4 + h) * 128) + (pos >> 6)) * 32768; }
    const int r2 = row - 32768; key = r2 & 63; return P.KVS + (size_t)((r2 >> 6) * 4 + h) * 32768; }
template <int KIND> __device__ __forceinline__ void win_qk(const EpiWinPtrs P, const f32x4 (&acc)[2][2][4][2], const Unit& u, int wr, int wc, int fr, int fq) {
    const int row0 = u.pm * BM + wr * 64 + fr, half = u.pn & 1;
    const float* gp = KIND == 0 ? P.gq : P.gk; const float qs = KIND == 0 ? 0.125f * 1.4426950408889634f : 1.0f;
    const f32x4 g00 = *(const f32x4*)(gp + 8 * fq) * qs, g01 = *(const f32x4*)(gp + 8 * fq + 4) * qs, g10 = *(const f32x4*)(gp + 32 + 8 * fq) * qs, g11 = *(const f32x4*)(gp + 32 + 8 * fq + 4) * qs;
    const int cbase = 256 * half + 64 * wc + 8 * fq;
#pragma unroll
    for (int ai = 0; ai < 2; ++ai)
#pragma unroll
        for (int m = 0; m < 4; ++m) { const int row = row0 + ai * HALF + m * 16; const float rs = rstd_from_ssq(P.ssq1, row, fq);
            const f32x4 v00 = acc[ai][0][m][0] * rs, v01 = acc[ai][0][m][1] * rs, v10 = acc[ai][1][m][0] * rs, v11 = acc[ai][1][m][1] * rs;
            float ss = (v00[0] * v00[0] + v00[1] * v00[1]) + (v00[2] * v00[2] + v00[3] * v00[3]);
            ss += (v01[0] * v01[0] + v01[1] * v01[1]) + (v01[2] * v01[2] + v01[3] * v01[3]);
            ss += (v10[0] * v10[0] + v10[1] * v10[1]) + (v10[2] * v10[2] + v10[3] * v10[3]);
            ss += (v11[0] * v11[0] + v11[1] * v11[1]) + (v11[2] * v11[2] + v11[3] * v11[3]);
            ss += __shfl_xor(ss, 16); ss += __shfl_xor(ss, 32);
            const float rn = __builtin_amdgcn_rsqf(ss * (1.0f / 64.0f) + 1e-6f);
            const f32x4 a0 = v00 * rn * g00, b0 = v01 * rn * g01, a1 = v10 * rn * g10, b1 = v11 * rn * g11;
            if (KIND == 0) { *(u32x4*)(P.Q + (size_t)row * 512 + cbase) = pack8(a0, b0); *(u32x4*)(P.Q + (size_t)row * 512 + cbase + 32) = pack8(a1, b1); }
            else { float* o = (row < 32768 ? P.out + 35651584 + (size_t)row * 512 : P.out + 69214208 + (size_t)(row - 32768) * 512) + cbase;
                *(f32x4*)o = a0; *(f32x4*)(o + 4) = b0; *(f32x4*)(o + 32) = a1; *(f32x4*)(o + 36) = b1;
                int key; unsigned char* tb = tile_of(P, row, 2 * half + (wc >> 1), key) + (wc & 1) * 8192 + fq * 1024 + key * 16;
                *(u32x4*)tb = pack8(a0, b0); *(u32x4*)(tb + 4096) = pack8(a1, b1); }
            asm volatile("" ::: "memory"); }
}
template <int KIND> __device__ __forceinline__ void win_plain(const EpiWinPtrs P, const f32x4 (&acc)[2][2][4][2], const Unit& u, int wr, int wc, int fr, int fq) {
    const int row0 = u.pm * BM + wr * 64 + fr, half = u.pn & 1;
    const int cbase = 256 * half + 32 * wc + 8 * fq;
    bf16_t* dst = KIND == 3 ? P.XR : P.XG;
#pragma unroll
    for (int ai = 0; ai < 2; ++ai)
#pragma unroll
        for (int m = 0; m < 4; ++m) { const int row = row0 + ai * HALF + m * 16; const float rs = rstd_from_ssq(P.ssq1, row, fq);
#pragma unroll
            for (int bj = 0; bj < 2; ++bj) { const f32x4 a = acc[ai][bj][m][0] * rs, b = acc[ai][bj][m][1] * rs; const int c = cbase + 128 * bj;
                if (KIND == 2) { int key; unsigned char* tb = tile_of(P, row, 2 * half + bj, key) + 16384 + wc * 4096 + key * 64 + fq * 16; *(u32x4*)tb = pack8(a, b); }
                else *(u32x4*)(dst + (size_t)row * 512 + c) = pack8(a, b);
                if (KIND == 2) { float* o = (row < 32768 ? P.out + 52428800 + (size_t)row * 512 : P.out + 70262784 + (size_t)(row - 32768) * 512) + c; *(f32x4*)o = a; *(f32x4*)(o + 4) = b; }
                if (KIND == 3) {
                    if (row < 32768) { const int t = row & 8191; if (t >= 8189) { float* o = P.out + 69208064 + (size_t)((row >> 13) * 3 + (t - 8189)) * 512 + c; *(f32x4*)o = a; *(f32x4*)(o + 4) = b; } }
                    else { const int t = (row - 32768) & 63; if (t >= 61) { float* o = P.out + 71327744 + (size_t)(((row - 32768) >> 6) * 3 + (t - 61)) * 512 + c; *(f32x4*)o = a; *(f32x4*)(o + 4) = b; } } } }
            asm volatile("" ::: "memory"); }
}
struct EpiWin {
    static constexpr bool PERM = true, AFTER_DRAIN = false, TWICE_OK = (EPI_TWICE == 2);
    unsigned char* wsb; float* out; const float *gq, *gk;
    __device__ __forceinline__ void operator()(const f32x4 (&acc)[2][2][4][2], const Unit& u, int wr, int wc, int fr, int fq) const {
        unsigned char* w = wsb; asm volatile("" : "+s"(w));
        const EpiWinPtrs P{(const float*)(w + OFF_SSQ1), (bf16_t*)(w + OFF_Q), w + OFF_KVP, w + OFF_KVS, (bf16_t*)(w + OFF_XR), (bf16_t*)(w + OFF_XG), out, gq, gk};
        const int kind = u.pn >> 1;
        if (kind == 0) win_qk<0>(P, acc, u, wr, wc, fr, fq);
        else if (kind == 1) win_qk<1>(P, acc, u, wr, wc, fr, fq);
        else if (kind == 2) win_plain<2>(P, acc, u, wr, wc, fr, fq);
        else if (kind == 3) win_plain<3>(P, acc, u, wr, wc, fr, fq);
        else win_plain<4>(P, acc, u, wr, wc, fr, fq);
    }
};
template <class Epi, class Sched, bool ALIGN_EPI = false, bool SP2 = false>
__device__ __forceinline__ void gemm_phase(PG8_LAS unsigned char* lds, const Gemm g, const Sched& S, const Epi& E) {
    int tid_ = threadIdx.x; asm volatile("" : "+v"(tid_));
    const int tid = tid_, wid = __builtin_amdgcn_readfirstlane(tid >> 6), lane = tid & 63, wr = wid >> 2, wc = wid & 3, fr = lane & 15, fq = lane >> 4;
    const int K = g.K;
    unsigned voffA[2], voffB[2];
#pragma unroll
    for (int i = 0; i < 2; ++i) { int R, C; stage_rc(tid * 16 + i * 8192, R, C); const int Rb = Epi::PERM ? ((R & ~31) + perm32(R & 31)) : R;
        voffA[i] = (unsigned)(R * K + C) * 2u; voffB[i] = (unsigned)(Rb * K + C) * 2u; }
    const size_t kstep = (size_t)(BK * 2);
    const size_t hstep = (size_t)HALF * K * 2;
    const size_t tstep = 2 * hstep;
    const unsigned ldsw = (unsigned)wid * 1024u;
    const int aoff = lds_byte(wr * 64 + fr, fq * 8), boff = lds_byte(wc * 32 + fr, fq * 8);
#define PG8_SA(b, h) (((b) * 2 + (h)) * HTB)
#define PG8_SB(b, h) ((4 + (b) * 2 + (h)) * HTB)
#define PG8_STAGE(bufoff, gbase, voff) do { _Pragma("unroll") for (int _i = 0; _i < 2; ++_i) \
        __builtin_amdgcn_global_load_lds((const unsigned*)((const char*)(gbase) + (voff)[_i]), (PG8_LAS unsigned*)(lds + (bufoff) + ldsw + _i * 8192), 16, 0, 0); } while (0)
#define PG8_LDA(dst, b, h) do { _Pragma("unroll") for (int m = 0; m < 4; ++m) _Pragma("unroll") for (int k = 0; k < 2; ++k) dst[m][k] = *(const PG8_LAS bf16x8*)(lds + PG8_SA(b, h) + aoff + m * 2048 + k * 1024); } while (0)
#define PG8_LDB(dst, b, h) do { _Pragma("unroll") for (int n = 0; n < 2; ++n) _Pragma("unroll") for (int k = 0; k < 2; ++k) dst[n][k] = *(const PG8_LAS bf16x8*)(lds + PG8_SB(b, h) + boff + n * 2048 + k * 1024); } while (0)
#define PG8_MMA(ai, bj, At, Bt) do { __builtin_amdgcn_s_setprio(1); _Pragma("unroll") for (int m = 0; m < 4; ++m) _Pragma("unroll") for (int n = 0; n < 2; ++n) _Pragma("unroll") for (int k = 0; k < 2; ++k) \
        acc[ai][bj][m][n] = __builtin_amdgcn_mfma_f32_16x16x32_bf16(Bt[n][k], At[m][k], acc[ai][bj][m][n], 0, 0, 0); __builtin_amdgcn_s_setprio(0); } while (0)
#define PG8_WAIT_V(n) asm volatile("s_waitcnt vmcnt(" #n ")" ::: "memory")
#define PG8_WAIT_L(n) asm volatile("s_waitcnt lgkmcnt(" #n ")" ::: "memory")
#define PG8_BAR __builtin_amdgcn_s_barrier()
#define PG8_SCHED __builtin_amdgcn_sched_barrier(0)
    Unit cur, nxt; int ui = 0;
    if (!S.next(0, cur)) return;
    f32x4 acc[2][2][4][2];
#pragma unroll
    for (int a = 0; a < 2; ++a)
#pragma unroll
        for (int b = 0; b < 2; ++b)
#pragma unroll
            for (int m = 0; m < 4; ++m)
#pragma unroll
                for (int n = 0; n < 2; ++n) acc[a][b][m][n] = (f32x4){0.f, 0.f, 0.f, 0.f};
    bf16x8 At[4][2], B0[2][2], B1[2][2];
    const char* cA = (const char*)g.A + (size_t)cur.pm * tstep + (Sched::SPLIT ? (size_t)cur.kt0 * kstep : (size_t)0); const char* cB = (const char*)g.Bt + (size_t)cur.pn * tstep + (Sched::SPLIT ? (size_t)cur.kt0 * kstep : (size_t)0);
    S.a_ready(cur);
    if constexpr (SP2) {
        PG8_STAGE(PG8_SB(0, 0), cB, voffB); PG8_STAGE(PG8_SB(0, 1), cB + hstep, voffB); PG8_STAGE(PG8_SA(0, 0), cA, voffA); PG8_STAGE(PG8_SA(0, 1), cA + hstep, voffA);
        if (wr == 1) PG8_BAR;
        PG8_WAIT_V(2); PG8_BAR;
        PG8_STAGE(PG8_SB(1, 0), cB + kstep, voffB); PG8_STAGE(PG8_SA(1, 0), cA + kstep, voffA); PG8_STAGE(PG8_SB(1, 1), cB + hstep + kstep, voffB);
        PG8_WAIT_V(6); PG8_BAR;
    } else {
        PG8_STAGE(PG8_SB(0, 0), cB, voffB); PG8_STAGE(PG8_SA(0, 0), cA, voffA); PG8_STAGE(PG8_SB(0, 1), cB + hstep, voffB); PG8_STAGE(PG8_SA(0, 1), cA + hstep, voffA);
        if (wr == 1) PG8_BAR;
        PG8_WAIT_V(4); PG8_BAR;
        PG8_STAGE(PG8_SB(1, 0), cB + kstep, voffB); PG8_STAGE(PG8_SA(1, 0), cA + kstep, voffA); PG8_STAGE(PG8_SB(1, 1), cB + hstep + kstep, voffB);
        PG8_WAIT_V(6); PG8_BAR;
    }
    for (;;) {
        const bool has_next = S.next(ui + 1, nxt);
        const char* nA = has_next ? (const char*)g.A + (size_t)nxt.pm * tstep + (Sched::SPLIT ? (size_t)nxt.kt0 * kstep : (size_t)0) : cA; const char* nB = has_next ? (const char*)g.Bt + (size_t)nxt.pn * tstep + (Sched::SPLIT ? (size_t)nxt.kt0 * kstep : (size_t)0) : cB;
        const int nt = Sched::SPLIT ? cur.nkt : K / BK;
        for (int t = 0; t < nt; t += 2) {
            const bool last = (t == nt - 2);
            const char* a1 = cA + (size_t)(t + 1) * kstep;
            const char* a2 = last ? nA : cA + (size_t)(t + 2) * kstep; const char* b2 = last ? nB : cB + (size_t)(t + 2) * kstep;
            const char* a3 = a2 + kstep; const char* b3 = b2 + kstep;
            if (last && has_next) S.a_ready(nxt);
            if constexpr (SP2) {
            PG8_LDB(B0, 0, 0); PG8_LDB(B1, 0, 1); PG8_SCHED; PG8_LDA(At, 0, 0); PG8_STAGE(PG8_SA(1, 1), a1 + hstep, voffA);
            PG8_WAIT_V(8); PG8_WAIT_L(0); PG8_BAR; PG8_MMA(0, 0, At, B0); PG8_MMA(0, 1, At, B1); PG8_BAR; PG8_SCHED;
            PG8_LDA(At, 0, 1); PG8_STAGE(PG8_SB(0, 0), b2, voffB); PG8_STAGE(PG8_SB(0, 1), b2 + hstep, voffB); PG8_STAGE(PG8_SA(0, 0), a2, voffA);
            PG8_WAIT_V(8); PG8_WAIT_L(0); PG8_BAR; PG8_MMA(1, 0, At, B0); PG8_MMA(1, 1, At, B1); PG8_BAR; PG8_SCHED;
            PG8_LDB(B0, 1, 0); PG8_LDB(B1, 1, 1); PG8_SCHED; PG8_LDA(At, 1, 0); PG8_STAGE(PG8_SA(0, 1), a2 + hstep, voffA);
            PG8_WAIT_V(8); PG8_WAIT_L(0); PG8_BAR; PG8_MMA(0, 0, At, B0); PG8_MMA(0, 1, At, B1); PG8_BAR; PG8_SCHED;
            PG8_LDA(At, 1, 1); PG8_STAGE(PG8_SB(1, 0), b3, voffB); PG8_STAGE(PG8_SB(1, 1), b3 + hstep, voffB); PG8_STAGE(PG8_SA(1, 0), a3, voffA);
            PG8_WAIT_V(8); PG8_WAIT_L(0); PG8_BAR; PG8_MMA(1, 0, At, B0); PG8_MMA(1, 1, At, B1); PG8_BAR; PG8_SCHED;
            } else {
            PG8_LDB(B0, 0, 0); PG8_SCHED; PG8_LDA(At, 0, 0); PG8_STAGE(PG8_SA(1, 1), a1 + hstep, voffA);
            PG8_WAIT_L(8); PG8_BAR; PG8_WAIT_L(0); PG8_MMA(0, 0, At, B0); PG8_BAR; PG8_SCHED;
            PG8_LDB(B1, 0, 1); PG8_STAGE(PG8_SB(0, 0), b2, voffB);
            PG8_BAR; PG8_WAIT_L(0); PG8_MMA(0, 1, At, B1); PG8_BAR;
            PG8_LDA(At, 0, 1); PG8_STAGE(PG8_SA(0, 0), a2, voffA);
            PG8_BAR; PG8_WAIT_L(0); PG8_MMA(1, 0, At, B0); PG8_BAR; PG8_SCHED;
            PG8_STAGE(PG8_SB(0, 1), b2 + hstep, voffB);
            PG8_WAIT_V(6); PG8_BAR; PG8_MMA(1, 1, At, B1); PG8_BAR;
            PG8_LDB(B0, 1, 0); PG8_SCHED; PG8_LDA(At, 1, 0); PG8_STAGE(PG8_SA(0, 1), a2 + hstep, voffA);
            PG8_WAIT_L(8); PG8_BAR; PG8_WAIT_L(0); PG8_MMA(0, 0, At, B0); PG8_BAR; PG8_SCHED;
            PG8_LDB(B1, 1, 1); PG8_STAGE(PG8_SB(1, 0), b3, voffB);
            PG8_BAR; PG8_WAIT_L(0); PG8_MMA(0, 1, At, B1); PG8_BAR;
            PG8_LDA(At, 1, 1); PG8_STAGE(PG8_SA(1, 0), a3, voffA);
            PG8_BAR; PG8_WAIT_L(0); PG8_MMA(1, 0, At, B0); PG8_BAR; PG8_SCHED;
            PG8_STAGE(PG8_SB(1, 1), b3 + hstep, voffB);
            PG8_WAIT_V(6); PG8_BAR; PG8_MMA(1, 1, At, B1); PG8_BAR;
            }
        }
        if constexpr (ALIGN_EPI) { if (wr == 0) PG8_BAR; }
        if constexpr (!Epi::AFTER_DRAIN) { if (Sched::SPLIT && cur.kind == 1) S.put_partial(acc, tid, lane); else { E(acc, cur, wr, wc, fr, fq);
#if EPI_TWICE
            if (Epi::TWICE_OK) { asm volatile("" ::: "memory"); E(acc, cur, wr, wc, fr, fq); }
#endif
            } S.done(cur); }
        if (!has_next) break;
        if (Sched::SPLIT && nxt.kind == 2) S.load_partial(acc, tid, lane);
        else {
#pragma unroll
        for (int a = 0; a < 2; ++a)
#pragma unroll
            for (int b = 0; b < 2; ++b)
#pragma unroll
                for (int m = 0; m < 4; ++m)
#pragma unroll
                    for (int n = 0; n < 2; ++n) acc[a][b][m][n] = (f32x4){0.f, 0.f, 0.f, 0.f};
        }
        cur = nxt; cA = nA; cB = nB; ++ui;
        if constexpr (ALIGN_EPI) { if (wr == 1) PG8_BAR; }
    }
    PG8_WAIT_V(0);
    if constexpr (!ALIGN_EPI) { if (wr == 0) PG8_BAR; }
    PG8_BAR;
    if constexpr (Epi::AFTER_DRAIN) { E.fused(acc, cur, wr, wc, fr, fq, lds, wid, lane); S.done(cur); }
#undef PG8_SA
#undef PG8_SB
#undef PG8_STAGE
#undef PG8_LDA
#undef PG8_LDB
#undef PG8_MMA
#undef PG8_WAIT_V
#undef PG8_WAIT_L
#undef PG8_BAR
#undef PG8_SCHED
}
}

constexpr size_t MiB = 1u << 20;
constexpr size_t WS_CTL = 0, CTL_ZERO_BYTES = 64 * 1024;
constexpr size_t WS_W1GU = 1 * MiB, WS_W1D = 12 * MiB, WS_W2GU = 18 * MiB, WS_W2D = 29 * MiB, WS_WIN = 35 * MiB, WS_WOUT = 40 * MiB;
constexpr size_t WS_GATEW = 42 * MiB;
constexpr size_t WS_SP8 = WS_GATEW + 256 * 1024;
constexpr size_t WS_RSTD0 = 43 * MiB;
constexpr size_t WS_SSQ1 = 44 * MiB, WS_SSQ2 = 47 * MiB;
constexpr size_t WS_LSUM = 50 * MiB;
constexpr size_t WS_XB = 53 * MiB;
constexpr size_t WS_H = 121 * MiB;
constexpr size_t WS_Q = WS_H, WS_KVP = WS_H + 34 * MiB, WS_KVS = WS_H + 98 * MiB, WS_XR = WS_H + 102 * MiB, WS_XG = WS_H + 136 * MiB;
constexpr size_t WS_CAT = 308 * MiB;
constexpr size_t WS_CK = 376 * MiB, WS_CV = 440 * MiB;
constexpr size_t WS_END = 504 * MiB;
static_assert(OFF_SSQ1 == WS_SSQ1 && OFF_Q == WS_Q && OFF_KVP == WS_KVP && OFF_KVS == WS_KVS && OFF_XR == WS_XR && OFF_XG == WS_XG, "epilogue offsets");
static_assert(WS_H + (size_t)TT * FF * 2 <= WS_CAT && WS_XB + (size_t)TT * DM * 2 <= WS_H && WS_XG + (size_t)TT * 512 * 2 <= WS_CAT, "d_ws map");
constexpr int CW_BAR = 1024;
constexpr int CW_SK = 12288;
constexpr int CW_QUEUE = 8192;

constexpr int RING_BYTES = 131072;
constexpr int MISC_OFF = RING_BYTES;
constexpr int LDS_BYTES = 147456;

#define GAS __attribute__((address_space(1)))
#define LAS __attribute__((address_space(3)))
typedef unsigned short bf16;
typedef unsigned v4u __attribute__((ext_vector_type(4)));
typedef unsigned v2u __attribute__((ext_vector_type(2)));
typedef float f32x4 __attribute__((ext_vector_type(4)));
typedef float f32x16 __attribute__((ext_vector_type(16)));
typedef short bf16x8 __attribute__((ext_vector_type(8)));
typedef short s16x4 __attribute__((ext_vector_type(4)));
#define LDS_WAIT() asm volatile("s_waitcnt lgkmcnt(0)" ::: "memory")
#define VM_WAIT() asm volatile("s_waitcnt vmcnt(0)" ::: "memory")
__device__ __forceinline__ unsigned f2bf(float f) { unsigned u = __builtin_bit_cast(unsigned, f); return (u + 0x7fffu + ((u >> 16) & 1u)) >> 16; }
__device__ __forceinline__ unsigned pk2(float lo, float hi) { return f2bf(lo) | (f2bf(hi) << 16); }
__device__ __forceinline__ float bf2f(unsigned short b) { return __builtin_bit_cast(float, (unsigned)b << 16); }
__device__ __forceinline__ float bflo(unsigned w) { return __builtin_bit_cast(float, w << 16); }
__device__ __forceinline__ float bfhi(unsigned w) { return __builtin_bit_cast(float, w & 0xffff0000u); }
__device__ __forceinline__ float wave_sum(float v) {
#pragma unroll
    for (int o = 1; o < 64; o <<= 1) v += __shfl_xor(v, o);
    return v;
}

#define XB_TMO      128
#define XB_XCNT(j)  (256  + 64 * (j))
#define XB_XSUB(j)  (1280 + 64 * (j))
#define XB_XGEN(j)  (2304 + 64 * (j))
#define XB_TOP      3328
#define XB_TOPGEN   3392
#define XCD_BAR_WORDS 3456
#define XB_SPIN_CAP (1u << 18)

__device__ __forceinline__ unsigned xb_ld(unsigned* p)              { return __hip_atomic_load(p, __ATOMIC_RELAXED, __HIP_MEMORY_SCOPE_AGENT); }
__device__ __forceinline__ unsigned xb_add(unsigned* p, unsigned v) { return __hip_atomic_fetch_add(p, v, __ATOMIC_RELAXED, __HIP_MEMORY_SCOPE_AGENT); }
__device__ __forceinline__ unsigned xb_xcc_id() { return (unsigned)__builtin_amdgcn_s_getreg((3 << 11) | 20) & 0xFu; }
#define XB_SPIN(cond, bar) do { unsigned _sp = 0; while (cond) { __builtin_amdgcn_s_sleep(1); \
    if ((++_sp & 255u) == 0u) { if (xb_ld(&(bar)[XB_TMO])) break; if (_sp > XB_SPIN_CAP) { atomicAdd(&(bar)[XB_TMO], 1u); break; } } } } while (0)

struct XcdBarrier {
    unsigned* bar; unsigned x;
    volatile LAS unsigned* st;
};

__device__ __forceinline__ XcdBarrier xcd_barrier_post(unsigned* bar, volatile LAS unsigned* st) {
    XcdBarrier b; b.bar = bar; b.x = xb_xcc_id(); b.st = st;
    if (threadIdx.x == 0) (void)xb_add(&bar[XB_XCNT(b.x)], 1u);
    return b;
}
__device__ __forceinline__ void xcd_barrier_complete(unsigned* bar, unsigned x, unsigned& nloc, unsigned& nx) {
    const unsigned G = gridDim.x * gridDim.y * gridDim.z;
    unsigned sum, cnt, mine, sp = 0u;
    for (;;) {
        sum = 0u; cnt = 0u; mine = 0u;
#pragma unroll
        for (unsigned j = 0; j < 16; ++j) { const unsigned c = xb_ld(&bar[XB_XCNT(j)]); sum += c; cnt += (c > 0u) ? 1u : 0u; mine = (j == x) ? c : mine; }
        if (sum == G) break;
        __builtin_amdgcn_s_sleep(1);
        if ((++sp & 255u) == 0u) { if (xb_ld(&bar[XB_TMO])) break; if (sp > XB_SPIN_CAP) { atomicAdd(&bar[XB_TMO], 1u); break; } }
    }
    nloc = mine > 0u ? mine : 1u; nx = cnt > 0u ? cnt : 1u;
}

__device__ __forceinline__ void xcd_barrier(const XcdBarrier& b) {
    asm volatile("s_waitcnt vmcnt(0)" ::: "memory");
    __syncthreads();
    if (threadIdx.x == 0) {
        unsigned* bar = b.bar;
        __builtin_amdgcn_s_waitcnt(0);
        unsigned nloc = b.st[0], nx = b.st[1];
        if (nloc == 0u) { xcd_barrier_complete(bar, b.x, nloc, nx); b.st[0] = nloc; b.st[1] = nx; }
        const unsigned old = xb_add(&bar[XB_XSUB(b.x)], 1u);
        const unsigned gen = old / nloc;
        if (old + 1u == (gen + 1u) * nloc) {
            __builtin_amdgcn_fence(__ATOMIC_RELEASE, "agent");
            asm volatile("s_waitcnt vmcnt(0)" ::: "memory");
            const unsigned og = xb_add(&bar[XB_TOP], 1u);
            const unsigned tg = og / nx;
            if (og + 1u == (tg + 1u) * nx) xb_add(&bar[XB_TOPGEN], 1u);
            else XB_SPIN(xb_ld(&bar[XB_TOPGEN]) == tg, bar);
            __builtin_amdgcn_fence(__ATOMIC_ACQUIRE, "agent");
            xb_add(&bar[XB_XGEN(b.x)], 1u);
            asm volatile("s_waitcnt vmcnt(0)" ::: "memory");
        } else {
            XB_SPIN(xb_ld(&bar[XB_XGEN(b.x)]) == gen, bar);
            __builtin_amdgcn_fence(__ATOMIC_ACQUIRE, "agent");
            asm volatile("s_waitcnt vmcnt(0)" ::: "memory");
        }
    }
    __syncthreads();
}

typedef __attribute__((address_space(4))) const unsigned char* kptr_t;
struct Frame {
    LAS unsigned char* lds;
    int tid, lane, wave, G, bx;
    kptr_t ka; int z;
    float* out; unsigned char* ws;
};
__device__ __forceinline__ const float* fin(const Frame& F, int k) { typedef const float* cfp; return *(const __attribute__((address_space(4))) cfp*)(F.ka + (k * 8 + F.z)); }
#define NEW_PHASE() do { int z_ = 0; asm volatile("" : "+s"(z_)); F.z = z_; } while (0)

__device__ __forceinline__ void p0_transpose_item(const float* W, int K, int N, bf16* WT, int kb, int n0, int drow0, const float* gain, LAS float* scr, int lane) {
    const int k0 = 64 * kb;
#pragma unroll 8
    for (int i = 0; i < 32; ++i) { const int kk = 2 * i + (lane >> 5); float w = W[(size_t)(k0 + kk) * N + n0 + (lane & 31)]; if (gain) w *= gain[k0 + kk]; scr[kk * 33 + (lane & 31)] = w; }
    LDS_WAIT(); asm volatile("" ::: "memory");
    const int c = lane & 7;
#pragma unroll
    for (int j = 0; j < 4; ++j) { const int n = (lane >> 3) + 8 * j; const LAS float* s = scr + (8 * c) * 33 + n;
        v4u o; o.x = pk2(s[0 * 33], s[1 * 33]); o.y = pk2(s[2 * 33], s[3 * 33]); o.z = pk2(s[4 * 33], s[5 * 33]); o.w = pk2(s[6 * 33], s[7 * 33]);
        *(GAS v4u*)(WT + (size_t)(drow0 + n) * K + k0 + 8 * c) = o; }
    LDS_WAIT(); asm volatile("" ::: "memory");
}
__device__ __forceinline__ void p0_prologue(Frame& F) {
    LAS float* scr = (LAS float*)(F.lds + F.wave * 16384);
    const int gw = F.bx * 8 + F.wave, NGW = F.G * 8;
    unsigned char* ws = F.ws;
    constexpr int I_GU = 16 * 88, I_DN = 44 * 32, I_IN = 16 * 80, I_OUT = 16 * 32;
    constexpr int NITEMS = 2 * (2 * I_GU + I_DN) + I_IN + I_OUT;
    constexpr int I_FFN = 2 * I_GU + I_DN;
    for (int it = gw; it < NITEMS; it += NGW) {
        int r = it;
        if (r < 2 * I_FFN) {
            const int f = r >= I_FFN; r -= f * I_FFN;
            const float* Wg = f == 0 ? fin(F, 8) : fin(F, 30); const float* Wu = f == 0 ? fin(F, 9) : fin(F, 31); const float* Wd = f == 0 ? fin(F, 10) : fin(F, 32); const float* gn = f == 0 ? fin(F, 7) : fin(F, 29);
            bf16* GU = (bf16*)(ws + (f == 0 ? WS_W1GU : WS_W2GU)); bf16* DN = (bf16*)(ws + (f == 0 ? WS_W1D : WS_W2D));
            if (r < 2 * I_GU) { const int up = r >= I_GU; const int q = up ? r - I_GU : r; const int kb = q / 88, nb = q % 88, n0 = 32 * nb;
                p0_transpose_item(up ? Wu : Wg, 1024, FF, GU, kb, n0, 256 * (n0 >> 7) + (n0 & 127) + (up ? 128 : 0), gn, scr, F.lane); }
            else { r -= 2 * I_GU; const int kb = r / 32, nb = r % 32; p0_transpose_item(Wd, FF, 1024, DN, kb, 32 * nb, 32 * nb, nullptr, scr, F.lane); }
            continue;
        }
        r -= 2 * I_FFN;
        if (r < I_IN) { const int kb = r / 80, nb = r % 80, n0 = 32 * nb; int dr = n0;
            if (n0 < 1024) { const int oc = n0 & 255, wc = oc >> 6, bj = (oc >> 5) & 1; dr = (n0 & ~255) + 128 * bj + 32 * wc; }
            p0_transpose_item(fin(F, 12), 1024, INW, (bf16*)(ws + WS_WIN), kb, n0, dr, fin(F, 11), scr, F.lane); continue; }
        r -= I_IN;
        { const int kb = r / 32, nb = r % 32; p0_transpose_item(fin(F, 28), 1024, 1024, (bf16*)(ws + WS_WOUT), kb, 32 * nb, 32 * nb, nullptr, scr, F.lane); }
    }
    {   bf16* XB = (bf16*)(ws + WS_XB); float* rstd0 = (float*)(ws + WS_RSTD0);
        for (int m = gw; m < TT; m += NGW) {
            const float* xrow = m < TP ? fin(F, 0) + (size_t)m * DM : fin(F, 1) + (size_t)(m - TP) * DM;
            const GAS f32x4* xr = (const GAS f32x4*)xrow + F.lane;
            f32x4 v[4]; float s = 0.f;
#pragma unroll
            for (int j = 0; j < 4; ++j) { v[j] = xr[64 * j]; s += (v[j].x * v[j].x + v[j].y * v[j].y) + (v[j].z * v[j].z + v[j].w * v[j].w); }
            s = wave_sum(s);
            if (F.lane == 0) rstd0[m] = __builtin_amdgcn_rsqf(s * (1.0f / DM) + EPS);
            GAS unsigned long long* o8 = (GAS unsigned long long*)(XB + (size_t)m * DM) + F.lane;
#pragma unroll
            for (int j = 0; j < 4; ++j) o8[64 * j] = (unsigned long long)pk2(v[j].x, v[j].y) | ((unsigned long long)pk2(v[j].z, v[j].w) << 32);
        }
    }
    {   const unsigned gt = (unsigned)F.bx * 512u + (unsigned)F.tid, NTH = (unsigned)F.G * 512u;
        unsigned char* CI = ws + WS_CK;
        const float* ck = fin(F, 2); const float* cv = fin(F, 3);
        for (unsigned w = gt; w < (1u << 22); w += NTH) {
            const unsigned jl = w & 3, kk = (w >> 2) & 15, jh = (w >> 6) & 1, kh = (w >> 7) & 3, c = (w >> 9) & 1, t = (w >> 10) & 31, h = (w >> 15) & 3, sb = w >> 17;
            const unsigned key = kh * 16 + kk, j = jh * 4 + jl, pos = t * 64 + key;
            const GAS f32x4* src = (const GAS f32x4*)(ck + ((((size_t)sb * PAST + pos) * 4 + h) * 2 + c) * 64 + j * 8);
            const f32x4 a = __builtin_nontemporal_load(src), bq = __builtin_nontemporal_load(src + 1);
            v4u o; o.x = pk2(a.x, a.y); o.y = pk2(a.z, a.w); o.z = pk2(bq.x, bq.y); o.w = pk2(bq.z, bq.w);
            *(GAS v4u*)(CI + ((size_t)((sb * 4 + h) * 32 + t)) * 32768 + c * 8192 + j * 1024 + key * 16) = o; }
        for (unsigned w = gt; w < (1u << 22); w += NTH) {
            const unsigned ch = w & 3, kk = (w >> 2) & 15, db = (w >> 6) & 3, kh = (w >> 8) & 3, t = (w >> 10) & 31, h = (w >> 15) & 3, sb = w >> 17;
            const unsigned key = kh * 16 + kk, pos = t * 64 + key;
            const GAS f32x4* src = (const GAS f32x4*)(cv + (((size_t)sb * PAST + pos) * 4 + h) * 128 + db * 32 + ch * 8);
            const f32x4 a = __builtin_nontemporal_load(src), bq = __builtin_nontemporal_load(src + 1);
            v4u o; o.x = pk2(a.x, a.y); o.y = pk2(a.z, a.w); o.z = pk2(bq.x, bq.y); o.w = pk2(bq.z, bq.w);
            *(GAS v4u*)(CI + ((size_t)((sb * 4 + h) * 32 + t)) * 32768 + 16384 + db * 4096 + key * 64 + ch * 16) = o; }
    }
    {   bf16* GW = (bf16*)(ws + WS_GATEW); float* sp8 = (float*)(ws + WS_SP8);
        const int gt = F.bx * 512 + F.tid, NT = F.G * 512;
        for (int i = gt; i < 2 * 8 * 64 * 64; i += NT) { const int g = i >> 15, n = (i >> 12) & 7, j = (i >> 6) & 63, c = i & 63;
            GW[i] = (bf16)f2bf((g == 0 ? fin(F, 22) : fin(F, 24))[(n * 64 + c) * 64 + j]); }
        for (int i = gt; i < 512; i += NT) { const float L = fin(F, 26)[i]; sp8[i] = 8.0f * (L > 20.f ? __expf(-L) : log1pf(__expf(-L))); }
    }
}

namespace lru {
constexpr int L_XC = 0;
constexpr int L_HIN = 65536;
constexpr int L_PART = 65536 + 2048;
constexpr int L_O0 = 65536 + 4096;
__device__ __forceinline__ int crow(int r, int hi) { return (r & 3) + 8 * (r >> 2) + 4 * hi; }
__device__ __forceinline__ float sigmoid_f(float x) { return __builtin_amdgcn_rcpf(1.0f + __builtin_amdgcn_exp2f(-x * LOG2E)); }

template <int CTRL, int RM> __device__ __forceinline__ float dpp_f(float oldv, float src) {
    return __builtin_bit_cast(float, __builtin_amdgcn_update_dpp(__builtin_bit_cast(int, oldv), __builtin_bit_cast(int, src), CTRL, RM, 0xF, false)); }
#define LRU_SCAN_STEP(CTRL, RM) do { const float ap_ = dpp_f<CTRL, RM>(1.0f, a), bp_ = dpp_f<CTRL, RM>(0.0f, b); b = a * bp_ + b; a = a * ap_; } while (0)
__device__ __forceinline__ float rl_half(float v, int hi) {
    return __builtin_bit_cast(float, __builtin_amdgcn_ds_bpermute((hi * 32 + 31) * 4, __builtin_bit_cast(int, v))); }
template <int PASS> __device__ __forceinline__ void lru_unit(Frame& F, int u) {
    int tid_ = F.tid; asm volatile("" : "+v"(tid_));
    const int tid = tid_, lane = tid & 63, wid = F.wave, r32 = lane & 31, hi = lane >> 5;
    const bool smp = u >= 512; const int sb = u - 512, pb = u >> 7, ck = smp ? 0 : (u & 127);
    const int row0 = smp ? TP + sb * 64 : pb * SEQ + ck * 64;
    const bf16* XR = (const bf16*)(F.ws + WS_XR); const bf16* XG = (const bf16*)(F.ws + WS_XG);
    LAS unsigned char* lds = F.lds;
    {   const int cg = tid & 63, tg = tid >> 6, c0 = 8 * cg;
        float xw[11][8];
#pragma unroll
        for (int i = 0; i < 11; ++i) { const int tt = 8 * tg + i - 3;
            if (tt >= 0 || ck > 0) { const v4u w = *(const GAS v4u*)(XR + (size_t)(row0 + tt) * 512 + c0);
                xw[i][0] = bflo(w.x); xw[i][1] = bfhi(w.x); xw[i][2] = bflo(w.y); xw[i][3] = bfhi(w.y); xw[i][4] = bflo(w.z); xw[i][5] = bfhi(w.z); xw[i][6] = bflo(w.w); xw[i][7] = bfhi(w.w); }
            else if (smp) { const float* sc = fin(F, 5) + (size_t)(sb * 3 + (tt + 3)) * 512 + c0; const f32x4 a = *(const f32x4*)sc, b = *(const f32x4*)(sc + 4);
                xw[i][0] = a[0]; xw[i][1] = a[1]; xw[i][2] = a[2]; xw[i][3] = a[3]; xw[i][4] = b[0]; xw[i][5] = b[1]; xw[i][6] = b[2]; xw[i][7] = b[3]; }
            else {
#pragma unroll
                for (int e = 0; e < 8; ++e) xw[i][e] = 0.f; } }
        float cw[4][8], cb[8];
#pragma unroll
        for (int j = 0; j < 4; ++j) { const f32x4 a = *(const f32x4*)(fin(F, 20) + j * 512 + c0), b = *(const f32x4*)(fin(F, 20) + j * 512 + c0 + 4);
            cw[j][0] = a[0]; cw[j][1] = a[1]; cw[j][2] = a[2]; cw[j][3] = a[3]; cw[j][4] = b[0]; cw[j][5] = b[1]; cw[j][6] = b[2]; cw[j][7] = b[3]; }
        { const f32x4 a = *(const f32x4*)(fin(F, 21) + c0), b = *(const f32x4*)(fin(F, 21) + c0 + 4); cb[0] = a[0]; cb[1] = a[1]; cb[2] = a[2]; cb[3] = a[3]; cb[4] = b[0]; cb[5] = b[1]; cb[6] = b[2]; cb[7] = b[3]; }
#pragma unroll
        for (int i = 0; i < 8; ++i) { const int t = 8 * tg + i; float xc[8];
#pragma unroll
            for (int e = 0; e < 8; ++e) xc[e] = cb[e] + cw[0][e] * xw[i][e] + cw[1][e] * xw[i + 1][e] + cw[2][e] * xw[i + 2][e] + cw[3][e] * xw[i + 3][e];
            v4u o; o.x = pk2(xc[0], xc[1]); o.y = pk2(xc[2], xc[3]); o.z = pk2(xc[4], xc[5]); o.w = pk2(xc[6], xc[7]);
            *(LAS v4u*)(lds + L_XC + t * 1024 + ((cg ^ (t & 15)) << 4)) = o; }
    }
    if (PASS == 2) {
        float h = 0.f;
        if (smp) h = fin(F, 4)[sb * 512 + tid];
        else { const float* S = (const float*)(F.ws + WS_LSUM) + ((size_t)(pb * 128) * 512 + tid) * 2;
            int c = 0;
            for (; c + 8 <= ck; c += 8) { float2 v[8];
#pragma unroll
                for (int k = 0; k < 8; ++k) v[k] = *(const float2*)(S + (size_t)(c + k) * 1024);
#pragma unroll
                for (int k = 0; k < 8; ++k) h = v[k].x * h + v[k].y; }
            for (; c < ck; ++c) { const float2 v = *(const float2*)(S + (size_t)c * 1024); h = v.x * h + v.y; } }
        ((LAS float*)(lds + L_HIN))[tid] = h;
    }
    LDS_WAIT(); __syncthreads();
    const int n = wid;
    const bf16* GW = (const bf16*)(F.ws + WS_GATEW);
    const float* sp8 = (const float*)(F.ws + WS_SP8);
    float ssq_t[2] = {0.f, 0.f};
    float outv[2][16];
#pragma unroll
    for (int jb = 0; jb < 2; ++jb) {
        f32x16 accr[2], acci[2];
#pragma unroll
        for (int tb = 0; tb < 2; ++tb) { accr[tb] = f32x16{}; acci[tb] = f32x16{}; }
#pragma unroll
        for (int ks = 0; ks < 4; ++ks) {
            const bf16x8 ar = *(const GAS bf16x8*)(GW + ((size_t)((0 * 8 + n) * 64 + jb * 32 + r32) * 64 + ks * 16 + hi * 8));
            const bf16x8 ax = *(const GAS bf16x8*)(GW + ((size_t)((1 * 8 + n) * 64 + jb * 32 + r32) * 64 + ks * 16 + hi * 8));
#pragma unroll
            for (int tb = 0; tb < 2; ++tb) { const int t = tb * 32 + r32; const int chunk = 8 * n + 2 * ks + hi;
                const bf16x8 bfr = *(const LAS bf16x8*)(lds + L_XC + t * 1024 + ((chunk ^ (t & 15)) << 4));
                accr[tb] = __builtin_amdgcn_mfma_f32_32x32x16_bf16(ar, bfr, accr[tb], 0, 0, 0);
                acci[tb] = __builtin_amdgcn_mfma_f32_32x32x16_bf16(ax, bfr, acci[tb], 0, 0, 0); }
        }
        float av[2][16], bv[2][16];
#pragma unroll
        for (int q4 = 0; q4 < 4; ++q4) {
            const int chb = 64 * n + 32 * jb + 8 * q4 + 4 * hi;
            const f32x4 ba = *(const f32x4*)(fin(F, 23) + chb), bx = *(const f32x4*)(fin(F, 25) + chb), sp = *(const f32x4*)(sp8 + chb);
#pragma unroll
            for (int tb = 0; tb < 2; ++tb) { const int t = tb * 32 + r32;
                const v2u xw = *(const LAS v2u*)(lds + L_XC + t * 1024 + ((((chb >> 3) ^ (t & 15)) << 4) | ((chb & 7) << 1)));
                const float xc[4] = {bflo(xw.x), bfhi(xw.x), bflo(xw.y), bfhi(xw.y)};
#pragma unroll
                for (int e = 0; e < 4; ++e) { const int r = 4 * q4 + e;
                    const float rg = sigmoid_f(accr[tb][r] + ba[e]), ig = sigmoid_f(acci[tb][r] + bx[e]);
                    const float a = __builtin_amdgcn_exp2f(-rg * sp[e] * LOG2E);
                    av[tb][r] = a; bv[tb][r] = __builtin_amdgcn_sqrtf(fmaxf(1.0f - a * a, 0.f)) * (ig * xc[e]); } }
        }
#pragma unroll
        for (int r = 0; r < 16; ++r) {
#pragma unroll
            for (int tb = 0; tb < 2; ++tb) {
                float a = av[tb][r], b = bv[tb][r];
                LRU_SCAN_STEP(0x111, 0xF); LRU_SCAN_STEP(0x112, 0xF); LRU_SCAN_STEP(0x114, 0xF); LRU_SCAN_STEP(0x118, 0xF);
                LRU_SCAN_STEP(0x142, 0xA);
                av[tb][r] = a; bv[tb][r] = b; }
            const float A0 = rl_half(av[0][r], hi), B0 = rl_half(bv[0][r], hi);
            bv[1][r] = av[1][r] * B0 + bv[1][r]; av[1][r] = av[1][r] * A0;
        }
        if (PASS == 1) {
            if (r32 == 31) { float* S = (float*)(F.ws + WS_LSUM) + (size_t)u * 1024;
#pragma unroll
                for (int r = 0; r < 16; ++r) { const int ch = 64 * n + 32 * jb + crow(r, hi); *(float2*)(S + 2 * ch) = make_float2(av[1][r], bv[1][r]); } }
        } else {
#pragma unroll
            for (int q4 = 0; q4 < 4; ++q4) { const int chb = 64 * n + 32 * jb + 8 * q4 + 4 * hi;
                const f32x4 hin = *(const LAS f32x4*)(lds + L_HIN + chb * 4);
#pragma unroll
                for (int tb = 0; tb < 2; ++tb) { const int t = tb * 32 + r32;
                    const v2u gw = *(const GAS v2u*)(XG + (size_t)(row0 + t) * 512 + chb);
                    const float xg[4] = {bflo(gw.x), bfhi(gw.x), bflo(gw.y), bfhi(gw.y)};
#pragma unroll
                    for (int e = 0; e < 4; ++e) { const int r = 4 * q4 + e; const float h = av[tb][r] * hin[e] + bv[tb][r];
                        const float x = xg[e], uu = 0.7978845608028654f * (x + 0.044715f * x * x * x);
                        const float ge = x * __builtin_amdgcn_rcpf(1.0f + __builtin_amdgcn_exp2f(-2.0f * LOG2E * uu));
                        const float o = h * ge; ssq_t[tb] += o * o;
                        if (jb == 0) ((LAS float*)(lds + L_O0))[(wid * 32 + tb * 16 + r) * 64 + lane] = o; else outv[tb][r] = o;
                        if (tb == 1 && r32 == 31 && (smp || ck == 127)) { float* dst = smp ? F.out + O_LS + sb * 512 : F.out + O_LP + pb * 512; dst[chb + e] = h; } } } }
        }
        __builtin_amdgcn_sched_barrier(0);
    }
    if (PASS == 2) {
        LAS float* part = (LAS float*)(lds + L_PART);
#pragma unroll
        for (int tb = 0; tb < 2; ++tb) { float s = ssq_t[tb]; s += __shfl_xor(s, 32); if (hi == 0) part[wid * 64 + tb * 32 + r32] = s; }
        LDS_WAIT(); __syncthreads();
        bf16* CAT = (bf16*)(F.ws + WS_CAT);
#pragma unroll
        for (int tb = 0; tb < 2; ++tb) { const int t = tb * 32 + r32; float tot = 0.f;
#pragma unroll
            for (int w = 0; w < 8; ++w) tot += part[w * 64 + t];
            const float rn = __builtin_amdgcn_rsqf(tot * (1.0f / 512.0f) + EPS);
#pragma unroll
            for (int jb = 0; jb < 2; ++jb)
#pragma unroll
                for (int q4 = 0; q4 < 4; ++q4) { const int chb = 64 * n + 32 * jb + 8 * q4 + 4 * hi; const f32x4 gn = *(const f32x4*)(fin(F, 27) + chb);
                    float ov[4];
#pragma unroll
                    for (int e = 0; e < 4; ++e) ov[e] = jb == 0 ? ((const LAS float*)(lds + L_O0))[(wid * 32 + tb * 16 + 4 * q4 + e) * 64 + lane] : outv[tb][4 * q4 + e];
                    v2u o; o.x = pk2(ov[0] * rn * gn[0], ov[1] * rn * gn[1]); o.y = pk2(ov[2] * rn * gn[2], ov[3] * rn * gn[3]);
                    *(GAS v2u*)(CAT + (size_t)(row0 + t) * 1024 + 512 + chb) = o; } }
    }
    LDS_WAIT(); __syncthreads();
}
}

#ifndef ATT_PROBE
#define ATT_PROBE 0
#endif
namespace att {
constexpr int SLOT = 32768, NSLOT = 4;
constexpr int A_RING = 0;
constexpr int A_EX = 0;
constexpr int A_TAB = 131072;
constexpr int A_WSF = 131072 + 1024;
constexpr int A_MISC = 143360;
__device__ __forceinline__ int crow(int r, int hi) { return (r & 3) + 8 * (r >> 2) + 4 * hi; }
__device__ __forceinline__ void glds16(const void* gsrc, unsigned lds_dst) { unsigned keep;
    asm volatile("s_mov_b32 %0, m0\n\ts_mov_b32 m0, %2\n\ts_nop 0\n\tglobal_load_lds_dwordx4 %1, off\n\ts_mov_b32 m0, %0" : "=&s"(keep) : "v"(gsrc), "s"(lds_dst) : "memory"); }
typedef __attribute__((address_space(3))) const char* lds_cptr;
typedef short v4i16_t __attribute__((ext_vector_type(4)));
__device__ __forceinline__ s16x4 vtr(lds_cptr p) { return __builtin_bit_cast(s16x4, __builtin_amdgcn_ds_read_tr16_b64_v4i16((__attribute__((address_space(3))) v4i16_t*)p)); }
__device__ __forceinline__ unsigned cvtpk(float lo, float hi) { typedef float f2 __attribute__((ext_vector_type(2))); typedef __bf16 b2 __attribute__((ext_vector_type(2)));
    f2 v = {lo, hi}; b2 b = __builtin_convertvector(v, b2); return __builtin_bit_cast(unsigned, b); }
#define ATT_WAIT_BAR(N) asm volatile("s_waitcnt vmcnt(" #N ") lgkmcnt(0)\n\ts_barrier" ::: "memory")

template <bool SMP, bool DESC> __device__ __forceinline__ void attn_unit(Frame& F, int sidx, int h, int qb, float lam) {
    int tid_ = F.tid; asm volatile("" : "+v"(tid_));
    const int tid = tid_, lane = tid & 63, wid = F.wave, r32 = lane & 31, hi = lane >> 5;
    const int comp = wid >> 2, g = wid & 3;
    LAS unsigned char* lds = F.lds;
    const unsigned lds0 = (unsigned)(uintptr_t)lds;
    const bf16* Qb = (const bf16*)(F.ws + WS_Q);
    const int qrow0 = SMP ? TP + sidx * 64 : sidx * SEQ + qb * 128;
    const int qpos0 = SMP ? PAST : qb * 128;
    const int NT = SMP ? 33 : 2 * qb + 2;
    const bool active = SMP ? (g < 2) : true;
    const int gq = SMP ? (g & 1) : g;
    const int qw = qpos0 + 32 * gq;
    const int t_last = active ? (qw >> 6) : -1;
    const int t_near0 = (qw - 90) > 0 ? ((qw - 90) >> 6) : 0;
    if (tid < 256) { float v = 0.f;
        if (tid >= 97 && tid <= 250) { const int delta = tid - 187; const int rel = delta < 0 ? -delta : delta; int bk;
            if (rel < 8) bk = rel; else { bk = 2 + (31 - __builtin_clz((unsigned)(rel * rel))); bk = bk > 15 ? 15 : bk; }
            if (delta > 0) bk += 16;
            v = (fin(F, 6)[bk * 4 + h] - fin(F, 6)[15 * 4 + h]) * LOG2E; }
        ((LAS float*)(lds + A_TAB))[tid] = v; }
    const unsigned char* img0 = SMP ? F.ws + WS_CK + (size_t)((sidx * 4 + h) * 32) * 32768 : F.ws + WS_KVP + (size_t)((sidx * 4 + h) * 128) * 32768;
    const unsigned char* imgn = F.ws + WS_KVS + (size_t)(sidx * 4 + h) * 32768;
    const unsigned poff = (unsigned)(wid * 1024 + lane * 16);
    const unsigned pdst = lds0 + A_RING + wid * 1024;
#define ATT_TILE(i) (DESC ? NT - 1 - (i) : (i))
#define ATT_ISSUE(i) do { const int i_ = (i); const int t_ = ATT_TILE(i_); const unsigned so_ = (unsigned)((i_ % NSLOT) * SLOT); \
        const unsigned char* src_ = ((SMP && t_ == 32) ? imgn : img0 + (size_t)t_ * 32768) + poff; \
        glds16(src_, (unsigned)__builtin_amdgcn_readfirstlane(pdst + so_)); \
        glds16(src_ + 8192, (unsigned)__builtin_amdgcn_readfirstlane(pdst + so_ + 8192)); \
        glds16(src_ + 16384, (unsigned)__builtin_amdgcn_readfirstlane(pdst + so_ + 16384)); \
        glds16(src_ + 24576, (unsigned)__builtin_amdgcn_readfirstlane(pdst + so_ + 24576)); } while (0)
    bf16x8 qr[4];
    { const bf16* Qw = Qb + (size_t)(qrow0 + 32 * gq + r32) * 512 + h * 128 + comp * 64;
#pragma unroll
      for (int d0 = 0; d0 < 4; ++d0) qr[d0] = *(const GAS bf16x8*)(Qw + d0 * 16 + hi * 8); }
    VM_WAIT();
    asm volatile("" : "+v"(qr[0]), "+v"(qr[1]), "+v"(qr[2]), "+v"(qr[3]));
#ifdef ATT_PRIO
    if (comp == ATT_PRIO - 1) __builtin_amdgcn_s_setprio(1);
#endif
    ATT_ISSUE(0); if (NT > 1) ATT_ISSUE(1);
    f32x16 o[4]; o[0] = f32x16{}; o[1] = f32x16{}; o[2] = f32x16{}; o[3] = f32x16{};
    float lsum = 0.f;
    const lds_cptr l3 = (lds_cptr)lds;
    const int kfo = A_RING + comp * 8192 + hi * 1024 + r32 * 16;
    const int vfo = A_RING + 16384 + ((lane >> 4) & 1) * 32 + (lane & 3) * 8 + (4 * hi + ((lane & 15) >> 2)) * 64;
    const int qposl = qw + r32;
    v4u pw[4]; bool have_p = false;
    int so_prev = 0;
#define ATT_VRD(j) do { vlo[j] = vtr(vp + ((j) >> 2) * 4096 + ((j) & 3) * 1024); vhi[j] = vtr(vp + ((j) >> 2) * 4096 + ((j) & 3) * 1024 + 512); } while (0)
#define ATT_VFR(j) (bf16x8){vlo[j][0], vlo[j][1], vlo[j][2], vlo[j][3], vhi[j][0], vhi[j][1], vhi[j][2], vhi[j][3]}
#define ATT_G2(j) do { if ((j) + 3 < 16) ATT_VRD((j) + 3); \
        o[(j) >> 2] = __builtin_amdgcn_mfma_f32_32x32x16_bf16(__builtin_bit_cast(bf16x8, pw[(j) & 3]), ATT_VFR(j), o[(j) >> 2], 0, 0, 0); __builtin_amdgcn_sched_barrier(0); } while (0)
#define ATT_QKEXP(t_, so_) do { f32x16 p0, p1; \
        if ((t_) >= t_near0) { const LAS float* tb = (const LAS float*)(lds + A_TAB) + (64 * (t_) + 4 * hi - qposl + 187);     \
            _Pragma("unroll") for (int r = 0; r < 16; ++r) { p0[r] = tb[(r & 3) + 8 * (r >> 2)]; p1[r] = tb[(r & 3) + 8 * (r >> 2) + 32]; } } \
        else { p0 = f32x16{}; p1 = f32x16{}; } \
        const lds_cptr kp = l3 + kfo + (so_); \
        _Pragma("unroll") for (int d0 = 0; d0 < 4; ++d0) { \
            const bf16x8 k0 = *(const __attribute__((address_space(3))) bf16x8*)(kp + d0 * 2048); \
            const bf16x8 k1 = *(const __attribute__((address_space(3))) bf16x8*)(kp + d0 * 2048 + 512); \
            p0 = __builtin_amdgcn_mfma_f32_32x32x16_bf16(k0, qr[d0], p0, 0, 0, 0); \
            p1 = __builtin_amdgcn_mfma_f32_32x32x16_bf16(k1, qr[d0], p1, 0, 0, 0); } \
        float sacc = 0.f; \
        _Pragma("unroll") for (int r = 0; r < 16; ++r) { p0[r] = __builtin_amdgcn_exp2f(p0[r]); p1[r] = __builtin_amdgcn_exp2f(p1[r]); sacc += p0[r] + p1[r]; } \
        lsum += sacc; \
        _Pragma("unroll") for (int k = 0; k < 2; ++k) { pw[k] = (v4u){cvtpk(p0[8 * k], p0[8 * k + 1]), cvtpk(p0[8 * k + 2], p0[8 * k + 3]), cvtpk(p0[8 * k + 4], p0[8 * k + 5]), cvtpk(p0[8 * k + 6], p0[8 * k + 7])}; \
                                      pw[2 + k] = (v4u){cvtpk(p1[8 * k], p1[8 * k + 1]), cvtpk(p1[8 * k + 2], p1[8 * k + 3]), cvtpk(p1[8 * k + 4], p1[8 * k + 5]), cvtpk(p1[8 * k + 6], p1[8 * k + 7])}; } } while (0)
#define ATT_PV(so_) do { const lds_cptr vp = l3 + vfo + (so_); s16x4 vlo[16], vhi[16]; ATT_VRD(0); ATT_VRD(1); ATT_VRD(2); __builtin_amdgcn_sched_barrier(0); \
        ATT_G2(0); ATT_G2(1); ATT_G2(2); ATT_G2(3); ATT_G2(4); ATT_G2(5); ATT_G2(6); ATT_G2(7); ATT_G2(8); ATT_G2(9); ATT_G2(10); ATT_G2(11); ATT_G2(12); ATT_G2(13); ATT_G2(14); ATT_G2(15); } while (0)
#define ATT_SYNC(it_) do { if ((it_) + 1 < NT) ATT_WAIT_BAR(4); else ATT_WAIT_BAR(0);     \
        if ((it_) + 2 < NT) ATT_ISSUE((it_) + 2); } while (0)
    const bool skew = comp == 1;
    for (int it = 0; it < NT; ++it) {
        const int t = ATT_TILE(it);
        if (skew) ATT_SYNC(it);
        if (have_p) { ATT_PV(so_prev); __builtin_amdgcn_sched_barrier(0); }
        if (!skew) ATT_SYNC(it);
        const int so = (it % NSLOT) * SLOT;
        have_p = (t <= t_last);
        if (have_p) { ATT_QKEXP(t, so); so_prev = so; }
    }
    if (have_p) { ATT_PV(so_prev); }
#undef ATT_SYNC
#undef ATT_VRD
#undef ATT_VFR
#undef ATT_G2
#undef ATT_QKEXP
#undef ATT_PV
#ifdef ATT_PRIO
    __builtin_amdgcn_s_setprio(0);
#endif
    int lane_e = lane; asm volatile("" : "+v"(lane_e));
    const int r32e = lane_e & 31, hie = lane_e >> 5;
    { auto rr = __builtin_amdgcn_permlane32_swap(__float_as_uint(lsum), __float_as_uint(lsum), false, false); lsum = __uint_as_float(rr[0]) + __uint_as_float(rr[1]); }
    LAS float* wsf = (LAS float*)(lds + A_WSF) + wid * 32;
    if (hie == 0) wsf[r32e] = lsum;
    ATT_WAIT_BAR(0);
    float rli[16];
#pragma unroll
    for (int r = 0; r < 16; ++r) rli[r] = __builtin_amdgcn_rcpf(wsf[crow(r, hie)]);
    LAS float* ex = (LAS float*)(lds + A_EX) + g * 4096;
    if (comp == 1) {
#pragma unroll
        for (int db = 0; db < 4; ++db)
#pragma unroll
            for (int r = 0; r < 16; ++r) ex[crow(r, hie) * 128 + db * 32 + r32e] = o[db][r] * (rli[r] * lam);
    }
    LDS_WAIT(); __syncthreads();
    if (comp == 0 && active) {
        float ss[16];
#pragma unroll
        for (int r = 0; r < 16; ++r) ss[r] = 0.f;
#pragma unroll
        for (int db = 0; db < 4; ++db)
#pragma unroll
            for (int r = 0; r < 16; ++r) { const float v = o[db][r] * rli[r] - ex[crow(r, hie) * 128 + db * 32 + r32e]; o[db][r] = v; ss[r] += v * v; }
#pragma unroll
        for (int r = 0; r < 16; ++r) { float s = ss[r];
#pragma unroll
            for (int m = 1; m < 32; m <<= 1) s += __shfl_xor(s, m);
            ss[r] = __builtin_amdgcn_rsqf(s * (1.0f / 128.0f) + EPS) * 0.8f; }
        LDS_WAIT();
        LAS unsigned short* stg = (LAS unsigned short*)ex;
#pragma unroll
        for (int db = 0; db < 4; ++db) { const float gn = fin(F, 19)[db * 32 + r32e];
#pragma unroll
            for (int r = 0; r < 16; ++r) stg[crow(r, hie) * 128 + db * 32 + r32e] = (unsigned short)f2bf(o[db][r] * ss[r] * gn); }
        LDS_WAIT();
        bf16* CAT = (bf16*)(F.ws + WS_CAT);
#pragma unroll
        for (int i = 0; i < 8; ++i) { const int row = i * 4 + (lane_e >> 4), ch = lane_e & 15;
            const v4u v = *(const LAS v4u*)(stg + row * 128 + ch * 8);
            *(GAS v4u*)(CAT + (size_t)(qrow0 + 32 * g + row) * 1024 + h * 128 + ch * 8) = v; }
    }
    VM_WAIT(); LDS_WAIT(); __syncthreads();
#undef ATT_ISSUE
#undef ATT_TILE
}
#undef ATT_WAIT_BAR
}

__device__ __forceinline__ void phase_p0(Frame& F) {
    unsigned char* ws = F.ws; (void)ws;
#ifndef NO_P0
    p0_prologue(F);
#endif
}

__device__ __forceinline__ void phase_g1(Frame& F) {
    unsigned char* ws = F.ws; (void)ws;
#ifndef NO_G1
    {   pg8::Gemm g{(const pg8::bf16_t*)(ws + WS_XB), (const pg8::bf16_t*)(ws + WS_W1GU), TT, 2 * FF, DM}; pg8::StreamK<false> S; S.init(TT, 2 * FF, DM, F.G, F.bx, (float*)(ws + WS_CAT), (unsigned*)(ws + WS_CTL) + CW_SK + 0 * 512);
        pg8::EpiSwiGLU<0> E{(pg8::bf16_t*)(ws + WS_H), (const float*)(ws + WS_RSTD0)};
        pg8::gemm_phase<pg8::EpiSwiGLU<0>, pg8::StreamK<false>, true, true>(F.lds, g, S, E); }
#endif
}

__device__ __forceinline__ void phase_g2(Frame& F) {
    unsigned char* ws = F.ws; (void)ws;
#ifndef NO_G2
    {   pg8::Gemm g{(const pg8::bf16_t*)(ws + WS_H), (const pg8::bf16_t*)(ws + WS_W1D), TT, DM, FF}; pg8::StreamK<true> S; S.init(TT, DM, FF, F.G, F.bx, (float*)(ws + WS_CAT), (unsigned*)(ws + WS_CTL) + CW_SK + 1 * 512);
        pg8::EpiResid<0> E{(pg8::bf16_t*)(ws + WS_XB), F.out, (float*)(ws + WS_SSQ1)};
        pg8::gemm_phase<pg8::EpiResid<0>, pg8::StreamK<true>, true, true>(F.lds, g, S, E); }
#endif
}

__device__ __forceinline__ void phase_g3(Frame& F) {
    unsigned char* ws = F.ws; (void)ws;
#ifndef NO_G3
    {   pg8::Gemm g{(const pg8::bf16_t*)(ws + WS_XB), (const pg8::bf16_t*)(ws + WS_WIN), TT, INW, DM}; pg8::StreamK<false> S; S.init(TT, INW, DM, F.G, F.bx, (float*)(ws + WS_CAT), (unsigned*)(ws + WS_CTL) + CW_SK + 2 * 512);
        pg8::EpiWin E{ws, F.out, fin(F, 13), fin(F, 14)};
        pg8::gemm_phase<pg8::EpiWin, pg8::StreamK<false>, true, true>(F.lds, g, S, E); }
#endif
}

__device__ __forceinline__ void phase_l1(Frame& F) {
    unsigned char* ws = F.ws; (void)ws;
#ifndef NO_L1
    for (int u = F.bx; u < 544; u += F.G) lru::lru_unit<1>(F, u);
#endif
}

__device__ __forceinline__ void phase_g5(Frame& F) {
    unsigned char* ws = F.ws; (void)ws;
#ifndef NO_G5
    {   pg8::Gemm g{(const pg8::bf16_t*)(ws + WS_CAT), (const pg8::bf16_t*)(ws + WS_WOUT), TT, DM, DM}; pg8::StreamK<true> S; S.init(TT, DM, DM, F.G, F.bx, (float*)(ws + WS_CK), (unsigned*)(ws + WS_CTL) + CW_SK + 3 * 512);
        pg8::EpiResid<1> E{(pg8::bf16_t*)(ws + WS_XB), F.out, (float*)(ws + WS_SSQ2)};
        pg8::gemm_phase<pg8::EpiResid<1>, pg8::StreamK<true>, true, true>(F.lds, g, S, E); }
#endif
}

__device__ __forceinline__ void phase_g6(Frame& F) {
    unsigned char* ws = F.ws; (void)ws;
#ifndef NO_G6
    {   pg8::Gemm g{(const pg8::bf16_t*)(ws + WS_XB), (const pg8::bf16_t*)(ws + WS_W2GU), TT, 2 * FF, DM}; pg8::StreamK<false> S; S.init(TT, 2 * FF, DM, F.G, F.bx, (float*)(ws + WS_CK), (unsigned*)(ws + WS_CTL) + CW_SK + 4 * 512);
        pg8::EpiSwiGLU<1> E{(pg8::bf16_t*)(ws + WS_H), (const float*)(ws + WS_SSQ2)};
        pg8::gemm_phase<pg8::EpiSwiGLU<1>, pg8::StreamK<false>, true, true>(F.lds, g, S, E); }
#endif
}

__device__ __forceinline__ void phase_g7(Frame& F) {
    unsigned char* ws = F.ws; (void)ws;
#ifndef NO_G7
    {   pg8::Gemm g{(const pg8::bf16_t*)(ws + WS_H), (const pg8::bf16_t*)(ws + WS_W2D), TT, DM, FF}; pg8::StreamK<true> S; S.init(TT, DM, FF, F.G, F.bx, (float*)(ws + WS_CK), (unsigned*)(ws + WS_CTL) + CW_SK + 5 * 512);
        pg8::EpiResid<2> E{(pg8::bf16_t*)(ws + WS_XB), F.out, nullptr};
        pg8::gemm_phase<pg8::EpiResid<2>, pg8::StreamK<true>, true, true>(F.lds, g, S, E); }
#endif
}

struct Args { const float* in[33]; float* out; unsigned char* ws; int pad0, pad1; };
__global__ void __launch_bounds__(512, 2) hymba_fwd(Args args) {
    extern __shared__ __attribute__((aligned(16))) unsigned char lds_raw[];
    cg::grid_group grid = cg::this_grid();
    Frame F;
    F.lds = (LAS unsigned char*)lds_raw;
    F.tid = threadIdx.x; F.lane = F.tid & 63; F.wave = __builtin_amdgcn_readfirstlane(F.tid >> 6);
    F.G = gridDim.x; F.bx = blockIdx.x;
    F.ka = (kptr_t)__builtin_amdgcn_kernarg_segment_ptr(); F.z = 0;
    F.out = args.out; F.ws = args.ws;
    unsigned char* ws = F.ws;
    unsigned* ctl = (unsigned*)(ws + WS_CTL);
    volatile LAS unsigned* MISCW = (volatile LAS unsigned*)(F.lds + 144384);
    if (F.tid < 16) MISCW[F.tid] = 0u;
    __syncthreads();
    XcdBarrier bar = xcd_barrier_post(ctl + CW_BAR, MISCW + 8);
#define GRID_BAR() do { xcd_barrier(bar); NEW_PHASE(); } while (0)
#define GRID_BAR_CG() do { __threadfence(); grid.sync(); NEW_PHASE(); } while (0)

    phase_p0(F);
#if defined(REP_P0)
    GRID_BAR(); phase_p0(F);
#endif
    GRID_BAR_CG();
    phase_g1(F);
#if defined(REP_G1)
    GRID_BAR(); phase_g1(F);
#endif
    GRID_BAR();
    phase_g2(F);
#if defined(REP_G2)
    GRID_BAR(); phase_g2(F);
#endif
    GRID_BAR();
    phase_g3(F);
#if defined(REP_G3)
    GRID_BAR(); phase_g3(F);
#endif
    GRID_BAR();
    phase_l1(F);
#if defined(REP_L1)
    GRID_BAR(); phase_l1(F);
#endif
    GRID_BAR();
    {
        LAS float* misc = (LAS float*)(F.lds + att::A_MISC);
        if (F.wave == 0) { const float a = wave_sum(fin(F, 15)[F.lane] * fin(F, 16)[F.lane]), b = wave_sum(fin(F, 17)[F.lane] * fin(F, 18)[F.lane]);
            if (F.lane == 0) misc[0] = __expf(a) - __expf(b) + 0.2f; }
        __syncthreads();
        const float lam = misc[0];
        const int grp = F.bx & 7;
#ifdef ATT_TWICE
        for (int rep = 0; rep < 2; ++rep) {
        unsigned* head = ctl + CW_QUEUE + 64 * grp + 1024 * rep;
#else
        unsigned* head = ctl + CW_QUEUE + 64 * grp;
#endif
        const int wq = F.bx >> 3;
        if (F.G == 256) {
#ifndef NO_ATT
#pragma unroll 1
            for (int k = 0; k < 2; ++k) { const int st = grp + 8 * k;
                att::attn_unit<false, false>(F, st >> 2, st & 3, wq, lam);
                att::attn_unit<false, true>(F, st >> 2, st & 3, 63 - wq, lam); }
#endif
        }
        const int qbase = (F.G == 256) ? 128 : 0;
        for (;;) {
            if (F.tid == 0) ((LAS int*)misc)[1] = qbase + (int)atomicAdd(head, 1u);
            __syncthreads();
            const int it = ((LAS int*)misc)[1];
            __syncthreads();
            if (it >= 212) break;
#ifndef NO_ATT
            if (it < 128) { const int st = grp + 8 * (it >> 6), qb = 63 - (it & 63); att::attn_unit<false, false>(F, st >> 2, st & 3, qb, lam); }
            else if (it < 144) { const int su = grp * 16 + (it - 128); att::attn_unit<true, false>(F, su >> 2, su & 3, 0, lam); }
            else
#endif
#ifndef NO_L2
            { lru::lru_unit<2>(F, grp * 68 + (it - 144));
#ifdef L2_TWICE
              lru::lru_unit<2>(F, grp * 68 + (it - 144));
#endif
            }
#else
            {}
#endif
        }
#ifdef ATT_TWICE
        __syncthreads(); }
#endif
    }
    GRID_BAR();
    phase_g5(F);
#if defined(REP_G5)
    GRID_BAR(); phase_g5(F);
#endif
    GRID_BAR();
    phase_g6(F);
#if defined(REP_G6)
    GRID_BAR(); phase_g6(F);
#endif
    GRID_BAR();
    phase_g7(F);
#if defined(REP_G7)
    GRID_BAR(); phase_g7(F);
#endif
}

extern "C" void kernel_launch(void* const* d_in, const int* in_sizes, int n_in, void* d_out, int out_size, void* d_ws, size_t ws_size, hipStream_t stream) {
    static int grid = 0;
    if (grid == 0) {
        if (n_in != 33 || out_size != (int)O_END || ws_size < WS_END) { fprintf(stderr, "kernel_launch: unexpected shapes: n_in %d out %d ws %zu (need %zu)\n", n_in, out_size, ws_size, (size_t)WS_END); grid = -1; return; }
        int dev = 0, cus = 0, per_cu = 0;
        hipGetDevice(&dev); hipDeviceGetAttribute(&cus, hipDeviceAttributeMultiprocessorCount, dev);
        if (hipFuncSetAttribute((const void*)hymba_fwd, hipFuncAttributeMaxDynamicSharedMemorySize, LDS_BYTES) != hipSuccess) { fprintf(stderr, "kernel_launch: hipFuncSetAttribute failed\n"); grid = -1; return; }
        if (hipOccupancyMaxActiveBlocksPerMultiprocessor(&per_cu, (const void*)hymba_fwd, 512, LDS_BYTES) != hipSuccess || per_cu < 1) { fprintf(stderr, "kernel_launch: occupancy query says %d\n", per_cu); per_cu = 1; }
        (void)hipGetLastError();
        grid = cus * 1;
        if (grid % 8 != 0 || grid < 8) { fprintf(stderr, "kernel_launch: grid %d not a multiple of 8\n", grid); }
    }
    if (grid < 0) return;
    (void)hipMemsetAsync((char*)d_ws + WS_CTL, 0, CTL_ZERO_BYTES, stream);
    Args a{};
    for (int i = 0; i < 33; ++i) a.in[i] = (const float*)d_in[i];
    a.out = (float*)d_out; a.ws = (unsigned char*)d_ws;
    void* kargs[] = {&a};
    hipError_t e = hipLaunchCooperativeKernel((const void*)hymba_fwd, dim3(grid), dim3(512), kargs, LDS_BYTES, stream);
    if (e != hipSuccess) fprintf(stderr, "kernel_launch: cooperative launch failed: %s (grid %d)\n", hipGetErrorString(e), grid);
}
```

```cpp
#include <hip/hip_runtime.h>
#include <hip/hip_cooperative_groups.h>
#include <hip/hip_bf16.h>
#include <cstdio>
#include <cstdint>
namespace cg = cooperative_groups;

constexpr int DM = 1024, NBP = 4, SEQ = 8192, NBS = 32, DSQ = 64, PAST = 2048;
constexpr int TP = NBP * SEQ, TS = NBS * DSQ, TT = TP + TS;
constexpr int FF = 2816, AW = 512, LW = 512, INW = 2560, NH = 4, HD = 64, VD = 128;
constexpr float EPS = 1e-6f;
constexpr float LOG2E = 1.4426950408889634f;
constexpr float QSCALE = 0.125f * LOG2E;
constexpr size_t O_Y = 0, O_KP = (size_t)TT * DM, O_VP = O_KP + (size_t)TP * 512, O_LP = O_VP + (size_t)TP * 512, O_CP = O_LP + NBP * 512,
                 O_KS = O_CP + NBP * 3 * 512, O_VS = O_KS + (size_t)TS * 512, O_LS = O_VS + (size_t)TS * 512, O_CS = O_LS + NBS * 512, O_END = O_CS + NBS * 3 * 512;
static_assert(O_END == 71376896, "output size");
constexpr size_t OFF_SSQ1 = 44u << 20, OFF_Q = 121u << 20, OFF_KVP = (121u + 34u) << 20, OFF_KVS = (121u + 98u) << 20, OFF_XR = (121u + 102u) << 20, OFF_XG = (121u + 136u) << 20;
namespace pg8 {
#define PG8_LAS __attribute__((address_space(3)))
typedef unsigned short bf16_t;
typedef short bf16x8 __attribute__((ext_vector_type(8)));
typedef float f32x4 __attribute__((ext_vector_type(4)));
typedef unsigned u32x4 __attribute__((ext_vector_type(4)));
constexpr int BM = 256, BK = 64, HALF = 128, HTB = HALF * BK * 2  , STAGE_BYTES = 8 * HTB, NXCD = 8, WGM = 8;

__host__ __device__ __forceinline__ int lds_byte(int r, int c) { const int st = (r >> 4) * 2 + (c >> 5), rr = r & 15, cc = c & 31, ob = rr * 64 + cc * 2; return st * 1024 + (ob ^ (((ob >> 9) & 1) << 5)); }
__host__ __device__ __forceinline__ void stage_rc(int b, int& R, int& C) { const int st = b / 1024, sb = b % 1024, swz = sb ^ (((sb >> 9) & 1) << 5); R = (st >> 1) * 16 + swz / 64; C = (st & 1) * 32 + (swz % 64) / 2; }
__host__ __device__ __forceinline__ int perm32(int rho) { const int n = rho >> 4, i = rho & 15; return 8 * (i >> 2) + 4 * n + (i & 3); }

struct Unit { int pm, pn, kt0, nkt, kind; };
struct Gemm { const bf16_t* A; const bf16_t* Bt; int M, N, K; };

struct StaticOrder {
    static constexpr bool SPLIT = false;
    int nM, nN, nwg, G, c;
    __host__ __device__ void init(int M, int N, int G_, int c_) { nM = M / BM; nN = N / BM; nwg = nM * nN; G = G_; c = c_; }
    __host__ __device__ bool next(int i, Unit& u) const {
        const long L = (long)i * G + c; if (L >= nwg) return false;
        int wgid = (int)L; { const int q = nwg / NXCD, r = nwg % NXCD, xcd = wgid % NXCD, off = wgid / NXCD; wgid = (xcd < r ? xcd * (q + 1) : r * (q + 1) + (xcd - r) * q) + off; }
        const int nig = WGM * nN, gid = wgid / nig, fm = gid * WGM, gsz = (nM - fm) < WGM ? (nM - fm) : WGM;
        u.pm = fm + ((wgid % nig) % gsz); u.pn = (wgid % nig) / gsz; u.kt0 = 0; u.nkt = nkt; u.kind = 0; return true;
    }
    int nkt;
    __device__ __forceinline__ void a_ready(const Unit&) const {}
    __device__ __forceinline__ void done(const Unit&) const {}
    __device__ __forceinline__ void put_partial(const f32x4 (&)[2][2][4][2], int, int) const {}
    __device__ __forceinline__ void load_partial(f32x4 (&)[2][2][4][2], int, int) const {}
};


template <bool SPLIT_> struct StreamK {
    static constexpr bool SPLIT = SPLIT_;
    int nM, nN, P, W, x, w, q, R1, Dq; long lo, hi; int v; float* slab; unsigned* flag;
    __device__ void init(int M, int N, int K, int G_, int bx, float* slab_, unsigned* flag_) { nM = M / BM; nN = N / BM; P = K / (2 * BK); W = G_ / NXCD; x = bx % NXCD; w = bx / NXCD;
        const int nwg = nM * nN; q = nwg / NXCD;
        if (!SPLIT) { R1 = (nwg + G_ - 1) / G_; Dq = q; } else { R1 = nwg / G_ - 1; Dq = R1 * W; }
        const long tot = (long)(q - Dq) * P; lo = tot * w / W; hi = tot * (w + 1) / W; v = x * W + w; slab = slab_; flag = flag_; }
    __device__ bool next(int i, Unit& u) const {
        int L;
        if (i < R1) { L = x * q + i * W + w; u.kt0 = 0; u.nkt = 2 * P; u.kind = 0; if (!SPLIT && i * W + w >= q) return false; }
        else if (!SPLIT) return false;
        else { const int k = i - R1; const long u0 = lo / P; const long base = (u0 + k) * P; const long start = (k == 0) ? lo - base : 0; if (base + start >= hi) return false;
            const long end = (hi - base) < P ? (hi - base) : P;
            L = x * q + Dq + (int)(u0 + k); u.kt0 = (int)(2 * start); u.nkt = (int)(2 * (end - start)); u.kind = start > 0 ? 1 : (end < P ? 2 : 0); }
        const int nig = WGM * nN, gid = L / nig, fm = gid * WGM, gsz = (nM - fm) < WGM ? (nM - fm) : WGM;
        u.pm = fm + ((L % nig) % gsz); u.pn = (L % nig) / gsz; return true;
    }
    __device__ __forceinline__ void a_ready(const Unit&) const {}
    __device__ __forceinline__ void done(const Unit&) const {}
    __device__ __forceinline__ void put_partial(const f32x4 (&acc)[2][2][4][2], int tid, int lane) const {
        f32x4* dst = (f32x4*)slab + (size_t)v * (32 * 512) + tid;
#pragma unroll
        for (int ai = 0; ai < 2; ++ai)
#pragma unroll
            for (int bj = 0; bj < 2; ++bj)
#pragma unroll
                for (int m = 0; m < 4; ++m)
#pragma unroll
                    for (int n = 0; n < 2; ++n) { const f32x4 val = acc[ai][bj][m][n];
                        asm volatile("global_store_dwordx4 %0, %1, off sc1\n\ts_nop 1" :: "v"(dst), "v"(val) : "memory");
                        dst += 512; asm volatile("" : "+v"(dst)); }
        asm volatile("s_waitcnt vmcnt(0)" ::: "memory");
        if (lane == 0) __hip_atomic_fetch_add(flag + v, 1u, __ATOMIC_RELAXED, __HIP_MEMORY_SCOPE_AGENT);
    }
    __device__ __forceinline__ void load_partial(f32x4 (&acc)[2][2][4][2], int tid, int lane) const {
        unsigned spins = 0;
        while ((unsigned)__builtin_amdgcn_readfirstlane(__hip_atomic_load(flag + v + 1, __ATOMIC_RELAXED, __HIP_MEMORY_SCOPE_AGENT)) < 8u) { __builtin_amdgcn_s_sleep(2); if (++spins > (1u << 22)) break; }
        __builtin_amdgcn_fence(__ATOMIC_ACQUIRE, "agent");
        const f32x4* src = (const f32x4*)slab + (size_t)(v + 1) * (32 * 512) + tid;
#pragma unroll
        for (int ai = 0; ai < 2; ++ai)
#pragma unroll
            for (int bj = 0; bj < 2; ++bj)
#pragma unroll
                for (int m = 0; m < 4; ++m)
#pragma unroll
                    for (int n = 0; n < 2; ++n) { acc[ai][bj][m][n] = *src; src += 512; asm volatile("" : "+v"(src)); }
    }
};

__device__ __forceinline__ unsigned cvt_pk_bf16(float lo, float hi) { unsigned r; asm volatile("v_cvt_pk_bf16_f32 %0, %1, %2" : "=v"(r) : "v"(lo), "v"(hi)); return r; }
__device__ __forceinline__ u32x4 pack8(const f32x4& a, const f32x4& b) { u32x4 w; w.x = cvt_pk_bf16(a[0], a[1]); w.y = cvt_pk_bf16(a[2], a[3]); w.z = cvt_pk_bf16(b[0], b[1]); w.w = cvt_pk_bf16(b[2], b[3]); return w; }
__device__ __forceinline__ float silu_f(float g) { return g * __builtin_amdgcn_rcpf(1.0f + __builtin_amdgcn_exp2f(-g * 1.4426950408889634f)); }
__device__ __forceinline__ float rstd_from_ssq(const float* ssq, int row, int fq) {
    const f32x4 p = *(const f32x4*)(ssq + (size_t)row * 16 + 4 * fq);
    float s = (p[0] + p[1]) + (p[2] + p[3]); s += __shfl_xor(s, 16); s += __shfl_xor(s, 32);
    return __builtin_amdgcn_rsqf(s * (1.0f / 1024.0f) + 1e-6f);
}
#ifndef EPI_TWICE
#define EPI_TWICE 0
#endif
template <int RSMODE  > struct EpiSwiGLU {
    static constexpr bool PERM = true, AFTER_DRAIN = false, TWICE_OK = (EPI_TWICE == 1);
    bf16_t* H; const float* rs;
    __device__ __forceinline__ void operator()(const f32x4 (&acc)[2][2][4][2], const Unit& u, int wr, int wc, int fr, int fq) const {
        const int row0 = u.pm * BM + wr * 64 + fr, col0 = u.pn * 128 + wc * 32 + 8 * fq;
#pragma unroll
        for (int ai = 0; ai < 2; ++ai)
#pragma unroll
            for (int m = 0; m < 4; ++m) { const int row = row0 + ai * HALF + m * 16;
                const float s = RSMODE == 0 ? rs[row] : rstd_from_ssq(rs, row, fq);
                f32x4 h0, h1;
#pragma unroll
                for (int e = 0; e < 4; ++e) { h0[e] = silu_f(acc[ai][0][m][0][e] * s) * (acc[ai][1][m][0][e] * s); h1[e] = silu_f(acc[ai][0][m][1][e] * s) * (acc[ai][1][m][1][e] * s); }
                *(u32x4*)(H + (size_t)row * 2816 + col0) = pack8(h0, h1); }
    }
};
__device__ __forceinline__ f32x4 bf4lo(const u32x4& w) { f32x4 r; r[0] = __builtin_bit_cast(float, w.x << 16); r[1] = __builtin_bit_cast(float, w.x & 0xffff0000u); r[2] = __builtin_bit_cast(float, w.y << 16); r[3] = __builtin_bit_cast(float, w.y & 0xffff0000u); return r; }
__device__ __forceinline__ f32x4 bf4hi(const u32x4& w) { f32x4 r; r[0] = __builtin_bit_cast(float, w.z << 16); r[1] = __builtin_bit_cast(float, w.z & 0xffff0000u); r[2] = __builtin_bit_cast(float, w.w << 16); r[3] = __builtin_bit_cast(float, w.w & 0xffff0000u); return r; }
template <int KIND> struct EpiResid {
    static constexpr bool PERM = true, AFTER_DRAIN = false, TWICE_OK = (EPI_TWICE == 3 && KIND == 2);
    bf16_t* xb; float* out; float* ssq;
    __device__ __forceinline__ void operator()(const f32x4 (&acc)[2][2][4][2], const Unit& u, int wr, int wc, int fr, int fq) const {
        const int row0 = u.pm * BM + wr * 64 + fr, col0 = u.pn * BM + wc * 32 + 8 * fq;
        const float sc = KIND == 1 ? 1.0f : 0.5f;
        u32x4 r0 = *(const u32x4*)(xb + (size_t)row0 * 1024 + col0), r1 = *(const u32x4*)(xb + (size_t)row0 * 1024 + col0 + HALF);
#pragma unroll
        for (int ai = 0; ai < 2; ++ai)
#pragma unroll
            for (int m = 0; m < 4; ++m) { const int row = row0 + ai * HALF + m * 16;
                const u32x4 c0 = r0, c1 = r1;
                if (ai * 4 + m < 7) { const int nrow = row0 + ((ai * 4 + m + 1) >> 2) * HALF + ((ai * 4 + m + 1) & 3) * 16;
                    r0 = *(const u32x4*)(xb + (size_t)nrow * 1024 + col0); r1 = *(const u32x4*)(xb + (size_t)nrow * 1024 + col0 + HALF); }
                const f32x4 v00 = bf4lo(c0) + acc[ai][0][m][0] * sc, v01 = bf4hi(c0) + acc[ai][0][m][1] * sc, v10 = bf4lo(c1) + acc[ai][1][m][0] * sc, v11 = bf4hi(c1) + acc[ai][1][m][1] * sc;
                if (KIND < 2) {
                    *(u32x4*)(xb + (size_t)row * 1024 + col0) = pack8(v00, v01); *(u32x4*)(xb + (size_t)row * 1024 + col0 + HALF) = pack8(v10, v11);
                    float ss = (v00[0] * v00[0] + v00[1] * v00[1]) + (v00[2] * v00[2] + v00[3] * v00[3]) + (v01[0] * v01[0] + v01[1] * v01[1]) + (v01[2] * v01[2] + v01[3] * v01[3]);
                    ss += (v10[0] * v10[0] + v10[1] * v10[1]) + (v10[2] * v10[2] + v10[3] * v10[3]) + (v11[0] * v11[0] + v11[1] * v11[1]) + (v11[2] * v11[2] + v11[3] * v11[3]);
                    ss += __shfl_xor(ss, 16); ss += __shfl_xor(ss, 32); if (fq == 0) ssq[(size_t)row * 16 + u.pn * 4 + wc] = ss;
                } else { float* orow = out + (size_t)row * 1024 + col0;
                    *(f32x4*)orow = v00; *(f32x4*)(orow + 4) = v01; *(f32x4*)(orow + HALF) = v10; *(f32x4*)(orow + HALF + 4) = v11; } }
    }
};
struct EpiWinPtrs { const float* ssq1; bf16_t* Q; unsigned char *KVP, *KVS; bf16_t *XR, *XG; float* out; const float *gq, *gk; };
__device__ __forceinline__ unsigned char* tile_of(const EpiWinPtrs& P, int row, int h, int& key) {
    if (row < 32768) { const int pos = row & 8191; key = pos & 63; return P.KVP + (size_t)((((row >> 13) * 4 + h) * 128) + (pos >> 6)) * 32768; }
    const int r2 = row - 32768; key = r2 & 63; return P.KVS + (size_t)((r2 >> 6) * 4 + h) * 32768; }
template <int KIND> __device__ __forceinline__ void win_qk(const EpiWinPtrs P, const f32x4 (&acc)[2][2][4][2], const Unit& u, int wr, int wc, int fr, int fq) {
    const int row0 = u.pm * BM + wr * 64 + fr, half = u.pn & 1;
    const float* gp = KIND == 0 ? P.gq : P.gk; const float qs = KIND == 0 ? 0.125f * 1.4426950408889634f : 1.0f;
    const f32x4 g00 = *(const f32x4*)(gp + 8 * fq) * qs, g01 = *(const f32x4*)(gp + 8 * fq + 4) * qs, g10 = *(const f32x4*)(gp + 32 + 8 * fq) * qs, g11 = *(const f32x4*)(gp + 32 + 8 * fq + 4) * qs;
    const int cbase = 256 * half + 64 * wc + 8 * fq;
#pragma unroll
    for (int ai = 0; ai < 2; ++ai)
#pragma unroll
        for (int m = 0; m < 4; ++m) { const int row = row0 + ai * HALF + m * 16; const float rs = rstd_from_ssq(P.ssq1, row, fq);
            const f32x4 v00 = acc[ai][0][m][0] * rs, v01 = acc[ai][0][m][1] * rs, v10 = acc[ai][1][m][0] * rs, v11 = acc[ai][1][m][1] * rs;
            float ss = (v00[0] * v00[0] + v00[1] * v00[1]) + (v00[2] * v00[2] + v00[3] * v00[3]);
            ss += (v01[0] * v01[0] + v01[1] * v01[1]) + (v01[2] * v01[2] + v01[3] * v01[3]);
            ss += (v10[0] * v10[0] + v10[1] * v10[1]) + (v10[2] * v10[2] + v10[3] * v10[3]);
            ss += (v11[0] * v11[0] + v11[1] * v11[1]) + (v11[2] * v11[2] + v11[3] * v11[3]);
            ss += __shfl_xor(ss, 16); ss += __shfl_xor(ss, 32);
            const float rn = __builtin_amdgcn_rsqf(ss * (1.0f / 64.0f) + 1e-6f);
            const f32x4 a0 = v00 * rn * g00, b0 = v01 * rn * g01, a1 = v10 * rn * g10, b1 = v11 * rn * g11;
            if (KIND == 0) { *(u32x4*)(P.Q + (size_t)row * 512 + cbase) = pack8(a0, b0); *(u32x4*)(P.Q + (size_t)row * 512 + cbase + 32) = pack8(a1, b1); }
            else { float* o = (row < 32768 ? P.out + 35651584 + (size_t)row * 512 : P.out + 69214208 + (size_t)(row - 32768) * 512) + cbase;
                *(f32x4*)o = a0; *(f32x4*)(o + 4) = b0; *(f32x4*)(o + 32) = a1; *(f32x4*)(o + 36) = b1;
                int key; unsigned char* tb = tile_of(P, row, 2 * half + (wc >> 1), key) + (wc & 1) * 8192 + fq * 1024 + key * 16;
                *(u32x4*)tb = pack8(a0, b0); *(u32x4*)(tb + 4096) = pack8(a1, b1); }
            asm volatile("" ::: "memory"); }
}
template <int KIND> __device__ __forceinline__ void win_plain(const EpiWinPtrs P, const f32x4 (&acc)[2][2][4][2], const Unit& u, int wr, int wc, int fr, int fq) {
    const int row0 = u.pm * BM + wr * 64 + fr, half = u.pn & 1;
    const int cbase = 256 * half + 32 * wc + 8 * fq;
    bf16_t* dst = KIND == 3 ? P.XR : P.XG;
#pragma unroll
    for (int ai = 0; ai < 2; ++ai)
#pragma unroll
        for (int m = 0; m < 4; ++m) { const int row = row0 + ai * HALF + m * 16; const float rs = rstd_from_ssq(P.ssq1, row, fq);
#pragma unroll
            for (int bj = 0; bj < 2; ++bj) { const f32x4 a = acc[ai][bj][m][0] * rs, b = acc[ai][bj][m][1] * rs; const int c = cbase + 128 * bj;
                if (KIND == 2) { int key; unsigned char* tb = tile_of(P, row, 2 * half + bj, key) + 16384 + wc * 4096 + key * 64 + fq * 16; *(u32x4*)tb = pack8(a, b); }
                else *(u32x4*)(dst + (size_t)row * 512 + c) = pack8(a, b);
                if (KIND == 2) { float* o = (row < 32768 ? P.out + 52428800 + (size_t)row * 512 : P.out + 70262784 + (size_t)(row - 32768) * 512) + c; *(f32x4*)o = a; *(f32x4*)(o + 4) = b; }
                if (KIND == 3) {
                    if (row < 32768) { const int t = row & 8191; if (t >= 8189) { float* o = P.out + 69208064 + (size_t)((row >> 13) * 3 + (t - 8189)) * 512 + c; *(f32x4*)o = a; *(f32x4*)(o + 4) = b; } }
                    else { const int t = (row - 32768) & 63; if (t >= 61) { float* o = P.out + 71327744 + (size_t)(((row - 32768) >> 6) * 3 + (t - 61)) * 512 + c; *(f32x4*)o = a; *(f32x4*)(o + 4) = b; } } } }
            asm volatile("" ::: "memory"); }
}
struct EpiWin {
    static constexpr bool PERM = true, AFTER_DRAIN = false, TWICE_OK = (EPI_TWICE == 2);
    unsigned char* wsb; float* out; const float *gq, *gk;
    __device__ __forceinline__ void operator()(const f32x4 (&acc)[2][2][4][2], const Unit& u, int wr, int wc, int fr, int fq) const {
        unsigned char* w = wsb; asm volatile("" : "+s"(w));
        const EpiWinPtrs P{(const float*)(w + OFF_SSQ1), (bf16_t*)(w + OFF_Q), w + OFF_KVP, w + OFF_KVS, (bf16_t*)(w + OFF_XR), (bf16_t*)(w + OFF_XG), out, gq, gk};
        const int kind = u.pn >> 1;
        if (kind == 0) win_qk<0>(P, acc, u, wr, wc, fr, fq);
        else if (kind == 1) win_qk<1>(P, acc, u, wr, wc, fr, fq);
        else if (kind == 2) win_plain<2>(P, acc, u, wr, wc, fr, fq);
        else if (kind == 3) win_plain<3>(P, acc, u, wr, wc, fr, fq);
        else win_plain<4>(P, acc, u, wr, wc, fr, fq);
    }
};
template <class Epi, class Sched, bool ALIGN_EPI = false, bool SP2 = false>
__device__ __forceinline__ void gemm_phase(PG8_LAS unsigned char* lds, const Gemm g, const Sched& S, const Epi& E) {
    int tid_ = threadIdx.x; asm volatile("" : "+v"(tid_));
    const int tid = tid_, wid = __builtin_amdgcn_readfirstlane(tid >> 6), lane = tid & 63, wr = wid >> 2, wc = wid & 3, fr = lane & 15, fq = lane >> 4;
    const int K = g.K;
    unsigned voffA[2], voffB[2];
#pragma unroll
    for (int i = 0; i < 2; ++i) { int R, C; stage_rc(tid * 16 + i * 8192, R, C); const int Rb = Epi::PERM ? ((R & ~31) + perm32(R & 31)) : R;
        voffA[i] = (unsigned)(R * K + C) * 2u; voffB[i] = (unsigned)(Rb * K + C) * 2u; }
    const size_t kstep = (size_t)(BK * 2);
    const size_t hstep = (size_t)HALF * K * 2;
    const size_t tstep = 2 * hstep;
    const unsigned ldsw = (unsigned)wid * 1024u;
    const int aoff = lds_byte(wr * 64 + fr, fq * 8), boff = lds_byte(wc * 32 + fr, fq * 8);
#define PG8_SA(b, h) (((b) * 2 + (h)) * HTB)
#define PG8_SB(b, h) ((4 + (b) * 2 + (h)) * HTB)
#define PG8_STAGE(bufoff, gbase, voff) do { _Pragma("unroll") for (int _i = 0; _i < 2; ++_i) \
        __builtin_amdgcn_global_load_lds((const unsigned*)((const char*)(gbase) + (voff)[_i]), (PG8_LAS unsigned*)(lds + (bufoff) + ldsw + _i * 8192), 16, 0, 0); } while (0)
#define PG8_LDA(dst, b, h) do { _Pragma("unroll") for (int m = 0; m < 4; ++m) _Pragma("unroll") for (int k = 0; k < 2; ++k) dst[m][k] = *(const PG8_LAS bf16x8*)(lds + PG8_SA(b, h) + aoff + m * 2048 + k * 1024); } while (0)
#define PG8_LDB(dst, b, h) do { _Pragma("unroll") for (int n = 0; n < 2; ++n) _Pragma("unroll") for (int k = 0; k < 2; ++k) dst[n][k] = *(const PG8_LAS bf16x8*)(lds + PG8_SB(b, h) + boff + n * 2048 + k * 1024); } while (0)
#define PG8_MMA(ai, bj, At, Bt) do { __builtin_amdgcn_s_setprio(1); _Pragma("unroll") for (int m = 0; m < 4; ++m) _Pragma("unroll") for (int n = 0; n < 2; ++n) _Pragma("unroll") for (int k = 0; k < 2; ++k) \
        acc[ai][bj][m][n] = __builtin_amdgcn_mfma_f32_16x16x32_bf16(Bt[n][k], At[m][k], acc[ai][bj][m][n], 0, 0, 0); __builtin_amdgcn_s_setprio(0); } while (0)
#define PG8_WAIT_V(n) asm volatile("s_waitcnt vmcnt(" #n ")" ::: "memory")
#define PG8_WAIT_L(n) asm volatile("s_waitcnt lgkmcnt(" #n ")" ::: "memory")
#define PG8_BAR __builtin_amdgcn_s_barrier()
#define PG8_SCHED __builtin_amdgcn_sched_barrier(0)
    Unit cur, nxt; int ui = 0;
    if (!S.next(0, cur)) return;
    f32x4 acc[2][2][4][2];
#pragma unroll
    for (int a = 0; a < 2; ++a)
#pragma unroll
        for (int b = 0; b < 2; ++b)
#pragma unroll
            for (int m = 0; m < 4; ++m)
#pragma unroll
                for (int n = 0; n < 2; ++n) acc[a][b][m][n] = (f32x4){0.f, 0.f, 0.f, 0.f};
    bf16x8 At[4][2], B0[2][2], B1[2][2];
    const char* cA = (const char*)g.A + (size_t)cur.pm * tstep + (Sched::SPLIT ? (size_t)cur.kt0 * kstep : (size_t)0); const char* cB = (const char*)g.Bt + (size_t)cur.pn * tstep + (Sched::SPLIT ? (size_t)cur.kt0 * kstep : (size_t)0);
    S.a_ready(cur);
    if constexpr (SP2) {
        PG8_STAGE(PG8_SB(0, 0), cB, voffB); PG8_STAGE(PG8_SB(0, 1), cB + hstep, voffB); PG8_STAGE(PG8_SA(0, 0), cA, voffA); PG8_STAGE(PG8_SA(0, 1), cA + hstep, voffA);
        if (wr == 1) PG8_BAR;
        PG8_WAIT_V(2); PG8_BAR;
        PG8_STAGE(PG8_SB(1, 0), cB + kstep, voffB); PG8_STAGE(PG8_SA(1, 0), cA + kstep, voffA); PG8_STAGE(PG8_SB(1, 1), cB + hstep + kstep, voffB);
        PG8_WAIT_V(6); PG8_BAR;
    } else {
        PG8_STAGE(PG8_SB(0, 0), cB, voffB); PG8_STAGE(PG8_SA(0, 0), cA, voffA); PG8_STAGE(PG8_SB(0, 1), cB + hstep, voffB); PG8_STAGE(PG8_SA(0, 1), cA + hstep, voffA);
        if (wr == 1) PG8_BAR;
        PG8_WAIT_V(4); PG8_BAR;
        PG8_STAGE(PG8_SB(1, 0), cB + kstep, voffB); PG8_STAGE(PG8_SA(1, 0), cA + kstep, voffA); PG8_STAGE(PG8_SB(1, 1), cB + hstep + kstep, voffB);
        PG8_WAIT_V(6); PG8_BAR;
    }
    for (;;) {
        const bool has_next = S.next(ui + 1, nxt);
        const char* nA = has_next ? (const char*)g.A + (size_t)nxt.pm * tstep + (Sched::SPLIT ? (size_t)nxt.kt0 * kstep : (size_t)0) : cA; const char* nB = has_next ? (const char*)g.Bt + (size_t)nxt.pn * tstep + (Sched::SPLIT ? (size_t)nxt.kt0 * kstep : (size_t)0) : cB;
        const int nt = Sched::SPLIT ? cur.nkt : K / BK;
        for (int t = 0; t < nt; t += 2) {
            const bool last = (t == nt - 2);
            const char* a1 = cA + (size_t)(t + 1) * kstep;
            const char* a2 = last ? nA : cA + (size_t)(t + 2) * kstep; const char* b2 = last ? nB : cB + (size_t)(t + 2) * kstep;
            const char* a3 = a2 + kstep; const char* b3 = b2 + kstep;
            if (last && has_next) S.a_ready(nxt);
            if constexpr (SP2) {
            PG8_LDB(B0, 0, 0); PG8_LDB(B1, 0, 1); PG8_SCHED; PG8_LDA(At, 0, 0); PG8_STAGE(PG8_SA(1, 1), a1 + hstep, voffA);
            PG8_WAIT_V(8); PG8_WAIT_L(0); PG8_BAR; PG8_MMA(0, 0, At, B0); PG8_MMA(0, 1, At, B1); PG8_BAR; PG8_SCHED;
            PG8_LDA(At, 0, 1); PG8_STAGE(PG8_SB(0, 0), b2, voffB); PG8_STAGE(PG8_SB(0, 1), b2 + hstep, voffB); PG8_STAGE(PG8_SA(0, 0), a2, voffA);
            PG8_WAIT_V(8); PG8_WAIT_L(0); PG8_BAR; PG8_MMA(1, 0, At, B0); PG8_MMA(1, 1, At, B1); PG8_BAR; PG8_SCHED;
            PG8_LDB(B0, 1, 0); PG8_LDB(B1, 1, 1); PG8_SCHED; PG8_LDA(At, 1, 0); PG8_STAGE(PG8_SA(0, 1), a2 + hstep, voffA);
            PG8_WAIT_V(8); PG8_WAIT_L(0); PG8_BAR; PG8_MMA(0, 0, At, B0); PG8_MMA(0, 1, At, B1); PG8_BAR; PG8_SCHED;
            PG8_LDA(At, 1, 1); PG8_STAGE(PG8_SB(1, 0), b3, voffB); PG8_STAGE(PG8_SB(1, 1), b3 + hstep, voffB); PG8_STAGE(PG8_SA(1, 0), a3, voffA);
            PG8_WAIT_V(8); PG8_WAIT_L(0); PG8_BAR; PG8_MMA(1, 0, At, B0); PG8_MMA(1, 1, At, B1); PG8_BAR; PG8_SCHED;
            } else {
            PG8_LDB(B0, 0, 0); PG8_SCHED; PG8_LDA(At, 0, 0); PG8_STAGE(PG8_SA(1, 1), a1 + hstep, voffA);
            PG8_WAIT_L(8); PG8_BAR; PG8_WAIT_L(0); PG8_MMA(0, 0, At, B0); PG8_BAR; PG8_SCHED;
            PG8_LDB(B1, 0, 1); PG8_STAGE(PG8_SB(0, 0), b2, voffB);
            PG8_BAR; PG8_WAIT_L(0); PG8_MMA(0, 1, At, B1); PG8_BAR;
            PG8_LDA(At, 0, 1); PG8_STAGE(PG8_SA(0, 0), a2, voffA);
            PG8_BAR; PG8_WAIT_L(0); PG8_MMA(1, 0, At, B0); PG8_BAR; PG8_SCHED;
            PG8_STAGE(PG8_SB(0, 1), b2 + hstep, voffB);
            PG8_WAIT_V(6); PG8_BAR; PG8_MMA(1, 1, At, B1); PG8_BAR;
            PG8_LDB(B0, 1, 0); PG8_SCHED; PG8_LDA(At, 1, 0); PG8_STAGE(PG8_SA(0, 1), a2 + hstep, voffA);
            PG8_WAIT_L(8); PG8_BAR; PG8_WAIT_L(0); PG8_MMA(0, 0, At, B0); PG8_BAR; PG8_SCHED;
            PG8_LDB(B1, 1, 1); PG8_STAGE(PG8_SB(1, 0), b3, voffB);
            PG8_BAR; PG8_WAIT_L(0); PG8_MMA(0, 1, At, B1); PG8_BAR;
            PG8_LDA(At, 1, 1); PG8_STAGE(PG8_SA(1, 0), a3, voffA);
            PG8_BAR; PG8_WAIT_L(0); PG8_MMA(1, 0, At, B0); PG8_BAR; PG8_SCHED;
            PG8_STAGE(PG8_SB(1, 1), b3 + hstep, voffB);
            PG8_WAIT_V(6); PG8_BAR; PG8_MMA(1, 1, At, B1); PG8_BAR;
            }
        }
        if constexpr (ALIGN_EPI) { if (wr == 0) PG8_BAR; }
        if constexpr (!Epi::AFTER_DRAIN) { if (Sched::SPLIT && cur.kind == 1) S.put_partial(acc, tid, lane); else { E(acc, cur, wr, wc, fr, fq);
#if EPI_TWICE
            if (Epi::TWICE_OK) { asm volatile("" ::: "memory"); E(acc, cur, wr, wc, fr, fq); }
#endif
            } S.done(cur); }
        if (!has_next) break;
        if (Sched::SPLIT && nxt.kind == 2) S.load_partial(acc, tid, lane);
        else {
#pragma unroll
        for (int a = 0; a < 2; ++a)
#pragma unroll
            for (int b = 0; b < 2; ++b)
#pragma unroll
                for (int m = 0; m < 4; ++m)
#pragma unroll
                    for (int n = 0; n < 2; ++n) acc[a][b][m][n] = (f32x4){0.f, 0.f, 0.f, 0.f};
        }
        cur = nxt; cA = nA; cB = nB; ++ui;
        if constexpr (ALIGN_EPI) { if (wr == 1) PG8_BAR; }
    }
    PG8_WAIT_V(0);
    if constexpr (!ALIGN_EPI) { if (wr == 0) PG8_BAR; }
    PG8_BAR;
    if constexpr (Epi::AFTER_DRAIN) { E.fused(acc, cur, wr, wc, fr, fq, lds, wid, lane); S.done(cur); }
#undef PG8_SA
#undef PG8_SB
#undef PG8_STAGE
#undef PG8_LDA
#undef PG8_LDB
#undef PG8_MMA
#undef PG8_WAIT_V
#undef PG8_WAIT_L
#undef PG8_BAR
#undef PG8_SCHED
}
}

constexpr size_t MiB = 1u << 20;
constexpr size_t WS_CTL = 0, CTL_ZERO_BYTES = 64 * 1024;
constexpr size_t WS_W1GU = 1 * MiB, WS_W1D = 12 * MiB, WS_W2GU = 18 * MiB, WS_W2D = 29 * MiB, WS_WIN = 35 * MiB, WS_WOUT = 40 * MiB;
constexpr size_t WS_GATEW = 42 * MiB;
constexpr size_t WS_SP8 = WS_GATEW + 256 * 1024;
constexpr size_t WS_RSTD0 = 43 * MiB;
constexpr size_t WS_SSQ1 = 44 * MiB, WS_SSQ2 = 47 * MiB;
constexpr size_t WS_LSUM = 50 * MiB;
constexpr size_t WS_XB = 53 * MiB;
constexpr size_t WS_H = 121 * MiB;
constexpr size_t WS_Q = WS_H, WS_KVP = WS_H + 34 * MiB, WS_KVS = WS_H + 98 * MiB, WS_XR = WS_H + 102 * MiB, WS_XG = WS_H + 136 * MiB;
constexpr size_t WS_CAT = 308 * MiB;
constexpr size_t WS_CK = 376 * MiB, WS_CV = 440 * MiB;
constexpr size_t WS_END = 504 * MiB;
static_assert(OFF_SSQ1 == WS_SSQ1 && OFF_Q == WS_Q && OFF_KVP == WS_KVP && OFF_KVS == WS_KVS && OFF_XR == WS_XR && OFF_XG == WS_XG, "epilogue offsets");
static_assert(WS_H + (size_t)TT * FF * 2 <= WS_CAT && WS_XB + (size_t)TT * DM * 2 <= WS_H && WS_XG + (size_t)TT * 512 * 2 <= WS_CAT, "d_ws map");
constexpr int CW_BAR = 1024;
constexpr int CW_SK = 12288;
constexpr int CW_QUEUE = 8192;

constexpr int RING_BYTES = 131072;
constexpr int MISC_OFF = RING_BYTES;
constexpr int LDS_BYTES = 147456;

#define GAS __attribute__((address_space(1)))
#define LAS __attribute__((address_space(3)))
typedef unsigned short bf16;
typedef unsigned v4u __attribute__((ext_vector_type(4)));
typedef unsigned v2u __attribute__((ext_vector_type(2)));
typedef float f32x4 __attribute__((ext_vector_type(4)));
typedef float f32x16 __attribute__((ext_vector_type(16)));
typedef short bf16x8 __attribute__((ext_vector_type(8)));
typedef short s16x4 __attribute__((ext_vector_type(4)));
#define LDS_WAIT() asm volatile("s_waitcnt lgkmcnt(0)" ::: "memory")
#define VM_WAIT() asm volatile("s_waitcnt vmcnt(0)" ::: "memory")
__device__ __forceinline__ unsigned f2bf(float f) { unsigned u = __builtin_bit_cast(unsigned, f); return (u + 0x7fffu + ((u >> 16) & 1u)) >> 16; }
__device__ __forceinline__ unsigned pk2(float lo, float hi) { return f2bf(lo) | (f2bf(hi) << 16); }
__device__ __forceinline__ float bf2f(unsigned short b) { return __builtin_bit_cast(float, (unsigned)b << 16); }
__device__ __forceinline__ float bflo(unsigned w) { return __builtin_bit_cast(float, w << 16); }
__device__ __forceinline__ float bfhi(unsigned w) { return __builtin_bit_cast(float, w & 0xffff0000u); }
__device__ __forceinline__ float wave_sum(float v) {
#pragma unroll
    for (int o = 1; o < 64; o <<= 1) v += __shfl_xor(v, o);
    return v;
}

#define XB_TMO      128
#define XB_XCNT(j)  (256  + 64 * (j))
#define XB_XSUB(j)  (1280 + 64 * (j))
#define XB_XGEN(j)  (2304 + 64 * (j))
#define XB_TOP      3328
#define XB_TOPGEN   3392
#define XCD_BAR_WORDS 3456
#define XB_SPIN_CAP (1u << 18)

__device__ __forceinline__ unsigned xb_ld(unsigned* p)              { return __hip_atomic_load(p, __ATOMIC_RELAXED, __HIP_MEMORY_SCOPE_AGENT); }
__device__ __forceinline__ unsigned xb_add(unsigned* p, unsigned v) { return __hip_atomic_fetch_add(p, v, __ATOMIC_RELAXED, __HIP_MEMORY_SCOPE_AGENT); }
__device__ __forceinline__ unsigned xb_xcc_id() { return (unsigned)__builtin_amdgcn_s_getreg((3 << 11) | 20) & 0xFu; }
#define XB_SPIN(cond, bar) do { unsigned _sp = 0; while (cond) { __builtin_amdgcn_s_sleep(1); \
    if ((++_sp & 255u) == 0u) { if (xb_ld(&(bar)[XB_TMO])) break; if (_sp > XB_SPIN_CAP) { atomicAdd(&(bar)[XB_TMO], 1u); break; } } } } while (0)

struct XcdBarrier {
    unsigned* bar; unsigned x;
    volatile LAS unsigned* st;
};

__device__ __forceinline__ XcdBarrier xcd_barrier_post(unsigned* bar, volatile LAS unsigned* st) {
    XcdBarrier b; b.bar = bar; b.x = xb_xcc_id(); b.st = st;
    if (threadIdx.x == 0) (void)xb_add(&bar[XB_XCNT(b.x)], 1u);
    return b;
}
__device__ __forceinline__ void xcd_barrier_complete(unsigned* bar, unsigned x, unsigned& nloc, unsigned& nx) {
    const unsigned G = gridDim.x * gridDim.y * gridDim.z;
    unsigned sum, cnt, mine, sp = 0u;
    for (;;) {
        sum = 0u; cnt = 0u; mine = 0u;
#pragma unroll
        for (unsigned j = 0; j < 16; ++j) { const unsigned c = xb_ld(&bar[XB_XCNT(j)]); sum += c; cnt += (c > 0u) ? 1u : 0u; mine = (j == x) ? c : mine; }
        if (sum == G) break;
        __builtin_amdgcn_s_sleep(1);
        if ((++sp & 255u) == 0u) { if (xb_ld(&bar[XB_TMO])) break; if (sp > XB_SPIN_CAP) { atomicAdd(&bar[XB_TMO], 1u); break; } }
    }
    nloc = mine > 0u ? mine : 1u; nx = cnt > 0u ? cnt : 1u;
}

__device__ __forceinline__ void xcd_barrier(const XcdBarrier& b) {
    asm volatile("s_waitcnt vmcnt(0)" ::: "memory");
    __syncthreads();
    if (threadIdx.x == 0) {
        unsigned* bar = b.bar;
        __builtin_amdgcn_s_waitcnt(0);
        unsigned nloc = b.st[0], nx = b.st[1];
        if (nloc == 0u) { xcd_barrier_complete(bar, b.x, nloc, nx); b.st[0] = nloc; b.st[1] = nx; }
        const unsigned old = xb_add(&bar[XB_XSUB(b.x)], 1u);
        const unsigned gen = old / nloc;
        if (old + 1u == (gen + 1u) * nloc) {
            __builtin_amdgcn_fence(__ATOMIC_RELEASE, "agent");
            asm volatile("s_waitcnt vmcnt(0)" ::: "memory");
            const unsigned og = xb_add(&bar[XB_TOP], 1u);
            const unsigned tg = og / nx;
            if (og + 1u == (tg + 1u) * nx) xb_add(&bar[XB_TOPGEN], 1u);
            else XB_SPIN(xb_ld(&bar[XB_TOPGEN]) == tg, bar);
            __builtin_amdgcn_fence(__ATOMIC_ACQUIRE, "agent");
            xb_add(&bar[XB_XGEN(b.x)], 1u);
            asm volatile("s_waitcnt vmcnt(0)" ::: "memory");
        } else {
            XB_SPIN(xb_ld(&bar[XB_XGEN(b.x)]) == gen, bar);
            __builtin_amdgcn_fence(__ATOMIC_ACQUIRE, "agent");
            asm volatile("s_waitcnt vmcnt(0)" ::: "memory");
        }
    }
    __syncthreads();
}

typedef __attribute__((address_space(4))) const unsigned char* kptr_t;
struct Frame {
    LAS unsigned char* lds;
    int tid, lane, wave, G, bx;
    kptr_t ka; int z;
    float* out; unsigned char* ws;
};
__device__ __forceinline__ const float* fin(const Frame& F, int k) { typedef const float* cfp; return *(const __attribute__((address_space(4))) cfp*)(F.ka + (k * 8 + F.z)); }
#define NEW_PHASE() do { int z_ = 0; asm volatile("" : "+s"(z_)); F.z = z_; } while (0)

__device__ __forceinline__ void p0_transpose_item(const float* W, int K, int N, bf16* WT, int kb, int n0, int drow0, const float* gain, LAS float* scr, int lane) {
    const int k0 = 64 * kb;
#pragma unroll 8
    for (int i = 0; i < 32; ++i) { const int kk = 2 * i + (lane >> 5); float w = W[(size_t)(k0 + kk) * N + n0 + (lane & 31)]; if (gain) w *= gain[k0 + kk]; scr[kk * 33 + (lane & 31)] = w; }
    LDS_WAIT(); asm volatile("" ::: "memory");
    const int c = lane & 7;
#pragma unroll
    for (int j = 0; j < 4; ++j) { const int n = (lane >> 3) + 8 * j; const LAS float* s = scr + (8 * c) * 33 + n;
        v4u o; o.x = pk2(s[0 * 33], s[1 * 33]); o.y = pk2(s[2 * 33], s[3 * 33]); o.z = pk2(s[4 * 33], s[5 * 33]); o.w = pk2(s[6 * 33], s[7 * 33]);
        *(GAS v4u*)(WT + (size_t)(drow0 + n) * K + k0 + 8 * c) = o; }
    LDS_WAIT(); asm volatile("" ::: "memory");
}
__device__ __forceinline__ void p0_prologue(Frame& F) {
    LAS float* scr = (LAS float*)(F.lds + F.wave * 16384);
    const int gw = F.bx * 8 + F.wave, NGW = F.G * 8;
    unsigned char* ws = F.ws;
    constexpr int I_GU = 16 * 88, I_DN = 44 * 32, I_IN = 16 * 80, I_OUT = 16 * 32;
    constexpr int NITEMS = 2 * (2 * I_GU + I_DN) + I_IN + I_OUT;
    constexpr int I_FFN = 2 * I_GU + I_DN;
    for (int it = gw; it < NITEMS; it += NGW) {
        int r = it;
        if (r < 2 * I_FFN) {
            const int f = r >= I_FFN; r -= f * I_FFN;
            const float* Wg = f == 0 ? fin(F, 8) : fin(F, 30); const float* Wu = f == 0 ? fin(F, 9) : fin(F, 31); const float* Wd = f == 0 ? fin(F, 10) : fin(F, 32); const float* gn = f == 0 ? fin(F, 7) : fin(F, 29);
            bf16* GU = (bf16*)(ws + (f == 0 ? WS_W1GU : WS_W2GU)); bf16* DN = (bf16*)(ws + (f == 0 ? WS_W1D : WS_W2D));
            if (r < 2 * I_GU) { const int up = r >= I_GU; const int q = up ? r - I_GU : r; const int kb = q / 88, nb = q % 88, n0 = 32 * nb;
                p0_transpose_item(up ? Wu : Wg, 1024, FF, GU, kb, n0, 256 * (n0 >> 7) + (n0 & 127) + (up ? 128 : 0), gn, scr, F.lane); }
            else { r -= 2 * I_GU; const int kb = r / 32, nb = r % 32; p0_transpose_item(Wd, FF, 1024, DN, kb, 32 * nb, 32 * nb, nullptr, scr, F.lane); }
            continue;
        }
        r -= 2 * I_FFN;
        if (r < I_IN) { const int kb = r / 80, nb = r % 80, n0 = 32 * nb; int dr = n0;
            if (n0 < 1024) { const int oc = n0 & 255, wc = oc >> 6, bj = (oc >> 5) & 1; dr = (n0 & ~255) + 128 * bj + 32 * wc; }
            p0_transpose_item(fin(F, 12), 1024, INW, (bf16*)(ws + WS_WIN), kb, n0, dr, fin(F, 11), scr, F.lane); continue; }
        r -= I_IN;
        { const int kb = r / 32, nb = r % 32; p0_transpose_item(fin(F, 28), 1024, 1024, (bf16*)(ws + WS_WOUT), kb, 32 * nb, 32 * nb, nullptr, scr, F.lane); }
    }
    {   bf16* XB = (bf16*)(ws + WS_XB); float* rstd0 = (float*)(ws + WS_RSTD0);
        for (int m = gw; m < TT; m += NGW) {
            const float* xrow = m < TP ? fin(F, 0) + (size_t)m * DM : fin(F, 1) + (size_t)(m - TP) * DM;
            const GAS f32x4* xr = (const GAS f32x4*)xrow + F.lane;
            f32x4 v[4]; float s = 0.f;
#pragma unroll
            for (int j = 0; j < 4; ++j) { v[j] = xr[64 * j]; s += (v[j].x * v[j].x + v[j].y * v[j].y) + (v[j].z * v[j].z + v[j].w * v[j].w); }
            s = wave_sum(s);
            if (F.lane == 0) rstd0[m] = __builtin_amdgcn_rsqf(s * (1.0f / DM) + EPS);
            GAS unsigned long long* o8 = (GAS unsigned long long*)(XB + (size_t)m * DM) + F.lane;
#pragma unroll
            for (int j = 0; j < 4; ++j) o8[64 * j] = (unsigned long long)pk2(v[j].x, v[j].y) | ((unsigned long long)pk2(v[j].z, v[j].w) << 32);
        }
    }
    {   const unsigned gt = (unsigned)F.bx * 512u + (unsigned)F.tid, NTH = (unsigned)F.G * 512u;
        unsigned char* CI = ws + WS_CK;
        const float* ck = fin(F, 2); const float* cv = fin(F, 3);
        for (unsigned w0 = gt; w0 < (1u << 22); w0 += 4 * NTH) {
            f32x4 a[4], bq[4]; size_t dsto[4];
#pragma unroll
            for (int u = 0; u < 4; ++u) { const unsigned w = w0 + u * NTH;
                const unsigned jl = w & 3, kk = (w >> 2) & 15, jh = (w >> 6) & 1, kh = (w >> 7) & 3, c = (w >> 9) & 1, t = (w >> 10) & 31, h = (w >> 15) & 3, sb = w >> 17;
                const unsigned key = kh * 16 + kk, j = jh * 4 + jl, pos = t * 64 + key;
                const GAS f32x4* src = (const GAS f32x4*)(ck + ((((size_t)sb * PAST + pos) * 4 + h) * 2 + c) * 64 + j * 8);
                a[u] = __builtin_nontemporal_load(src); bq[u] = __builtin_nontemporal_load(src + 1);
                dsto[u] = ((size_t)((sb * 4 + h) * 32 + t)) * 32768 + c * 8192 + j * 1024 + key * 16; }
#pragma unroll
            for (int u = 0; u < 4; ++u) { v4u o; o.x = pk2(a[u].x, a[u].y); o.y = pk2(a[u].z, a[u].w); o.z = pk2(bq[u].x, bq[u].y); o.w = pk2(bq[u].z, bq[u].w); *(GAS v4u*)(CI + dsto[u]) = o; } }
        for (unsigned w0 = gt; w0 < (1u << 22); w0 += 4 * NTH) {
            f32x4 a[4], bq[4]; size_t dsto[4];
#pragma unroll
            for (int u = 0; u < 4; ++u) { const unsigned w = w0 + u * NTH;
                const unsigned ch = w & 3, kk = (w >> 2) & 15, db = (w >> 6) & 3, kh = (w >> 8) & 3, t = (w >> 10) & 31, h = (w >> 15) & 3, sb = w >> 17;
                const unsigned key = kh * 16 + kk, pos = t * 64 + key;
                const GAS f32x4* src = (const GAS f32x4*)(cv + (((size_t)sb * PAST + pos) * 4 + h) * 128 + db * 32 + ch * 8);
                a[u] = __builtin_nontemporal_load(src); bq[u] = __builtin_nontemporal_load(src + 1);
                dsto[u] = ((size_t)((sb * 4 + h) * 32 + t)) * 32768 + 16384 + db * 4096 + key * 64 + ch * 16; }
#pragma unroll
            for (int u = 0; u < 4; ++u) { v4u o; o.x = pk2(a[u].x, a[u].y); o.y = pk2(a[u].z, a[u].w); o.z = pk2(bq[u].x, bq[u].y); o.w = pk2(bq[u].z, bq[u].w); *(GAS v4u*)(CI + dsto[u]) = o; } }
    }
    {   bf16* GW = (bf16*)(ws + WS_GATEW); float* sp8 = (float*)(ws + WS_SP8);
        const int gt = F.bx * 512 + F.tid, NT = F.G * 512;
        for (int i = gt; i < 2 * 8 * 64 * 64; i += NT) { const int g = i >> 15, n = (i >> 12) & 7, j = (i >> 6) & 63, c = i & 63;
            GW[i] = (bf16)f2bf((g == 0 ? fin(F, 22) : fin(F, 24))[(n * 64 + c) * 64 + j]); }
        for (int i = gt; i < 512; i += NT) { const float L = fin(F, 26)[i]; sp8[i] = 8.0f * (L > 20.f ? __expf(-L) : log1pf(__expf(-L))); }
    }
}

namespace lru {
constexpr int L_XC = 0;
constexpr int L_HIN = 65536;
constexpr int L_PART = 65536 + 2048;
constexpr int L_PAR = 135168;
constexpr int L_O0 = 65536 + 4096;
__device__ __forceinline__ int crow(int r, int hi) { return (r & 3) + 8 * (r >> 2) + 4 * hi; }
__device__ __forceinline__ float sigmoid_f(float x) { return __builtin_amdgcn_rcpf(1.0f + __builtin_amdgcn_exp2f(-x * LOG2E)); }

template <int CTRL, int RM> __device__ __forceinline__ float dpp_f(float oldv, float src) {
    return __builtin_bit_cast(float, __builtin_amdgcn_update_dpp(__builtin_bit_cast(int, oldv), __builtin_bit_cast(int, src), CTRL, RM, 0xF, false)); }
#define LRU_SCAN_STEP(CTRL, RM) do { const float ap_ = dpp_f<CTRL, RM>(1.0f, a), bp_ = dpp_f<CTRL, RM>(0.0f, b); b = a * bp_ + b; a = a * ap_; } while (0)
__device__ __forceinline__ float rl_half(float v, int hi) {
    return __builtin_bit_cast(float, __builtin_amdgcn_ds_bpermute((hi * 32 + 31) * 4, __builtin_bit_cast(int, v))); }
template <int PASS> __device__ __forceinline__ void lru_unit(Frame& F, int u) {
    int tid_ = F.tid; asm volatile("" : "+v"(tid_));
    const int tid = tid_, lane = tid & 63, wid = F.wave, r32 = lane & 31, hi = lane >> 5;
    const bool smp = u >= 512; const int sb = u - 512, pb = u >> 7, ck = smp ? 0 : (u & 127);
    const int row0 = smp ? TP + sb * 64 : pb * SEQ + ck * 64;
    const bf16* XR = (const bf16*)(F.ws + WS_XR); const bf16* XG = (const bf16*)(F.ws + WS_XG);
    LAS unsigned char* lds = F.lds;
    if (PASS == 2) {
        float h = 0.f;
        if (smp) h = fin(F, 4)[sb * 512 + tid];
        else { const float* S = (const float*)(F.ws + WS_LSUM) + ((size_t)(pb * 128) * 512 + tid) * 2;
            int c = 0;
            for (; c + 32 <= ck; c += 32) { float2 v[32];
#pragma unroll
                for (int k = 0; k < 32; ++k) v[k] = *(const float2*)(S + (size_t)(c + k) * 1024);
#pragma unroll
                for (int k = 0; k < 32; ++k) h = v[k].x * h + v[k].y; }
            for (; c + 8 <= ck; c += 8) { float2 v[8];
#pragma unroll
                for (int k = 0; k < 8; ++k) v[k] = *(const float2*)(S + (size_t)(c + k) * 1024);
#pragma unroll
                for (int k = 0; k < 8; ++k) h = v[k].x * h + v[k].y; }
            for (; c < ck; ++c) { const float2 v = *(const float2*)(S + (size_t)c * 1024); h = v.x * h + v.y; } }
        ((LAS float*)(lds + L_HIN))[tid] = h;
    }
    {   LAS float* par = (LAS float*)(lds + L_PAR);
        par[tid] = fin(F, 23)[tid]; par[512 + tid] = fin(F, 25)[tid]; par[1024 + tid] = ((const float*)(F.ws + WS_SP8))[tid]; if (PASS == 2) par[1536 + tid] = fin(F, 27)[tid]; }
    {   const int cg = tid & 63, tg = tid >> 6, c0 = 8 * cg;
        float xw[11][8];
#pragma unroll
        for (int i = 0; i < 11; ++i) { const int tt = 8 * tg + i - 3;
            if (tt >= 0 || ck > 0) { const v4u w = *(const GAS v4u*)(XR + (size_t)(row0 + tt) * 512 + c0);
                xw[i][0] = bflo(w.x); xw[i][1] = bfhi(w.x); xw[i][2] = bflo(w.y); xw[i][3] = bfhi(w.y); xw[i][4] = bflo(w.z); xw[i][5] = bfhi(w.z); xw[i][6] = bflo(w.w); xw[i][7] = bfhi(w.w); }
            else if (smp) { const float* sc = fin(F, 5) + (size_t)(sb * 3 + (tt + 3)) * 512 + c0; const f32x4 a = *(const f32x4*)sc, b = *(const f32x4*)(sc + 4);
                xw[i][0] = a[0]; xw[i][1] = a[1]; xw[i][2] = a[2]; xw[i][3] = a[3]; xw[i][4] = b[0]; xw[i][5] = b[1]; xw[i][6] = b[2]; xw[i][7] = b[3]; }
            else {
#pragma unroll
                for (int e = 0; e < 8; ++e) xw[i][e] = 0.f; } }
        float cw[4][8], cb[8];
#pragma unroll
        for (int j = 0; j < 4; ++j) { const f32x4 a = *(const f32x4*)(fin(F, 20) + j * 512 + c0), b = *(const f32x4*)(fin(F, 20) + j * 512 + c0 + 4);
            cw[j][0] = a[0]; cw[j][1] = a[1]; cw[j][2] = a[2]; cw[j][3] = a[3]; cw[j][4] = b[0]; cw[j][5] = b[1]; cw[j][6] = b[2]; cw[j][7] = b[3]; }
        { const f32x4 a = *(const f32x4*)(fin(F, 21) + c0), b = *(const f32x4*)(fin(F, 21) + c0 + 4); cb[0] = a[0]; cb[1] = a[1]; cb[2] = a[2]; cb[3] = a[3]; cb[4] = b[0]; cb[5] = b[1]; cb[6] = b[2]; cb[7] = b[3]; }
#pragma unroll
        for (int i = 0; i < 8; ++i) { const int t = 8 * tg + i; float xc[8];
#pragma unroll
            for (int e = 0; e < 8; ++e) xc[e] = cb[e] + cw[0][e] * xw[i][e] + cw[1][e] * xw[i + 1][e] + cw[2][e] * xw[i + 2][e] + cw[3][e] * xw[i + 3][e];
            v4u o; o.x = pk2(xc[0], xc[1]); o.y = pk2(xc[2], xc[3]); o.z = pk2(xc[4], xc[5]); o.w = pk2(xc[6], xc[7]);
            *(LAS v4u*)(lds + L_XC + t * 1024 + ((cg ^ (t & 15)) << 4)) = o; }
    }
    LDS_WAIT(); __syncthreads();
    const int n = wid;
    const bf16* GW = (const bf16*)(F.ws + WS_GATEW);
    float ssq_t[2] = {0.f, 0.f};
    float outv[2][16];
#pragma unroll
    for (int jb = 0; jb < 2; ++jb) {
        v2u gwv[4][2];
        if (PASS == 2) {
#pragma unroll
            for (int q4 = 0; q4 < 4; ++q4)
#pragma unroll
                for (int tb = 0; tb < 2; ++tb) gwv[q4][tb] = *(const GAS v2u*)(XG + (size_t)(row0 + tb * 32 + r32) * 512 + 64 * n + 32 * jb + 8 * q4 + 4 * hi); }
        f32x16 accr[2], acci[2];
#pragma unroll
        for (int tb = 0; tb < 2; ++tb) { accr[tb] = f32x16{}; acci[tb] = f32x16{}; }
#pragma unroll
        for (int ks = 0; ks < 4; ++ks) {
            const bf16x8 ar = *(const GAS bf16x8*)(GW + ((size_t)((0 * 8 + n) * 64 + jb * 32 + r32) * 64 + ks * 16 + hi * 8));
            const bf16x8 ax = *(const GAS bf16x8*)(GW + ((size_t)((1 * 8 + n) * 64 + jb * 32 + r32) * 64 + ks * 16 + hi * 8));
#pragma unroll
            for (int tb = 0; tb < 2; ++tb) { const int t = tb * 32 + r32; const int chunk = 8 * n + 2 * ks + hi;
                const bf16x8 bfr = *(const LAS bf16x8*)(lds + L_XC + t * 1024 + ((chunk ^ (t & 15)) << 4));
                accr[tb] = __builtin_amdgcn_mfma_f32_32x32x16_bf16(ar, bfr, accr[tb], 0, 0, 0);
                acci[tb] = __builtin_amdgcn_mfma_f32_32x32x16_bf16(ax, bfr, acci[tb], 0, 0, 0); }
        }
        float av[2][16], bv[2][16];
#pragma unroll
        for (int q4 = 0; q4 < 4; ++q4) {
            const int chb = 64 * n + 32 * jb + 8 * q4 + 4 * hi;
            const f32x4 ba = *(const LAS f32x4*)(lds + L_PAR + chb * 4), bx = *(const LAS f32x4*)(lds + L_PAR + 2048 + chb * 4), sp = *(const LAS f32x4*)(lds + L_PAR + 4096 + chb * 4);
#pragma unroll
            for (int tb = 0; tb < 2; ++tb) { const int t = tb * 32 + r32;
                const v2u xw = *(const LAS v2u*)(lds + L_XC + t * 1024 + ((((chb >> 3) ^ (t & 15)) << 4) | ((chb & 7) << 1)));
                const float xc[4] = {bflo(xw.x), bfhi(xw.x), bflo(xw.y), bfhi(xw.y)};
#pragma unroll
                for (int e = 0; e < 4; ++e) { const int r = 4 * q4 + e;
                    const float rg = sigmoid_f(accr[tb][r] + ba[e]), ig = sigmoid_f(acci[tb][r] + bx[e]);
                    const float a = __builtin_amdgcn_exp2f(-rg * sp[e] * LOG2E);
                    av[tb][r] = a; bv[tb][r] = __builtin_amdgcn_sqrtf(fmaxf(1.0f - a * a, 0.f)) * (ig * xc[e]); } }
        }
#pragma unroll
        for (int r = 0; r < 16; ++r) {
#pragma unroll
            for (int tb = 0; tb < 2; ++tb) {
                float a = av[tb][r], b = bv[tb][r];
                LRU_SCAN_STEP(0x111, 0xF); LRU_SCAN_STEP(0x112, 0xF); LRU_SCAN_STEP(0x114, 0xF); LRU_SCAN_STEP(0x118, 0xF);
                LRU_SCAN_STEP(0x142, 0xA);
                av[tb][r] = a; bv[tb][r] = b; }
            const float A0 = rl_half(av[0][r], hi), B0 = rl_half(bv[0][r], hi);
            bv[1][r] = av[1][r] * B0 + bv[1][r]; av[1][r] = av[1][r] * A0;
        }
        if (PASS == 1) {
            if (r32 == 31) { float* S = (float*)(F.ws + WS_LSUM) + (size_t)u * 1024;
#pragma unroll
                for (int r = 0; r < 16; ++r) { const int ch = 64 * n + 32 * jb + crow(r, hi); *(float2*)(S + 2 * ch) = make_float2(av[1][r], bv[1][r]); } }
        } else {
#pragma unroll
            for (int q4 = 0; q4 < 4; ++q4) { const int chb = 64 * n + 32 * jb + 8 * q4 + 4 * hi;
                const f32x4 hin = *(const LAS f32x4*)(lds + L_HIN + chb * 4);
#pragma unroll
                for (int tb = 0; tb < 2; ++tb) { const int t = tb * 32 + r32;
                    const v2u gw = gwv[q4][tb];
                    const float xg[4] = {bflo(gw.x), bfhi(gw.x), bflo(gw.y), bfhi(gw.y)};
#pragma unroll
                    for (int e = 0; e < 4; ++e) { const int r = 4 * q4 + e; const float h = av[tb][r] * hin[e] + bv[tb][r];
                        const float x = xg[e], uu = 0.7978845608028654f * (x + 0.044715f * x * x * x);
                        const float ge = x * __builtin_amdgcn_rcpf(1.0f + __builtin_amdgcn_exp2f(-2.0f * LOG2E * uu));
                        const float o = h * ge; ssq_t[tb] += o * o;
                        if (jb == 0) ((LAS float*)(lds + L_O0))[(wid * 32 + tb * 16 + r) * 64 + lane] = o; else outv[tb][r] = o;
                        if (tb == 1 && r32 == 31 && (smp || ck == 127)) { float* dst = smp ? F.out + O_LS + sb * 512 : F.out + O_LP + pb * 512; dst[chb + e] = h; } } } }
        }
        __builtin_amdgcn_sched_barrier(0);
    }
    if (PASS == 2) {
        LAS float* part = (LAS float*)(lds + L_PART);
#pragma unroll
        for (int tb = 0; tb < 2; ++tb) { float s = ssq_t[tb]; s += __shfl_xor(s, 32); if (hi == 0) part[wid * 64 + tb * 32 + r32] = s; }
        LDS_WAIT(); __syncthreads();
        bf16* CAT = (bf16*)(F.ws + WS_CAT);
#pragma unroll
        for (int tb = 0; tb < 2; ++tb) { const int t = tb * 32 + r32; float tot = 0.f;
#pragma unroll
            for (int w = 0; w < 8; ++w) tot += part[w * 64 + t];
            const float rn = __builtin_amdgcn_rsqf(tot * (1.0f / 512.0f) + EPS);
#pragma unroll
            for (int jb = 0; jb < 2; ++jb)
#pragma unroll
                for (int q4 = 0; q4 < 4; ++q4) { const int chb = 64 * n + 32 * jb + 8 * q4 + 4 * hi; const f32x4 gn = *(const LAS f32x4*)(lds + L_PAR + 6144 + chb * 4);
                    float ov[4];
#pragma unroll
                    for (int e = 0; e < 4; ++e) ov[e] = jb == 0 ? ((const LAS float*)(lds + L_O0))[(wid * 32 + tb * 16 + 4 * q4 + e) * 64 + lane] : outv[tb][4 * q4 + e];
                    v2u o; o.x = pk2(ov[0] * rn * gn[0], ov[1] * rn * gn[1]); o.y = pk2(ov[2] * rn * gn[2], ov[3] * rn * gn[3]);
                    *(GAS v2u*)(CAT + (size_t)(row0 + t) * 1024 + 512 + chb) = o; } }
    }
    LDS_WAIT(); __syncthreads();
}
}

#ifndef ATT_PROBE
#define ATT_PROBE 0
#endif
namespace att {
constexpr int SLOT = 32768, NSLOT = 4;
constexpr int A_RING = 0;
constexpr int A_EX = 0;
constexpr int A_TAB = 131072;
constexpr int A_WSF = 131072 + 1024;
constexpr int A_MISC = 143360;
__device__ __forceinline__ int crow(int r, int hi) { return (r & 3) + 8 * (r >> 2) + 4 * hi; }
__device__ __forceinline__ void glds16(const void* gsrc, unsigned lds_dst) { unsigned keep;
    asm volatile("s_mov_b32 %0, m0\n\ts_mov_b32 m0, %2\n\ts_nop 0\n\tglobal_load_lds_dwordx4 %1, off\n\ts_mov_b32 m0, %0" : "=&s"(keep) : "v"(gsrc), "s"(lds_dst) : "memory"); }
typedef __attribute__((address_space(3))) const char* lds_cptr;
typedef short v4i16_t __attribute__((ext_vector_type(4)));
__device__ __forceinline__ s16x4 vtr(lds_cptr p) { return __builtin_bit_cast(s16x4, __builtin_amdgcn_ds_read_tr16_b64_v4i16((__attribute__((address_space(3))) v4i16_t*)p)); }
__device__ __forceinline__ unsigned cvtpk(float lo, float hi) { typedef float f2 __attribute__((ext_vector_type(2))); typedef __bf16 b2 __attribute__((ext_vector_type(2)));
    f2 v = {lo, hi}; b2 b = __builtin_convertvector(v, b2); return __builtin_bit_cast(unsigned, b); }
#define ATT_WAIT_BAR(N) asm volatile("s_waitcnt vmcnt(" #N ") lgkmcnt(0)\n\ts_barrier" ::: "memory")

template <bool SMP, bool DESC> __device__ __forceinline__ void attn_unit(Frame& F, int sidx, int h, int qb, float lam) {
    int tid_ = F.tid; asm volatile("" : "+v"(tid_));
    const int tid = tid_, lane = tid & 63, wid = F.wave, r32 = lane & 31, hi = lane >> 5;
    const int comp = wid >> 2, g = wid & 3;
    LAS unsigned char* lds = F.lds;
    const unsigned lds0 = (unsigned)(uintptr_t)lds;
    const bf16* Qb = (const bf16*)(F.ws + WS_Q);
    const int qrow0 = SMP ? TP + sidx * 64 : sidx * SEQ + qb * 128;
    const int qpos0 = SMP ? PAST : qb * 128;
    const int NT = SMP ? 33 : 2 * qb + 2;
    const bool active = SMP ? (g < 2) : true;
    const int gq = SMP ? (g & 1) : g;
    const int qw = qpos0 + 32 * gq;
    const int t_last = active ? (qw >> 6) : -1;
    const int t_near0 = (qw - 90) > 0 ? ((qw - 90) >> 6) : 0;
    if (tid < 256) { float v = 0.f;
        if (tid >= 97 && tid <= 250) { const int delta = tid - 187; const int rel = delta < 0 ? -delta : delta; int bk;
            if (rel < 8) bk = rel; else { bk = 2 + (31 - __builtin_clz((unsigned)(rel * rel))); bk = bk > 15 ? 15 : bk; }
            if (delta > 0) bk += 16;
            v = (fin(F, 6)[bk * 4 + h] - fin(F, 6)[15 * 4 + h]) * LOG2E; }
        ((LAS float*)(lds + A_TAB))[tid] = v; }
    const unsigned char* img0 = SMP ? F.ws + WS_CK + (size_t)((sidx * 4 + h) * 32) * 32768 : F.ws + WS_KVP + (size_t)((sidx * 4 + h) * 128) * 32768;
    const unsigned char* imgn = F.ws + WS_KVS + (size_t)(sidx * 4 + h) * 32768;
    const unsigned poff = (unsigned)(wid * 1024 + lane * 16);
    const unsigned pdst = lds0 + A_RING + wid * 1024;
#define ATT_TILE(i) (DESC ? NT - 1 - (i) : (i))
#define ATT_ISSUE(i) do { const int i_ = (i); const int t_ = ATT_TILE(i_); const unsigned so_ = (unsigned)((i_ % NSLOT) * SLOT); \
        const unsigned char* src_ = ((SMP && t_ == 32) ? imgn : img0 + (size_t)t_ * 32768) + poff; \
        glds16(src_, (unsigned)__builtin_amdgcn_readfirstlane(pdst + so_)); \
        glds16(src_ + 8192, (unsigned)__builtin_amdgcn_readfirstlane(pdst + so_ + 8192)); \
        glds16(src_ + 16384, (unsigned)__builtin_amdgcn_readfirstlane(pdst + so_ + 16384)); \
        glds16(src_ + 24576, (unsigned)__builtin_amdgcn_readfirstlane(pdst + so_ + 24576)); } while (0)
    bf16x8 qr[4];
    { const bf16* Qw = Qb + (size_t)(qrow0 + 32 * gq + r32) * 512 + h * 128 + comp * 64;
#pragma unroll
      for (int d0 = 0; d0 < 4; ++d0) qr[d0] = *(const GAS bf16x8*)(Qw + d0 * 16 + hi * 8); }
    VM_WAIT();
    asm volatile("" : "+v"(qr[0]), "+v"(qr[1]), "+v"(qr[2]), "+v"(qr[3]));
#ifdef ATT_PRIO
    if (comp == ATT_PRIO - 1) __builtin_amdgcn_s_setprio(1);
#endif
    ATT_ISSUE(0); if (NT > 1) ATT_ISSUE(1);
    f32x16 o[4]; o[0] = f32x16{}; o[1] = f32x16{}; o[2] = f32x16{}; o[3] = f32x16{};
    float lsum = 0.f;
    const lds_cptr l3 = (lds_cptr)lds;
    const int kfo = A_RING + comp * 8192 + hi * 1024 + r32 * 16;
    const int vfo = A_RING + 16384 + ((lane >> 4) & 1) * 32 + (lane & 3) * 8 + (4 * hi + ((lane & 15) >> 2)) * 64;
    const int qposl = qw + r32;
    v4u pw[4]; bool have_p = false;
    int so_prev = 0;
#define ATT_VRD(j) do { vlo[j] = vtr(vp + ((j) >> 2) * 4096 + ((j) & 3) * 1024); vhi[j] = vtr(vp + ((j) >> 2) * 4096 + ((j) & 3) * 1024 + 512); } while (0)
#define ATT_VFR(j) (bf16x8){vlo[j][0], vlo[j][1], vlo[j][2], vlo[j][3], vhi[j][0], vhi[j][1], vhi[j][2], vhi[j][3]}
#define ATT_G2(j) do { if ((j) + 3 < 16) ATT_VRD((j) + 3); \
        o[(j) >> 2] = __builtin_amdgcn_mfma_f32_32x32x16_bf16(__builtin_bit_cast(bf16x8, pw[(j) & 3]), ATT_VFR(j), o[(j) >> 2], 0, 0, 0); __builtin_amdgcn_sched_barrier(0); } while (0)
#define ATT_QKEXP(t_, so_) do { f32x16 p0, p1; \
        if ((t_) >= t_near0) { const LAS float* tb = (const LAS float*)(lds + A_TAB) + (64 * (t_) + 4 * hi - qposl + 187);     \
            _Pragma("unroll") for (int r = 0; r < 16; ++r) { p0[r] = tb[(r & 3) + 8 * (r >> 2)]; p1[r] = tb[(r & 3) + 8 * (r >> 2) + 32]; } } \
        else { p0 = f32x16{}; p1 = f32x16{}; } \
        const lds_cptr kp = l3 + kfo + (so_); \
        _Pragma("unroll") for (int d0 = 0; d0 < 4; ++d0) { \
            const bf16x8 k0 = *(const __attribute__((address_space(3))) bf16x8*)(kp + d0 * 2048); \
            const bf16x8 k1 = *(const __attribute__((address_space(3))) bf16x8*)(kp + d0 * 2048 + 512); \
            p0 = __builtin_amdgcn_mfma_f32_32x32x16_bf16(k0, qr[d0], p0, 0, 0, 0); \
            p1 = __builtin_amdgcn_mfma_f32_32x32x16_bf16(k1, qr[d0], p1, 0, 0, 0); } \
        float sacc = 0.f; \
        _Pragma("unroll") for (int r = 0; r < 16; ++r) { p0[r] = __builtin_amdgcn_exp2f(p0[r]); p1[r] = __builtin_amdgcn_exp2f(p1[r]); sacc += p0[r] + p1[r]; } \
        lsum += sacc; \
        _Pragma("unroll") for (int k = 0; k < 2; ++k) { pw[k] = (v4u){cvtpk(p0[8 * k], p0[8 * k + 1]), cvtpk(p0[8 * k + 2], p0[8 * k + 3]), cvtpk(p0[8 * k + 4], p0[8 * k + 5]), cvtpk(p0[8 * k + 6], p0[8 * k + 7])}; \
                                      pw[2 + k] = (v4u){cvtpk(p1[8 * k], p1[8 * k + 1]), cvtpk(p1[8 * k + 2], p1[8 * k + 3]), cvtpk(p1[8 * k + 4], p1[8 * k + 5]), cvtpk(p1[8 * k + 6], p1[8 * k + 7])}; } } while (0)
#define ATT_PV(so_) do { const lds_cptr vp = l3 + vfo + (so_); s16x4 vlo[16], vhi[16]; ATT_VRD(0); ATT_VRD(1); ATT_VRD(2); __builtin_amdgcn_sched_barrier(0); \
        ATT_G2(0); ATT_G2(1); ATT_G2(2); ATT_G2(3); ATT_G2(4); ATT_G2(5); ATT_G2(6); ATT_G2(7); ATT_G2(8); ATT_G2(9); ATT_G2(10); ATT_G2(11); ATT_G2(12); ATT_G2(13); ATT_G2(14); ATT_G2(15); } while (0)
#define ATT_SYNC(it_) do { if ((it_) + 1 < NT) ATT_WAIT_BAR(4); else ATT_WAIT_BAR(0);     \
        if ((it_) + 2 < NT) ATT_ISSUE((it_) + 2); } while (0)
    const bool skew = comp == 1;
    for (int it = 0; it < NT; ++it) {
        const int t = ATT_TILE(it);
        if (skew) ATT_SYNC(it);
        if (have_p) { ATT_PV(so_prev); __builtin_amdgcn_sched_barrier(0); }
        if (!skew) ATT_SYNC(it);
        const int so = (it % NSLOT) * SLOT;
        have_p = (t <= t_last);
        if (have_p) { ATT_QKEXP(t, so); so_prev = so; }
    }
    if (have_p) { ATT_PV(so_prev); }
#undef ATT_SYNC
#undef ATT_VRD
#undef ATT_VFR
#undef ATT_G2
#undef ATT_QKEXP
#undef ATT_PV
#ifdef ATT_PRIO
    __builtin_amdgcn_s_setprio(0);
#endif
    int lane_e = lane; asm volatile("" : "+v"(lane_e));
    const int r32e = lane_e & 31, hie = lane_e >> 5;
    { auto rr = __builtin_amdgcn_permlane32_swap(__float_as_uint(lsum), __float_as_uint(lsum), false, false); lsum = __uint_as_float(rr[0]) + __uint_as_float(rr[1]); }
    LAS float* wsf = (LAS float*)(lds + A_WSF) + wid * 32;
    if (hie == 0) wsf[r32e] = lsum;
    ATT_WAIT_BAR(0);
    float rli[16];
#pragma unroll
    for (int r = 0; r < 16; ++r) rli[r] = __builtin_amdgcn_rcpf(wsf[crow(r, hie)]);
    LAS float* ex = (LAS float*)(lds + A_EX) + g * 4096;
    if (comp == 1) {
#pragma unroll
        for (int db = 0; db < 4; ++db)
#pragma unroll
            for (int r = 0; r < 16; ++r) ex[crow(r, hie) * 128 + db * 32 + r32e] = o[db][r] * (rli[r] * lam);
    }
    LDS_WAIT(); __syncthreads();
    if (comp == 0 && active) {
        float ss[16];
#pragma unroll
        for (int r = 0; r < 16; ++r) ss[r] = 0.f;
#pragma unroll
        for (int db = 0; db < 4; ++db)
#pragma unroll
            for (int r = 0; r < 16; ++r) { const float v = o[db][r] * rli[r] - ex[crow(r, hie) * 128 + db * 32 + r32e]; o[db][r] = v; ss[r] += v * v; }
#pragma unroll
        for (int r = 0; r < 16; ++r) { float s = ss[r];
#pragma unroll
            for (int m = 1; m < 32; m <<= 1) s += __shfl_xor(s, m);
            ss[r] = __builtin_amdgcn_rsqf(s * (1.0f / 128.0f) + EPS) * 0.8f; }
        LDS_WAIT();
        LAS unsigned short* stg = (LAS unsigned short*)ex;
#pragma unroll
        for (int db = 0; db < 4; ++db) { const float gn = fin(F, 19)[db * 32 + r32e];
#pragma unroll
            for (int r = 0; r < 16; ++r) stg[crow(r, hie) * 128 + db * 32 + r32e] = (unsigned short)f2bf(o[db][r] * ss[r] * gn); }
        LDS_WAIT();
        bf16* CAT = (bf16*)(F.ws + WS_CAT);
#pragma unroll
        for (int i = 0; i < 8; ++i) { const int row = i * 4 + (lane_e >> 4), ch = lane_e & 15;
            const v4u v = *(const LAS v4u*)(stg + row * 128 + ch * 8);
            *(GAS v4u*)(CAT + (size_t)(qrow0 + 32 * g + row) * 1024 + h * 128 + ch * 8) = v; }
    }
    VM_WAIT(); LDS_WAIT(); __syncthreads();
#undef ATT_ISSUE
#undef ATT_TILE
}
#undef ATT_WAIT_BAR
}

__device__ __forceinline__ void phase_p0(Frame& F) {
    unsigned char* ws = F.ws; (void)ws;
#ifndef NO_P0
    p0_prologue(F);
#endif
}

__device__ __forceinline__ void phase_g1(Frame& F) {
    unsigned char* ws = F.ws; (void)ws;
#ifndef NO_G1
    {   pg8::Gemm g{(const pg8::bf16_t*)(ws + WS_XB), (const pg8::bf16_t*)(ws + WS_W1GU), TT, 2 * FF, DM}; pg8::StreamK<false> S; S.init(TT, 2 * FF, DM, F.G, F.bx, (float*)(ws + WS_CAT), (unsigned*)(ws + WS_CTL) + CW_SK + 0 * 512);
        pg8::EpiSwiGLU<0> E{(pg8::bf16_t*)(ws + WS_H), (const float*)(ws + WS_RSTD0)};
        pg8::gemm_phase<pg8::EpiSwiGLU<0>, pg8::StreamK<false>, true, true>(F.lds, g, S, E); }
#endif
}

__device__ __forceinline__ void phase_g2(Frame& F) {
    unsigned char* ws = F.ws; (void)ws;
#ifndef NO_G2
    {   pg8::Gemm g{(const pg8::bf16_t*)(ws + WS_H), (const pg8::bf16_t*)(ws + WS_W1D), TT, DM, FF}; pg8::StreamK<true> S; S.init(TT, DM, FF, F.G, F.bx, (float*)(ws + WS_CAT), (unsigned*)(ws + WS_CTL) + CW_SK + 1 * 512);
        pg8::EpiResid<0> E{(pg8::bf16_t*)(ws + WS_XB), F.out, (float*)(ws + WS_SSQ1)};
        pg8::gemm_phase<pg8::EpiResid<0>, pg8::StreamK<true>, true, true>(F.lds, g, S, E); }
#endif
}

__device__ __forceinline__ void phase_g3(Frame& F) {
    unsigned char* ws = F.ws; (void)ws;
#ifndef NO_G3
    {   pg8::Gemm g{(const pg8::bf16_t*)(ws + WS_XB), (const pg8::bf16_t*)(ws + WS_WIN), TT, INW, DM}; pg8::StreamK<false> S; S.init(TT, INW, DM, F.G, F.bx, (float*)(ws + WS_CAT), (unsigned*)(ws + WS_CTL) + CW_SK + 2 * 512);
        pg8::EpiWin E{ws, F.out, fin(F, 13), fin(F, 14)};
        pg8::gemm_phase<pg8::EpiWin, pg8::StreamK<false>, true, true>(F.lds, g, S, E); }
#endif
}

__device__ __forceinline__ void phase_l1(Frame& F) {
    unsigned char* ws = F.ws; (void)ws;
#ifndef NO_L1
    for (int u = F.bx; u < 544; u += F.G) lru::lru_unit<1>(F, u);
#endif
}

__device__ __forceinline__ void phase_g5(Frame& F) {
    unsigned char* ws = F.ws; (void)ws;
#ifndef NO_G5
    {   pg8::Gemm g{(const pg8::bf16_t*)(ws + WS_CAT), (const pg8::bf16_t*)(ws + WS_WOUT), TT, DM, DM}; pg8::StreamK<true> S; S.init(TT, DM, DM, F.G, F.bx, (float*)(ws + WS_CK), (unsigned*)(ws + WS_CTL) + CW_SK + 3 * 512);
        pg8::EpiResid<1> E{(pg8::bf16_t*)(ws + WS_XB), F.out, (float*)(ws + WS_SSQ2)};
        pg8::gemm_phase<pg8::EpiResid<1>, pg8::StreamK<true>, true, true>(F.lds, g, S, E); }
#endif
}

__device__ __forceinline__ void phase_g6(Frame& F) {
    unsigned char* ws = F.ws; (void)ws;
#ifndef NO_G6
    {   pg8::Gemm g{(const pg8::bf16_t*)(ws + WS_XB), (const pg8::bf16_t*)(ws + WS_W2GU), TT, 2 * FF, DM}; pg8::StreamK<false> S; S.init(TT, 2 * FF, DM, F.G, F.bx, (float*)(ws + WS_CK), (unsigned*)(ws + WS_CTL) + CW_SK + 4 * 512);
        pg8::EpiSwiGLU<1> E{(pg8::bf16_t*)(ws + WS_H), (const float*)(ws + WS_SSQ2)};
        pg8::gemm_phase<pg8::EpiSwiGLU<1>, pg8::StreamK<false>, true, true>(F.lds, g, S, E); }
#endif
}

__device__ __forceinline__ void phase_g7(Frame& F) {
    unsigned char* ws = F.ws; (void)ws;
#ifndef NO_G7
    {   pg8::Gemm g{(const pg8::bf16_t*)(ws + WS_H), (const pg8::bf16_t*)(ws + WS_W2D), TT, DM, FF}; pg8::StreamK<true> S; S.init(TT, DM, FF, F.G, F.bx, (float*)(ws + WS_CK), (unsigned*)(ws + WS_CTL) + CW_SK + 5 * 512);
        pg8::EpiResid<2> E{(pg8::bf16_t*)(ws + WS_XB), F.out, nullptr};
        pg8::gemm_phase<pg8::EpiResid<2>, pg8::StreamK<true>, true, true>(F.lds, g, S, E); }
#endif
}

struct Args { const float* in[33]; float* out; unsigned char* ws; int pad0, pad1; };
__global__ void __launch_bounds__(512, 2) hymba_fwd(Args args) {
    extern __shared__ __attribute__((aligned(16))) unsigned char lds_raw[];
    cg::grid_group grid = cg::this_grid();
    Frame F;
    F.lds = (LAS unsigned char*)lds_raw;
    F.tid = threadIdx.x; F.lane = F.tid & 63; F.wave = __builtin_amdgcn_readfirstlane(F.tid >> 6);
    F.G = gridDim.x; F.bx = blockIdx.x;
    F.ka = (kptr_t)__builtin_amdgcn_kernarg_segment_ptr(); F.z = 0;
    F.out = args.out; F.ws = args.ws;
    unsigned char* ws = F.ws;
    unsigned* ctl = (unsigned*)(ws + WS_CTL);
    volatile LAS unsigned* MISCW = (volatile LAS unsigned*)(F.lds + 144384);
    if (F.tid < 16) MISCW[F.tid] = 0u;
    __syncthreads();
    XcdBarrier bar = xcd_barrier_post(ctl + CW_BAR, MISCW + 8);
#define GRID_BAR() do { xcd_barrier(bar); NEW_PHASE(); } while (0)
#define GRID_BAR_CG() do { __threadfence(); grid.sync(); NEW_PHASE(); } while (0)

    phase_p0(F);
#if defined(REP_P0)
    GRID_BAR(); phase_p0(F);
#endif
#ifdef USE_CG_SYNC
    GRID_BAR_CG();
#else
    GRID_BAR();
#endif
    phase_g1(F);
#if defined(REP_G1)
    GRID_BAR(); phase_g1(F);
#endif
    GRID_BAR();
    phase_g2(F);
#if defined(REP_G2)
    GRID_BAR(); phase_g2(F);
#endif
    GRID_BAR();
    phase_g3(F);
#if defined(REP_G3)
    GRID_BAR(); phase_g3(F);
#endif
    GRID_BAR();
    phase_l1(F);
#if defined(REP_L1)
    GRID_BAR(); phase_l1(F);
#endif
    GRID_BAR();
    {
        LAS float* misc = (LAS float*)(F.lds + att::A_MISC);
        if (F.wave == 0) { const float a = wave_sum(fin(F, 15)[F.lane] * fin(F, 16)[F.lane]), b = wave_sum(fin(F, 17)[F.lane] * fin(F, 18)[F.lane]);
            if (F.lane == 0) misc[0] = __expf(a) - __expf(b) + 0.2f; }
        __syncthreads();
        const float lam = misc[0];
        const int grp = F.bx & 7;
#ifdef ATT_TWICE
        for (int rep = 0; rep < 2; ++rep) {
        unsigned* head = ctl + CW_QUEUE + 64 * grp + 1024 * rep;
#else
        unsigned* head = ctl + CW_QUEUE + 64 * grp;
#endif
        const int wq = F.bx >> 3;
        if (F.G == 256) {
#ifndef NO_ATT
#pragma unroll 1
            for (int k = 0; k < 2; ++k) { const int st = grp + 8 * k;
                att::attn_unit<false, false>(F, st >> 2, st & 3, wq, lam);
                att::attn_unit<false, true>(F, st >> 2, st & 3, 63 - wq, lam); }
#endif
        }
        const int qbase = (F.G == 256) ? 128 : 0;
        for (;;) {
            if (F.tid == 0) ((LAS int*)misc)[1] = qbase + (int)atomicAdd(head, 1u);
            __syncthreads();
            const int it = ((LAS int*)misc)[1];
            __syncthreads();
            if (it >= 212) break;
#ifndef NO_ATT
            if (it < 128) { const int st = grp + 8 * (it >> 6), qb = 63 - (it & 63); att::attn_unit<false, false>(F, st >> 2, st & 3, qb, lam); }
            else if (it < 144) { const int su = grp * 16 + (it - 128); att::attn_unit<true, false>(F, su >> 2, su & 3, 0, lam); }
            else
#endif
#ifndef NO_L2
            { lru::lru_unit<2>(F, grp * 68 + (it - 144));
#ifdef L2_TWICE
              lru::lru_unit<2>(F, grp * 68 + (it - 144));
#endif
            }
#else
            {}
#endif
        }
#ifdef ATT_TWICE
        __syncthreads(); }
#endif
    }
    GRID_BAR();
    phase_g5(F);
#if defined(REP_G5)
    GRID_BAR(); phase_g5(F);
#endif
    GRID_BAR();
    phase_g6(F);
#if defined(REP_G6)
    GRID_BAR(); phase_g6(F);
#endif
    GRID_BAR();
    phase_g7(F);
#if defined(REP_G7)
    GRID_BAR(); phase_g7(F);
#endif
}

extern "C" void kernel_launch(void* const* d_in, const int* in_sizes, int n_in, void* d_out, int out_size, void* d_ws, size_t ws_size, hipStream_t stream) {
    static int grid = 0;
    if (grid == 0) {
        if (n_in != 33 || out_size != (int)O_END || ws_size < WS_END) { fprintf(stderr, "kernel_launch: unexpected shapes: n_in %d out %d ws %zu (need %zu)\n", n_in, out_size, ws_size, (size_t)WS_END); grid = -1; return; }
        int dev = 0, cus = 0, per_cu = 0;
        hipGetDevice(&dev); hipDeviceGetAttribute(&cus, hipDeviceAttributeMultiprocessorCount, dev);
        if (hipFuncSetAttribute((const void*)hymba_fwd, hipFuncAttributeMaxDynamicSharedMemorySize, LDS_BYTES) != hipSuccess) { fprintf(stderr, "kernel_launch: hipFuncSetAttribute failed\n"); grid = -1; return; }
        if (hipOccupancyMaxActiveBlocksPerMultiprocessor(&per_cu, (const void*)hymba_fwd, 512, LDS_BYTES) != hipSuccess || per_cu < 1) { fprintf(stderr, "kernel_launch: occupancy query says %d\n", per_cu); per_cu = 1; }
        (void)hipGetLastError();
        grid = cus * 1;
        if (grid % 8 != 0 || grid < 8) { fprintf(stderr, "kernel_launch: grid %d not a multiple of 8\n", grid); }
    }
    if (grid < 0) return;
    (void)hipMemsetAsync((char*)d_ws + WS_CTL, 0, CTL_ZERO_BYTES, stream);
    Args a{};
    for (int i = 0; i < 33; ++i) a.in[i] = (const float*)d_in[i];
    a.out = (float*)d_out; a.ws = (unsigned char*)d_ws;
    void* kargs[] = {&a};
    hipError_t e = hipLaunchCooperativeKernel((const void*)hymba_fwd, dim3(grid), dim3(512), kargs, LDS_BYTES, stream);
    if (e != hipSuccess) fprintf(stderr, "kernel_launch: cooperative launch failed: %s (grid %d)\n", hipGetErrorString(e), grid);
}
```

```cpp
#include <hip/hip_runtime.h>
#include <hip/hip_cooperative_groups.h>
#include <hip/hip_bf16.h>
#include <cstdio>
#include <cstdint>
namespace cg = cooperative_groups;

constexpr int DM = 1024, NBP = 4, SEQ = 8192, NBS = 32, DSQ = 64, PAST = 2048;
constexpr int TP = NBP * SEQ, TS = NBS * DSQ, TT = TP + TS;
constexpr int FF = 2816, AW = 512, LW = 512, INW = 2560, NH = 4, HD = 64, VD = 128;
constexpr float EPS = 1e-6f;
constexpr float LOG2E = 1.4426950408889634f;
constexpr float QSCALE = 0.125f * LOG2E;
constexpr size_t O_Y = 0, O_KP = (size_t)TT * DM, O_VP = O_KP + (size_t)TP * 512, O_LP = O_VP + (size_t)TP * 512, O_CP = O_LP + NBP * 512,
                 O_KS = O_CP + NBP * 3 * 512, O_VS = O_KS + (size_t)TS * 512, O_LS = O_VS + (size_t)TS * 512, O_CS = O_LS + NBS * 512, O_END = O_CS + NBS * 3 * 512;
static_assert(O_END == 71376896, "output size");
constexpr size_t OFF_SSQ1 = 44u << 20, OFF_Q = 121u << 20, OFF_KVP = (121u + 34u) << 20, OFF_KVS = (121u + 98u) << 20, OFF_XR = (121u + 102u) << 20, OFF_XG = (121u + 136u) << 20;
namespace pg8 {
#define PG8_LAS __attribute__((address_space(3)))
typedef unsigned short bf16_t;
typedef short bf16x8 __attribute__((ext_vector_type(8)));
typedef float f32x4 __attribute__((ext_vector_type(4)));
typedef unsigned u32x4 __attribute__((ext_vector_type(4)));
constexpr int BM = 256, BK = 64, HALF = 128, HTB = HALF * BK * 2  , STAGE_BYTES = 8 * HTB, NXCD = 8, WGM = 8;

__host__ __device__ __forceinline__ int lds_byte(int r, int c) { const int st = (r >> 4) * 2 + (c >> 5), rr = r & 15, cc = c & 31, ob = rr * 64 + cc * 2; return st * 1024 + (ob ^ (((ob >> 9) & 1) << 5)); }
__host__ __device__ __forceinline__ void stage_rc(int b, int& R, int& C) { const int st = b / 1024, sb = b % 1024, swz = sb ^ (((sb >> 9) & 1) << 5); R = (st >> 1) * 16 + swz / 64; C = (st & 1) * 32 + (swz % 64) / 2; }
__host__ __device__ __forceinline__ int perm32(int rho) { const int n = rho >> 4, i = rho & 15; return 8 * (i >> 2) + 4 * n + (i & 3); }

struct Unit { int pm, pn, kt0, nkt, kind; };
struct Gemm { const bf16_t* A; const bf16_t* Bt; int M, N, K; };

struct StaticOrder {
    static constexpr bool SPLIT = false;
    int nM, nN, nwg, G, c;
    __host__ __device__ void init(int M, int N, int G_, int c_) { nM = M / BM; nN = N / BM; nwg = nM * nN; G = G_; c = c_; }
    __host__ __device__ bool next(int i, Unit& u) const {
        const long L = (long)i * G + c; if (L >= nwg) return false;
        int wgid = (int)L; { const int q = nwg / NXCD, r = nwg % NXCD, xcd = wgid % NXCD, off = wgid / NXCD; wgid = (xcd < r ? xcd * (q + 1) : r * (q + 1) + (xcd - r) * q) + off; }
        const int nig = WGM * nN, gid = wgid / nig, fm = gid * WGM, gsz = (nM - fm) < WGM ? (nM - fm) : WGM;
        u.pm = fm + ((wgid % nig) % gsz); u.pn = (wgid % nig) / gsz; u.kt0 = 0; u.nkt = nkt; u.kind = 0; return true;
    }
    int nkt;
    __device__ __forceinline__ void a_ready(const Unit&) const {}
    __device__ __forceinline__ void done(const Unit&) const {}
    __device__ __forceinline__ void put_partial(const f32x4 (&)[2][2][4][2], int, int) const {}
    __device__ __forceinline__ void load_partial(f32x4 (&)[2][2][4][2], int, int) const {}
};


template <int MODE  > struct StreamK {
    static constexpr bool SPLIT = MODE != 0;
    int nM, nN, P, W, x, w, q, R1, Dq; long lo, hi; int v; float* slab; unsigned* flag;
    __device__ void init(int M, int N, int K, int G_, int bx, float* slab_, unsigned* flag_) { nM = M / BM; nN = N / BM; P = K / (2 * BK); W = G_ / NXCD; x = bx % NXCD; w = bx / NXCD;
        const int nwg = nM * nN; q = nwg / NXCD;
        if (!SPLIT) { R1 = (nwg + G_ - 1) / G_; Dq = q; } else { R1 = nwg / G_ - 1; Dq = R1 * W; }
        const long tot = (long)(q - Dq) * P; lo = tot * w / W; hi = tot * (w + 1) / W; v = x * W + w; slab = slab_; flag = flag_; }
    __device__ bool next(int i, Unit& u) const {
        int L; int j = i, k = -1;
        if (MODE == 2 && (lo % P) != 0) { if (i == 0) k = 0; else j = i - 1; }
        if (k < 0 && j >= R1) { if (!SPLIT) return false; k = j - R1 + ((MODE == 2 && (lo % P) != 0) ? 1 : 0); }
        if (k < 0) { L = x * q + j * W + w; u.kt0 = 0; u.nkt = 2 * P; u.kind = 0; if (!SPLIT && j * W + w >= q) return false; }
        else { const long u0 = lo / P; const long base = (u0 + k) * P; const long start = (k == 0) ? lo - base : 0; if (base + start >= hi) return false;
            const long end = (hi - base) < P ? (hi - base) : P;
            L = x * q + Dq + (int)(u0 + k); u.kt0 = (int)(2 * start); u.nkt = (int)(2 * (end - start)); u.kind = start > 0 ? 1 : (end < P ? 2 : 0); }
        const int nig = WGM * nN, gid = L / nig, fm = gid * WGM, gsz = (nM - fm) < WGM ? (nM - fm) : WGM;
        u.pm = fm + ((L % nig) % gsz); u.pn = (L % nig) / gsz; return true;
    }
    __device__ __forceinline__ void a_ready(const Unit&) const {}
    __device__ __forceinline__ void done(const Unit&) const {}
    __device__ __forceinline__ void put_partial(const f32x4 (&acc)[2][2][4][2], int tid, int lane) const {
        f32x4* dst = (f32x4*)slab + (size_t)v * (32 * 512) + tid;
#pragma unroll
        for (int ai = 0; ai < 2; ++ai)
#pragma unroll
            for (int bj = 0; bj < 2; ++bj)
#pragma unroll
                for (int m = 0; m < 4; ++m)
#pragma unroll
                    for (int n = 0; n < 2; ++n) { const f32x4 val = acc[ai][bj][m][n];
                        asm volatile("global_store_dwordx4 %0, %1, off sc1\n\ts_nop 1" :: "v"(dst), "v"(val) : "memory");
                        dst += 512; asm volatile("" : "+v"(dst)); }
        asm volatile("s_waitcnt vmcnt(0)" ::: "memory");
        if (lane == 0) __hip_atomic_fetch_add(flag + v, 1u, __ATOMIC_RELAXED, __HIP_MEMORY_SCOPE_AGENT);
    }
    __device__ __forceinline__ void load_partial(f32x4 (&acc)[2][2][4][2], int tid, int lane) const {
        unsigned spins = 0;
        while ((unsigned)__builtin_amdgcn_readfirstlane(__hip_atomic_load(flag + v + 1, __ATOMIC_RELAXED, __HIP_MEMORY_SCOPE_AGENT)) < 8u) { __builtin_amdgcn_s_sleep(2); if (++spins > (1u << 22)) break; }
        __builtin_amdgcn_fence(__ATOMIC_ACQUIRE, "agent");
        const f32x4* src = (const f32x4*)slab + (size_t)(v + 1) * (32 * 512) + tid;
#pragma unroll
        for (int ai = 0; ai < 2; ++ai)
#pragma unroll
            for (int bj = 0; bj < 2; ++bj)
#pragma unroll
                for (int m = 0; m < 4; ++m)
#pragma unroll
                    for (int n = 0; n < 2; ++n) { acc[ai][bj][m][n] = *src; src += 512; asm volatile("" : "+v"(src)); }
    }
};

__device__ __forceinline__ unsigned cvt_pk_bf16(float lo, float hi) { unsigned r; asm volatile("v_cvt_pk_bf16_f32 %0, %1, %2" : "=v"(r) : "v"(lo), "v"(hi)); return r; }
__device__ __forceinline__ u32x4 pack8(const f32x4& a, const f32x4& b) { u32x4 w; w.x = cvt_pk_bf16(a[0], a[1]); w.y = cvt_pk_bf16(a[2], a[3]); w.z = cvt_pk_bf16(b[0], b[1]); w.w = cvt_pk_bf16(b[2], b[3]); return w; }
__device__ __forceinline__ float silu_f(float g) { return g * __builtin_amdgcn_rcpf(1.0f + __builtin_amdgcn_exp2f(-g * 1.4426950408889634f)); }
__device__ __forceinline__ float rstd_from_ssq(const float* ssq, int row, int fq) {
    const f32x4 p = *(const f32x4*)(ssq + (size_t)row * 16 + 4 * fq);
    float s = (p[0] + p[1]) + (p[2] + p[3]); s += __shfl_xor(s, 16); s += __shfl_xor(s, 32);
    return __builtin_amdgcn_rsqf(s * (1.0f / 1024.0f) + 1e-6f);
}
#ifndef EPI_TWICE
#define EPI_TWICE 0
#endif
template <int RSMODE  > struct EpiSwiGLU {
    static constexpr bool PERM = true, AFTER_DRAIN = false, TWICE_OK = (EPI_TWICE == 1);
    bf16_t* H; const float* rs;
    __device__ __forceinline__ void operator()(const f32x4 (&acc)[2][2][4][2], const Unit& u, int wr, int wc, int fr, int fq) const {
        const int row0 = u.pm * BM + wr * 64 + fr, col0 = u.pn * 128 + wc * 32 + 8 * fq;
#pragma unroll
        for (int ai = 0; ai < 2; ++ai)
#pragma unroll
            for (int m = 0; m < 4; ++m) { const int row = row0 + ai * HALF + m * 16;
                const float s = RSMODE == 0 ? rs[row] : rstd_from_ssq(rs, row, fq);
                f32x4 h0, h1;
#pragma unroll
                for (int e = 0; e < 4; ++e) { h0[e] = silu_f(acc[ai][0][m][0][e] * s) * (acc[ai][1][m][0][e] * s); h1[e] = silu_f(acc[ai][0][m][1][e] * s) * (acc[ai][1][m][1][e] * s); }
                *(u32x4*)(H + (size_t)row * 2816 + col0) = pack8(h0, h1); }
    }
};
__device__ __forceinline__ f32x4 bf4lo(const u32x4& w) { f32x4 r; r[0] = __builtin_bit_cast(float, w.x << 16); r[1] = __builtin_bit_cast(float, w.x & 0xffff0000u); r[2] = __builtin_bit_cast(float, w.y << 16); r[3] = __builtin_bit_cast(float, w.y & 0xffff0000u); return r; }
__device__ __forceinline__ f32x4 bf4hi(const u32x4& w) { f32x4 r; r[0] = __builtin_bit_cast(float, w.z << 16); r[1] = __builtin_bit_cast(float, w.z & 0xffff0000u); r[2] = __builtin_bit_cast(float, w.w << 16); r[3] = __builtin_bit_cast(float, w.w & 0xffff0000u); return r; }
template <int KIND> struct EpiResid {
    static constexpr bool PERM = true, AFTER_DRAIN = false, TWICE_OK = (EPI_TWICE == 3 && KIND == 2);
    bf16_t* xb; float* out; float* ssq;
    __device__ __forceinline__ void operator()(const f32x4 (&acc)[2][2][4][2], const Unit& u, int wr, int wc, int fr, int fq) const {
        const int row0 = u.pm * BM + wr * 64 + fr, col0 = u.pn * BM + wc * 32 + 8 * fq;
        const float sc = KIND == 1 ? 1.0f : 0.5f;
        u32x4 r0 = *(const u32x4*)(xb + (size_t)row0 * 1024 + col0), r1 = *(const u32x4*)(xb + (size_t)row0 * 1024 + col0 + HALF);
#pragma unroll
        for (int ai = 0; ai < 2; ++ai)
#pragma unroll
            for (int m = 0; m < 4; ++m) { const int row = row0 + ai * HALF + m * 16;
                const u32x4 c0 = r0, c1 = r1;
                if (ai * 4 + m < 7) { const int nrow = row0 + ((ai * 4 + m + 1) >> 2) * HALF + ((ai * 4 + m + 1) & 3) * 16;
                    r0 = *(const u32x4*)(xb + (size_t)nrow * 1024 + col0); r1 = *(const u32x4*)(xb + (size_t)nrow * 1024 + col0 + HALF); }
                const f32x4 v00 = bf4lo(c0) + acc[ai][0][m][0] * sc, v01 = bf4hi(c0) + acc[ai][0][m][1] * sc, v10 = bf4lo(c1) + acc[ai][1][m][0] * sc, v11 = bf4hi(c1) + acc[ai][1][m][1] * sc;
                if (KIND < 2) {
                    *(u32x4*)(xb + (size_t)row * 1024 + col0) = pack8(v00, v01); *(u32x4*)(xb + (size_t)row * 1024 + col0 + HALF) = pack8(v10, v11);
                    float ss = (v00[0] * v00[0] + v00[1] * v00[1]) + (v00[2] * v00[2] + v00[3] * v00[3]) + (v01[0] * v01[0] + v01[1] * v01[1]) + (v01[2] * v01[2] + v01[3] * v01[3]);
                    ss += (v10[0] * v10[0] + v10[1] * v10[1]) + (v10[2] * v10[2] + v10[3] * v10[3]) + (v11[0] * v11[0] + v11[1] * v11[1]) + (v11[2] * v11[2] + v11[3] * v11[3]);
                    ss += __shfl_xor(ss, 16); ss += __shfl_xor(ss, 32); if (fq == 0) ssq[(size_t)row * 16 + u.pn * 4 + wc] = ss;
                } else { float* orow = out + (size_t)row * 1024 + col0;
                    *(f32x4*)orow = v00; *(f32x4*)(orow + 4) = v01; *(f32x4*)(orow + HALF) = v10; *(f32x4*)(orow + HALF + 4) = v11; } }
    }
};
struct EpiWinPtrs { const float* ssq1; bf16_t* Q; unsigned char *KVP, *KVS; bf16_t *XR, *XG; float* out; const float *gq, *gk; };
__device__ __forceinline__ unsigned char* tile_of(const EpiWinPtrs& P, int row, int h, int& key) {
    if (row < 32768) { const int pos = row & 8191; key = pos & 63; return P.KVP + (size_t)((((row >> 13) * 4 + h) * 128) + (pos >> 6)) * 32768; }
    const int r2 = row - 32768; key = r2 & 63; return P.KVS + (size_t)((r2 >> 6) * 4 + h) * 32768; }
template <int KIND> __device__ __forceinline__ void win_qk(const EpiWinPtrs P, const f32x4 (&acc)[2][2][4][2], const Unit& u, int wr, int wc, int fr, int fq) {
    const int row0 = u.pm * BM + wr * 64 + fr, half = u.pn & 1;
    const float* gp = KIND == 0 ? P.gq : P.gk; const float qs = KIND == 0 ? 0.125f * 1.4426950408889634f : 1.0f;
    const f32x4 g00 = *(const f32x4*)(gp + 8 * fq) * qs, g01 = *(const f32x4*)(gp + 8 * fq + 4) * qs, g10 = *(const f32x4*)(gp + 32 + 8 * fq) * qs, g11 = *(const f32x4*)(gp + 32 + 8 * fq + 4) * qs;
    const int cbase = 256 * half + 64 * wc + 8 * fq;
#pragma unroll
    for (int ai = 0; ai < 2; ++ai)
#pragma unroll
        for (int m = 0; m < 4; ++m) { const int row = row0 + ai * HALF + m * 16; const float rs = rstd_from_ssq(P.ssq1, row, fq);
            const f32x4 v00 = acc[ai][0][m][0] * rs, v01 = acc[ai][0][m][1] * rs, v10 = acc[ai][1][m][0] * rs, v11 = acc[ai][1][m][1] * rs;
            float ss = (v00[0] * v00[0] + v00[1] * v00[1]) + (v00[2] * v00[2] + v00[3] * v00[3]);
            ss += (v01[0] * v01[0] + v01[1] * v01[1]) + (v01[2] * v01[2] + v01[3] * v01[3]);
            ss += (v10[0] * v10[0] + v10[1] * v10[1]) + (v10[2] * v10[2] + v10[3] * v10[3]);
            ss += (v11[0] * v11[0] + v11[1] * v11[1]) + (v11[2] * v11[2] + v11[3] * v11[3]);
            ss += __shfl_xor(ss, 16); ss += __shfl_xor(ss, 32);
            const float rn = __builtin_amdgcn_rsqf(ss * (1.0f / 64.0f) + 1e-6f);
            const f32x4 a0 = v00 * rn * g00, b0 = v01 * rn * g01, a1 = v10 * rn * g10, b1 = v11 * rn * g11;
            if (KIND == 0) { *(u32x4*)(P.Q + (size_t)row * 512 + cbase) = pack8(a0, b0); *(u32x4*)(P.Q + (size_t)row * 512 + cbase + 32) = pack8(a1, b1); }
            else { float* o = (row < 32768 ? P.out + 35651584 + (size_t)row * 512 : P.out + 69214208 + (size_t)(row - 32768) * 512) + cbase;
                *(f32x4*)o = a0; *(f32x4*)(o + 4) = b0; *(f32x4*)(o + 32) = a1; *(f32x4*)(o + 36) = b1;
                int key; unsigned char* tb = tile_of(P, row, 2 * half + (wc >> 1), key) + (wc & 1) * 8192 + fq * 1024 + key * 16;
                *(u32x4*)tb = pack8(a0, b0); *(u32x4*)(tb + 4096) = pack8(a1, b1); }
            asm volatile("" ::: "memory"); }
}
template <int KIND> __device__ __forceinline__ void win_plain(const EpiWinPtrs P, const f32x4 (&acc)[2][2][4][2], const Unit& u, int wr, int wc, int fr, int fq) {
    const int row0 = u.pm * BM + wr * 64 + fr, half = u.pn & 1;
    const int cbase = 256 * half + 32 * wc + 8 * fq;
    bf16_t* dst = KIND == 3 ? P.XR : P.XG;
#pragma unroll
    for (int ai = 0; ai < 2; ++ai)
#pragma unroll
        for (int m = 0; m < 4; ++m) { const int row = row0 + ai * HALF + m * 16; const float rs = rstd_from_ssq(P.ssq1, row, fq);
#pragma unroll
            for (int bj = 0; bj < 2; ++bj) { const f32x4 a = acc[ai][bj][m][0] * rs, b = acc[ai][bj][m][1] * rs; const int c = cbase + 128 * bj;
                if (KIND == 2) { int key; unsigned char* tb = tile_of(P, row, 2 * half + bj, key) + 16384 + wc * 4096 + key * 64 + fq * 16; *(u32x4*)tb = pack8(a, b); }
                else *(u32x4*)(dst + (size_t)row * 512 + c) = pack8(a, b);
                if (KIND == 2) { float* o = (row < 32768 ? P.out + 52428800 + (size_t)row * 512 : P.out + 70262784 + (size_t)(row - 32768) * 512) + c; *(f32x4*)o = a; *(f32x4*)(o + 4) = b; }
                if (KIND == 3) {
                    if (row < 32768) { const int t = row & 8191; if (t >= 8189) { float* o = P.out + 69208064 + (size_t)((row >> 13) * 3 + (t - 8189)) * 512 + c; *(f32x4*)o = a; *(f32x4*)(o + 4) = b; } }
                    else { const int t = (row - 32768) & 63; if (t >= 61) { float* o = P.out + 71327744 + (size_t)(((row - 32768) >> 6) * 3 + (t - 61)) * 512 + c; *(f32x4*)o = a; *(f32x4*)(o + 4) = b; } } } }
            asm volatile("" ::: "memory"); }
}
struct EpiWin {
    static constexpr bool PERM = true, AFTER_DRAIN = false, TWICE_OK = (EPI_TWICE == 2);
    unsigned char* wsb; float* out; const float *gq, *gk;
    __device__ __forceinline__ void operator()(const f32x4 (&acc)[2][2][4][2], const Unit& u, int wr, int wc, int fr, int fq) const {
        unsigned char* w = wsb; asm volatile("" : "+s"(w));
        const EpiWinPtrs P{(const float*)(w + OFF_SSQ1), (bf16_t*)(w + OFF_Q), w + OFF_KVP, w + OFF_KVS, (bf16_t*)(w + OFF_XR), (bf16_t*)(w + OFF_XG), out, gq, gk};
        const int kind = u.pn >> 1;
        if (kind == 0) win_qk<0>(P, acc, u, wr, wc, fr, fq);
        else if (kind == 1) win_qk<1>(P, acc, u, wr, wc, fr, fq);
        else if (kind == 2) win_plain<2>(P, acc, u, wr, wc, fr, fq);
        else if (kind == 3) win_plain<3>(P, acc, u, wr, wc, fr, fq);
        else win_plain<4>(P, acc, u, wr, wc, fr, fq);
    }
};
template <class Epi, class Sched, bool ALIGN_EPI = false, bool SP2 = false>
__device__ __forceinline__ void gemm_phase(PG8_LAS unsigned char* lds, const Gemm g, const Sched& S, const Epi& E) {
    int tid_ = threadIdx.x; asm volatile("" : "+v"(tid_));
    const int tid = tid_, wid = __builtin_amdgcn_readfirstlane(tid >> 6), lane = tid & 63, wr = wid >> 2, wc = wid & 3, fr = lane & 15, fq = lane >> 4;
    const int K = g.K;
    unsigned voffA[2], voffB[2];
#pragma unroll
    for (int i = 0; i < 2; ++i) { int R, C; stage_rc(tid * 16 + i * 8192, R, C); const int Rb = Epi::PERM ? ((R & ~31) + perm32(R & 31)) : R;
        voffA[i] = (unsigned)(R * K + C) * 2u; voffB[i] = (unsigned)(Rb * K + C) * 2u; }
    const size_t kstep = (size_t)(BK * 2);
    const size_t hstep = (size_t)HALF * K * 2;
    const size_t tstep = 2 * hstep;
    const unsigned ldsw = (unsigned)wid * 1024u;
    const int aoff = lds_byte(wr * 64 + fr, fq * 8), boff = lds_byte(wc * 32 + fr, fq * 8);
#define PG8_SA(b, h) (((b) * 2 + (h)) * HTB)
#define PG8_SB(b, h) ((4 + (b) * 2 + (h)) * HTB)
#define PG8_STAGE(bufoff, gbase, voff) do { _Pragma("unroll") for (int _i = 0; _i < 2; ++_i) \
        __builtin_amdgcn_global_load_lds((const unsigned*)((const char*)(gbase) + (voff)[_i]), (PG8_LAS unsigned*)(lds + (bufoff) + ldsw + _i * 8192), 16, 0, 0); } while (0)
#define PG8_LDA(dst, b, h) do { _Pragma("unroll") for (int m = 0; m < 4; ++m) _Pragma("unroll") for (int k = 0; k < 2; ++k) dst[m][k] = *(const PG8_LAS bf16x8*)(lds + PG8_SA(b, h) + aoff + m * 2048 + k * 1024); } while (0)
#define PG8_LDB(dst, b, h) do { _Pragma("unroll") for (int n = 0; n < 2; ++n) _Pragma("unroll") for (int k = 0; k < 2; ++k) dst[n][k] = *(const PG8_LAS bf16x8*)(lds + PG8_SB(b, h) + boff + n * 2048 + k * 1024); } while (0)
#define PG8_MMA(ai, bj, At, Bt) do { __builtin_amdgcn_s_setprio(1); _Pragma("unroll") for (int m = 0; m < 4; ++m) _Pragma("unroll") for (int n = 0; n < 2; ++n) _Pragma("unroll") for (int k = 0; k < 2; ++k) \
        acc[ai][bj][m][n] = __builtin_amdgcn_mfma_f32_16x16x32_bf16(Bt[n][k], At[m][k], acc[ai][bj][m][n], 0, 0, 0); __builtin_amdgcn_s_setprio(0); } while (0)
#define PG8_WAIT_V(n) asm volatile("s_waitcnt vmcnt(" #n ")" ::: "memory")
#define PG8_WAIT_L(n) asm volatile("s_waitcnt lgkmcnt(" #n ")" ::: "memory")
#define PG8_BAR __builtin_amdgcn_s_barrier()
#define PG8_SCHED __builtin_amdgcn_sched_barrier(0)
    Unit cur, nxt; int ui = 0;
    if (!S.next(0, cur)) return;
    f32x4 acc[2][2][4][2];
#pragma unroll
    for (int a = 0; a < 2; ++a)
#pragma unroll
        for (int b = 0; b < 2; ++b)
#pragma unroll
            for (int m = 0; m < 4; ++m)
#pragma unroll
                for (int n = 0; n < 2; ++n) acc[a][b][m][n] = (f32x4){0.f, 0.f, 0.f, 0.f};
    bf16x8 At[4][2], B0[2][2], B1[2][2];
    const char* cA = (const char*)g.A + (size_t)cur.pm * tstep + (Sched::SPLIT ? (size_t)cur.kt0 * kstep : (size_t)0); const char* cB = (const char*)g.Bt + (size_t)cur.pn * tstep + (Sched::SPLIT ? (size_t)cur.kt0 * kstep : (size_t)0);
    S.a_ready(cur);
    if constexpr (SP2) {
        PG8_STAGE(PG8_SB(0, 0), cB, voffB); PG8_STAGE(PG8_SB(0, 1), cB + hstep, voffB); PG8_STAGE(PG8_SA(0, 0), cA, voffA); PG8_STAGE(PG8_SA(0, 1), cA + hstep, voffA);
        if (wr == 1) PG8_BAR;
        PG8_WAIT_V(2); PG8_BAR;
        PG8_STAGE(PG8_SB(1, 0), cB + kstep, voffB); PG8_STAGE(PG8_SA(1, 0), cA + kstep, voffA); PG8_STAGE(PG8_SB(1, 1), cB + hstep + kstep, voffB);
        PG8_WAIT_V(6); PG8_BAR;
    } else {
        PG8_STAGE(PG8_SB(0, 0), cB, voffB); PG8_STAGE(PG8_SA(0, 0), cA, voffA); PG8_STAGE(PG8_SB(0, 1), cB + hstep, voffB); PG8_STAGE(PG8_SA(0, 1), cA + hstep, voffA);
        if (wr == 1) PG8_BAR;
        PG8_WAIT_V(4); PG8_BAR;
        PG8_STAGE(PG8_SB(1, 0), cB + kstep, voffB); PG8_STAGE(PG8_SA(1, 0), cA + kstep, voffA); PG8_STAGE(PG8_SB(1, 1), cB + hstep + kstep, voffB);
        PG8_WAIT_V(6); PG8_BAR;
    }
    for (;;) {
        const bool has_next = S.next(ui + 1, nxt);
        const char* nA = has_next ? (const char*)g.A + (size_t)nxt.pm * tstep + (Sched::SPLIT ? (size_t)nxt.kt0 * kstep : (size_t)0) : cA; const char* nB = has_next ? (const char*)g.Bt + (size_t)nxt.pn * tstep + (Sched::SPLIT ? (size_t)nxt.kt0 * kstep : (size_t)0) : cB;
        const int nt = Sched::SPLIT ? cur.nkt : K / BK;
        for (int t = 0; t < nt; t += 2) {
            const bool last = (t == nt - 2);
            const char* a1 = cA + (size_t)(t + 1) * kstep;
            const char* a2 = last ? nA : cA + (size_t)(t + 2) * kstep; const char* b2 = last ? nB : cB + (size_t)(t + 2) * kstep;
            const char* a3 = a2 + kstep; const char* b3 = b2 + kstep;
            if (last && has_next) S.a_ready(nxt);
            if constexpr (SP2) {
            PG8_LDB(B0, 0, 0); PG8_LDB(B1, 0, 1); PG8_SCHED; PG8_LDA(At, 0, 0); PG8_STAGE(PG8_SA(1, 1), a1 + hstep, voffA);
            PG8_WAIT_V(8); PG8_WAIT_L(0); PG8_BAR; PG8_MMA(0, 0, At, B0); PG8_MMA(0, 1, At, B1); PG8_BAR; PG8_SCHED;
            PG8_LDA(At, 0, 1); PG8_STAGE(PG8_SB(0, 0), b2, voffB); PG8_STAGE(PG8_SB(0, 1), b2 + hstep, voffB); PG8_STAGE(PG8_SA(0, 0), a2, voffA);
            PG8_WAIT_V(8); PG8_WAIT_L(0); PG8_BAR; PG8_MMA(1, 0, At, B0); PG8_MMA(1, 1, At, B1); PG8_BAR; PG8_SCHED;
            PG8_LDB(B0, 1, 0); PG8_LDB(B1, 1, 1); PG8_SCHED; PG8_LDA(At, 1, 0); PG8_STAGE(PG8_SA(0, 1), a2 + hstep, voffA);
            PG8_WAIT_V(8); PG8_WAIT_L(0); PG8_BAR; PG8_MMA(0, 0, At, B0); PG8_MMA(0, 1, At, B1); PG8_BAR; PG8_SCHED;
            PG8_LDA(At, 1, 1); PG8_STAGE(PG8_SB(1, 0), b3, voffB); PG8_STAGE(PG8_SB(1, 1), b3 + hstep, voffB); PG8_STAGE(PG8_SA(1, 0), a3, voffA);
            PG8_WAIT_V(8); PG8_WAIT_L(0); PG8_BAR; PG8_MMA(1, 0, At, B0); PG8_MMA(1, 1, At, B1); PG8_BAR; PG8_SCHED;
            } else {
            PG8_LDB(B0, 0, 0); PG8_SCHED; PG8_LDA(At, 0, 0); PG8_STAGE(PG8_SA(1, 1), a1 + hstep, voffA);
            PG8_WAIT_L(8); PG8_BAR; PG8_WAIT_L(0); PG8_MMA(0, 0, At, B0); PG8_BAR; PG8_SCHED;
            PG8_LDB(B1, 0, 1); PG8_STAGE(PG8_SB(0, 0), b2, voffB);
            PG8_BAR; PG8_WAIT_L(0); PG8_MMA(0, 1, At, B1); PG8_BAR;
            PG8_LDA(At, 0, 1); PG8_STAGE(PG8_SA(0, 0), a2, voffA);
            PG8_BAR; PG8_WAIT_L(0); PG8_MMA(1, 0, At, B0); PG8_BAR; PG8_SCHED;
            PG8_STAGE(PG8_SB(0, 1), b2 + hstep, voffB);
            PG8_WAIT_V(6); PG8_BAR; PG8_MMA(1, 1, At, B1); PG8_BAR;
            PG8_LDB(B0, 1, 0); PG8_SCHED; PG8_LDA(At, 1, 0); PG8_STAGE(PG8_SA(0, 1), a2 + hstep, voffA);
            PG8_WAIT_L(8); PG8_BAR; PG8_WAIT_L(0); PG8_MMA(0, 0, At, B0); PG8_BAR; PG8_SCHED;
            PG8_LDB(B1, 1, 1); PG8_STAGE(PG8_SB(1, 0), b3, voffB);
            PG8_BAR; PG8_WAIT_L(0); PG8_MMA(0, 1, At, B1); PG8_BAR;
            PG8_LDA(At, 1, 1); PG8_STAGE(PG8_SA(1, 0), a3, voffA);
            PG8_BAR; PG8_WAIT_L(0); PG8_MMA(1, 0, At, B0); PG8_BAR; PG8_SCHED;
            PG8_STAGE(PG8_SB(1, 1), b3 + hstep, voffB);
            PG8_WAIT_V(6); PG8_BAR; PG8_MMA(1, 1, At, B1); PG8_BAR;
            }
        }
        if constexpr (ALIGN_EPI) { if (wr == 0) PG8_BAR; }
        if constexpr (!Epi::AFTER_DRAIN) { if (Sched::SPLIT && cur.kind == 1) S.put_partial(acc, tid, lane); else { E(acc, cur, wr, wc, fr, fq);
#if EPI_TWICE
            if (Epi::TWICE_OK) { asm volatile("" ::: "memory"); E(acc, cur, wr, wc, fr, fq); }
#endif
            } S.done(cur); }
        if (!has_next) break;
        if (Sched::SPLIT && nxt.kind == 2) S.load_partial(acc, tid, lane);
        else {
#pragma unroll
        for (int a = 0; a < 2; ++a)
#pragma unroll
            for (int b = 0; b < 2; ++b)
#pragma unroll
                for (int m = 0; m < 4; ++m)
#pragma unroll
                    for (int n = 0; n < 2; ++n) acc[a][b][m][n] = (f32x4){0.f, 0.f, 0.f, 0.f};
        }
        cur = nxt; cA = nA; cB = nB; ++ui;
        if constexpr (ALIGN_EPI) { if (wr == 1) PG8_BAR; }
    }
    PG8_WAIT_V(0);
    if constexpr (!ALIGN_EPI) { if (wr == 0) PG8_BAR; }
    PG8_BAR;
    if constexpr (Epi::AFTER_DRAIN) { E.fused(acc, cur, wr, wc, fr, fq, lds, wid, lane); S.done(cur); }
#undef PG8_SA
#undef PG8_SB
#undef PG8_STAGE
#undef PG8_LDA
#undef PG8_LDB
#undef PG8_MMA
#undef PG8_WAIT_V
#undef PG8_WAIT_L
#undef PG8_BAR
#undef PG8_SCHED
}
}

constexpr size_t MiB = 1u << 20;
constexpr size_t WS_CTL = 0, CTL_ZERO_BYTES = 64 * 1024;
constexpr size_t WS_W1GU = 1 * MiB, WS_W1D = 12 * MiB, WS_W2GU = 18 * MiB, WS_W2D = 29 * MiB, WS_WIN = 35 * MiB, WS_WOUT = 40 * MiB;
constexpr size_t WS_GATEW = 42 * MiB;
constexpr size_t WS_SP8 = WS_GATEW + 256 * 1024;
constexpr size_t WS_RSTD0 = 43 * MiB;
constexpr size_t WS_SSQ1 = 44 * MiB, WS_SSQ2 = 47 * MiB;
constexpr size_t WS_LSUM = 50 * MiB;
constexpr size_t WS_XB = 53 * MiB;
constexpr size_t WS_H = 121 * MiB;
constexpr size_t WS_Q = WS_H, WS_KVP = WS_H + 34 * MiB, WS_KVS = WS_H + 98 * MiB, WS_XR = WS_H + 102 * MiB, WS_XG = WS_H + 136 * MiB;
constexpr size_t WS_CAT = 308 * MiB;
constexpr size_t WS_CK = 376 * MiB, WS_CV = 440 * MiB;
constexpr size_t WS_END = 504 * MiB;
static_assert(OFF_SSQ1 == WS_SSQ1 && OFF_Q == WS_Q && OFF_KVP == WS_KVP && OFF_KVS == WS_KVS && OFF_XR == WS_XR && OFF_XG == WS_XG, "epilogue offsets");
static_assert(WS_H + (size_t)TT * FF * 2 <= WS_CAT && WS_XB + (size_t)TT * DM * 2 <= WS_H && WS_XG + (size_t)TT * 512 * 2 <= WS_CAT, "d_ws map");
constexpr int CW_BAR = 1024;
constexpr int CW_SK = 12288;
constexpr int CW_QUEUE = 8192;

constexpr int RING_BYTES = 131072;
constexpr int MISC_OFF = RING_BYTES;
constexpr int LDS_BYTES = 147456;

#define GAS __attribute__((address_space(1)))
#define LAS __attribute__((address_space(3)))
typedef unsigned short bf16;
typedef unsigned v4u __attribute__((ext_vector_type(4)));
typedef unsigned v2u __attribute__((ext_vector_type(2)));
typedef float f32x4 __attribute__((ext_vector_type(4)));
typedef float f32x16 __attribute__((ext_vector_type(16)));
typedef short bf16x8 __attribute__((ext_vector_type(8)));
typedef short s16x4 __attribute__((ext_vector_type(4)));
#define LDS_WAIT() asm volatile("s_waitcnt lgkmcnt(0)" ::: "memory")
#define VM_WAIT() asm volatile("s_waitcnt vmcnt(0)" ::: "memory")
__device__ __forceinline__ unsigned f2bf(float f) { unsigned u = __builtin_bit_cast(unsigned, f); return (u + 0x7fffu + ((u >> 16) & 1u)) >> 16; }
__device__ __forceinline__ unsigned pk2(float lo, float hi) { return f2bf(lo) | (f2bf(hi) << 16); }
__device__ __forceinline__ float bf2f(unsigned short b) { return __builtin_bit_cast(float, (unsigned)b << 16); }
__device__ __forceinline__ float bflo(unsigned w) { return __builtin_bit_cast(float, w << 16); }
__device__ __forceinline__ float bfhi(unsigned w) { return __builtin_bit_cast(float, w & 0xffff0000u); }
__device__ __forceinline__ float wave_sum(float v) {
#pragma unroll
    for (int o = 1; o < 64; o <<= 1) v += __shfl_xor(v, o);
    return v;
}

#define XB_TMO      128
#define XB_XCNT(j)  (256  + 64 * (j))
#define XB_XSUB(j)  (1280 + 64 * (j))
#define XB_XGEN(j)  (2304 + 64 * (j))
#define XB_TOP      3328
#define XB_TOPGEN   3392
#define XCD_BAR_WORDS 3456
#define XB_SPIN_CAP (1u << 18)

__device__ __forceinline__ unsigned xb_ld(unsigned* p)              { return __hip_atomic_load(p, __ATOMIC_RELAXED, __HIP_MEMORY_SCOPE_AGENT); }
__device__ __forceinline__ unsigned xb_add(unsigned* p, unsigned v) { return __hip_atomic_fetch_add(p, v, __ATOMIC_RELAXED, __HIP_MEMORY_SCOPE_AGENT); }
__device__ __forceinline__ unsigned xb_xcc_id() { return (unsigned)__builtin_amdgcn_s_getreg((3 << 11) | 20) & 0xFu; }
#define XB_SPIN(cond, bar) do { unsigned _sp = 0; while (cond) { __builtin_amdgcn_s_sleep(1); \
    if ((++_sp & 255u) == 0u) { if (xb_ld(&(bar)[XB_TMO])) break; if (_sp > XB_SPIN_CAP) { atomicAdd(&(bar)[XB_TMO], 1u); break; } } } } while (0)

struct XcdBarrier {
    unsigned* bar; unsigned x;
    volatile LAS unsigned* st;
};

__device__ __forceinline__ XcdBarrier xcd_barrier_post(unsigned* bar, volatile LAS unsigned* st) {
    XcdBarrier b; b.bar = bar; b.x = xb_xcc_id(); b.st = st;
    if (threadIdx.x == 0) (void)xb_add(&bar[XB_XCNT(b.x)], 1u);
    return b;
}
__device__ __forceinline__ void xcd_barrier_complete(unsigned* bar, unsigned x, unsigned& nloc, unsigned& nx) {
    const unsigned G = gridDim.x * gridDim.y * gridDim.z;
    unsigned sum, cnt, mine, sp = 0u;
    for (;;) {
        sum = 0u; cnt = 0u; mine = 0u;
#pragma unroll
        for (unsigned j = 0; j < 16; ++j) { const unsigned c = xb_ld(&bar[XB_XCNT(j)]); sum += c; cnt += (c > 0u) ? 1u : 0u; mine = (j == x) ? c : mine; }
        if (sum == G) break;
        __builtin_amdgcn_s_sleep(1);
        if ((++sp & 255u) == 0u) { if (xb_ld(&bar[XB_TMO])) break; if (sp > XB_SPIN_CAP) { atomicAdd(&bar[XB_TMO], 1u); break; } }
    }
    nloc = mine > 0u ? mine : 1u; nx = cnt > 0u ? cnt : 1u;
}

__device__ __forceinline__ void xcd_barrier(const XcdBarrier& b) {
    asm volatile("s_waitcnt vmcnt(0)" ::: "memory");
    __syncthreads();
    if (threadIdx.x == 0) {
        unsigned* bar = b.bar;
        __builtin_amdgcn_s_waitcnt(0);
        unsigned nloc = b.st[0], nx = b.st[1];
        if (nloc == 0u) { xcd_barrier_complete(bar, b.x, nloc, nx); b.st[0] = nloc; b.st[1] = nx; }
        const unsigned old = xb_add(&bar[XB_XSUB(b.x)], 1u);
        const unsigned gen = old / nloc;
        if (old + 1u == (gen + 1u) * nloc) {
            __builtin_amdgcn_fence(__ATOMIC_RELEASE, "agent");
            asm volatile("s_waitcnt vmcnt(0)" ::: "memory");
            const unsigned og = xb_add(&bar[XB_TOP], 1u);
            const unsigned tg = og / nx;
            if (og + 1u == (tg + 1u) * nx) xb_add(&bar[XB_TOPGEN], 1u);
            else XB_SPIN(xb_ld(&bar[XB_TOPGEN]) == tg, bar);
            __builtin_amdgcn_fence(__ATOMIC_ACQUIRE, "agent");
            xb_add(&bar[XB_XGEN(b.x)], 1u);
            asm volatile("s_waitcnt vmcnt(0)" ::: "memory");
        } else {
            XB_SPIN(xb_ld(&bar[XB_XGEN(b.x)]) == gen, bar);
            __builtin_amdgcn_fence(__ATOMIC_ACQUIRE, "agent");
            asm volatile("s_waitcnt vmcnt(0)" ::: "memory");
        }
    }
    __syncthreads();
}

typedef __attribute__((address_space(4))) const unsigned char* kptr_t;
struct Frame {
    LAS unsigned char* lds;
    int tid, lane, wave, G, bx;
    kptr_t ka; int z;
    float* out; unsigned char* ws;
};
__device__ __forceinline__ const float* fin(const Frame& F, int k) { typedef const float* cfp; return *(const __attribute__((address_space(4))) cfp*)(F.ka + (k * 8 + F.z)); }
#define NEW_PHASE() do { int z_ = 0; asm volatile("" : "+s"(z_)); F.z = z_; } while (0)

__device__ __forceinline__ void p0_transpose_item(const float* W, int K, int N, bf16* WT, int kb, int n0, int drow0, const float* gain, LAS float* scr, int lane) {
    const int k0 = 64 * kb;
#pragma unroll 8
    for (int i = 0; i < 32; ++i) { const int kk = 2 * i + (lane >> 5); float w = W[(size_t)(k0 + kk) * N + n0 + (lane & 31)]; if (gain) w *= gain[k0 + kk]; scr[kk * 33 + (lane & 31)] = w; }
    LDS_WAIT(); asm volatile("" ::: "memory");
    const int c = lane & 7;
#pragma unroll
    for (int j = 0; j < 4; ++j) { const int n = (lane >> 3) + 8 * j; const LAS float* s = scr + (8 * c) * 33 + n;
        v4u o; o.x = pk2(s[0 * 33], s[1 * 33]); o.y = pk2(s[2 * 33], s[3 * 33]); o.z = pk2(s[4 * 33], s[5 * 33]); o.w = pk2(s[6 * 33], s[7 * 33]);
        *(GAS v4u*)(WT + (size_t)(drow0 + n) * K + k0 + 8 * c) = o; }
    LDS_WAIT(); asm volatile("" ::: "memory");
}
__device__ __forceinline__ void p0_prologue(Frame& F) {
    LAS float* scr = (LAS float*)(F.lds + F.wave * 16384);
    const int gw = F.bx * 8 + F.wave, NGW = F.G * 8;
    unsigned char* ws = F.ws;
    constexpr int I_GU = 16 * 88, I_DN = 44 * 32, I_IN = 16 * 80, I_OUT = 16 * 32;
    constexpr int NITEMS = 2 * (2 * I_GU + I_DN) + I_IN + I_OUT;
    constexpr int I_FFN = 2 * I_GU + I_DN;
    for (int it = gw; it < NITEMS; it += NGW) {
        int r = it;
        if (r < 2 * I_FFN) {
            const int f = r >= I_FFN; r -= f * I_FFN;
            const float* Wg = f == 0 ? fin(F, 8) : fin(F, 30); const float* Wu = f == 0 ? fin(F, 9) : fin(F, 31); const float* Wd = f == 0 ? fin(F, 10) : fin(F, 32); const float* gn = f == 0 ? fin(F, 7) : fin(F, 29);
            bf16* GU = (bf16*)(ws + (f == 0 ? WS_W1GU : WS_W2GU)); bf16* DN = (bf16*)(ws + (f == 0 ? WS_W1D : WS_W2D));
            if (r < 2 * I_GU) { const int up = r >= I_GU; const int q = up ? r - I_GU : r; const int kb = q / 88, nb = q % 88, n0 = 32 * nb;
                p0_transpose_item(up ? Wu : Wg, 1024, FF, GU, kb, n0, 256 * (n0 >> 7) + (n0 & 127) + (up ? 128 : 0), gn, scr, F.lane); }
            else { r -= 2 * I_GU; const int kb = r / 32, nb = r % 32; p0_transpose_item(Wd, FF, 1024, DN, kb, 32 * nb, 32 * nb, nullptr, scr, F.lane); }
            continue;
        }
        r -= 2 * I_FFN;
        if (r < I_IN) { const int kb = r / 80, nb = r % 80, n0 = 32 * nb; int dr = n0;
            if (n0 < 1024) { const int oc = n0 & 255, wc = oc >> 6, bj = (oc >> 5) & 1; dr = (n0 & ~255) + 128 * bj + 32 * wc; }
            p0_transpose_item(fin(F, 12), 1024, INW, (bf16*)(ws + WS_WIN), kb, n0, dr, fin(F, 11), scr, F.lane); continue; }
        r -= I_IN;
        { const int kb = r / 32, nb = r % 32; p0_transpose_item(fin(F, 28), 1024, 1024, (bf16*)(ws + WS_WOUT), kb, 32 * nb, 32 * nb, nullptr, scr, F.lane); }
    }
    {   bf16* XB = (bf16*)(ws + WS_XB); float* rstd0 = (float*)(ws + WS_RSTD0);
        for (int m = gw; m < TT; m += NGW) {
            const float* xrow = m < TP ? fin(F, 0) + (size_t)m * DM : fin(F, 1) + (size_t)(m - TP) * DM;
            const GAS f32x4* xr = (const GAS f32x4*)xrow + F.lane;
            f32x4 v[4]; float s = 0.f;
#pragma unroll
            for (int j = 0; j < 4; ++j) { v[j] = xr[64 * j]; s += (v[j].x * v[j].x + v[j].y * v[j].y) + (v[j].z * v[j].z + v[j].w * v[j].w); }
            s = wave_sum(s);
            if (F.lane == 0) rstd0[m] = __builtin_amdgcn_rsqf(s * (1.0f / DM) + EPS);
            GAS unsigned long long* o8 = (GAS unsigned long long*)(XB + (size_t)m * DM) + F.lane;
#pragma unroll
            for (int j = 0; j < 4; ++j) o8[64 * j] = (unsigned long long)pk2(v[j].x, v[j].y) | ((unsigned long long)pk2(v[j].z, v[j].w) << 32);
        }
    }
    {   const unsigned gt = (unsigned)F.bx * 512u + (unsigned)F.tid, NTH = (unsigned)F.G * 512u;
        unsigned char* CI = ws + WS_CK;
        const float* ck = fin(F, 2); const float* cv = fin(F, 3);
        for (unsigned w0 = gt; w0 < (1u << 22); w0 += 4 * NTH) {
            f32x4 a[4], bq[4]; size_t dsto[4];
#pragma unroll
            for (int u = 0; u < 4; ++u) { const unsigned w = w0 + u * NTH;
                const unsigned jl = w & 3, kk = (w >> 2) & 15, jh = (w >> 6) & 1, kh = (w >> 7) & 3, c = (w >> 9) & 1, t = (w >> 10) & 31, h = (w >> 15) & 3, sb = w >> 17;
                const unsigned key = kh * 16 + kk, j = jh * 4 + jl, pos = t * 64 + key;
                const GAS f32x4* src = (const GAS f32x4*)(ck + ((((size_t)sb * PAST + pos) * 4 + h) * 2 + c) * 64 + j * 8);
                a[u] = __builtin_nontemporal_load(src); bq[u] = __builtin_nontemporal_load(src + 1);
                dsto[u] = ((size_t)((sb * 4 + h) * 32 + t)) * 32768 + c * 8192 + j * 1024 + key * 16; }
#pragma unroll
            for (int u = 0; u < 4; ++u) { v4u o; o.x = pk2(a[u].x, a[u].y); o.y = pk2(a[u].z, a[u].w); o.z = pk2(bq[u].x, bq[u].y); o.w = pk2(bq[u].z, bq[u].w); *(GAS v4u*)(CI + dsto[u]) = o; } }
        for (unsigned w0 = gt; w0 < (1u << 22); w0 += 4 * NTH) {
            f32x4 a[4], bq[4]; size_t dsto[4];
#pragma unroll
            for (int u = 0; u < 4; ++u) { const unsigned w = w0 + u * NTH;
                const unsigned ch = w & 3, kk = (w >> 2) & 15, db = (w >> 6) & 3, kh = (w >> 8) & 3, t = (w >> 10) & 31, h = (w >> 15) & 3, sb = w >> 17;
                const unsigned key = kh * 16 + kk, pos = t * 64 + key;
                const GAS f32x4* src = (const GAS f32x4*)(cv + (((size_t)sb * PAST + pos) * 4 + h) * 128 + db * 32 + ch * 8);
                a[u] = __builtin_nontemporal_load(src); bq[u] = __builtin_nontemporal_load(src + 1);
                dsto[u] = ((size_t)((sb * 4 + h) * 32 + t)) * 32768 + 16384 + db * 4096 + key * 64 + ch * 16; }
#pragma unroll
            for (int u = 0; u < 4; ++u) { v4u o; o.x = pk2(a[u].x, a[u].y); o.y = pk2(a[u].z, a[u].w); o.z = pk2(bq[u].x, bq[u].y); o.w = pk2(bq[u].z, bq[u].w); *(GAS v4u*)(CI + dsto[u]) = o; } }
    }
    {   bf16* GW = (bf16*)(ws + WS_GATEW); float* sp8 = (float*)(ws + WS_SP8);
        const int gt = F.bx * 512 + F.tid, NT = F.G * 512;
        for (int i = gt; i < 2 * 8 * 64 * 64; i += NT) { const int g = i >> 15, n = (i >> 12) & 7, j = (i >> 6) & 63, c = i & 63;
            GW[i] = (bf16)f2bf((g == 0 ? fin(F, 22) : fin(F, 24))[(n * 64 + c) * 64 + j]); }
        for (int i = gt; i < 512; i += NT) { const float L = fin(F, 26)[i]; sp8[i] = 8.0f * (L > 20.f ? __expf(-L) : log1pf(__expf(-L))); }
    }
}

namespace lru {
constexpr int L_XC = 0;
constexpr int L_HIN = 65536;
constexpr int L_PART = 65536 + 2048;
constexpr int L_PAR = 135168;
constexpr int L_O0 = 65536 + 4096;
__device__ __forceinline__ int crow(int r, int hi) { return (r & 3) + 8 * (r >> 2) + 4 * hi; }
__device__ __forceinline__ float sigmoid_f(float x) { return __builtin_amdgcn_rcpf(1.0f + __builtin_amdgcn_exp2f(-x * LOG2E)); }

template <int CTRL, int RM> __device__ __forceinline__ float dpp_f(float oldv, float src) {
    return __builtin_bit_cast(float, __builtin_amdgcn_update_dpp(__builtin_bit_cast(int, oldv), __builtin_bit_cast(int, src), CTRL, RM, 0xF, false)); }
#define LRU_SCAN_STEP(CTRL, RM) do { const float ap_ = dpp_f<CTRL, RM>(1.0f, a), bp_ = dpp_f<CTRL, RM>(0.0f, b); b = a * bp_ + b; a = a * ap_; } while (0)
__device__ __forceinline__ float rl_half(float v, int hi) {
    return __builtin_bit_cast(float, __builtin_amdgcn_ds_bpermute((hi * 32 + 31) * 4, __builtin_bit_cast(int, v))); }
template <int PASS> __device__ __forceinline__ void lru_unit(Frame& F, int u) {
    int tid_ = F.tid; asm volatile("" : "+v"(tid_));
    const int tid = tid_, lane = tid & 63, wid = F.wave, r32 = lane & 31, hi = lane >> 5;
    const bool smp = u >= 512; const int sb = u - 512, pb = u >> 7, ck = smp ? 0 : (u & 127);
    const int row0 = smp ? TP + sb * 64 : pb * SEQ + ck * 64;
    const bf16* XR = (const bf16*)(F.ws + WS_XR); const bf16* XG = (const bf16*)(F.ws + WS_XG);
    LAS unsigned char* lds = F.lds;
    if (PASS == 2) {
        float h = 0.f;
        if (smp) h = fin(F, 4)[sb * 512 + tid];
        else { const float* S = (const float*)(F.ws + WS_LSUM) + ((size_t)(pb * 128) * 512 + tid) * 2;
            int c = 0;
            for (; c + 32 <= ck; c += 32) { float2 v[32];
#pragma unroll
                for (int k = 0; k < 32; ++k) v[k] = *(const float2*)(S + (size_t)(c + k) * 1024);
#pragma unroll
                for (int k = 0; k < 32; ++k) h = v[k].x * h + v[k].y; }
            for (; c + 8 <= ck; c += 8) { float2 v[8];
#pragma unroll
                for (int k = 0; k < 8; ++k) v[k] = *(const float2*)(S + (size_t)(c + k) * 1024);
#pragma unroll
                for (int k = 0; k < 8; ++k) h = v[k].x * h + v[k].y; }
            for (; c < ck; ++c) { const float2 v = *(const float2*)(S + (size_t)c * 1024); h = v.x * h + v.y; } }
        ((LAS float*)(lds + L_HIN))[tid] = h;
    }
    {   LAS float* par = (LAS float*)(lds + L_PAR);
        par[tid] = fin(F, 23)[tid]; par[512 + tid] = fin(F, 25)[tid]; par[1024 + tid] = ((const float*)(F.ws + WS_SP8))[tid]; if (PASS == 2) par[1536 + tid] = fin(F, 27)[tid]; }
    {   const int cg = tid & 63, tg = tid >> 6, c0 = 8 * cg;
        float xw[11][8];
#pragma unroll
        for (int i = 0; i < 11; ++i) { const int tt = 8 * tg + i - 3;
            if (tt >= 0 || ck > 0) { const v4u w = *(const GAS v4u*)(XR + (size_t)(row0 + tt) * 512 + c0);
                xw[i][0] = bflo(w.x); xw[i][1] = bfhi(w.x); xw[i][2] = bflo(w.y); xw[i][3] = bfhi(w.y); xw[i][4] = bflo(w.z); xw[i][5] = bfhi(w.z); xw[i][6] = bflo(w.w); xw[i][7] = bfhi(w.w); }
            else if (smp) { const float* sc = fin(F, 5) + (size_t)(sb * 3 + (tt + 3)) * 512 + c0; const f32x4 a = *(const f32x4*)sc, b = *(const f32x4*)(sc + 4);
                xw[i][0] = a[0]; xw[i][1] = a[1]; xw[i][2] = a[2]; xw[i][3] = a[3]; xw[i][4] = b[0]; xw[i][5] = b[1]; xw[i][6] = b[2]; xw[i][7] = b[3]; }
            else {
#pragma unroll
                for (int e = 0; e < 8; ++e) xw[i][e] = 0.f; } }
        float cw[4][8], cb[8];
#pragma unroll
        for (int j = 0; j < 4; ++j) { const f32x4 a = *(const f32x4*)(fin(F, 20) + j * 512 + c0), b = *(const f32x4*)(fin(F, 20) + j * 512 + c0 + 4);
            cw[j][0] = a[0]; cw[j][1] = a[1]; cw[j][2] = a[2]; cw[j][3] = a[3]; cw[j][4] = b[0]; cw[j][5] = b[1]; cw[j][6] = b[2]; cw[j][7] = b[3]; }
        { const f32x4 a = *(const f32x4*)(fin(F, 21) + c0), b = *(const f32x4*)(fin(F, 21) + c0 + 4); cb[0] = a[0]; cb[1] = a[1]; cb[2] = a[2]; cb[3] = a[3]; cb[4] = b[0]; cb[5] = b[1]; cb[6] = b[2]; cb[7] = b[3]; }
#pragma unroll
        for (int i = 0; i < 8; ++i) { const int t = 8 * tg + i; float xc[8];
#pragma unroll
            for (int e = 0; e < 8; ++e) xc[e] = cb[e] + cw[0][e] * xw[i][e] + cw[1][e] * xw[i + 1][e] + cw[2][e] * xw[i + 2][e] + cw[3][e] * xw[i + 3][e];
            v4u o; o.x = pk2(xc[0], xc[1]); o.y = pk2(xc[2], xc[3]); o.z = pk2(xc[4], xc[5]); o.w = pk2(xc[6], xc[7]);
            *(LAS v4u*)(lds + L_XC + t * 1024 + ((cg ^ (t & 15)) << 4)) = o; }
    }
    LDS_WAIT(); __syncthreads();
    const int n = wid;
    const bf16* GW = (const bf16*)(F.ws + WS_GATEW);
    float ssq_t[2] = {0.f, 0.f};
    float outv[2][16];
#pragma unroll
    for (int jb = 0; jb < 2; ++jb) {
        v2u gwv[4][2];
        if (PASS == 2) {
#pragma unroll
            for (int q4 = 0; q4 < 4; ++q4)
#pragma unroll
                for (int tb = 0; tb < 2; ++tb) gwv[q4][tb] = *(const GAS v2u*)(XG + (size_t)(row0 + tb * 32 + r32) * 512 + 64 * n + 32 * jb + 8 * q4 + 4 * hi); }
        f32x16 accr[2], acci[2];
#pragma unroll
        for (int tb = 0; tb < 2; ++tb) { accr[tb] = f32x16{}; acci[tb] = f32x16{}; }
#pragma unroll
        for (int ks = 0; ks < 4; ++ks) {
            const bf16x8 ar = *(const GAS bf16x8*)(GW + ((size_t)((0 * 8 + n) * 64 + jb * 32 + r32) * 64 + ks * 16 + hi * 8));
            const bf16x8 ax = *(const GAS bf16x8*)(GW + ((size_t)((1 * 8 + n) * 64 + jb * 32 + r32) * 64 + ks * 16 + hi * 8));
#pragma unroll
            for (int tb = 0; tb < 2; ++tb) { const int t = tb * 32 + r32; const int chunk = 8 * n + 2 * ks + hi;
                const bf16x8 bfr = *(const LAS bf16x8*)(lds + L_XC + t * 1024 + ((chunk ^ (t & 15)) << 4));
                accr[tb] = __builtin_amdgcn_mfma_f32_32x32x16_bf16(ar, bfr, accr[tb], 0, 0, 0);
                acci[tb] = __builtin_amdgcn_mfma_f32_32x32x16_bf16(ax, bfr, acci[tb], 0, 0, 0); }
        }
        float av[2][16], bv[2][16];
#pragma unroll
        for (int q4 = 0; q4 < 4; ++q4) {
            const int chb = 64 * n + 32 * jb + 8 * q4 + 4 * hi;
            const f32x4 ba = *(const LAS f32x4*)(lds + L_PAR + chb * 4), bx = *(const LAS f32x4*)(lds + L_PAR + 2048 + chb * 4), sp = *(const LAS f32x4*)(lds + L_PAR + 4096 + chb * 4);
#pragma unroll
            for (int tb = 0; tb < 2; ++tb) { const int t = tb * 32 + r32;
                const v2u xw = *(const LAS v2u*)(lds + L_XC + t * 1024 + ((((chb >> 3) ^ (t & 15)) << 4) | ((chb & 7) << 1)));
                const float xc[4] = {bflo(xw.x), bfhi(xw.x), bflo(xw.y), bfhi(xw.y)};
#pragma unroll
                for (int e = 0; e < 4; ++e) { const int r = 4 * q4 + e;
                    const float rg = sigmoid_f(accr[tb][r] + ba[e]), ig = sigmoid_f(acci[tb][r] + bx[e]);
                    const float a = __builtin_amdgcn_exp2f(-rg * sp[e] * LOG2E);
                    av[tb][r] = a; bv[tb][r] = __builtin_amdgcn_sqrtf(fmaxf(1.0f - a * a, 0.f)) * (ig * xc[e]); } }
        }
#pragma unroll
        for (int r = 0; r < 16; ++r) {
#pragma unroll
            for (int tb = 0; tb < 2; ++tb) {
                float a = av[tb][r], b = bv[tb][r];
                LRU_SCAN_STEP(0x111, 0xF); LRU_SCAN_STEP(0x112, 0xF); LRU_SCAN_STEP(0x114, 0xF); LRU_SCAN_STEP(0x118, 0xF);
                LRU_SCAN_STEP(0x142, 0xA);
                av[tb][r] = a; bv[tb][r] = b; }
            const float A0 = rl_half(av[0][r], hi), B0 = rl_half(bv[0][r], hi);
            bv[1][r] = av[1][r] * B0 + bv[1][r]; av[1][r] = av[1][r] * A0;
        }
        if (PASS == 1) {
            if (r32 == 31) { float* S = (float*)(F.ws + WS_LSUM) + (size_t)u * 1024;
#pragma unroll
                for (int r = 0; r < 16; ++r) { const int ch = 64 * n + 32 * jb + crow(r, hi); *(float2*)(S + 2 * ch) = make_float2(av[1][r], bv[1][r]); } }
        } else {
#pragma unroll
            for (int q4 = 0; q4 < 4; ++q4) { const int chb = 64 * n + 32 * jb + 8 * q4 + 4 * hi;
                const f32x4 hin = *(const LAS f32x4*)(lds + L_HIN + chb * 4);
#pragma unroll
                for (int tb = 0; tb < 2; ++tb) { const int t = tb * 32 + r32;
                    const v2u gw = gwv[q4][tb];
                    const float xg[4] = {bflo(gw.x), bfhi(gw.x), bflo(gw.y), bfhi(gw.y)};
#pragma unroll
                    for (int e = 0; e < 4; ++e) { const int r = 4 * q4 + e; const float h = av[tb][r] * hin[e] + bv[tb][r];
                        const float x = xg[e], uu = 0.7978845608028654f * (x + 0.044715f * x * x * x);
                        const float ge = x * __builtin_amdgcn_rcpf(1.0f + __builtin_amdgcn_exp2f(-2.0f * LOG2E * uu));
                        const float o = h * ge; ssq_t[tb] += o * o;
                        if (jb == 0) ((LAS float*)(lds + L_O0))[(wid * 32 + tb * 16 + r) * 64 + lane] = o; else outv[tb][r] = o;
                        if (tb == 1 && r32 == 31 && (smp || ck == 127)) { float* dst = smp ? F.out + O_LS + sb * 512 : F.out + O_LP + pb * 512; dst[chb + e] = h; } } } }
        }
        __builtin_amdgcn_sched_barrier(0);
    }
    if (PASS == 2) {
        LAS float* part = (LAS float*)(lds + L_PART);
#pragma unroll
        for (int tb = 0; tb < 2; ++tb) { float s = ssq_t[tb]; s += __shfl_xor(s, 32); if (hi == 0) part[wid * 64 + tb * 32 + r32] = s; }
        LDS_WAIT(); __syncthreads();
        bf16* CAT = (bf16*)(F.ws + WS_CAT);
#pragma unroll
        for (int tb = 0; tb < 2; ++tb) { const int t = tb * 32 + r32; float tot = 0.f;
#pragma unroll
            for (int w = 0; w < 8; ++w) tot += part[w * 64 + t];
            const float rn = __builtin_amdgcn_rsqf(tot * (1.0f / 512.0f) + EPS);
#pragma unroll
            for (int jb = 0; jb < 2; ++jb)
#pragma unroll
                for (int q4 = 0; q4 < 4; ++q4) { const int chb = 64 * n + 32 * jb + 8 * q4 + 4 * hi; const f32x4 gn = *(const LAS f32x4*)(lds + L_PAR + 6144 + chb * 4);
                    float ov[4];
#pragma unroll
                    for (int e = 0; e < 4; ++e) ov[e] = jb == 0 ? ((const LAS float*)(lds + L_O0))[(wid * 32 + tb * 16 + 4 * q4 + e) * 64 + lane] : outv[tb][4 * q4 + e];
                    v2u o; o.x = pk2(ov[0] * rn * gn[0], ov[1] * rn * gn[1]); o.y = pk2(ov[2] * rn * gn[2], ov[3] * rn * gn[3]);
                    *(GAS v2u*)(CAT + (size_t)(row0 + t) * 1024 + 512 + chb) = o; } }
    }
    LDS_WAIT(); __syncthreads();
}
}

#ifndef ATT_PROBE
#define ATT_PROBE 0
#endif
namespace att {
constexpr int SLOT = 32768, NSLOT = 4;
constexpr int A_RING = 0;
constexpr int A_EX = 0;
constexpr int A_TAB = 131072;
constexpr int A_WSF = 131072 + 1024;
constexpr int A_MISC = 143360;
__device__ __forceinline__ int crow(int r, int hi) { return (r & 3) + 8 * (r >> 2) + 4 * hi; }
__device__ __forceinline__ void glds16(const void* gsrc, unsigned lds_dst) { unsigned keep;
    asm volatile("s_mov_b32 %0, m0\n\ts_mov_b32 m0, %2\n\ts_nop 0\n\tglobal_load_lds_dwordx4 %1, off\n\ts_mov_b32 m0, %0" : "=&s"(keep) : "v"(gsrc), "s"(lds_dst) : "memory"); }
typedef __attribute__((address_space(3))) const char* lds_cptr;
typedef short v4i16_t __attribute__((ext_vector_type(4)));
__device__ __forceinline__ s16x4 vtr(lds_cptr p) { return __builtin_bit_cast(s16x4, __builtin_amdgcn_ds_read_tr16_b64_v4i16((__attribute__((address_space(3))) v4i16_t*)p)); }
__device__ __forceinline__ unsigned cvtpk(float lo, float hi) { typedef float f2 __attribute__((ext_vector_type(2))); typedef __bf16 b2 __attribute__((ext_vector_type(2)));
    f2 v = {lo, hi}; b2 b = __builtin_convertvector(v, b2); return __builtin_bit_cast(unsigned, b); }
#define ATT_WAIT_BAR(N) asm volatile("s_waitcnt vmcnt(" #N ") lgkmcnt(0)\n\ts_barrier" ::: "memory")

template <bool SMP, bool DESC> __device__ __forceinline__ void attn_unit(Frame& F, int sidx, int h, int qb, float lam) {
    int tid_ = F.tid; asm volatile("" : "+v"(tid_));
    const int tid = tid_, lane = tid & 63, wid = F.wave, r32 = lane & 31, hi = lane >> 5;
    const int comp = wid >> 2, g = wid & 3;
    LAS unsigned char* lds = F.lds;
    const unsigned lds0 = (unsigned)(uintptr_t)lds;
    const bf16* Qb = (const bf16*)(F.ws + WS_Q);
    const int qrow0 = SMP ? TP + sidx * 64 : sidx * SEQ + qb * 128;
    const int qpos0 = SMP ? PAST : qb * 128;
    const int NT = SMP ? 33 : 2 * qb + 2;
    const bool active = SMP ? (g < 2) : true;
    const int gq = SMP ? (g & 1) : g;
    const int qw = qpos0 + 32 * gq;
    const int t_last = active ? (qw >> 6) : -1;
    const int t_near0 = (qw - 90) > 0 ? ((qw - 90) >> 6) : 0;
    if (tid < 256) { float v = 0.f;
        if (tid >= 97 && tid <= 250) { const int delta = tid - 187; const int rel = delta < 0 ? -delta : delta; int bk;
            if (rel < 8) bk = rel; else { bk = 2 + (31 - __builtin_clz((unsigned)(rel * rel))); bk = bk > 15 ? 15 : bk; }
            if (delta > 0) bk += 16;
            v = (fin(F, 6)[bk * 4 + h] - fin(F, 6)[15 * 4 + h]) * LOG2E; }
        ((LAS float*)(lds + A_TAB))[tid] = v; }
    const unsigned char* img0 = SMP ? F.ws + WS_CK + (size_t)((sidx * 4 + h) * 32) * 32768 : F.ws + WS_KVP + (size_t)((sidx * 4 + h) * 128) * 32768;
    const unsigned char* imgn = F.ws + WS_KVS + (size_t)(sidx * 4 + h) * 32768;
    const unsigned poff = (unsigned)(wid * 1024 + lane * 16);
    const unsigned pdst = lds0 + A_RING + wid * 1024;
#define ATT_TILE(i) (DESC ? NT - 1 - (i) : (i))
#define ATT_ISSUE(i) do { const int i_ = (i); const int t_ = ATT_TILE(i_); const unsigned so_ = (unsigned)((i_ % NSLOT) * SLOT); \
        const unsigned char* src_ = ((SMP && t_ == 32) ? imgn : img0 + (size_t)t_ * 32768) + poff; \
        glds16(src_, (unsigned)__builtin_amdgcn_readfirstlane(pdst + so_)); \
        glds16(src_ + 8192, (unsigned)__builtin_amdgcn_readfirstlane(pdst + so_ + 8192)); \
        glds16(src_ + 16384, (unsigned)__builtin_amdgcn_readfirstlane(pdst + so_ + 16384)); \
        glds16(src_ + 24576, (unsigned)__builtin_amdgcn_readfirstlane(pdst + so_ + 24576)); } while (0)
    bf16x8 qr[4];
    { const bf16* Qw = Qb + (size_t)(qrow0 + 32 * gq + r32) * 512 + h * 128 + comp * 64;
#pragma unroll
      for (int d0 = 0; d0 < 4; ++d0) qr[d0] = *(const GAS bf16x8*)(Qw + d0 * 16 + hi * 8); }
    VM_WAIT();
    asm volatile("" : "+v"(qr[0]), "+v"(qr[1]), "+v"(qr[2]), "+v"(qr[3]));
#ifdef ATT_PRIO
    if (comp == ATT_PRIO - 1) __builtin_amdgcn_s_setprio(1);
#endif
    ATT_ISSUE(0); if (NT > 1) ATT_ISSUE(1);
    f32x16 o[4]; o[0] = f32x16{}; o[1] = f32x16{}; o[2] = f32x16{}; o[3] = f32x16{};
    float lsum = 0.f;
    const lds_cptr l3 = (lds_cptr)lds;
    const int kfo = A_RING + comp * 8192 + hi * 1024 + r32 * 16;
    const int vfo = A_RING + 16384 + ((lane >> 4) & 1) * 32 + (lane & 3) * 8 + (4 * hi + ((lane & 15) >> 2)) * 64;
    const int qposl = qw + r32;
    v4u pw[4]; bool have_p = false;
    int so_prev = 0;
#define ATT_VRD(j) do { vlo[j] = vtr(vp + ((j) >> 2) * 4096 + ((j) & 3) * 1024); vhi[j] = vtr(vp + ((j) >> 2) * 4096 + ((j) & 3) * 1024 + 512); } while (0)
#define ATT_VFR(j) (bf16x8){vlo[j][0], vlo[j][1], vlo[j][2], vlo[j][3], vhi[j][0], vhi[j][1], vhi[j][2], vhi[j][3]}
#define ATT_G2(j) do { if ((j) + 3 < 16) ATT_VRD((j) + 3); \
        o[(j) >> 2] = __builtin_amdgcn_mfma_f32_32x32x16_bf16(__builtin_bit_cast(bf16x8, pw[(j) & 3]), ATT_VFR(j), o[(j) >> 2], 0, 0, 0); __builtin_amdgcn_sched_barrier(0); } while (0)
#define ATT_QKEXP(t_, so_) do { f32x16 p0, p1; \
        if ((t_) >= t_near0) { const LAS float* tb = (const LAS float*)(lds + A_TAB) + (64 * (t_) + 4 * hi - qposl + 187);     \
            _Pragma("unroll") for (int r = 0; r < 16; ++r) { p0[r] = tb[(r & 3) + 8 * (r >> 2)]; p1[r] = tb[(r & 3) + 8 * (r >> 2) + 32]; } } \
        else { p0 = f32x16{}; p1 = f32x16{}; } \
        const lds_cptr kp = l3 + kfo + (so_); \
        _Pragma("unroll") for (int d0 = 0; d0 < 4; ++d0) { \
            const bf16x8 k0 = *(const __attribute__((address_space(3))) bf16x8*)(kp + d0 * 2048); \
            const bf16x8 k1 = *(const __attribute__((address_space(3))) bf16x8*)(kp + d0 * 2048 + 512); \
            p0 = __builtin_amdgcn_mfma_f32_32x32x16_bf16(k0, qr[d0], p0, 0, 0, 0); \
            p1 = __builtin_amdgcn_mfma_f32_32x32x16_bf16(k1, qr[d0], p1, 0, 0, 0); } \
        float sacc = 0.f; \
        _Pragma("unroll") for (int r = 0; r < 16; ++r) { p0[r] = __builtin_amdgcn_exp2f(p0[r]); p1[r] = __builtin_amdgcn_exp2f(p1[r]); sacc += p0[r] + p1[r]; } \
        lsum += sacc; \
        _Pragma("unroll") for (int k = 0; k < 2; ++k) { pw[k] = (v4u){cvtpk(p0[8 * k], p0[8 * k + 1]), cvtpk(p0[8 * k + 2], p0[8 * k + 3]), cvtpk(p0[8 * k + 4], p0[8 * k + 5]), cvtpk(p0[8 * k + 6], p0[8 * k + 7])}; \
                                      pw[2 + k] = (v4u){cvtpk(p1[8 * k], p1[8 * k + 1]), cvtpk(p1[8 * k + 2], p1[8 * k + 3]), cvtpk(p1[8 * k + 4], p1[8 * k + 5]), cvtpk(p1[8 * k + 6], p1[8 * k + 7])}; } } while (0)
#define ATT_PV(so_) do { const lds_cptr vp = l3 + vfo + (so_); s16x4 vlo[16], vhi[16]; ATT_VRD(0); ATT_VRD(1); ATT_VRD(2); __builtin_amdgcn_sched_barrier(0); \
        ATT_G2(0); ATT_G2(1); ATT_G2(2); ATT_G2(3); ATT_G2(4); ATT_G2(5); ATT_G2(6); ATT_G2(7); ATT_G2(8); ATT_G2(9); ATT_G2(10); ATT_G2(11); ATT_G2(12); ATT_G2(13); ATT_G2(14); ATT_G2(15); } while (0)
#define ATT_SYNC(it_) do { if ((it_) + 1 < NT) ATT_WAIT_BAR(4); else ATT_WAIT_BAR(0);     \
        if ((it_) + 2 < NT) ATT_ISSUE((it_) + 2); } while (0)
    const bool skew = comp == 1;
    for (int it = 0; it < NT; ++it) {
        const int t = ATT_TILE(it);
        if (skew) ATT_SYNC(it);
        if (have_p) { ATT_PV(so_prev); __builtin_amdgcn_sched_barrier(0); }
        if (!skew) ATT_SYNC(it);
        const int so = (it % NSLOT) * SLOT;
        have_p = (t <= t_last);
        if (have_p) { ATT_QKEXP(t, so); so_prev = so; }
    }
    if (have_p) { ATT_PV(so_prev); }
#undef ATT_SYNC
#undef ATT_VRD
#undef ATT_VFR
#undef ATT_G2
#undef ATT_QKEXP
#undef ATT_PV
#ifdef ATT_PRIO
    __builtin_amdgcn_s_setprio(0);
#endif
    int lane_e = lane; asm volatile("" : "+v"(lane_e));
    const int r32e = lane_e & 31, hie = lane_e >> 5;
    { auto rr = __builtin_amdgcn_permlane32_swap(__float_as_uint(lsum), __float_as_uint(lsum), false, false); lsum = __uint_as_float(rr[0]) + __uint_as_float(rr[1]); }
    LAS float* wsf = (LAS float*)(lds + A_WSF) + wid * 32;
    if (hie == 0) wsf[r32e] = lsum;
    ATT_WAIT_BAR(0);
    float rli[16];
#pragma unroll
    for (int r = 0; r < 16; ++r) rli[r] = __builtin_amdgcn_rcpf(wsf[crow(r, hie)]);
    LAS float* ex = (LAS float*)(lds + A_EX) + g * 4096;
    if (comp == 1) {
#pragma unroll
        for (int db = 0; db < 4; ++db)
#pragma unroll
            for (int r = 0; r < 16; ++r) ex[crow(r, hie) * 128 + db * 32 + r32e] = o[db][r] * (rli[r] * lam);
    }
    LDS_WAIT(); __syncthreads();
    if (comp == 0 && active) {
        float ss[16];
#pragma unroll
        for (int r = 0; r < 16; ++r) ss[r] = 0.f;
#pragma unroll
        for (int db = 0; db < 4; ++db)
#pragma unroll
            for (int r = 0; r < 16; ++r) { const float v = o[db][r] * rli[r] - ex[crow(r, hie) * 128 + db * 32 + r32e]; o[db][r] = v; ss[r] += v * v; }
#pragma unroll
        for (int r = 0; r < 16; ++r) { float s = ss[r];
#pragma unroll
            for (int m = 1; m < 32; m <<= 1) s += __shfl_xor(s, m);
            ss[r] = __builtin_amdgcn_rsqf(s * (1.0f / 128.0f) + EPS) * 0.8f; }
        LDS_WAIT();
        LAS unsigned short* stg = (LAS unsigned short*)ex;
#pragma unroll
        for (int db = 0; db < 4; ++db) { const float gn = fin(F, 19)[db * 32 + r32e];
#pragma unroll
            for (int r = 0; r < 16; ++r) stg[crow(r, hie) * 128 + db * 32 + r32e] = (unsigned short)f2bf(o[db][r] * ss[r] * gn); }
        LDS_WAIT();
        bf16* CAT = (bf16*)(F.ws + WS_CAT);
#pragma unroll
        for (int i = 0; i < 8; ++i) { const int row = i * 4 + (lane_e >> 4), ch = lane_e & 15;
            const v4u v = *(const LAS v4u*)(stg + row * 128 + ch * 8);
            *(GAS v4u*)(CAT + (size_t)(qrow0 + 32 * g + row) * 1024 + h * 128 + ch * 8) = v; }
    }
    VM_WAIT(); LDS_WAIT(); __syncthreads();
#undef ATT_ISSUE
#undef ATT_TILE
}
#undef ATT_WAIT_BAR
}

#ifndef SKM_G1
#define SKM_G1 0
#endif
#ifndef SKM_G2
#define SKM_G2 0
#endif
#ifndef SKM_G3
#define SKM_G3 0
#endif
#ifndef SKM_G5
#define SKM_G5 0
#endif
#ifndef SKM_G6
#define SKM_G6 0
#endif
#ifndef SKM_G7
#define SKM_G7 0
#endif
__device__ __forceinline__ void phase_p0(Frame& F) {
    unsigned char* ws = F.ws; (void)ws;
#ifndef NO_P0
    p0_prologue(F);
#endif
}

__device__ __forceinline__ void phase_g1(Frame& F) {
    unsigned char* ws = F.ws; (void)ws;
#ifndef NO_G1
    {   pg8::Gemm g{(const pg8::bf16_t*)(ws + WS_XB), (const pg8::bf16_t*)(ws + WS_W1GU), TT, 2 * FF, DM}; pg8::StreamK<SKM_G1> S; S.init(TT, 2 * FF, DM, F.G, F.bx, (float*)(ws + WS_CAT), (unsigned*)(ws + WS_CTL) + CW_SK + 0 * 512);
        pg8::EpiSwiGLU<0> E{(pg8::bf16_t*)(ws + WS_H), (const float*)(ws + WS_RSTD0)};
        pg8::gemm_phase<pg8::EpiSwiGLU<0>, pg8::StreamK<SKM_G1>, true, true>(F.lds, g, S, E); }
#endif
}

__device__ __forceinline__ void phase_g2(Frame& F) {
    unsigned char* ws = F.ws; (void)ws;
#ifndef NO_G2
    {   pg8::Gemm g{(const pg8::bf16_t*)(ws + WS_H), (const pg8::bf16_t*)(ws + WS_W1D), TT, DM, FF}; pg8::StreamK<SKM_G2> S; S.init(TT, DM, FF, F.G, F.bx, (float*)(ws + WS_CAT), (unsigned*)(ws + WS_CTL) + CW_SK + 1 * 512);
        pg8::EpiResid<0> E{(pg8::bf16_t*)(ws + WS_XB), F.out, (float*)(ws + WS_SSQ1)};
        pg8::gemm_phase<pg8::EpiResid<0>, pg8::StreamK<SKM_G2>, true, true>(F.lds, g, S, E); }
#endif
}

__device__ __forceinline__ void phase_g3(Frame& F) {
    unsigned char* ws = F.ws; (void)ws;
#ifndef NO_G3
    {   pg8::Gemm g{(const pg8::bf16_t*)(ws + WS_XB), (const pg8::bf16_t*)(ws + WS_WIN), TT, INW, DM}; pg8::StreamK<SKM_G3> S; S.init(TT, INW, DM, F.G, F.bx, (float*)(ws + WS_CAT), (unsigned*)(ws + WS_CTL) + CW_SK + 2 * 512);
        pg8::EpiWin E{ws, F.out, fin(F, 13), fin(F, 14)};
        pg8::gemm_phase<pg8::EpiWin, pg8::StreamK<SKM_G3>, true, true>(F.lds, g, S, E); }
#endif
}

__device__ __forceinline__ void phase_l1(Frame& F) {
    unsigned char* ws = F.ws; (void)ws;
#ifndef NO_L1
    for (int u = F.bx; u < 544; u += F.G) lru::lru_unit<1>(F, u);
#endif
}

__device__ __forceinline__ void phase_g5(Frame& F) {
    unsigned char* ws = F.ws; (void)ws;
#ifndef NO_G5
    {   pg8::Gemm g{(const pg8::bf16_t*)(ws + WS_CAT), (const pg8::bf16_t*)(ws + WS_WOUT), TT, DM, DM}; pg8::StreamK<SKM_G5> S; S.init(TT, DM, DM, F.G, F.bx, (float*)(ws + WS_CK), (unsigned*)(ws + WS_CTL) + CW_SK + 3 * 512);
        pg8::EpiResid<1> E{(pg8::bf16_t*)(ws + WS_XB), F.out, (float*)(ws + WS_SSQ2)};
        pg8::gemm_phase<pg8::EpiResid<1>, pg8::StreamK<SKM_G5>, true, true>(F.lds, g, S, E); }
#endif
}

__device__ __forceinline__ void phase_g6(Frame& F) {
    unsigned char* ws = F.ws; (void)ws;
#ifndef NO_G6
    {   pg8::Gemm g{(const pg8::bf16_t*)(ws + WS_XB), (const pg8::bf16_t*)(ws + WS_W2GU), TT, 2 * FF, DM}; pg8::StreamK<SKM_G6> S; S.init(TT, 2 * FF, DM, F.G, F.bx, (float*)(ws + WS_CK), (unsigned*)(ws + WS_CTL) + CW_SK + 4 * 512);
        pg8::EpiSwiGLU<1> E{(pg8::bf16_t*)(ws + WS_H), (const float*)(ws + WS_SSQ2)};
        pg8::gemm_phase<pg8::EpiSwiGLU<1>, pg8::StreamK<SKM_G6>, true, true>(F.lds, g, S, E); }
#endif
}

__device__ __forceinline__ void phase_g7(Frame& F) {
    unsigned char* ws = F.ws; (void)ws;
#ifndef NO_G7
    {   pg8::Gemm g{(const pg8::bf16_t*)(ws + WS_H), (const pg8::bf16_t*)(ws + WS_W2D), TT, DM, FF}; pg8::StreamK<SKM_G7> S; S.init(TT, DM, FF, F.G, F.bx, (float*)(ws + WS_CK), (unsigned*)(ws + WS_CTL) + CW_SK + 5 * 512);
        pg8::EpiResid<2> E{(pg8::bf16_t*)(ws + WS_XB), F.out, nullptr};
        pg8::gemm_phase<pg8::EpiResid<2>, pg8::StreamK<SKM_G7>, true, true>(F.lds, g, S, E); }
#endif
}

struct Args { const float* in[33]; float* out; unsigned char* ws; int pad0, pad1; };
__global__ void __launch_bounds__(512, 2) hymba_fwd(Args args) {
    extern __shared__ __attribute__((aligned(16))) unsigned char lds_raw[];
    cg::grid_group grid = cg::this_grid();
    Frame F;
    F.lds = (LAS unsigned char*)lds_raw;
    F.tid = threadIdx.x; F.lane = F.tid & 63; F.wave = __builtin_amdgcn_readfirstlane(F.tid >> 6);
    F.G = gridDim.x; F.bx = blockIdx.x;
    F.ka = (kptr_t)__builtin_amdgcn_kernarg_segment_ptr(); F.z = 0;
    F.out = args.out; F.ws = args.ws;
    unsigned char* ws = F.ws;
    unsigned* ctl = (unsigned*)(ws + WS_CTL);
    volatile LAS unsigned* MISCW = (volatile LAS unsigned*)(F.lds + 144384);
    if (F.tid < 16) MISCW[F.tid] = 0u;
    __syncthreads();
    XcdBarrier bar = xcd_barrier_post(ctl + CW_BAR, MISCW + 8);
#define GRID_BAR() do { xcd_barrier(bar); NEW_PHASE(); } while (0)
#define GRID_BAR_CG() do { __threadfence(); grid.sync(); NEW_PHASE(); } while (0)

    phase_p0(F);
#if defined(REP_P0)
    GRID_BAR(); phase_p0(F);
#endif
#ifdef USE_CG_SYNC
    GRID_BAR_CG();
#else
    GRID_BAR();
#endif
    phase_g1(F);
#if defined(REP_G1)
    GRID_BAR(); phase_g1(F);
#endif
    GRID_BAR();
    phase_g2(F);
#if defined(REP_G2)
    GRID_BAR(); phase_g2(F);
#endif
    GRID_BAR();
    phase_g3(F);
#if defined(REP_G3)
    GRID_BAR(); phase_g3(F);
#endif
    GRID_BAR();
    phase_l1(F);
#if defined(REP_L1)
    GRID_BAR(); phase_l1(F);
#endif
    GRID_BAR();
    {
        LAS float* misc = (LAS float*)(F.lds + att::A_MISC);
        if (F.wave == 0) { const float a = wave_sum(fin(F, 15)[F.lane] * fin(F, 16)[F.lane]), b = wave_sum(fin(F, 17)[F.lane] * fin(F, 18)[F.lane]);
            if (F.lane == 0) misc[0] = __expf(a) - __expf(b) + 0.2f; }
        __syncthreads();
        const float lam = misc[0];
        const int grp = F.bx & 7;
#ifdef ATT_TWICE
        for (int rep = 0; rep < 2; ++rep) {
        unsigned* head = ctl + CW_QUEUE + 64 * grp + 1024 * rep;
#else
        unsigned* head = ctl + CW_QUEUE + 64 * grp;
#endif
        const int wq = F.bx >> 3;
        if (F.G == 256) {
#ifndef NO_ATT
#pragma unroll 1
            for (int k = 0; k < 2; ++k) { const int st = grp + 8 * k;
                att::attn_unit<false, false>(F, st >> 2, st & 3, wq, lam);
                att::attn_unit<false, true>(F, st >> 2, st & 3, 63 - wq, lam); }
#endif
        }
        const int qbase = (F.G == 256) ? 128 : 0;
        for (;;) {
            if (F.tid == 0) ((LAS int*)misc)[1] = qbase + (int)atomicAdd(head, 1u);
            __syncthreads();
            const int it = ((LAS int*)misc)[1];
            __syncthreads();
            if (it >= 212) break;
#ifndef NO_ATT
            if (it < 128) { const int st = grp + 8 * (it >> 6), qb = 63 - (it & 63); att::attn_unit<false, false>(F, st >> 2, st & 3, qb, lam); }
            else if (it < 144) { const int su = grp * 16 + (it - 128); att::attn_unit<true, false>(F, su >> 2, su & 3, 0, lam); }
            else
#endif
#ifndef NO_L2
            { lru::lru_unit<2>(F, grp * 68 + (it - 144));
#ifdef L2_TWICE
              lru::lru_unit<2>(F, grp * 68 + (it - 144));
#endif
            }
#else
            {}
#endif
        }
#ifdef ATT_TWICE
        __syncthreads(); }
#endif
    }
    GRID_BAR();
    phase_g5(F);
#if defined(REP_G5)
    GRID_BAR(); phase_g5(F);
#endif
    GRID_BAR();
    phase_g6(F);
#if defined(REP_G6)
    GRID_BAR(); phase_g6(F);
#endif
    GRID_BAR();
    phase_g7(F);
#if defined(REP_G7)
    GRID_BAR(); phase_g7(F);
#endif
}

extern "C" void kernel_launch(void* const* d_in, const int* in_sizes, int n_in, void* d_out, int out_size, void* d_ws, size_t ws_size, hipStream_t stream) {
    static int grid = 0;
    if (grid == 0) {
        if (n_in != 33 || out_size != (int)O_END || ws_size < WS_END) { fprintf(stderr, "kernel_launch: unexpected shapes: n_in %d out %d ws %zu (need %zu)\n", n_in, out_size, ws_size, (size_t)WS_END); grid = -1; return; }
        int dev = 0, cus = 0, per_cu = 0;
        hipGetDevice(&dev); hipDeviceGetAttribute(&cus, hipDeviceAttributeMultiprocessorCount, dev);
        if (hipFuncSetAttribute((const void*)hymba_fwd, hipFuncAttributeMaxDynamicSharedMemorySize, LDS_BYTES) != hipSuccess) { fprintf(stderr, "kernel_launch: hipFuncSetAttribute failed\n"); grid = -1; return; }
        if (hipOccupancyMaxActiveBlocksPerMultiprocessor(&per_cu, (const void*)hymba_fwd, 512, LDS_BYTES) != hipSuccess || per_cu < 1) { fprintf(stderr, "kernel_launch: occupancy query says %d\n", per_cu); per_cu = 1; }
        (void)hipGetLastError();
        grid = cus * 1;
        if (grid % 8 != 0 || grid < 8) { fprintf(stderr, "kernel_launch: grid %d not a multiple of 8\n", grid); }
    }
    if (grid < 0) return;
    (void)hipMemsetAsync((char*)d_ws + WS_CTL, 0, CTL_ZERO_BYTES, stream);
    Args a{};
    for (int i = 0; i < 33; ++i) a.in[i] = (const float*)d_in[i];
    a.out = (float*)d_out; a.ws = (unsigned char*)d_ws;
    void* kargs[] = {&a};
    hipError_t e = hipLaunchCooperativeKernel((const void*)hymba_fwd, dim3(grid), dim3(512), kargs, LDS_BYTES, stream);
    if (e != hipSuccess) fprintf(stderr, "kernel_launch: cooperative launch failed: %s (grid %d)\n", hipGetErrorString(e), grid);
}
```

```cpp
#include <hip/hip_runtime.h>
#include <hip/hip_cooperative_groups.h>
#include <hip/hip_bf16.h>
#include <cstdio>
#include <cstdint>
namespace cg = cooperative_groups;

constexpr int DM = 1024, NBP = 4, SEQ = 8192, NBS = 32, DSQ = 64, PAST = 2048;
constexpr int TP = NBP * SEQ, TS = NBS * DSQ, TT = TP + TS;
constexpr int FF = 2816, AW = 512, LW = 512, INW = 2560, NH = 4, HD = 64, VD = 128;
constexpr float EPS = 1e-6f;
constexpr float LOG2E = 1.4426950408889634f;
constexpr float QSCALE = 0.125f * LOG2E;
constexpr size_t O_Y = 0, O_KP = (size_t)TT * DM, O_VP = O_KP + (size_t)TP * 512, O_LP = O_VP + (size_t)TP * 512, O_CP = O_LP + NBP * 512,
                 O_KS = O_CP + NBP * 3 * 512, O_VS = O_KS + (size_t)TS * 512, O_LS = O_VS + (size_t)TS * 512, O_CS = O_LS + NBS * 512, O_END = O_CS + NBS * 3 * 512;
static_assert(O_END == 71376896, "output size");
constexpr size_t OFF_SSQ1 = 44u << 20, OFF_Q = 121u << 20, OFF_KVP = (121u + 34u) << 20, OFF_KVS = (121u + 98u) << 20, OFF_XR = (121u + 102u) << 20, OFF_XG = (121u + 136u) << 20;
namespace pg8 {
#define PG8_LAS __attribute__((address_space(3)))
typedef unsigned short bf16_t;
typedef short bf16x8 __attribute__((ext_vector_type(8)));
typedef float f32x4 __attribute__((ext_vector_type(4)));
typedef unsigned u32x4 __attribute__((ext_vector_type(4)));
constexpr int BM = 256, BK = 64, HALF = 128, HTB = HALF * BK * 2  , STAGE_BYTES = 8 * HTB, NXCD = 8, WGM = 8;

__host__ __device__ __forceinline__ int lds_byte(int r, int c) { const int st = (r >> 4) * 2 + (c >> 5), rr = r & 15, cc = c & 31, ob = rr * 64 + cc * 2; return st * 1024 + (ob ^ (((ob >> 9) & 1) << 5)); }
__host__ __device__ __forceinline__ void stage_rc(int b, int& R, int& C) { const int st = b / 1024, sb = b % 1024, swz = sb ^ (((sb >> 9) & 1) << 5); R = (st >> 1) * 16 + swz / 64; C = (st & 1) * 32 + (swz % 64) / 2; }
__host__ __device__ __forceinline__ int perm32(int rho) { const int n = rho >> 4, i = rho & 15; return 8 * (i >> 2) + 4 * n + (i & 3); }

struct Unit { int pm, pn, kt0, nkt, kind; };
struct Gemm { const bf16_t* A; const bf16_t* Bt; int M, N, K; };

struct StaticOrder {
    static constexpr bool SPLIT = false;
    int nM, nN, nwg, G, c;
    __host__ __device__ void init(int M, int N, int G_, int c_) { nM = M / BM; nN = N / BM; nwg = nM * nN; G = G_; c = c_; }
    __host__ __device__ bool next(int i, Unit& u) const {
        const long L = (long)i * G + c; if (L >= nwg) return false;
        int wgid = (int)L; { const int q = nwg / NXCD, r = nwg % NXCD, xcd = wgid % NXCD, off = wgid / NXCD; wgid = (xcd < r ? xcd * (q + 1) : r * (q + 1) + (xcd - r) * q) + off; }
        const int nig = WGM * nN, gid = wgid / nig, fm = gid * WGM, gsz = (nM - fm) < WGM ? (nM - fm) : WGM;
        u.pm = fm + ((wgid % nig) % gsz); u.pn = (wgid % nig) / gsz; u.kt0 = 0; u.nkt = nkt; u.kind = 0; return true;
    }
    int nkt;
    __device__ __forceinline__ void a_ready(const Unit&) const {}
    __device__ __forceinline__ void done(const Unit&) const {}
    __device__ __forceinline__ void put_partial(const f32x4 (&)[2][2][4][2], int, int) const {}
    __device__ __forceinline__ void load_partial(f32x4 (&)[2][2][4][2], int, int) const {}
};


template <int MODE  > struct StreamK {
    static constexpr bool SPLIT = MODE != 0;
    int nM, nN, P, W, x, w, q, R1, Dq; long lo, hi; int v; float* slab; unsigned* flag;
    __device__ void init(int M, int N, int K, int G_, int bx, float* slab_, unsigned* flag_) { nM = M / BM; nN = N / BM; P = K / (2 * BK); W = G_ / NXCD; x = bx % NXCD; w = bx / NXCD;
        const int nwg = nM * nN; q = nwg / NXCD;
        if (!SPLIT) { R1 = (nwg + G_ - 1) / G_; Dq = q; } else { R1 = nwg / G_ - 1; Dq = R1 * W; }
        const long tot = (long)(q - Dq) * P; lo = tot * w / W; hi = tot * (w + 1) / W; v = x * W + w; slab = slab_; flag = flag_; }
    __device__ bool next(int i, Unit& u) const {
        int L; int j = i, k = -1;
        if (MODE == 2 && (lo % P) != 0) { if (i == 0) k = 0; else j = i - 1; }
        if (k < 0 && j >= R1) { if (!SPLIT) return false; k = j - R1 + ((MODE == 2 && (lo % P) != 0) ? 1 : 0); }
        if (k < 0) { L = x * q + j * W + w; u.kt0 = 0; u.nkt = 2 * P; u.kind = 0; if (!SPLIT && j * W + w >= q) return false; }
        else { const long u0 = lo / P; const long base = (u0 + k) * P; const long start = (k == 0) ? lo - base : 0; if (base + start >= hi) return false;
            const long end = (hi - base) < P ? (hi - base) : P;
            L = x * q + Dq + (int)(u0 + k); u.kt0 = (int)(2 * start); u.nkt = (int)(2 * (end - start)); u.kind = start > 0 ? 1 : (end < P ? 2 : 0); }
        const int nig = WGM * nN, gid = L / nig, fm = gid * WGM, gsz = (nM - fm) < WGM ? (nM - fm) : WGM;
        u.pm = fm + ((L % nig) % gsz); u.pn = (L % nig) / gsz; return true;
    }
    __device__ __forceinline__ void a_ready(const Unit&) const {}
    __device__ __forceinline__ void done(const Unit&) const {}
    __device__ __forceinline__ void put_partial(const f32x4 (&acc)[2][2][4][2], int tid, int lane) const {
        f32x4* dst = (f32x4*)slab + (size_t)v * (32 * 512) + tid;
#pragma unroll
        for (int ai = 0; ai < 2; ++ai)
#pragma unroll
            for (int bj = 0; bj < 2; ++bj)
#pragma unroll
                for (int m = 0; m < 4; ++m)
#pragma unroll
                    for (int n = 0; n < 2; ++n) { const f32x4 val = acc[ai][bj][m][n];
                        asm volatile("global_store_dwordx4 %0, %1, off sc1\n\ts_nop 1" :: "v"(dst), "v"(val) : "memory");
                        dst += 512; asm volatile("" : "+v"(dst)); }
        asm volatile("s_waitcnt vmcnt(0)" ::: "memory");
        if (lane == 0) __hip_atomic_fetch_add(flag + v, 1u, __ATOMIC_RELAXED, __HIP_MEMORY_SCOPE_AGENT);
    }
    __device__ __forceinline__ void load_partial(f32x4 (&acc)[2][2][4][2], int tid, int lane) const {
        unsigned spins = 0;
        while ((unsigned)__builtin_amdgcn_readfirstlane(__hip_atomic_load(flag + v + 1, __ATOMIC_RELAXED, __HIP_MEMORY_SCOPE_AGENT)) < 8u) { __builtin_amdgcn_s_sleep(2); if (++spins > (1u << 22)) break; }
        __builtin_amdgcn_fence(__ATOMIC_ACQUIRE, "agent");
        const f32x4* src = (const f32x4*)slab + (size_t)(v + 1) * (32 * 512) + tid;
#pragma unroll
        for (int ai = 0; ai < 2; ++ai)
#pragma unroll
            for (int bj = 0; bj < 2; ++bj)
#pragma unroll
                for (int m = 0; m < 4; ++m)
#pragma unroll
                    for (int n = 0; n < 2; ++n) { acc[ai][bj][m][n] = *src; src += 512; asm volatile("" : "+v"(src)); }
    }
};

__device__ __forceinline__ unsigned cvt_pk_bf16(float lo, float hi) { unsigned r; asm volatile("v_cvt_pk_bf16_f32 %0, %1, %2" : "=v"(r) : "v"(lo), "v"(hi)); return r; }
__device__ __forceinline__ u32x4 pack8(const f32x4& a, const f32x4& b) { u32x4 w; w.x = cvt_pk_bf16(a[0], a[1]); w.y = cvt_pk_bf16(a[2], a[3]); w.z = cvt_pk_bf16(b[0], b[1]); w.w = cvt_pk_bf16(b[2], b[3]); return w; }
__device__ __forceinline__ float silu_f(float g) { return g * __builtin_amdgcn_rcpf(1.0f + __builtin_amdgcn_exp2f(-g * 1.4426950408889634f)); }
__device__ __forceinline__ float rstd_from_ssq(const float* ssq, int row, int fq) {
    const f32x4 p = *(const f32x4*)(ssq + (size_t)row * 16 + 4 * fq);
    float s = (p[0] + p[1]) + (p[2] + p[3]); s += __shfl_xor(s, 16); s += __shfl_xor(s, 32);
    return __builtin_amdgcn_rsqf(s * (1.0f / 1024.0f) + 1e-6f);
}
#ifndef EPI_TWICE
#define EPI_TWICE 0
#endif
template <int RSMODE  > struct EpiSwiGLU {
    static constexpr bool PERM = true, AFTER_DRAIN = false, TWICE_OK = (EPI_TWICE == 1);
    bf16_t* H; const float* rs;
    __device__ __forceinline__ void operator()(const f32x4 (&acc)[2][2][4][2], const Unit& u, int wr, int wc, int fr, int fq) const {
        const int row0 = u.pm * BM + wr * 64 + fr, col0 = u.pn * 128 + wc * 32 + 8 * fq;
#pragma unroll
        for (int ai = 0; ai < 2; ++ai)
#pragma unroll
            for (int m = 0; m < 4; ++m) { const int row = row0 + ai * HALF + m * 16;
                const float s = RSMODE == 0 ? rs[row] : rstd_from_ssq(rs, row, fq);
                f32x4 h0, h1;
#pragma unroll
                for (int e = 0; e < 4; ++e) { h0[e] = silu_f(acc[ai][0][m][0][e] * s) * (acc[ai][1][m][0][e] * s); h1[e] = silu_f(acc[ai][0][m][1][e] * s) * (acc[ai][1][m][1][e] * s); }
                *(u32x4*)(H + (size_t)row * 2816 + col0) = pack8(h0, h1); }
    }
};
__device__ __forceinline__ f32x4 bf4lo(const u32x4& w) { f32x4 r; r[0] = __builtin_bit_cast(float, w.x << 16); r[1] = __builtin_bit_cast(float, w.x & 0xffff0000u); r[2] = __builtin_bit_cast(float, w.y << 16); r[3] = __builtin_bit_cast(float, w.y & 0xffff0000u); return r; }
__device__ __forceinline__ f32x4 bf4hi(const u32x4& w) { f32x4 r; r[0] = __builtin_bit_cast(float, w.z << 16); r[1] = __builtin_bit_cast(float, w.z & 0xffff0000u); r[2] = __builtin_bit_cast(float, w.w << 16); r[3] = __builtin_bit_cast(float, w.w & 0xffff0000u); return r; }
template <int KIND> struct EpiResid {
    static constexpr bool PERM = true, AFTER_DRAIN = false, TWICE_OK = (EPI_TWICE == 3 && KIND == 2);
    bf16_t* xb; float* out; float* ssq;
    __device__ __forceinline__ void operator()(const f32x4 (&acc)[2][2][4][2], const Unit& u, int wr, int wc, int fr, int fq) const {
        const int row0 = u.pm * BM + wr * 64 + fr, col0 = u.pn * BM + wc * 32 + 8 * fq;
        const float sc = KIND == 1 ? 1.0f : 0.5f;
        u32x4 r0 = *(const u32x4*)(xb + (size_t)row0 * 1024 + col0), r1 = *(const u32x4*)(xb + (size_t)row0 * 1024 + col0 + HALF);
#pragma unroll
        for (int ai = 0; ai < 2; ++ai)
#pragma unroll
            for (int m = 0; m < 4; ++m) { const int row = row0 + ai * HALF + m * 16;
                const u32x4 c0 = r0, c1 = r1;
                if (ai * 4 + m < 7) { const int nrow = row0 + ((ai * 4 + m + 1) >> 2) * HALF + ((ai * 4 + m + 1) & 3) * 16;
                    r0 = *(const u32x4*)(xb + (size_t)nrow * 1024 + col0); r1 = *(const u32x4*)(xb + (size_t)nrow * 1024 + col0 + HALF); }
                const f32x4 v00 = bf4lo(c0) + acc[ai][0][m][0] * sc, v01 = bf4hi(c0) + acc[ai][0][m][1] * sc, v10 = bf4lo(c1) + acc[ai][1][m][0] * sc, v11 = bf4hi(c1) + acc[ai][1][m][1] * sc;
                if (KIND < 2) {
                    *(u32x4*)(xb + (size_t)row * 1024 + col0) = pack8(v00, v01); *(u32x4*)(xb + (size_t)row * 1024 + col0 + HALF) = pack8(v10, v11);
                    float ss = (v00[0] * v00[0] + v00[1] * v00[1]) + (v00[2] * v00[2] + v00[3] * v00[3]) + (v01[0] * v01[0] + v01[1] * v01[1]) + (v01[2] * v01[2] + v01[3] * v01[3]);
                    ss += (v10[0] * v10[0] + v10[1] * v10[1]) + (v10[2] * v10[2] + v10[3] * v10[3]) + (v11[0] * v11[0] + v11[1] * v11[1]) + (v11[2] * v11[2] + v11[3] * v11[3]);
                    ss += __shfl_xor(ss, 16); ss += __shfl_xor(ss, 32); if (fq == 0) ssq[(size_t)row * 16 + u.pn * 4 + wc] = ss;
                } else { float* orow = out + (size_t)row * 1024 + col0;
                    *(f32x4*)orow = v00; *(f32x4*)(orow + 4) = v01; *(f32x4*)(orow + HALF) = v10; *(f32x4*)(orow + HALF + 4) = v11; } }
    }
};
struct EpiWinPtrs { const float* ssq1; bf16_t* Q; unsigned char *KVP, *KVS; bf16_t *XR, *XG; float* out; const float *gq, *gk; };
__device__ __forceinline__ unsigned char* tile_of(const EpiWinPtrs& P, int row, int h, int& key) {
    if (row < 32768) { const int pos = row & 8191; key = pos & 63; return P.KVP + (size_t)((((row >> 13) * 4 + h) * 128) + (pos >> 6)) * 32768; }
    const int r2 = row - 32768; key = r2 & 63; return P.KVS + (size_t)((r2 >> 6) * 4 + h) * 32768; }
template <int KIND> __device__ __forceinline__ void win_qk(const EpiWinPtrs P, const f32x4 (&acc)[2][2][4][2], const Unit& u, int wr, int wc, int fr, int fq) {
    const int row0 = u.pm * BM + wr * 64 + fr, half = u.pn & 1;
    const float* gp = KIND == 0 ? P.gq : P.gk; const float qs = KIND == 0 ? 0.125f * 1.4426950408889634f : 1.0f;
    const f32x4 g00 = *(const f32x4*)(gp + 8 * fq) * qs, g01 = *(const f32x4*)(gp + 8 * fq + 4) * qs, g10 = *(const f32x4*)(gp + 32 + 8 * fq) * qs, g11 = *(const f32x4*)(gp + 32 + 8 * fq + 4) * qs;
    const int cbase = 256 * half + 64 * wc + 8 * fq;
#pragma unroll
    for (int ai = 0; ai < 2; ++ai)
#pragma unroll
        for (int m = 0; m < 4; ++m) { const int row = row0 + ai * HALF + m * 16; const float rs = rstd_from_ssq(P.ssq1, row, fq);
            const f32x4 v00 = acc[ai][0][m][0] * rs, v01 = acc[ai][0][m][1] * rs, v10 = acc[ai][1][m][0] * rs, v11 = acc[ai][1][m][1] * rs;
            float ss = (v00[0] * v00[0] + v00[1] * v00[1]) + (v00[2] * v00[2] + v00[3] * v00[3]);
            ss += (v01[0] * v01[0] + v01[1] * v01[1]) + (v01[2] * v01[2] + v01[3] * v01[3]);
            ss += (v10[0] * v10[0] + v10[1] * v10[1]) + (v10[2] * v10[2] + v10[3] * v10[3]);
            ss += (v11[0] * v11[0] + v11[1] * v11[1]) + (v11[2] * v11[2] + v11[3] * v11[3]);
            ss += __shfl_xor(ss, 16); ss += __shfl_xor(ss, 32);
            const float rn = __builtin_amdgcn_rsqf(ss * (1.0f / 64.0f) + 1e-6f);
            const f32x4 a0 = v00 * rn * g00, b0 = v01 * rn * g01, a1 = v10 * rn * g10, b1 = v11 * rn * g11;
            if (KIND == 0) { *(u32x4*)(P.Q + (size_t)row * 512 + cbase) = pack8(a0, b0); *(u32x4*)(P.Q + (size_t)row * 512 + cbase + 32) = pack8(a1, b1); }
            else { float* o = (row < 32768 ? P.out + 35651584 + (size_t)row * 512 : P.out + 69214208 + (size_t)(row - 32768) * 512) + cbase;
                *(f32x4*)o = a0; *(f32x4*)(o + 4) = b0; *(f32x4*)(o + 32) = a1; *(f32x4*)(o + 36) = b1;
                int key; unsigned char* tb = tile_of(P, row, 2 * half + (wc >> 1), key) + (wc & 1) * 8192 + fq * 1024 + key * 16;
                *(u32x4*)tb = pack8(a0, b0); *(u32x4*)(tb + 4096) = pack8(a1, b1); }
            asm volatile("" ::: "memory"); }
}
template <int KIND> __device__ __forceinline__ void win_plain(const EpiWinPtrs P, const f32x4 (&acc)[2][2][4][2], const Unit& u, int wr, int wc, int fr, int fq) {
    const int row0 = u.pm * BM + wr * 64 + fr, half = u.pn & 1;
    const int cbase = 256 * half + 32 * wc + 8 * fq;
    bf16_t* dst = KIND == 3 ? P.XR : P.XG;
#pragma unroll
    for (int ai = 0; ai < 2; ++ai)
#pragma unroll
        for (int m = 0; m < 4; ++m) { const int row = row0 + ai * HALF + m * 16; const float rs = rstd_from_ssq(P.ssq1, row, fq);
#pragma unroll
            for (int bj = 0; bj < 2; ++bj) { const f32x4 a = acc[ai][bj][m][0] * rs, b = acc[ai][bj][m][1] * rs; const int c = cbase + 128 * bj;
                if (KIND == 2) { int key; unsigned char* tb = tile_of(P, row, 2 * half + bj, key) + 16384 + wc * 4096 + key * 64 + fq * 16; *(u32x4*)tb = pack8(a, b); }
                else *(u32x4*)(dst + (size_t)row * 512 + c) = pack8(a, b);
                if (KIND == 2) { float* o = (row < 32768 ? P.out + 52428800 + (size_t)row * 512 : P.out + 70262784 + (size_t)(row - 32768) * 512) + c; *(f32x4*)o = a; *(f32x4*)(o + 4) = b; }
                if (KIND == 3) {
                    if (row < 32768) { const int t = row & 8191; if (t >= 8189) { float* o = P.out + 69208064 + (size_t)((row >> 13) * 3 + (t - 8189)) * 512 + c; *(f32x4*)o = a; *(f32x4*)(o + 4) = b; } }
                    else { const int t = (row - 32768) & 63; if (t >= 61) { float* o = P.out + 71327744 + (size_t)(((row - 32768) >> 6) * 3 + (t - 61)) * 512 + c; *(f32x4*)o = a; *(f32x4*)(o + 4) = b; } } } }
            asm volatile("" ::: "memory"); }
}
struct EpiWin {
    static constexpr bool PERM = true, AFTER_DRAIN = false, TWICE_OK = (EPI_TWICE == 2);
    unsigned char* wsb; float* out; const float *gq, *gk;
    __device__ __forceinline__ void operator()(const f32x4 (&acc)[2][2][4][2], const Unit& u, int wr, int wc, int fr, int fq) const {
        unsigned char* w = wsb; asm volatile("" : "+s"(w));
        const EpiWinPtrs P{(const float*)(w + OFF_SSQ1), (bf16_t*)(w + OFF_Q), w + OFF_KVP, w + OFF_KVS, (bf16_t*)(w + OFF_XR), (bf16_t*)(w + OFF_XG), out, gq, gk};
        const int kind = u.pn >> 1;
        if (kind == 0) win_qk<0>(P, acc, u, wr, wc, fr, fq);
        else if (kind == 1) win_qk<1>(P, acc, u, wr, wc, fr, fq);
        else if (kind == 2) win_plain<2>(P, acc, u, wr, wc, fr, fq);
        else if (kind == 3) win_plain<3>(P, acc, u, wr, wc, fr, fq);
        else win_plain<4>(P, acc, u, wr, wc, fr, fq);
    }
};
template <class Epi, class Sched, bool ALIGN_EPI = false, bool SP2 = false>
__device__ __forceinline__ void gemm_phase(PG8_LAS unsigned char* lds, const Gemm g, const Sched& S, const Epi& E) {
    int tid_ = threadIdx.x; asm volatile("" : "+v"(tid_));
    const int tid = tid_, wid = __builtin_amdgcn_readfirstlane(tid >> 6), lane = tid & 63, wr = wid >> 2, wc = wid & 3, fr = lane & 15, fq = lane >> 4;
    const int K = g.K;
    unsigned voffA[2], voffB[2];
#pragma unroll
    for (int i = 0; i < 2; ++i) { int R, C; stage_rc(tid * 16 + i * 8192, R, C); const int Rb = Epi::PERM ? ((R & ~31) + perm32(R & 31)) : R;
        voffA[i] = (unsigned)(R * K + C) * 2u; voffB[i] = (unsigned)(Rb * K + C) * 2u; }
    const size_t kstep = (size_t)(BK * 2);
    const size_t hstep = (size_t)HALF * K * 2;
    const size_t tstep = 2 * hstep;
    const unsigned ldsw = (unsigned)wid * 1024u;
    const int aoff = lds_byte(wr * 64 + fr, fq * 8), boff = lds_byte(wc * 32 + fr, fq * 8);
#define PG8_SA(b, h) (((b) * 2 + (h)) * HTB)
#define PG8_SB(b, h) ((4 + (b) * 2 + (h)) * HTB)
#define PG8_STAGE(bufoff, gbase, voff) do { _Pragma("unroll") for (int _i = 0; _i < 2; ++_i) \
        __builtin_amdgcn_global_load_lds((const unsigned*)((const char*)(gbase) + (voff)[_i]), (PG8_LAS unsigned*)(lds + (bufoff) + ldsw + _i * 8192), 16, 0, 0); } while (0)
#define PG8_LDA(dst, b, h) do { _Pragma("unroll") for (int m = 0; m < 4; ++m) _Pragma("unroll") for (int k = 0; k < 2; ++k) dst[m][k] = *(const PG8_LAS bf16x8*)(lds + PG8_SA(b, h) + aoff + m * 2048 + k * 1024); } while (0)
#define PG8_LDB(dst, b, h) do { _Pragma("unroll") for (int n = 0; n < 2; ++n) _Pragma("unroll") for (int k = 0; k < 2; ++k) dst[n][k] = *(const PG8_LAS bf16x8*)(lds + PG8_SB(b, h) + boff + n * 2048 + k * 1024); } while (0)
#define PG8_MMA(ai, bj, At, Bt) do { __builtin_amdgcn_s_setprio(1); _Pragma("unroll") for (int m = 0; m < 4; ++m) _Pragma("unroll") for (int n = 0; n < 2; ++n) _Pragma("unroll") for (int k = 0; k < 2; ++k) \
        acc[ai][bj][m][n] = __builtin_amdgcn_mfma_f32_16x16x32_bf16(Bt[n][k], At[m][k], acc[ai][bj][m][n], 0, 0, 0); __builtin_amdgcn_s_setprio(0); } while (0)
#define PG8_WAIT_V(n) asm volatile("s_waitcnt vmcnt(" #n ")" ::: "memory")
#define PG8_WAIT_L(n) asm volatile("s_waitcnt lgkmcnt(" #n ")" ::: "memory")
#define PG8_BAR __builtin_amdgcn_s_barrier()
#define PG8_SCHED __builtin_amdgcn_sched_barrier(0)
    Unit cur, nxt; int ui = 0;
    if (!S.next(0, cur)) return;
    f32x4 acc[2][2][4][2];
#pragma unroll
    for (int a = 0; a < 2; ++a)
#pragma unroll
        for (int b = 0; b < 2; ++b)
#pragma unroll
            for (int m = 0; m < 4; ++m)
#pragma unroll
                for (int n = 0; n < 2; ++n) acc[a][b][m][n] = (f32x4){0.f, 0.f, 0.f, 0.f};
    bf16x8 At[4][2], B0[2][2], B1[2][2];
    const char* cA = (const char*)g.A + (size_t)cur.pm * tstep + (Sched::SPLIT ? (size_t)cur.kt0 * kstep : (size_t)0); const char* cB = (const char*)g.Bt + (size_t)cur.pn * tstep + (Sched::SPLIT ? (size_t)cur.kt0 * kstep : (size_t)0);
    S.a_ready(cur);
    if constexpr (SP2) {
        PG8_STAGE(PG8_SB(0, 0), cB, voffB); PG8_STAGE(PG8_SB(0, 1), cB + hstep, voffB); PG8_STAGE(PG8_SA(0, 0), cA, voffA); PG8_STAGE(PG8_SA(0, 1), cA + hstep, voffA);
        if (wr == 1) PG8_BAR;
        PG8_WAIT_V(2); PG8_BAR;
        PG8_STAGE(PG8_SB(1, 0), cB + kstep, voffB); PG8_STAGE(PG8_SA(1, 0), cA + kstep, voffA); PG8_STAGE(PG8_SB(1, 1), cB + hstep + kstep, voffB);
        PG8_WAIT_V(6); PG8_BAR;
    } else {
        PG8_STAGE(PG8_SB(0, 0), cB, voffB); PG8_STAGE(PG8_SA(0, 0), cA, voffA); PG8_STAGE(PG8_SB(0, 1), cB + hstep, voffB); PG8_STAGE(PG8_SA(0, 1), cA + hstep, voffA);
        if (wr == 1) PG8_BAR;
        PG8_WAIT_V(4); PG8_BAR;
        PG8_STAGE(PG8_SB(1, 0), cB + kstep, voffB); PG8_STAGE(PG8_SA(1, 0), cA + kstep, voffA); PG8_STAGE(PG8_SB(1, 1), cB + hstep + kstep, voffB);
        PG8_WAIT_V(6); PG8_BAR;
    }
    for (;;) {
        const bool has_next = S.next(ui + 1, nxt);
        const char* nA = has_next ? (const char*)g.A + (size_t)nxt.pm * tstep + (Sched::SPLIT ? (size_t)nxt.kt0 * kstep : (size_t)0) : cA; const char* nB = has_next ? (const char*)g.Bt + (size_t)nxt.pn * tstep + (Sched::SPLIT ? (size_t)nxt.kt0 * kstep : (size_t)0) : cB;
        const int nt = Sched::SPLIT ? cur.nkt : K / BK;
        for (int t = 0; t < nt; t += 2) {
            const bool last = (t == nt - 2);
            const char* a1 = cA + (size_t)(t + 1) * kstep;
            const char* a2 = last ? nA : cA + (size_t)(t + 2) * kstep; const char* b2 = last ? nB : cB + (size_t)(t + 2) * kstep;
            const char* a3 = a2 + kstep; const char* b3 = b2 + kstep;
            if (last && has_next) S.a_ready(nxt);
            if constexpr (SP2) {
            PG8_LDB(B0, 0, 0); PG8_LDB(B1, 0, 1); PG8_SCHED; PG8_LDA(At, 0, 0); PG8_STAGE(PG8_SA(1, 1), a1 + hstep, voffA);
            PG8_WAIT_V(8); PG8_WAIT_L(0); PG8_BAR; PG8_MMA(0, 0, At, B0); PG8_MMA(0, 1, At, B1); PG8_BAR; PG8_SCHED;
            PG8_LDA(At, 0, 1); PG8_STAGE(PG8_SB(0, 0), b2, voffB); PG8_STAGE(PG8_SB(0, 1), b2 + hstep, voffB); PG8_STAGE(PG8_SA(0, 0), a2, voffA);
            PG8_WAIT_V(8); PG8_WAIT_L(0); PG8_BAR; PG8_MMA(1, 0, At, B0); PG8_MMA(1, 1, At, B1); PG8_BAR; PG8_SCHED;
            PG8_LDB(B0, 1, 0); PG8_LDB(B1, 1, 1); PG8_SCHED; PG8_LDA(At, 1, 0); PG8_STAGE(PG8_SA(0, 1), a2 + hstep, voffA);
            PG8_WAIT_V(8); PG8_WAIT_L(0); PG8_BAR; PG8_MMA(0, 0, At, B0); PG8_MMA(0, 1, At, B1); PG8_BAR; PG8_SCHED;
            PG8_LDA(At, 1, 1); PG8_STAGE(PG8_SB(1, 0), b3, voffB); PG8_STAGE(PG8_SB(1, 1), b3 + hstep, voffB); PG8_STAGE(PG8_SA(1, 0), a3, voffA);
            PG8_WAIT_V(8); PG8_WAIT_L(0); PG8_BAR; PG8_MMA(1, 0, At, B0); PG8_MMA(1, 1, At, B1); PG8_BAR; PG8_SCHED;
            } else {
            PG8_LDB(B0, 0, 0); PG8_SCHED; PG8_LDA(At, 0, 0); PG8_STAGE(PG8_SA(1, 1), a1 + hstep, voffA);
            PG8_WAIT_L(8); PG8_BAR; PG8_WAIT_L(0); PG8_MMA(0, 0, At, B0); PG8_BAR; PG8_SCHED;
            PG8_LDB(B1, 0, 1); PG8_STAGE(PG8_SB(0, 0), b2, voffB);
            PG8_BAR; PG8_WAIT_L(0); PG8_MMA(0, 1, At, B1); PG8_BAR;
            PG8_LDA(At, 0, 1); PG8_STAGE(PG8_SA(0, 0), a2, voffA);
            PG8_BAR; PG8_WAIT_L(0); PG8_MMA(1, 0, At, B0); PG8_BAR; PG8_SCHED;
            PG8_STAGE(PG8_SB(0, 1), b2 + hstep, voffB);
            PG8_WAIT_V(6); PG8_BAR; PG8_MMA(1, 1, At, B1); PG8_BAR;
            PG8_LDB(B0, 1, 0); PG8_SCHED; PG8_LDA(At, 1, 0); PG8_STAGE(PG8_SA(0, 1), a2 + hstep, voffA);
            PG8_WAIT_L(8); PG8_BAR; PG8_WAIT_L(0); PG8_MMA(0, 0, At, B0); PG8_BAR; PG8_SCHED;
            PG8_LDB(B1, 1, 1); PG8_STAGE(PG8_SB(1, 0), b3, voffB);
            PG8_BAR; PG8_WAIT_L(0); PG8_MMA(0, 1, At, B1); PG8_BAR;
            PG8_LDA(At, 1, 1); PG8_STAGE(PG8_SA(1, 0), a3, voffA);
            PG8_BAR; PG8_WAIT_L(0); PG8_MMA(1, 0, At, B0); PG8_BAR; PG8_SCHED;
            PG8_STAGE(PG8_SB(1, 1), b3 + hstep, voffB);
            PG8_WAIT_V(6); PG8_BAR; PG8_MMA(1, 1, At, B1); PG8_BAR;
            }
        }
        if constexpr (ALIGN_EPI) { if (wr == 0) PG8_BAR; }
        if constexpr (!Epi::AFTER_DRAIN) { if (Sched::SPLIT && cur.kind == 1) S.put_partial(acc, tid, lane); else { E(acc, cur, wr, wc, fr, fq);
#if EPI_TWICE
            if (Epi::TWICE_OK) { asm volatile("" ::: "memory"); E(acc, cur, wr, wc, fr, fq); }
#endif
            } S.done(cur); }
        if (!has_next) break;
        if (Sched::SPLIT && nxt.kind == 2) S.load_partial(acc, tid, lane);
        else {
#pragma unroll
        for (int a = 0; a < 2; ++a)
#pragma unroll
            for (int b = 0; b < 2; ++b)
#pragma unroll
                for (int m = 0; m < 4; ++m)
#pragma unroll
                    for (int n = 0; n < 2; ++n) acc[a][b][m][n] = (f32x4){0.f, 0.f, 0.f, 0.f};
        }
        cur = nxt; cA = nA; cB = nB; ++ui;
        if constexpr (ALIGN_EPI) { if (wr == 1) PG8_BAR; }
    }
    PG8_WAIT_V(0);
    if constexpr (!ALIGN_EPI) { if (wr == 0) PG8_BAR; }
    PG8_BAR;
    if constexpr (Epi::AFTER_DRAIN) { E.fused(acc, cur, wr, wc, fr, fq, lds, wid, lane); S.done(cur); }
#undef PG8_SA
#undef PG8_SB
#undef PG8_STAGE
#undef PG8_LDA
#undef PG8_LDB
#undef PG8_MMA
#undef PG8_WAIT_V
#undef PG8_WAIT_L
#undef PG8_BAR
#undef PG8_SCHED
}
}

constexpr size_t MiB = 1u << 20;
constexpr size_t WS_CTL = 0, CTL_ZERO_BYTES = 64 * 1024;
constexpr size_t WS_W1GU = 1 * MiB, WS_W1D = 12 * MiB, WS_W2GU = 18 * MiB, WS_W2D = 29 * MiB, WS_WIN = 35 * MiB, WS_WOUT = 40 * MiB;
constexpr size_t WS_GATEW = 42 * MiB;
constexpr size_t WS_SP8 = WS_GATEW + 256 * 1024;
constexpr size_t WS_RSTD0 = 43 * MiB;
constexpr size_t WS_SSQ1 = 44 * MiB, WS_SSQ2 = 47 * MiB;
constexpr size_t WS_LSUM = 50 * MiB;
constexpr size_t WS_XB = 53 * MiB;
constexpr size_t WS_H = 121 * MiB;
constexpr size_t WS_Q = WS_H, WS_KVP = WS_H + 34 * MiB, WS_KVS = WS_H + 98 * MiB, WS_XR = WS_H + 102 * MiB, WS_XG = WS_H + 136 * MiB;
constexpr size_t WS_CAT = 308 * MiB;
constexpr size_t WS_CK = 376 * MiB, WS_CV = 440 * MiB;
constexpr size_t WS_END = 504 * MiB;
static_assert(OFF_SSQ1 == WS_SSQ1 && OFF_Q == WS_Q && OFF_KVP == WS_KVP && OFF_KVS == WS_KVS && OFF_XR == WS_XR && OFF_XG == WS_XG, "epilogue offsets");
static_assert(WS_H + (size_t)TT * FF * 2 <= WS_CAT && WS_XB + (size_t)TT * DM * 2 <= WS_H && WS_XG + (size_t)TT * 512 * 2 <= WS_CAT, "d_ws map");
constexpr int CW_BAR = 1024;
constexpr int CW_SK = 12288;
constexpr int CW_QUEUE = 8192;

constexpr int RING_BYTES = 131072;
constexpr int MISC_OFF = RING_BYTES;
constexpr int LDS_BYTES = 147456;

#define GAS __attribute__((address_space(1)))
#define LAS __attribute__((address_space(3)))
typedef unsigned short bf16;
typedef unsigned v4u __attribute__((ext_vector_type(4)));
typedef unsigned v2u __attribute__((ext_vector_type(2)));
typedef float f32x4 __attribute__((ext_vector_type(4)));
typedef float f32x16 __attribute__((ext_vector_type(16)));
typedef short bf16x8 __attribute__((ext_vector_type(8)));
typedef short s16x4 __attribute__((ext_vector_type(4)));
#define LDS_WAIT() asm volatile("s_waitcnt lgkmcnt(0)" ::: "memory")
#define VM_WAIT() asm volatile("s_waitcnt vmcnt(0)" ::: "memory")
__device__ __forceinline__ unsigned f2bf(float f) { unsigned u = __builtin_bit_cast(unsigned, f); return (u + 0x7fffu + ((u >> 16) & 1u)) >> 16; }
__device__ __forceinline__ unsigned pk2(float lo, float hi) { return f2bf(lo) | (f2bf(hi) << 16); }
__device__ __forceinline__ float bf2f(unsigned short b) { return __builtin_bit_cast(float, (unsigned)b << 16); }
__device__ __forceinline__ float bflo(unsigned w) { return __builtin_bit_cast(float, w << 16); }
__device__ __forceinline__ float bfhi(unsigned w) { return __builtin_bit_cast(float, w & 0xffff0000u); }
__device__ __forceinline__ float wave_sum(float v) {
#pragma unroll
    for (int o = 1; o < 64; o <<= 1) v += __shfl_xor(v, o);
    return v;
}

#define XB_TMO      128
#define XB_XCNT(j)  (256  + 64 * (j))
#define XB_XSUB(j)  (1280 + 64 * (j))
#define XB_XGEN(j)  (2304 + 64 * (j))
#define XB_TOP      3328
#define XB_TOPGEN   3392
#define XCD_BAR_WORDS 3456
#define XB_SPIN_CAP (1u << 18)

__device__ __forceinline__ unsigned xb_ld(unsigned* p)              { return __hip_atomic_load(p, __ATOMIC_RELAXED, __HIP_MEMORY_SCOPE_AGENT); }
__device__ __forceinline__ unsigned xb_add(unsigned* p, unsigned v) { return __hip_atomic_fetch_add(p, v, __ATOMIC_RELAXED, __HIP_MEMORY_SCOPE_AGENT); }
__device__ __forceinline__ unsigned xb_xcc_id() { return (unsigned)__builtin_amdgcn_s_getreg((3 << 11) | 20) & 0xFu; }
#define XB_SPIN(cond, bar) do { unsigned _sp = 0; while (cond) { __builtin_amdgcn_s_sleep(1); \
    if ((++_sp & 255u) == 0u) { if (xb_ld(&(bar)[XB_TMO])) break; if (_sp > XB_SPIN_CAP) { atomicAdd(&(bar)[XB_TMO], 1u); break; } } } } while (0)

struct XcdBarrier {
    unsigned* bar; unsigned x;
    volatile LAS unsigned* st;
};

__device__ __forceinline__ XcdBarrier xcd_barrier_post(unsigned* bar, volatile LAS unsigned* st) {
    XcdBarrier b; b.bar = bar; b.x = xb_xcc_id(); b.st = st;
    if (threadIdx.x == 0) (void)xb_add(&bar[XB_XCNT(b.x)], 1u);
    return b;
}
__device__ __forceinline__ void xcd_barrier_complete(unsigned* bar, unsigned x, unsigned& nloc, unsigned& nx) {
    const unsigned G = gridDim.x * gridDim.y * gridDim.z;
    unsigned sum, cnt, mine, sp = 0u;
    for (;;) {
        sum = 0u; cnt = 0u; mine = 0u;
#pragma unroll
        for (unsigned j = 0; j < 16; ++j) { const unsigned c = xb_ld(&bar[XB_XCNT(j)]); sum += c; cnt += (c > 0u) ? 1u : 0u; mine = (j == x) ? c : mine; }
        if (sum == G) break;
        __builtin_amdgcn_s_sleep(1);
        if ((++sp & 255u) == 0u) { if (xb_ld(&bar[XB_TMO])) break; if (sp > XB_SPIN_CAP) { atomicAdd(&bar[XB_TMO], 1u); break; } }
    }
    nloc = mine > 0u ? mine : 1u; nx = cnt > 0u ? cnt : 1u;
}

__device__ __forceinline__ void xcd_barrier(const XcdBarrier& b) {
    asm volatile("s_waitcnt vmcnt(0)" ::: "memory");
    __syncthreads();
    if (threadIdx.x == 0) {
        unsigned* bar = b.bar;
        __builtin_amdgcn_s_waitcnt(0);
        unsigned nloc = b.st[0], nx = b.st[1];
        if (nloc == 0u) { xcd_barrier_complete(bar, b.x, nloc, nx); b.st[0] = nloc; b.st[1] = nx; }
        const unsigned old = xb_add(&bar[XB_XSUB(b.x)], 1u);
        const unsigned gen = old / nloc;
        if (old + 1u == (gen + 1u) * nloc) {
            __builtin_amdgcn_fence(__ATOMIC_RELEASE, "agent");
            asm volatile("s_waitcnt vmcnt(0)" ::: "memory");
            const unsigned og = xb_add(&bar[XB_TOP], 1u);
            const unsigned tg = og / nx;
            if (og + 1u == (tg + 1u) * nx) xb_add(&bar[XB_TOPGEN], 1u);
            else XB_SPIN(xb_ld(&bar[XB_TOPGEN]) == tg, bar);
            __builtin_amdgcn_fence(__ATOMIC_ACQUIRE, "agent");
            xb_add(&bar[XB_XGEN(b.x)], 1u);
            asm volatile("s_waitcnt vmcnt(0)" ::: "memory");
        } else {
            XB_SPIN(xb_ld(&bar[XB_XGEN(b.x)]) == gen, bar);
            __builtin_amdgcn_fence(__ATOMIC_ACQUIRE, "agent");
            asm volatile("s_waitcnt vmcnt(0)" ::: "memory");
        }
    }
    __syncthreads();
}

typedef __attribute__((address_space(4))) const unsigned char* kptr_t;
struct Frame {
    LAS unsigned char* lds;
    int tid, lane, wave, G, bx;
    kptr_t ka; int z;
    float* out; unsigned char* ws;
};
__device__ __forceinline__ const float* fin(const Frame& F, int k) { typedef const float* cfp; return *(const __attribute__((address_space(4))) cfp*)(F.ka + (k * 8 + F.z)); }
#define NEW_PHASE() do { int z_ = 0; asm volatile("" : "+s"(z_)); F.z = z_; } while (0)

__device__ __forceinline__ void p0_transpose_item(const float* W, int K, int N, bf16* WT, int kb, int n0, int drow0, const float* gain, LAS float* scr, int lane) {
    const int k0 = 64 * kb;
#pragma unroll 8
    for (int i = 0; i < 32; ++i) { const int kk = 2 * i + (lane >> 5); float w = W[(size_t)(k0 + kk) * N + n0 + (lane & 31)]; if (gain) w *= gain[k0 + kk]; scr[kk * 33 + (lane & 31)] = w; }
    LDS_WAIT(); asm volatile("" ::: "memory");
    const int c = lane & 7;
#pragma unroll
    for (int j = 0; j < 4; ++j) { const int n = (lane >> 3) + 8 * j; const LAS float* s = scr + (8 * c) * 33 + n;
        v4u o; o.x = pk2(s[0 * 33], s[1 * 33]); o.y = pk2(s[2 * 33], s[3 * 33]); o.z = pk2(s[4 * 33], s[5 * 33]); o.w = pk2(s[6 * 33], s[7 * 33]);
        *(GAS v4u*)(WT + (size_t)(drow0 + n) * K + k0 + 8 * c) = o; }
    LDS_WAIT(); asm volatile("" ::: "memory");
}
__device__ __forceinline__ void p0_prologue(Frame& F) {
    LAS float* scr = (LAS float*)(F.lds + F.wave * 16384);
    const int gw = F.bx * 8 + F.wave, NGW = F.G * 8;
    unsigned char* ws = F.ws;
    constexpr int I_GU = 16 * 88, I_DN = 44 * 32, I_IN = 16 * 80, I_OUT = 16 * 32;
    constexpr int NITEMS = 2 * (2 * I_GU + I_DN) + I_IN + I_OUT;
    constexpr int I_FFN = 2 * I_GU + I_DN;
    for (int it = gw; it < NITEMS; it += NGW) {
        int r = it;
        if (r < 2 * I_FFN) {
            const int f = r >= I_FFN; r -= f * I_FFN;
            const float* Wg = f == 0 ? fin(F, 8) : fin(F, 30); const float* Wu = f == 0 ? fin(F, 9) : fin(F, 31); const float* Wd = f == 0 ? fin(F, 10) : fin(F, 32); const float* gn = f == 0 ? fin(F, 7) : fin(F, 29);
            bf16* GU = (bf16*)(ws + (f == 0 ? WS_W1GU : WS_W2GU)); bf16* DN = (bf16*)(ws + (f == 0 ? WS_W1D : WS_W2D));
            if (r < 2 * I_GU) { const int up = r >= I_GU; const int q = up ? r - I_GU : r; const int kb = q / 88, nb = q % 88, n0 = 32 * nb;
                p0_transpose_item(up ? Wu : Wg, 1024, FF, GU, kb, n0, 256 * (n0 >> 7) + (n0 & 127) + (up ? 128 : 0), gn, scr, F.lane); }
            else { r -= 2 * I_GU; const int kb = r / 32, nb = r % 32; p0_transpose_item(Wd, FF, 1024, DN, kb, 32 * nb, 32 * nb, nullptr, scr, F.lane); }
            continue;
        }
        r -= 2 * I_FFN;
        if (r < I_IN) { const int kb = r / 80, nb = r % 80, n0 = 32 * nb; int dr = n0;
            if (n0 < 1024) { const int oc = n0 & 255, wc = oc >> 6, bj = (oc >> 5) & 1; dr = (n0 & ~255) + 128 * bj + 32 * wc; }
            p0_transpose_item(fin(F, 12), 1024, INW, (bf16*)(ws + WS_WIN), kb, n0, dr, fin(F, 11), scr, F.lane); continue; }
        r -= I_IN;
        { const int kb = r / 32, nb = r % 32; p0_transpose_item(fin(F, 28), 1024, 1024, (bf16*)(ws + WS_WOUT), kb, 32 * nb, 32 * nb, nullptr, scr, F.lane); }
    }
    {   bf16* XB = (bf16*)(ws + WS_XB); float* rstd0 = (float*)(ws + WS_RSTD0);
        for (int m = gw; m < TT; m += NGW) {
            const float* xrow = m < TP ? fin(F, 0) + (size_t)m * DM : fin(F, 1) + (size_t)(m - TP) * DM;
            const GAS f32x4* xr = (const GAS f32x4*)xrow + F.lane;
            f32x4 v[4]; float s = 0.f;
#pragma unroll
            for (int j = 0; j < 4; ++j) { v[j] = xr[64 * j]; s += (v[j].x * v[j].x + v[j].y * v[j].y) + (v[j].z * v[j].z + v[j].w * v[j].w); }
            s = wave_sum(s);
            if (F.lane == 0) rstd0[m] = __builtin_amdgcn_rsqf(s * (1.0f / DM) + EPS);
            GAS unsigned long long* o8 = (GAS unsigned long long*)(XB + (size_t)m * DM) + F.lane;
#pragma unroll
            for (int j = 0; j < 4; ++j) o8[64 * j] = (unsigned long long)pk2(v[j].x, v[j].y) | ((unsigned long long)pk2(v[j].z, v[j].w) << 32);
        }
    }
    {   bf16* GW = (bf16*)(ws + WS_GATEW); float* sp8 = (float*)(ws + WS_SP8);
        const int gt = F.bx * 512 + F.tid, NT = F.G * 512;
        for (int i = gt; i < 2 * 8 * 64 * 64; i += NT) { const int g = i >> 15, n = (i >> 12) & 7, j = (i >> 6) & 63, c = i & 63;
            GW[i] = (bf16)f2bf((g == 0 ? fin(F, 22) : fin(F, 24))[(n * 64 + c) * 64 + j]); }
        for (int i = gt; i < 512; i += NT) { const float L = fin(F, 26)[i]; sp8[i] = 8.0f * (L > 20.f ? __expf(-L) : log1pf(__expf(-L))); }
    }
}

namespace lru {
constexpr int L_XC = 0;
constexpr int L_HIN = 65536;
constexpr int L_PART = 65536 + 2048;
constexpr int L_PAR = 135168;
constexpr int L_O0 = 65536 + 4096;
__device__ __forceinline__ int crow(int r, int hi) { return (r & 3) + 8 * (r >> 2) + 4 * hi; }
__device__ __forceinline__ float sigmoid_f(float x) { return __builtin_amdgcn_rcpf(1.0f + __builtin_amdgcn_exp2f(-x * LOG2E)); }

template <int CTRL, int RM> __device__ __forceinline__ float dpp_f(float oldv, float src) {
    return __builtin_bit_cast(float, __builtin_amdgcn_update_dpp(__builtin_bit_cast(int, oldv), __builtin_bit_cast(int, src), CTRL, RM, 0xF, false)); }
#define LRU_SCAN_STEP(CTRL, RM) do { const float ap_ = dpp_f<CTRL, RM>(1.0f, a), bp_ = dpp_f<CTRL, RM>(0.0f, b); b = a * bp_ + b; a = a * ap_; } while (0)
__device__ __forceinline__ float rl_half(float v, int hi) {
    return __builtin_bit_cast(float, __builtin_amdgcn_ds_bpermute((hi * 32 + 31) * 4, __builtin_bit_cast(int, v))); }
template <int PASS> __device__ __forceinline__ void lru_unit(Frame& F, int u) {
    int tid_ = F.tid; asm volatile("" : "+v"(tid_));
    const int tid = tid_, lane = tid & 63, wid = F.wave, r32 = lane & 31, hi = lane >> 5;
    const bool smp = u >= 512; const int sb = u - 512, pb = u >> 7, ck = smp ? 0 : (u & 127);
    const int row0 = smp ? TP + sb * 64 : pb * SEQ + ck * 64;
    const bf16* XR = (const bf16*)(F.ws + WS_XR); const bf16* XG = (const bf16*)(F.ws + WS_XG);
    LAS unsigned char* lds = F.lds;
    if (PASS == 2) {
        float h = 0.f;
        if (smp) h = fin(F, 4)[sb * 512 + tid];
        else { const float* S = (const float*)(F.ws + WS_LSUM) + ((size_t)(pb * 128) * 512 + tid) * 2;
            int c = 0;
            for (; c + 32 <= ck; c += 32) { float2 v[32];
#pragma unroll
                for (int k = 0; k < 32; ++k) v[k] = *(const float2*)(S + (size_t)(c + k) * 1024);
#pragma unroll
                for (int k = 0; k < 32; ++k) h = v[k].x * h + v[k].y; }
            for (; c + 8 <= ck; c += 8) { float2 v[8];
#pragma unroll
                for (int k = 0; k < 8; ++k) v[k] = *(const float2*)(S + (size_t)(c + k) * 1024);
#pragma unroll
                for (int k = 0; k < 8; ++k) h = v[k].x * h + v[k].y; }
            for (; c < ck; ++c) { const float2 v = *(const float2*)(S + (size_t)c * 1024); h = v.x * h + v.y; } }
        ((LAS float*)(lds + L_HIN))[tid] = h;
    }
    {   LAS float* par = (LAS float*)(lds + L_PAR);
        par[tid] = fin(F, 23)[tid]; par[512 + tid] = fin(F, 25)[tid]; par[1024 + tid] = ((const float*)(F.ws + WS_SP8))[tid]; if (PASS == 2) par[1536 + tid] = fin(F, 27)[tid]; }
    {   const int cg = tid & 63, tg = tid >> 6, c0 = 8 * cg;
        float xw[11][8];
#pragma unroll
        for (int i = 0; i < 11; ++i) { const int tt = 8 * tg + i - 3;
            if (tt >= 0 || ck > 0) { const v4u w = *(const GAS v4u*)(XR + (size_t)(row0 + tt) * 512 + c0);
                xw[i][0] = bflo(w.x); xw[i][1] = bfhi(w.x); xw[i][2] = bflo(w.y); xw[i][3] = bfhi(w.y); xw[i][4] = bflo(w.z); xw[i][5] = bfhi(w.z); xw[i][6] = bflo(w.w); xw[i][7] = bfhi(w.w); }
            else if (smp) { const float* sc = fin(F, 5) + (size_t)(sb * 3 + (tt + 3)) * 512 + c0; const f32x4 a = *(const f32x4*)sc, b = *(const f32x4*)(sc + 4);
                xw[i][0] = a[0]; xw[i][1] = a[1]; xw[i][2] = a[2]; xw[i][3] = a[3]; xw[i][4] = b[0]; xw[i][5] = b[1]; xw[i][6] = b[2]; xw[i][7] = b[3]; }
            else {
#pragma unroll
                for (int e = 0; e < 8; ++e) xw[i][e] = 0.f; } }
        float cw[4][8], cb[8];
#pragma unroll
        for (int j = 0; j < 4; ++j) { const f32x4 a = *(const f32x4*)(fin(F, 20) + j * 512 + c0), b = *(const f32x4*)(fin(F, 20) + j * 512 + c0 + 4);
            cw[j][0] = a[0]; cw[j][1] = a[1]; cw[j][2] = a[2]; cw[j][3] = a[3]; cw[j][4] = b[0]; cw[j][5] = b[1]; cw[j][6] = b[2]; cw[j][7] = b[3]; }
        { const f32x4 a = *(const f32x4*)(fin(F, 21) + c0), b = *(const f32x4*)(fin(F, 21) + c0 + 4); cb[0] = a[0]; cb[1] = a[1]; cb[2] = a[2]; cb[3] = a[3]; cb[4] = b[0]; cb[5] = b[1]; cb[6] = b[2]; cb[7] = b[3]; }
#pragma unroll
        for (int i = 0; i < 8; ++i) { const int t = 8 * tg + i; float xc[8];
#pragma unroll
            for (int e = 0; e < 8; ++e) xc[e] = cb[e] + cw[0][e] * xw[i][e] + cw[1][e] * xw[i + 1][e] + cw[2][e] * xw[i + 2][e] + cw[3][e] * xw[i + 3][e];
            v4u o; o.x = pk2(xc[0], xc[1]); o.y = pk2(xc[2], xc[3]); o.z = pk2(xc[4], xc[5]); o.w = pk2(xc[6], xc[7]);
            *(LAS v4u*)(lds + L_XC + t * 1024 + ((cg ^ (t & 15)) << 4)) = o; }
    }
    LDS_WAIT(); __syncthreads();
    const int n = wid;
    const bf16* GW = (const bf16*)(F.ws + WS_GATEW);
    float ssq_t[2] = {0.f, 0.f};
    float outv[2][16];
#pragma unroll
    for (int jb = 0; jb < 2; ++jb) {
        v2u gwv[4][2];
        if (PASS == 2) {
#pragma unroll
            for (int q4 = 0; q4 < 4; ++q4)
#pragma unroll
                for (int tb = 0; tb < 2; ++tb) gwv[q4][tb] = *(const GAS v2u*)(XG + (size_t)(row0 + tb * 32 + r32) * 512 + 64 * n + 32 * jb + 8 * q4 + 4 * hi); }
        f32x16 accr[2], acci[2];
#pragma unroll
        for (int tb = 0; tb < 2; ++tb) { accr[tb] = f32x16{}; acci[tb] = f32x16{}; }
#pragma unroll
        for (int ks = 0; ks < 4; ++ks) {
            const bf16x8 ar = *(const GAS bf16x8*)(GW + ((size_t)((0 * 8 + n) * 64 + jb * 32 + r32) * 64 + ks * 16 + hi * 8));
            const bf16x8 ax = *(const GAS bf16x8*)(GW + ((size_t)((1 * 8 + n) * 64 + jb * 32 + r32) * 64 + ks * 16 + hi * 8));
#pragma unroll
            for (int tb = 0; tb < 2; ++tb) { const int t = tb * 32 + r32; const int chunk = 8 * n + 2 * ks + hi;
                const bf16x8 bfr = *(const LAS bf16x8*)(lds + L_XC + t * 1024 + ((chunk ^ (t & 15)) << 4));
                accr[tb] = __builtin_amdgcn_mfma_f32_32x32x16_bf16(ar, bfr, accr[tb], 0, 0, 0);
                acci[tb] = __builtin_amdgcn_mfma_f32_32x32x16_bf16(ax, bfr, acci[tb], 0, 0, 0); }
        }
        float av[2][16], bv[2][16];
#pragma unroll
        for (int q4 = 0; q4 < 4; ++q4) {
            const int chb = 64 * n + 32 * jb + 8 * q4 + 4 * hi;
            const f32x4 ba = *(const LAS f32x4*)(lds + L_PAR + chb * 4), bx = *(const LAS f32x4*)(lds + L_PAR + 2048 + chb * 4), sp = *(const LAS f32x4*)(lds + L_PAR + 4096 + chb * 4);
#pragma unroll
            for (int tb = 0; tb < 2; ++tb) { const int t = tb * 32 + r32;
                const v2u xw = *(const LAS v2u*)(lds + L_XC + t * 1024 + ((((chb >> 3) ^ (t & 15)) << 4) | ((chb & 7) << 1)));
                const float xc[4] = {bflo(xw.x), bfhi(xw.x), bflo(xw.y), bfhi(xw.y)};
#pragma unroll
                for (int e = 0; e < 4; ++e) { const int r = 4 * q4 + e;
                    const float rg = sigmoid_f(accr[tb][r] + ba[e]), ig = sigmoid_f(acci[tb][r] + bx[e]);
                    const float a = __builtin_amdgcn_exp2f(-rg * sp[e] * LOG2E);
                    av[tb][r] = a; bv[tb][r] = __builtin_amdgcn_sqrtf(fmaxf(1.0f - a * a, 0.f)) * (ig * xc[e]); } }
        }
#pragma unroll
        for (int r = 0; r < 16; ++r) {
#pragma unroll
            for (int tb = 0; tb < 2; ++tb) {
                float a = av[tb][r], b = bv[tb][r];
                LRU_SCAN_STEP(0x111, 0xF); LRU_SCAN_STEP(0x112, 0xF); LRU_SCAN_STEP(0x114, 0xF); LRU_SCAN_STEP(0x118, 0xF);
                LRU_SCAN_STEP(0x142, 0xA);
                av[tb][r] = a; bv[tb][r] = b; }
            const float A0 = rl_half(av[0][r], hi), B0 = rl_half(bv[0][r], hi);
            bv[1][r] = av[1][r] * B0 + bv[1][r]; av[1][r] = av[1][r] * A0;
        }
        if (PASS == 1) {
            if (r32 == 31) { float* S = (float*)(F.ws + WS_LSUM) + (size_t)u * 1024;
#pragma unroll
                for (int r = 0; r < 16; ++r) { const int ch = 64 * n + 32 * jb + crow(r, hi); *(float2*)(S + 2 * ch) = make_float2(av[1][r], bv[1][r]); } }
        } else {
#pragma unroll
            for (int q4 = 0; q4 < 4; ++q4) { const int chb = 64 * n + 32 * jb + 8 * q4 + 4 * hi;
                const f32x4 hin = *(const LAS f32x4*)(lds + L_HIN + chb * 4);
#pragma unroll
                for (int tb = 0; tb < 2; ++tb) { const int t = tb * 32 + r32;
                    const v2u gw = gwv[q4][tb];
                    const float xg[4] = {bflo(gw.x), bfhi(gw.x), bflo(gw.y), bfhi(gw.y)};
#pragma unroll
                    for (int e = 0; e < 4; ++e) { const int r = 4 * q4 + e; const float h = av[tb][r] * hin[e] + bv[tb][r];
                        const float x = xg[e], uu = 0.7978845608028654f * (x + 0.044715f * x * x * x);
                        const float ge = x * __builtin_amdgcn_rcpf(1.0f + __builtin_amdgcn_exp2f(-2.0f * LOG2E * uu));
                        const float o = h * ge; ssq_t[tb] += o * o;
                        if (jb == 0) ((LAS float*)(lds + L_O0))[(wid * 32 + tb * 16 + r) * 64 + lane] = o; else outv[tb][r] = o;
                        if (tb == 1 && r32 == 31 && (smp || ck == 127)) { float* dst = smp ? F.out + O_LS + sb * 512 : F.out + O_LP + pb * 512; dst[chb + e] = h; } } } }
        }
        __builtin_amdgcn_sched_barrier(0);
    }
    if (PASS == 2) {
        LAS float* part = (LAS float*)(lds + L_PART);
#pragma unroll
        for (int tb = 0; tb < 2; ++tb) { float s = ssq_t[tb]; s += __shfl_xor(s, 32); if (hi == 0) part[wid * 64 + tb * 32 + r32] = s; }
        LDS_WAIT(); __syncthreads();
        bf16* CAT = (bf16*)(F.ws + WS_CAT);
#pragma unroll
        for (int tb = 0; tb < 2; ++tb) { const int t = tb * 32 + r32; float tot = 0.f;
#pragma unroll
            for (int w = 0; w < 8; ++w) tot += part[w * 64 + t];
            const float rn = __builtin_amdgcn_rsqf(tot * (1.0f / 512.0f) + EPS);
#pragma unroll
            for (int jb = 0; jb < 2; ++jb)
#pragma unroll
                for (int q4 = 0; q4 < 4; ++q4) { const int chb = 64 * n + 32 * jb + 8 * q4 + 4 * hi; const f32x4 gn = *(const LAS f32x4*)(lds + L_PAR + 6144 + chb * 4);
                    float ov[4];
#pragma unroll
                    for (int e = 0; e < 4; ++e) ov[e] = jb == 0 ? ((const LAS float*)(lds + L_O0))[(wid * 32 + tb * 16 + 4 * q4 + e) * 64 + lane] : outv[tb][4 * q4 + e];
                    v2u o; o.x = pk2(ov[0] * rn * gn[0], ov[1] * rn * gn[1]); o.y = pk2(ov[2] * rn * gn[2], ov[3] * rn * gn[3]);
                    *(GAS v2u*)(CAT + (size_t)(row0 + t) * 1024 + 512 + chb) = o; } }
    }
    LDS_WAIT(); __syncthreads();
}
}

#ifndef ATT_PROBE
#define ATT_PROBE 0
#endif
namespace att {
constexpr int SLOT = 32768, NSLOT = 4;
constexpr int A_RING = 0;
constexpr int A_EX = 0;
constexpr int A_TAB = 131072;
constexpr int A_WSF = 131072 + 1024;
constexpr int A_MISC = 143360;
__device__ __forceinline__ int crow(int r, int hi) { return (r & 3) + 8 * (r >> 2) + 4 * hi; }
__device__ __forceinline__ void glds16(const void* gsrc, unsigned lds_dst) { unsigned keep;
    asm volatile("s_mov_b32 %0, m0\n\ts_mov_b32 m0, %2\n\ts_nop 0\n\tglobal_load_lds_dwordx4 %1, off\n\ts_mov_b32 m0, %0" : "=&s"(keep) : "v"(gsrc), "s"(lds_dst) : "memory"); }
typedef __attribute__((address_space(3))) const char* lds_cptr;
typedef short v4i16_t __attribute__((ext_vector_type(4)));
__device__ __forceinline__ s16x4 vtr(lds_cptr p) { return __builtin_bit_cast(s16x4, __builtin_amdgcn_ds_read_tr16_b64_v4i16((__attribute__((address_space(3))) v4i16_t*)p)); }
__device__ __forceinline__ unsigned cvtpk(float lo, float hi) { typedef float f2 __attribute__((ext_vector_type(2))); typedef __bf16 b2 __attribute__((ext_vector_type(2)));
    f2 v = {lo, hi}; b2 b = __builtin_convertvector(v, b2); return __builtin_bit_cast(unsigned, b); }
#define ATT_WAIT_BAR(N) asm volatile("s_waitcnt vmcnt(" #N ") lgkmcnt(0)\n\ts_barrier" ::: "memory")

template <bool SMP, bool DESC> __device__ __forceinline__ void attn_unit(Frame& F, int sidx, int h, int qb, float lam) {
    int tid_ = F.tid; asm volatile("" : "+v"(tid_));
    const int tid = tid_, lane = tid & 63, wid = F.wave, r32 = lane & 31, hi = lane >> 5;
    const int comp = wid >> 2, g = wid & 3;
    LAS unsigned char* lds = F.lds;
    const unsigned lds0 = (unsigned)(uintptr_t)lds;
    const bf16* Qb = (const bf16*)(F.ws + WS_Q);
    const int qrow0 = SMP ? TP + sidx * 64 : sidx * SEQ + qb * 128;
    const int qpos0 = SMP ? PAST : qb * 128;
    const int NT = SMP ? 33 : 2 * qb + 2;
    const bool active = SMP ? (g < 2) : true;
    const int gq = SMP ? (g & 1) : g;
    const int qw = qpos0 + 32 * gq;
    const int t_last = active ? (qw >> 6) : -1;
    const int t_near0 = (qw - 90) > 0 ? ((qw - 90) >> 6) : 0;
    if (tid < 256) { float v = 0.f;
        if (tid >= 97 && tid <= 250) { const int delta = tid - 187; const int rel = delta < 0 ? -delta : delta; int bk;
            if (rel < 8) bk = rel; else { bk = 2 + (31 - __builtin_clz((unsigned)(rel * rel))); bk = bk > 15 ? 15 : bk; }
            if (delta > 0) bk += 16;
            v = (fin(F, 6)[bk * 4 + h] - fin(F, 6)[15 * 4 + h]) * LOG2E; }
        ((LAS float*)(lds + A_TAB))[tid] = v; }
    const unsigned char* img0 = F.ws + WS_KVP + (size_t)((SMP ? 0 : (sidx * 4 + h)) * 128) * 32768;
    const unsigned char* imgn = F.ws + WS_KVS + (size_t)(sidx * 4 + h) * 32768;
    const unsigned poff = (unsigned)(wid * 1024 + lane * 16);
    const unsigned pdst = lds0 + A_RING + wid * 1024;
#define ATT_TILE(i) (DESC ? NT - 1 - (i) : (i))
#define ATT_ISSUE(i) do { const int i_ = (i); const int t_ = ATT_TILE(i_); const unsigned so_ = (unsigned)((i_ % NSLOT) * SLOT); \
        if (SMP && t_ != 32) break;                                                 \
        const unsigned char* src_ = (SMP ? imgn : img0 + (size_t)t_ * 32768) + poff; \
        glds16(src_, (unsigned)__builtin_amdgcn_readfirstlane(pdst + so_)); \
        glds16(src_ + 8192, (unsigned)__builtin_amdgcn_readfirstlane(pdst + so_ + 8192)); \
        glds16(src_ + 16384, (unsigned)__builtin_amdgcn_readfirstlane(pdst + so_ + 16384)); \
        glds16(src_ + 24576, (unsigned)__builtin_amdgcn_readfirstlane(pdst + so_ + 24576)); } while (0)
    bf16x8 qr[4];
    { const bf16* Qw = Qb + (size_t)(qrow0 + 32 * gq + r32) * 512 + h * 128 + comp * 64;
#pragma unroll
      for (int d0 = 0; d0 < 4; ++d0) qr[d0] = *(const GAS bf16x8*)(Qw + d0 * 16 + hi * 8); }
    VM_WAIT();
    asm volatile("" : "+v"(qr[0]), "+v"(qr[1]), "+v"(qr[2]), "+v"(qr[3]));
#ifdef ATT_PRIO
    if (comp == ATT_PRIO - 1) __builtin_amdgcn_s_setprio(1);
#endif
    const bool loader = SMP && !active;
    const int wl = (wid & 1) | ((wid >> 2) << 1);
#define ATT_LOAD_TILE(tt, slot_) do { const int t_ = (tt); LAS unsigned char* sl_ = lds + A_RING + (slot_) * SLOT; \
        const float* ck_ = fin(F, 2) + ((size_t)(sidx * PAST + t_ * 64 + wl * 16) * 4 + h) * 128; const float* cv_ = fin(F, 3) + ((size_t)(sidx * PAST + t_ * 64 + wl * 16) * 4 + h) * 128; \
        f32x4 ka_[4][2], va_[4][2]; \
        _Pragma("unroll") for (int u = 0; u < 4; ++u) { const int cj = u * 4 + (lane >> 4); const float* s_ = ck_ + (size_t)(lane & 15) * 512 + cj * 8; \
            ka_[u][0] = __builtin_nontemporal_load((const f32x4*)s_); ka_[u][1] = __builtin_nontemporal_load((const f32x4*)s_ + 1); } \
        _Pragma("unroll") for (int u = 0; u < 4; ++u) { const float* s_ = cv_ + (size_t)(lane >> 2) * 512 + u * 32 + (lane & 3) * 8; \
            va_[u][0] = __builtin_nontemporal_load((const f32x4*)s_); va_[u][1] = __builtin_nontemporal_load((const f32x4*)s_ + 1); } \
        _Pragma("unroll") for (int u = 0; u < 4; ++u) { const int cj = u * 4 + (lane >> 4); v4u o_; o_.x = pk2(ka_[u][0].x, ka_[u][0].y); o_.y = pk2(ka_[u][0].z, ka_[u][0].w); o_.z = pk2(ka_[u][1].x, ka_[u][1].y); o_.w = pk2(ka_[u][1].z, ka_[u][1].w); \
            *(LAS v4u*)(sl_ + (cj >> 3) * 8192 + (cj & 7) * 1024 + (wl * 16 + (lane & 15)) * 16) = o_; } \
        _Pragma("unroll") for (int u = 0; u < 4; ++u) { v4u o_; o_.x = pk2(va_[u][0].x, va_[u][0].y); o_.y = pk2(va_[u][0].z, va_[u][0].w); o_.z = pk2(va_[u][1].x, va_[u][1].y); o_.w = pk2(va_[u][1].z, va_[u][1].w); \
            *(LAS v4u*)(sl_ + 16384 + u * 4096 + (wl * 16 + (lane >> 2)) * 64 + (lane & 3) * 16) = o_; } } while (0)
    if (loader) { ATT_LOAD_TILE(0, 0); ATT_LOAD_TILE(1, 1); VM_WAIT(); }
    ATT_ISSUE(0); if (NT > 1) ATT_ISSUE(1);
    f32x16 o[4]; o[0] = f32x16{}; o[1] = f32x16{}; o[2] = f32x16{}; o[3] = f32x16{};
    float lsum = 0.f;
    const lds_cptr l3 = (lds_cptr)lds;
    const int kfo = A_RING + comp * 8192 + hi * 1024 + r32 * 16;
    const int vfo = A_RING + 16384 + ((lane >> 4) & 1) * 32 + (lane & 3) * 8 + (4 * hi + ((lane & 15) >> 2)) * 64;
    const int qposl = qw + r32;
    v4u pw[4]; bool have_p = false;
    int so_prev = 0;
#define ATT_VRD(j) do { vlo[j] = vtr(vp + ((j) >> 2) * 4096 + ((j) & 3) * 1024); vhi[j] = vtr(vp + ((j) >> 2) * 4096 + ((j) & 3) * 1024 + 512); } while (0)
#define ATT_VFR(j) (bf16x8){vlo[j][0], vlo[j][1], vlo[j][2], vlo[j][3], vhi[j][0], vhi[j][1], vhi[j][2], vhi[j][3]}
#define ATT_G2(j) do { if ((j) + 3 < 16) ATT_VRD((j) + 3); \
        o[(j) >> 2] = __builtin_amdgcn_mfma_f32_32x32x16_bf16(__builtin_bit_cast(bf16x8, pw[(j) & 3]), ATT_VFR(j), o[(j) >> 2], 0, 0, 0); __builtin_amdgcn_sched_barrier(0); } while (0)
#define ATT_QKEXP(t_, so_) do { f32x16 p0, p1; \
        if ((t_) >= t_near0) { const LAS float* tb = (const LAS float*)(lds + A_TAB) + (64 * (t_) + 4 * hi - qposl + 187);     \
            _Pragma("unroll") for (int r = 0; r < 16; ++r) { p0[r] = tb[(r & 3) + 8 * (r >> 2)]; p1[r] = tb[(r & 3) + 8 * (r >> 2) + 32]; } } \
        else { p0 = f32x16{}; p1 = f32x16{}; } \
        const lds_cptr kp = l3 + kfo + (so_); \
        _Pragma("unroll") for (int d0 = 0; d0 < 4; ++d0) { \
            const bf16x8 k0 = *(const __attribute__((address_space(3))) bf16x8*)(kp + d0 * 2048); \
            const bf16x8 k1 = *(const __attribute__((address_space(3))) bf16x8*)(kp + d0 * 2048 + 512); \
            p0 = __builtin_amdgcn_mfma_f32_32x32x16_bf16(k0, qr[d0], p0, 0, 0, 0); \
            p1 = __builtin_amdgcn_mfma_f32_32x32x16_bf16(k1, qr[d0], p1, 0, 0, 0); } \
        float sacc = 0.f; \
        _Pragma("unroll") for (int r = 0; r < 16; ++r) { p0[r] = __builtin_amdgcn_exp2f(p0[r]); p1[r] = __builtin_amdgcn_exp2f(p1[r]); sacc += p0[r] + p1[r]; } \
        lsum += sacc; \
        _Pragma("unroll") for (int k = 0; k < 2; ++k) { pw[k] = (v4u){cvtpk(p0[8 * k], p0[8 * k + 1]), cvtpk(p0[8 * k + 2], p0[8 * k + 3]), cvtpk(p0[8 * k + 4], p0[8 * k + 5]), cvtpk(p0[8 * k + 6], p0[8 * k + 7])}; \
                                      pw[2 + k] = (v4u){cvtpk(p1[8 * k], p1[8 * k + 1]), cvtpk(p1[8 * k + 2], p1[8 * k + 3]), cvtpk(p1[8 * k + 4], p1[8 * k + 5]), cvtpk(p1[8 * k + 6], p1[8 * k + 7])}; } } while (0)
#define ATT_PV(so_) do { const lds_cptr vp = l3 + vfo + (so_); s16x4 vlo[16], vhi[16]; ATT_VRD(0); ATT_VRD(1); ATT_VRD(2); __builtin_amdgcn_sched_barrier(0); \
        ATT_G2(0); ATT_G2(1); ATT_G2(2); ATT_G2(3); ATT_G2(4); ATT_G2(5); ATT_G2(6); ATT_G2(7); ATT_G2(8); ATT_G2(9); ATT_G2(10); ATT_G2(11); ATT_G2(12); ATT_G2(13); ATT_G2(14); ATT_G2(15); } while (0)
#define ATT_SYNC(it_) do { if ((it_) + 1 < NT) ATT_WAIT_BAR(4); else ATT_WAIT_BAR(0);     \
        if ((it_) + 2 < NT) ATT_ISSUE((it_) + 2); } while (0)
    const bool skew = comp == 1;
    for (int it = 0; it < NT; ++it) {
        const int t = ATT_TILE(it);
        if (skew) ATT_SYNC(it);
        if (have_p) { ATT_PV(so_prev); __builtin_amdgcn_sched_barrier(0); }
        if (!skew) ATT_SYNC(it);
        const int so = (it % NSLOT) * SLOT;
        have_p = (t <= t_last);
        if (have_p) { ATT_QKEXP(t, so); so_prev = so; }
        if (loader && it + 2 < 32) { ATT_LOAD_TILE(it + 2, (it + 2) % NSLOT); VM_WAIT(); }
    }
    if (have_p) { ATT_PV(so_prev); }
#undef ATT_SYNC
#undef ATT_VRD
#undef ATT_VFR
#undef ATT_G2
#undef ATT_QKEXP
#undef ATT_PV
#ifdef ATT_PRIO
    __builtin_amdgcn_s_setprio(0);
#endif
    int lane_e = lane; asm volatile("" : "+v"(lane_e));
    const int r32e = lane_e & 31, hie = lane_e >> 5;
    { auto rr = __builtin_amdgcn_permlane32_swap(__float_as_uint(lsum), __float_as_uint(lsum), false, false); lsum = __uint_as_float(rr[0]) + __uint_as_float(rr[1]); }
    LAS float* wsf = (LAS float*)(lds + A_WSF) + wid * 32;
    if (hie == 0) wsf[r32e] = lsum;
    ATT_WAIT_BAR(0);
    float rli[16];
#pragma unroll
    for (int r = 0; r < 16; ++r) rli[r] = __builtin_amdgcn_rcpf(wsf[crow(r, hie)]);
    LAS float* ex = (LAS float*)(lds + A_EX) + g * 4096;
    if (comp == 1) {
#pragma unroll
        for (int db = 0; db < 4; ++db)
#pragma unroll
            for (int r = 0; r < 16; ++r) ex[crow(r, hie) * 128 + db * 32 + r32e] = o[db][r] * (rli[r] * lam);
    }
    LDS_WAIT(); __syncthreads();
    if (comp == 0 && active) {
        float ss[16];
#pragma unroll
        for (int r = 0; r < 16; ++r) ss[r] = 0.f;
#pragma unroll
        for (int db = 0; db < 4; ++db)
#pragma unroll
            for (int r = 0; r < 16; ++r) { const float v = o[db][r] * rli[r] - ex[crow(r, hie) * 128 + db * 32 + r32e]; o[db][r] = v; ss[r] += v * v; }
#pragma unroll
        for (int r = 0; r < 16; ++r) { float s = ss[r];
#pragma unroll
            for (int m = 1; m < 32; m <<= 1) s += __shfl_xor(s, m);
            ss[r] = __builtin_amdgcn_rsqf(s * (1.0f / 128.0f) + EPS) * 0.8f; }
        LDS_WAIT();
        LAS unsigned short* stg = (LAS unsigned short*)ex;
#pragma unroll
        for (int db = 0; db < 4; ++db) { const float gn = fin(F, 19)[db * 32 + r32e];
#pragma unroll
            for (int r = 0; r < 16; ++r) stg[crow(r, hie) * 128 + db * 32 + r32e] = (unsigned short)f2bf(o[db][r] * ss[r] * gn); }
        LDS_WAIT();
        bf16* CAT = (bf16*)(F.ws + WS_CAT);
#pragma unroll
        for (int i = 0; i < 8; ++i) { const int row = i * 4 + (lane_e >> 4), ch = lane_e & 15;
            const v4u v = *(const LAS v4u*)(stg + row * 128 + ch * 8);
            *(GAS v4u*)(CAT + (size_t)(qrow0 + 32 * g + row) * 1024 + h * 128 + ch * 8) = v; }
    }
    VM_WAIT(); LDS_WAIT(); __syncthreads();
#undef ATT_ISSUE
#undef ATT_LOAD_TILE
#undef ATT_TILE
}
#undef ATT_WAIT_BAR
}

#ifndef SKM_G1
#define SKM_G1 0
#endif
#ifndef SKM_G2
#define SKM_G2 0
#endif
#ifndef SKM_G3
#define SKM_G3 0
#endif
#ifndef SKM_G5
#define SKM_G5 0
#endif
#ifndef SKM_G6
#define SKM_G6 0
#endif
#ifndef SKM_G7
#define SKM_G7 0
#endif
__device__ __forceinline__ void phase_p0(Frame& F) {
    unsigned char* ws = F.ws; (void)ws;
#ifndef NO_P0
    p0_prologue(F);
#endif
}

__device__ __forceinline__ void phase_g1(Frame& F) {
    unsigned char* ws = F.ws; (void)ws;
#ifndef NO_G1
    {   pg8::Gemm g{(const pg8::bf16_t*)(ws + WS_XB), (const pg8::bf16_t*)(ws + WS_W1GU), TT, 2 * FF, DM}; pg8::StreamK<SKM_G1> S; S.init(TT, 2 * FF, DM, F.G, F.bx, (float*)(ws + WS_CAT), (unsigned*)(ws + WS_CTL) + CW_SK + 0 * 512);
        pg8::EpiSwiGLU<0> E{(pg8::bf16_t*)(ws + WS_H), (const float*)(ws + WS_RSTD0)};
        pg8::gemm_phase<pg8::EpiSwiGLU<0>, pg8::StreamK<SKM_G1>, true, true>(F.lds, g, S, E); }
#endif
}

__device__ __forceinline__ void phase_g2(Frame& F) {
    unsigned char* ws = F.ws; (void)ws;
#ifndef NO_G2
    {   pg8::Gemm g{(const pg8::bf16_t*)(ws + WS_H), (const pg8::bf16_t*)(ws + WS_W1D), TT, DM, FF}; pg8::StreamK<SKM_G2> S; S.init(TT, DM, FF, F.G, F.bx, (float*)(ws + WS_CAT), (unsigned*)(ws + WS_CTL) + CW_SK + 1 * 512);
        pg8::EpiResid<0> E{(pg8::bf16_t*)(ws + WS_XB), F.out, (float*)(ws + WS_SSQ1)};
        pg8::gemm_phase<pg8::EpiResid<0>, pg8::StreamK<SKM_G2>, true, true>(F.lds, g, S, E); }
#endif
}

__device__ __forceinline__ void phase_g3(Frame& F) {
    unsigned char* ws = F.ws; (void)ws;
#ifndef NO_G3
    {   pg8::Gemm g{(const pg8::bf16_t*)(ws + WS_XB), (const pg8::bf16_t*)(ws + WS_WIN), TT, INW, DM}; pg8::StreamK<SKM_G3> S; S.init(TT, INW, DM, F.G, F.bx, (float*)(ws + WS_CAT), (unsigned*)(ws + WS_CTL) + CW_SK + 2 * 512);
        pg8::EpiWin E{ws, F.out, fin(F, 13), fin(F, 14)};
        pg8::gemm_phase<pg8::EpiWin, pg8::StreamK<SKM_G3>, true, true>(F.lds, g, S, E); }
#endif
}

__device__ __forceinline__ void phase_l1(Frame& F) {
    unsigned char* ws = F.ws; (void)ws;
#ifndef NO_L1
    for (int u = F.bx; u < 544; u += F.G) lru::lru_unit<1>(F, u);
#endif
}

__device__ __forceinline__ void phase_g5(Frame& F) {
    unsigned char* ws = F.ws; (void)ws;
#ifndef NO_G5
    {   pg8::Gemm g{(const pg8::bf16_t*)(ws + WS_CAT), (const pg8::bf16_t*)(ws + WS_WOUT), TT, DM, DM}; pg8::StreamK<SKM_G5> S; S.init(TT, DM, DM, F.G, F.bx, (float*)(ws + WS_CK), (unsigned*)(ws + WS_CTL) + CW_SK + 3 * 512);
        pg8::EpiResid<1> E{(pg8::bf16_t*)(ws + WS_XB), F.out, (float*)(ws + WS_SSQ2)};
        pg8::gemm_phase<pg8::EpiResid<1>, pg8::StreamK<SKM_G5>, true, true>(F.lds, g, S, E); }
#endif
}

__device__ __forceinline__ void phase_g6(Frame& F) {
    unsigned char* ws = F.ws; (void)ws;
#ifndef NO_G6
    {   pg8::Gemm g{(const pg8::bf16_t*)(ws + WS_XB), (const pg8::bf16_t*)(ws + WS_W2GU), TT, 2 * FF, DM}; pg8::StreamK<SKM_G6> S; S.init(TT, 2 * FF, DM, F.G, F.bx, (float*)(ws + WS_CK), (unsigned*)(ws + WS_CTL) + CW_SK + 4 * 512);
        pg8::EpiSwiGLU<1> E{(pg8::bf16_t*)(ws + WS_H), (const float*)(ws + WS_SSQ2)};
        pg8::gemm_phase<pg8::EpiSwiGLU<1>, pg8::StreamK<SKM_G6>, true, true>(F.lds, g, S, E); }
#endif
}

__device__ __forceinline__ void phase_g7(Frame& F) {
    unsigned char* ws = F.ws; (void)ws;
#ifndef NO_G7
    {   pg8::Gemm g{(const pg8::bf16_t*)(ws + WS_H), (const pg8::bf16_t*)(ws + WS_W2D), TT, DM, FF}; pg8::StreamK<SKM_G7> S; S.init(TT, DM, FF, F.G, F.bx, (float*)(ws + WS_CK), (unsigned*)(ws + WS_CTL) + CW_SK + 5 * 512);
        pg8::EpiResid<2> E{(pg8::bf16_t*)(ws + WS_XB), F.out, nullptr};
        pg8::gemm_phase<pg8::EpiResid<2>, pg8::StreamK<SKM_G7>, true, true>(F.lds, g, S, E); }
#endif
}

struct Args { const float* in[33]; float* out; unsigned char* ws; int pad0, pad1; };
__global__ void __launch_bounds__(512, 2) hymba_fwd(Args args) {
    extern __shared__ __attribute__((aligned(16))) unsigned char lds_raw[];
    cg::grid_group grid = cg::this_grid();
    Frame F;
    F.lds = (LAS unsigned char*)lds_raw;
    F.tid = threadIdx.x; F.lane = F.tid & 63; F.wave = __builtin_amdgcn_readfirstlane(F.tid >> 6);
    F.G = gridDim.x; F.bx = blockIdx.x;
    F.ka = (kptr_t)__builtin_amdgcn_kernarg_segment_ptr(); F.z = 0;
    F.out = args.out; F.ws = args.ws;
    unsigned char* ws = F.ws;
    unsigned* ctl = (unsigned*)(ws + WS_CTL);
    volatile LAS unsigned* MISCW = (volatile LAS unsigned*)(F.lds + 144384);
    if (F.tid < 16) MISCW[F.tid] = 0u;
    __syncthreads();
    XcdBarrier bar = xcd_barrier_post(ctl + CW_BAR, MISCW + 8);
#define GRID_BAR() do { xcd_barrier(bar); NEW_PHASE(); } while (0)
#define GRID_BAR_CG() do { __threadfence(); grid.sync(); NEW_PHASE(); } while (0)

    phase_p0(F);
#if defined(REP_P0)
    GRID_BAR(); phase_p0(F);
#endif
#ifdef USE_CG_SYNC
    GRID_BAR_CG();
#else
    GRID_BAR();
#endif
    phase_g1(F);
#if defined(REP_G1)
    GRID_BAR(); phase_g1(F);
#endif
    GRID_BAR();
    phase_g2(F);
#if defined(REP_G2)
    GRID_BAR(); phase_g2(F);
#endif
    GRID_BAR();
    phase_g3(F);
#if defined(REP_G3)
    GRID_BAR(); phase_g3(F);
#endif
    GRID_BAR();
    phase_l1(F);
#if defined(REP_L1)
    GRID_BAR(); phase_l1(F);
#endif
    GRID_BAR();
    {
        LAS float* misc = (LAS float*)(F.lds + att::A_MISC);
        if (F.wave == 0) { const float a = wave_sum(fin(F, 15)[F.lane] * fin(F, 16)[F.lane]), b = wave_sum(fin(F, 17)[F.lane] * fin(F, 18)[F.lane]);
            if (F.lane == 0) misc[0] = __expf(a) - __expf(b) + 0.2f; }
        __syncthreads();
        const float lam = misc[0];
        const int grp = F.bx & 7;
#ifdef ATT_TWICE
        for (int rep = 0; rep < 2; ++rep) {
        unsigned* head = ctl + CW_QUEUE + 64 * grp + 1024 * rep;
#else
        unsigned* head = ctl + CW_QUEUE + 64 * grp;
#endif
        const int wq = F.bx >> 3;
        if (F.G == 256) {
#ifndef NO_ATT
#pragma unroll 1
            for (int k = 0; k < 2; ++k) { const int st = grp + 8 * k;
                att::attn_unit<false, false>(F, st >> 2, st & 3, wq, lam);
                att::attn_unit<false, true>(F, st >> 2, st & 3, 63 - wq, lam); }
#endif
        }
        const int qbase = (F.G == 256) ? 128 : 0;
        for (;;) {
            if (F.tid == 0) ((LAS int*)misc)[1] = qbase + (int)atomicAdd(head, 1u);
            __syncthreads();
            const int it = ((LAS int*)misc)[1];
            __syncthreads();
            if (it >= 212) break;
#ifndef NO_ATT
            if (it < 128) { const int st = grp + 8 * (it >> 6), qb = 63 - (it & 63); att::attn_unit<false, false>(F, st >> 2, st & 3, qb, lam); }
            else if (it < 144) { const int su = grp * 16 + (it - 128); att::attn_unit<true, false>(F, su >> 2, su & 3, 0, lam); }
            else
#endif
#ifndef NO_L2
            { lru::lru_unit<2>(F, grp * 68 + (it - 144));
#ifdef L2_TWICE
              lru::lru_unit<2>(F, grp * 68 + (it - 144));
#endif
            }
#else
            {}
#endif
        }
#ifdef ATT_TWICE
        __syncthreads(); }
#endif
    }
    GRID_BAR();
    phase_g5(F);
#if defined(REP_G5)
    GRID_BAR(); phase_g5(F);
#endif
    GRID_BAR();
    phase_g6(F);
#if defined(REP_G6)
    GRID_BAR(); phase_g6(F);
#endif
    GRID_BAR();
    phase_g7(F);
#if defined(REP_G7)
    GRID_BAR(); phase_g7(F);
#endif
}

extern "C" void kernel_launch(void* const* d_in, const int* in_sizes, int n_in, void* d_out, int out_size, void* d_ws, size_t ws_size, hipStream_t stream) {
    static int grid = 0;
    if (grid == 0) {
        if (n_in != 33 || out_size != (int)O_END || ws_size < WS_END) { fprintf(stderr, "kernel_launch: unexpected shapes: n_in %d out %d ws %zu (need %zu)\n", n_in, out_size, ws_size, (size_t)WS_END); grid = -1; return; }
        int dev = 0, cus = 0, per_cu = 0;
        hipGetDevice(&dev); hipDeviceGetAttribute(&cus, hipDeviceAttributeMultiprocessorCount, dev);
        if (hipFuncSetAttribute((const void*)hymba_fwd, hipFuncAttributeMaxDynamicSharedMemorySize, LDS_BYTES) != hipSuccess) { fprintf(stderr, "kernel_launch: hipFuncSetAttribute failed\n"); grid = -1; return; }
        if (hipOccupancyMaxActiveBlocksPerMultiprocessor(&per_cu, (const void*)hymba_fwd, 512, LDS_BYTES) != hipSuccess || per_cu < 1) { fprintf(stderr, "kernel_launch: occupancy query says %d\n", per_cu); per_cu = 1; }
        (void)hipGetLastError();
        grid = cus * 1;
        if (grid % 8 != 0 || grid < 8) { fprintf(stderr, "kernel_launch: grid %d not a multiple of 8\n", grid); }
    }
    if (grid < 0) return;
    (void)hipMemsetAsync((char*)d_ws + WS_CTL, 0, CTL_ZERO_BYTES, stream);
    Args a{};
    for (int i = 0; i < 33; ++i) a.in[i] = (const float*)d_in[i];
    a.out = (float*)d_out; a.ws = (unsigned char*)d_ws;
    void* kargs[] = {&a};
    hipError_t e = hipLaunchCooperativeKernel((const void*)hymba_fwd, dim3(grid), dim3(512), kargs, LDS_BYTES, stream);
    if (e != hipSuccess) fprintf(stderr, "kernel_launch: cooperative launch failed: %s (grid %d)\n", hipGetErrorString(e), grid);
}
```

```cpp
#include <hip/hip_runtime.h>
#include <hip/hip_cooperative_groups.h>
#include <hip/hip_bf16.h>
#include <cstdio>
#include <cstdint>
namespace cg = cooperative_groups;

constexpr int DM = 1024, NBP = 4, SEQ = 8192, NBS = 32, DSQ = 64, PAST = 2048;
constexpr int TP = NBP * SEQ, TS = NBS * DSQ, TT = TP + TS;
constexpr int FF = 2816, AW = 512, LW = 512, INW = 2560, NH = 4, HD = 64, VD = 128;
constexpr float EPS = 1e-6f;
constexpr float LOG2E = 1.4426950408889634f;
constexpr float QSCALE = 0.125f * LOG2E;
constexpr size_t O_Y = 0, O_KP = (size_t)TT * DM, O_VP = O_KP + (size_t)TP * 512, O_LP = O_VP + (size_t)TP * 512, O_CP = O_LP + NBP * 512,
                 O_KS = O_CP + NBP * 3 * 512, O_VS = O_KS + (size_t)TS * 512, O_LS = O_VS + (size_t)TS * 512, O_CS = O_LS + NBS * 512, O_END = O_CS + NBS * 3 * 512;
static_assert(O_END == 71376896, "output size");
constexpr size_t OFF_SSQ1 = 44u << 20, OFF_Q = 121u << 20, OFF_KVP = (121u + 34u) << 20, OFF_KVS = (121u + 98u) << 20, OFF_XR = (121u + 102u) << 20, OFF_XG = (121u + 136u) << 20;
namespace pg8 {
#define PG8_LAS __attribute__((address_space(3)))
typedef unsigned short bf16_t;
typedef short bf16x8 __attribute__((ext_vector_type(8)));
typedef float f32x4 __attribute__((ext_vector_type(4)));
typedef unsigned u32x4 __attribute__((ext_vector_type(4)));
constexpr int BM = 256, BK = 64, HALF = 128, HTB = HALF * BK * 2  , STAGE_BYTES = 8 * HTB, NXCD = 8, WGM = 8;

__host__ __device__ __forceinline__ int lds_byte(int r, int c) { const int st = (r >> 4) * 2 + (c >> 5), rr = r & 15, cc = c & 31, ob = rr * 64 + cc * 2; return st * 1024 + (ob ^ (((ob >> 9) & 1) << 5)); }
__host__ __device__ __forceinline__ void stage_rc(int b, int& R, int& C) { const int st = b / 1024, sb = b % 1024, swz = sb ^ (((sb >> 9) & 1) << 5); R = (st >> 1) * 16 + swz / 64; C = (st & 1) * 32 + (swz % 64) / 2; }
__host__ __device__ __forceinline__ int perm32(int rho) { const int n = rho >> 4, i = rho & 15; return 8 * (i >> 2) + 4 * n + (i & 3); }

struct Unit { int pm, pn, kt0, nkt, kind; };
struct Gemm { const bf16_t* A; const bf16_t* Bt; int M, N, K; };

struct StaticOrder {
    static constexpr bool SPLIT = false;
    int nM, nN, nwg, G, c;
    __host__ __device__ void init(int M, int N, int G_, int c_) { nM = M / BM; nN = N / BM; nwg = nM * nN; G = G_; c = c_; }
    __host__ __device__ bool next(int i, Unit& u) const {
        const long L = (long)i * G + c; if (L >= nwg) return false;
        int wgid = (int)L; { const int q = nwg / NXCD, r = nwg % NXCD, xcd = wgid % NXCD, off = wgid / NXCD; wgid = (xcd < r ? xcd * (q + 1) : r * (q + 1) + (xcd - r) * q) + off; }
        const int nig = WGM * nN, gid = wgid / nig, fm = gid * WGM, gsz = (nM - fm) < WGM ? (nM - fm) : WGM;
        u.pm = fm + ((wgid % nig) % gsz); u.pn = (wgid % nig) / gsz; u.kt0 = 0; u.nkt = nkt; u.kind = 0; return true;
    }
    int nkt;
    __device__ __forceinline__ void a_ready(const Unit&) const {}
    __device__ __forceinline__ void done(const Unit&) const {}
    __device__ __forceinline__ void put_partial(const f32x4 (&)[2][2][4][2], int, int) const {}
    __device__ __forceinline__ void load_partial(f32x4 (&)[2][2][4][2], int, int) const {}
};


template <int MODE  > struct StreamK {
    static constexpr bool SPLIT = MODE != 0;
    int nM, nN, P, W, x, w, q, R1, Dq; long lo, hi; int v; float* slab; unsigned* flag;
    __device__ void init(int M, int N, int K, int G_, int bx, float* slab_, unsigned* flag_) { nM = M / BM; nN = N / BM; P = K / (2 * BK); W = G_ / NXCD; x = bx % NXCD; w = bx / NXCD;
        const int nwg = nM * nN; q = nwg / NXCD;
        if (!SPLIT) { R1 = (nwg + G_ - 1) / G_; Dq = q; } else { R1 = nwg / G_ - 1; Dq = R1 * W; }
        const long tot = (long)(q - Dq) * P; lo = tot * w / W; hi = tot * (w + 1) / W; v = x * W + w; slab = slab_; flag = flag_; }
    __device__ bool next(int i, Unit& u) const {
        int L; int j = i, k = -1;
        if (MODE == 2 && (lo % P) != 0) { if (i == 0) k = 0; else j = i - 1; }
        if (k < 0 && j >= R1) { if (!SPLIT) return false; k = j - R1 + ((MODE == 2 && (lo % P) != 0) ? 1 : 0); }
        if (k < 0) { L = x * q + j * W + w; u.kt0 = 0; u.nkt = 2 * P; u.kind = 0; if (!SPLIT && j * W + w >= q) return false; }
        else { const long u0 = lo / P; const long base = (u0 + k) * P; const long start = (k == 0) ? lo - base : 0; if (base + start >= hi) return false;
            const long end = (hi - base) < P ? (hi - base) : P;
            L = x * q + Dq + (int)(u0 + k); u.kt0 = (int)(2 * start); u.nkt = (int)(2 * (end - start)); u.kind = start > 0 ? 1 : (end < P ? 2 : 0); }
        const int nig = WGM * nN, gid = L / nig, fm = gid * WGM, gsz = (nM - fm) < WGM ? (nM - fm) : WGM;
        u.pm = fm + ((L % nig) % gsz); u.pn = (L % nig) / gsz; return true;
    }
    __device__ __forceinline__ void a_ready(const Unit&) const {}
    __device__ __forceinline__ void done(const Unit&) const {}
    __device__ __forceinline__ void put_partial(const f32x4 (&acc)[2][2][4][2], int tid, int lane) const {
        f32x4* dst = (f32x4*)slab + (size_t)v * (32 * 512) + tid;
#pragma unroll
        for (int ai = 0; ai < 2; ++ai)
#pragma unroll
            for (int bj = 0; bj < 2; ++bj)
#pragma unroll
                for (int m = 0; m < 4; ++m)
#pragma unroll
                    for (int n = 0; n < 2; ++n) { const f32x4 val = acc[ai][bj][m][n];
                        asm volatile("global_store_dwordx4 %0, %1, off sc1\n\ts_nop 1" :: "v"(dst), "v"(val) : "memory");
                        dst += 512; asm volatile("" : "+v"(dst)); }
        asm volatile("s_waitcnt vmcnt(0)" ::: "memory");
        if (lane == 0) __hip_atomic_fetch_add(flag + v, 1u, __ATOMIC_RELAXED, __HIP_MEMORY_SCOPE_AGENT);
    }
    __device__ __forceinline__ void load_partial(f32x4 (&acc)[2][2][4][2], int tid, int lane) const {
        unsigned spins = 0;
        while ((unsigned)__builtin_amdgcn_readfirstlane(__hip_atomic_load(flag + v + 1, __ATOMIC_RELAXED, __HIP_MEMORY_SCOPE_AGENT)) < 8u) { __builtin_amdgcn_s_sleep(2); if (++spins > (1u << 22)) break; }
        __builtin_amdgcn_fence(__ATOMIC_ACQUIRE, "agent");
        const f32x4* src = (const f32x4*)slab + (size_t)(v + 1) * (32 * 512) + tid;
#pragma unroll
        for (int ai = 0; ai < 2; ++ai)
#pragma unroll
            for (int bj = 0; bj < 2; ++bj)
#pragma unroll
                for (int m = 0; m < 4; ++m)
#pragma unroll
                    for (int n = 0; n < 2; ++n) { acc[ai][bj][m][n] = *src; src += 512; asm volatile("" : "+v"(src)); }
    }
};

__device__ __forceinline__ unsigned cvt_pk_bf16(float lo, float hi) { unsigned r; asm volatile("v_cvt_pk_bf16_f32 %0, %1, %2" : "=v"(r) : "v"(lo), "v"(hi)); return r; }
__device__ __forceinline__ u32x4 pack8(const f32x4& a, const f32x4& b) { u32x4 w; w.x = cvt_pk_bf16(a[0], a[1]); w.y = cvt_pk_bf16(a[2], a[3]); w.z = cvt_pk_bf16(b[0], b[1]); w.w = cvt_pk_bf16(b[2], b[3]); return w; }
__device__ __forceinline__ float silu_f(float g) { return g * __builtin_amdgcn_rcpf(1.0f + __builtin_amdgcn_exp2f(-g * 1.4426950408889634f)); }
__device__ __forceinline__ float rstd_from_ssq(const float* ssq, int row, int fq) {
    const f32x4 p = *(const f32x4*)(ssq + (size_t)row * 16 + 4 * fq);
    float s = (p[0] + p[1]) + (p[2] + p[3]); s += __shfl_xor(s, 16); s += __shfl_xor(s, 32);
    return __builtin_amdgcn_rsqf(s * (1.0f / 1024.0f) + 1e-6f);
}
#ifndef EPI_TWICE
#define EPI_TWICE 0
#endif
template <int RSMODE  > struct EpiSwiGLU {
    static constexpr bool PERM = true, AFTER_DRAIN = false, TWICE_OK = (EPI_TWICE == 1);
    bf16_t* H; const float* rs;
    __device__ __forceinline__ void operator()(const f32x4 (&acc)[2][2][4][2], const Unit& u, int wr, int wc, int fr, int fq) const {
        const int row0 = u.pm * BM + wr * 64 + fr, col0 = u.pn * 128 + wc * 32 + 8 * fq;
#pragma unroll
        for (int ai = 0; ai < 2; ++ai)
#pragma unroll
            for (int m = 0; m < 4; ++m) { const int row = row0 + ai * HALF + m * 16;
                const float s = RSMODE == 0 ? rs[row] : rstd_from_ssq(rs, row, fq);
                f32x4 h0, h1;
#pragma unroll
                for (int e = 0; e < 4; ++e) { h0[e] = silu_f(acc[ai][0][m][0][e] * s) * (acc[ai][1][m][0][e] * s); h1[e] = silu_f(acc[ai][0][m][1][e] * s) * (acc[ai][1][m][1][e] * s); }
                *(u32x4*)(H + (size_t)row * 2816 + col0) = pack8(h0, h1); }
    }
};
__device__ __forceinline__ f32x4 bf4lo(const u32x4& w) { f32x4 r; r[0] = __builtin_bit_cast(float, w.x << 16); r[1] = __builtin_bit_cast(float, w.x & 0xffff0000u); r[2] = __builtin_bit_cast(float, w.y << 16); r[3] = __builtin_bit_cast(float, w.y & 0xffff0000u); return r; }
__device__ __forceinline__ f32x4 bf4hi(const u32x4& w) { f32x4 r; r[0] = __builtin_bit_cast(float, w.z << 16); r[1] = __builtin_bit_cast(float, w.z & 0xffff0000u); r[2] = __builtin_bit_cast(float, w.w << 16); r[3] = __builtin_bit_cast(float, w.w & 0xffff0000u); return r; }
template <int KIND> struct EpiResid {
    static constexpr bool PERM = true, AFTER_DRAIN = false, TWICE_OK = (EPI_TWICE == 3 && KIND == 2);
    bf16_t* xb; float* out; float* ssq;
    __device__ __forceinline__ void operator()(const f32x4 (&acc)[2][2][4][2], const Unit& u, int wr, int wc, int fr, int fq) const {
        const int row0 = u.pm * BM + wr * 64 + fr, col0 = u.pn * BM + wc * 32 + 8 * fq;
        const float sc = KIND == 1 ? 1.0f : 0.5f;
        u32x4 r0 = *(const u32x4*)(xb + (size_t)row0 * 1024 + col0), r1 = *(const u32x4*)(xb + (size_t)row0 * 1024 + col0 + HALF);
#pragma unroll
        for (int ai = 0; ai < 2; ++ai)
#pragma unroll
            for (int m = 0; m < 4; ++m) { const int row = row0 + ai * HALF + m * 16;
                const u32x4 c0 = r0, c1 = r1;
                if (ai * 4 + m < 7) { const int nrow = row0 + ((ai * 4 + m + 1) >> 2) * HALF + ((ai * 4 + m + 1) & 3) * 16;
                    r0 = *(const u32x4*)(xb + (size_t)nrow * 1024 + col0); r1 = *(const u32x4*)(xb + (size_t)nrow * 1024 + col0 + HALF); }
                const f32x4 v00 = bf4lo(c0) + acc[ai][0][m][0] * sc, v01 = bf4hi(c0) + acc[ai][0][m][1] * sc, v10 = bf4lo(c1) + acc[ai][1][m][0] * sc, v11 = bf4hi(c1) + acc[ai][1][m][1] * sc;
                if (KIND < 2) {
                    *(u32x4*)(xb + (size_t)row * 1024 + col0) = pack8(v00, v01); *(u32x4*)(xb + (size_t)row * 1024 + col0 + HALF) = pack8(v10, v11);
                    float ss = (v00[0] * v00[0] + v00[1] * v00[1]) + (v00[2] * v00[2] + v00[3] * v00[3]) + (v01[0] * v01[0] + v01[1] * v01[1]) + (v01[2] * v01[2] + v01[3] * v01[3]);
                    ss += (v10[0] * v10[0] + v10[1] * v10[1]) + (v10[2] * v10[2] + v10[3] * v10[3]) + (v11[0] * v11[0] + v11[1] * v11[1]) + (v11[2] * v11[2] + v11[3] * v11[3]);
                    ss += __shfl_xor(ss, 16); ss += __shfl_xor(ss, 32); if (fq == 0) ssq[(size_t)row * 16 + u.pn * 4 + wc] = ss;
                } else { float* orow = out + (size_t)row * 1024 + col0;
                    *(f32x4*)orow = v00; *(f32x4*)(orow + 4) = v01; *(f32x4*)(orow + HALF) = v10; *(f32x4*)(orow + HALF + 4) = v11; } }
    }
};
struct EpiWinPtrs { const float* ssq1; bf16_t* Q; unsigned char *KVP, *KVS; bf16_t *XR, *XG; float* out; const float *gq, *gk; };
__device__ __forceinline__ unsigned char* tile_of(const EpiWinPtrs& P, int row, int h, int& key) {
    if (row < 32768) { const int pos = row & 8191; key = pos & 63; return P.KVP + (size_t)((((row >> 13) * 4 + h) * 128) + (pos >> 6)) * 32768; }
    const int r2 = row - 32768; key = r2 & 63; return P.KVS + (size_t)((r2 >> 6) * 4 + h) * 32768; }
template <int KIND> __device__ __forceinline__ void win_qk(const EpiWinPtrs P, const f32x4 (&acc)[2][2][4][2], const Unit& u, int wr, int wc, int fr, int fq) {
    const int row0 = u.pm * BM + wr * 64 + fr, half = u.pn & 1;
    const float* gp = KIND == 0 ? P.gq : P.gk; const float qs = KIND == 0 ? 0.125f * 1.4426950408889634f : 1.0f;
    const f32x4 g00 = *(const f32x4*)(gp + 8 * fq) * qs, g01 = *(const f32x4*)(gp + 8 * fq + 4) * qs, g10 = *(const f32x4*)(gp + 32 + 8 * fq) * qs, g11 = *(const f32x4*)(gp + 32 + 8 * fq + 4) * qs;
    const int cbase = 256 * half + 64 * wc + 8 * fq;
#pragma unroll
    for (int ai = 0; ai < 2; ++ai)
#pragma unroll
        for (int m = 0; m < 4; ++m) { const int row = row0 + ai * HALF + m * 16; const float rs = rstd_from_ssq(P.ssq1, row, fq);
            const f32x4 v00 = acc[ai][0][m][0] * rs, v01 = acc[ai][0][m][1] * rs, v10 = acc[ai][1][m][0] * rs, v11 = acc[ai][1][m][1] * rs;
            float ss = (v00[0] * v00[0] + v00[1] * v00[1]) + (v00[2] * v00[2] + v00[3] * v00[3]);
            ss += (v01[0] * v01[0] + v01[1] * v01[1]) + (v01[2] * v01[2] + v01[3] * v01[3]);
            ss += (v10[0] * v10[0] + v10[1] * v10[1]) + (v10[2] * v10[2] + v10[3] * v10[3]);
            ss += (v11[0] * v11[0] + v11[1] * v11[1]) + (v11[2] * v11[2] + v11[3] * v11[3]);
            ss += __shfl_xor(ss, 16); ss += __shfl_xor(ss, 32);
            const float rn = __builtin_amdgcn_rsqf(ss * (1.0f / 64.0f) + 1e-6f);
            const f32x4 a0 = v00 * rn * g00, b0 = v01 * rn * g01, a1 = v10 * rn * g10, b1 = v11 * rn * g11;
            if (KIND == 0) { *(u32x4*)(P.Q + (size_t)row * 512 + cbase) = pack8(a0, b0); *(u32x4*)(P.Q + (size_t)row * 512 + cbase + 32) = pack8(a1, b1); }
            else { float* o = (row < 32768 ? P.out + 35651584 + (size_t)row * 512 : P.out + 69214208 + (size_t)(row - 32768) * 512) + cbase;
                *(f32x4*)o = a0; *(f32x4*)(o + 4) = b0; *(f32x4*)(o + 32) = a1; *(f32x4*)(o + 36) = b1;
                int key; unsigned char* tb = tile_of(P, row, 2 * half + (wc >> 1), key) + (wc & 1) * 8192 + fq * 1024 + key * 16;
                *(u32x4*)tb = pack8(a0, b0); *(u32x4*)(tb + 4096) = pack8(a1, b1); }
            asm volatile("" ::: "memory"); }
}
template <int KIND> __device__ __forceinline__ void win_plain(const EpiWinPtrs P, const f32x4 (&acc)[2][2][4][2], const Unit& u, int wr, int wc, int fr, int fq) {
    const int row0 = u.pm * BM + wr * 64 + fr, half = u.pn & 1;
    const int cbase = 256 * half + 32 * wc + 8 * fq;
    bf16_t* dst = KIND == 3 ? P.XR : P.XG;
#pragma unroll
    for (int ai = 0; ai < 2; ++ai)
#pragma unroll
        for (int m = 0; m < 4; ++m) { const int row = row0 + ai * HALF + m * 16; const float rs = rstd_from_ssq(P.ssq1, row, fq);
#pragma unroll
            for (int bj = 0; bj < 2; ++bj) { const f32x4 a = acc[ai][bj][m][0] * rs, b = acc[ai][bj][m][1] * rs; const int c = cbase + 128 * bj;
                if (KIND == 2) { int key; unsigned char* tb = tile_of(P, row, 2 * half + bj, key) + 16384 + wc * 4096 + key * 64 + fq * 16; *(u32x4*)tb = pack8(a, b); }
                else *(u32x4*)(dst + (size_t)row * 512 + c) = pack8(a, b);
                if (KIND == 2) { float* o = (row < 32768 ? P.out + 52428800 + (size_t)row * 512 : P.out + 70262784 + (size_t)(row - 32768) * 512) + c; *(f32x4*)o = a; *(f32x4*)(o + 4) = b; }
                if (KIND == 3) {
                    if (row < 32768) { const int t = row & 8191; if (t >= 8189) { float* o = P.out + 69208064 + (size_t)((row >> 13) * 3 + (t - 8189)) * 512 + c; *(f32x4*)o = a; *(f32x4*)(o + 4) = b; } }
                    else { const int t = (row - 32768) & 63; if (t >= 61) { float* o = P.out + 71327744 + (size_t)(((row - 32768) >> 6) * 3 + (t - 61)) * 512 + c; *(f32x4*)o = a; *(f32x4*)(o + 4) = b; } } } }
            asm volatile("" ::: "memory"); }
}
struct EpiWin {
    static constexpr bool PERM = true, AFTER_DRAIN = false, TWICE_OK = (EPI_TWICE == 2);
    unsigned char* wsb; float* out; const float *gq, *gk;
    __device__ __forceinline__ void operator()(const f32x4 (&acc)[2][2][4][2], const Unit& u, int wr, int wc, int fr, int fq) const {
        unsigned char* w = wsb; asm volatile("" : "+s"(w));
        const EpiWinPtrs P{(const float*)(w + OFF_SSQ1), (bf16_t*)(w + OFF_Q), w + OFF_KVP, w + OFF_KVS, (bf16_t*)(w + OFF_XR), (bf16_t*)(w + OFF_XG), out, gq, gk};
        const int kind = u.pn >> 1;
        if (kind == 0) win_qk<0>(P, acc, u, wr, wc, fr, fq);
        else if (kind == 1) win_qk<1>(P, acc, u, wr, wc, fr, fq);
        else if (kind == 2) win_plain<2>(P, acc, u, wr, wc, fr, fq);
        else if (kind == 3) win_plain<3>(P, acc, u, wr, wc, fr, fq);
        else win_plain<4>(P, acc, u, wr, wc, fr, fq);
    }
};
template <class Epi, class Sched, bool ALIGN_EPI = false, bool SP2 = false>
__device__ __forceinline__ void gemm_phase(PG8_LAS unsigned char* lds, const Gemm g, const Sched& S, const Epi& E) {
    int tid_ = threadIdx.x; asm volatile("" : "+v"(tid_));
    const int tid = tid_, wid = __builtin_amdgcn_readfirstlane(tid >> 6), lane = tid & 63, wr = wid >> 2, wc = wid & 3, fr = lane & 15, fq = lane >> 4;
    const int K = g.K;
    unsigned voffA[2], voffB[2];
#pragma unroll
    for (int i = 0; i < 2; ++i) { int R, C; stage_rc(tid * 16 + i * 8192, R, C); const int Rb = Epi::PERM ? ((R & ~31) + perm32(R & 31)) : R;
        voffA[i] = (unsigned)(R * K + C) * 2u; voffB[i] = (unsigned)(Rb * K + C) * 2u; }
    const size_t kstep = (size_t)(BK * 2);
    const size_t hstep = (size_t)HALF * K * 2;
    const size_t tstep = 2 * hstep;
    const unsigned ldsw = (unsigned)wid * 1024u;
    const int aoff = lds_byte(wr * 64 + fr, fq * 8), boff = lds_byte(wc * 32 + fr, fq * 8);
#define PG8_SA(b, h) (((b) * 2 + (h)) * HTB)
#define PG8_SB(b, h) ((4 + (b) * 2 + (h)) * HTB)
#define PG8_STAGE(bufoff, gbase, voff) do { _Pragma("unroll") for (int _i = 0; _i < 2; ++_i) \
        __builtin_amdgcn_global_load_lds((const unsigned*)((const char*)(gbase) + (voff)[_i]), (PG8_LAS unsigned*)(lds + (bufoff) + ldsw + _i * 8192), 16, 0, 0); } while (0)
#define PG8_LDA(dst, b, h) do { _Pragma("unroll") for (int m = 0; m < 4; ++m) _Pragma("unroll") for (int k = 0; k < 2; ++k) dst[m][k] = *(const PG8_LAS bf16x8*)(lds + PG8_SA(b, h) + aoff + m * 2048 + k * 1024); } while (0)
#define PG8_LDB(dst, b, h) do { _Pragma("unroll") for (int n = 0; n < 2; ++n) _Pragma("unroll") for (int k = 0; k < 2; ++k) dst[n][k] = *(const PG8_LAS bf16x8*)(lds + PG8_SB(b, h) + boff + n * 2048 + k * 1024); } while (0)
#define PG8_MMA(ai, bj, At, Bt) do { __builtin_amdgcn_s_setprio(1); _Pragma("unroll") for (int m = 0; m < 4; ++m) _Pragma("unroll") for (int n = 0; n < 2; ++n) _Pragma("unroll") for (int k = 0; k < 2; ++k) \
        acc[ai][bj][m][n] = __builtin_amdgcn_mfma_f32_16x16x32_bf16(Bt[n][k], At[m][k], acc[ai][bj][m][n], 0, 0, 0); __builtin_amdgcn_s_setprio(0); } while (0)
#define PG8_WAIT_V(n) asm volatile("s_waitcnt vmcnt(" #n ")" ::: "memory")
#define PG8_WAIT_L(n) asm volatile("s_waitcnt lgkmcnt(" #n ")" ::: "memory")
#define PG8_BAR __builtin_amdgcn_s_barrier()
#define PG8_SCHED __builtin_amdgcn_sched_barrier(0)
    Unit cur, nxt; int ui = 0;
    if (!S.next(0, cur)) return;
    f32x4 acc[2][2][4][2];
#pragma unroll
    for (int a = 0; a < 2; ++a)
#pragma unroll
        for (int b = 0; b < 2; ++b)
#pragma unroll
            for (int m = 0; m < 4; ++m)
#pragma unroll
                for (int n = 0; n < 2; ++n) acc[a][b][m][n] = (f32x4){0.f, 0.f, 0.f, 0.f};
    bf16x8 At[4][2], B0[2][2], B1[2][2];
    const char* cA = (const char*)g.A + (size_t)cur.pm * tstep + (Sched::SPLIT ? (size_t)cur.kt0 * kstep : (size_t)0); const char* cB = (const char*)g.Bt + (size_t)cur.pn * tstep + (Sched::SPLIT ? (size_t)cur.kt0 * kstep : (size_t)0);
    S.a_ready(cur);
    if constexpr (SP2) {
        PG8_STAGE(PG8_SB(0, 0), cB, voffB); PG8_STAGE(PG8_SB(0, 1), cB + hstep, voffB); PG8_STAGE(PG8_SA(0, 0), cA, voffA); PG8_STAGE(PG8_SA(0, 1), cA + hstep, voffA);
        if (wr == 1) PG8_BAR;
        PG8_WAIT_V(2); PG8_BAR;
        PG8_STAGE(PG8_SB(1, 0), cB + kstep, voffB); PG8_STAGE(PG8_SA(1, 0), cA + kstep, voffA); PG8_STAGE(PG8_SB(1, 1), cB + hstep + kstep, voffB);
        PG8_WAIT_V(6); PG8_BAR;
    } else {
        PG8_STAGE(PG8_SB(0, 0), cB, voffB); PG8_STAGE(PG8_SA(0, 0), cA, voffA); PG8_STAGE(PG8_SB(0, 1), cB + hstep, voffB); PG8_STAGE(PG8_SA(0, 1), cA + hstep, voffA);
        if (wr == 1) PG8_BAR;
        PG8_WAIT_V(4); PG8_BAR;
        PG8_STAGE(PG8_SB(1, 0), cB + kstep, voffB); PG8_STAGE(PG8_SA(1, 0), cA + kstep, voffA); PG8_STAGE(PG8_SB(1, 1), cB + hstep + kstep, voffB);
        PG8_WAIT_V(6); PG8_BAR;
    }
    for (;;) {
        const bool has_next = S.next(ui + 1, nxt);
        const char* nA = has_next ? (const char*)g.A + (size_t)nxt.pm * tstep + (Sched::SPLIT ? (size_t)nxt.kt0 * kstep : (size_t)0) : cA; const char* nB = has_next ? (const char*)g.Bt + (size_t)nxt.pn * tstep + (Sched::SPLIT ? (size_t)nxt.kt0 * kstep : (size_t)0) : cB;
        const int nt = Sched::SPLIT ? cur.nkt : K / BK;
        for (int t = 0; t < nt; t += 2) {
            const bool last = (t == nt - 2);
            const char* a1 = cA + (size_t)(t + 1) * kstep;
            const char* a2 = last ? nA : cA + (size_t)(t + 2) * kstep; const char* b2 = last ? nB : cB + (size_t)(t + 2) * kstep;
            const char* a3 = a2 + kstep; const char* b3 = b2 + kstep;
            if (last && has_next) S.a_ready(nxt);
            if constexpr (SP2) {
            PG8_LDB(B0, 0, 0); PG8_LDB(B1, 0, 1); PG8_SCHED; PG8_LDA(At, 0, 0); PG8_STAGE(PG8_SA(1, 1), a1 + hstep, voffA);
            PG8_WAIT_V(8); PG8_WAIT_L(0); PG8_BAR; PG8_MMA(0, 0, At, B0); PG8_MMA(0, 1, At, B1); PG8_BAR; PG8_SCHED;
            PG8_LDA(At, 0, 1); PG8_STAGE(PG8_SB(0, 0), b2, voffB); PG8_STAGE(PG8_SB(0, 1), b2 + hstep, voffB); PG8_STAGE(PG8_SA(0, 0), a2, voffA);
            PG8_WAIT_V(8); PG8_WAIT_L(0); PG8_BAR; PG8_MMA(1, 0, At, B0); PG8_MMA(1, 1, At, B1); PG8_BAR; PG8_SCHED;
            PG8_LDB(B0, 1, 0); PG8_LDB(B1, 1, 1); PG8_SCHED; PG8_LDA(At, 1, 0); PG8_STAGE(PG8_SA(0, 1), a2 + hstep, voffA);
            PG8_WAIT_V(8); PG8_WAIT_L(0); PG8_BAR; PG8_MMA(0, 0, At, B0); PG8_MMA(0, 1, At, B1); PG8_BAR; PG8_SCHED;
            PG8_LDA(At, 1, 1); PG8_STAGE(PG8_SB(1, 0), b3, voffB); PG8_STAGE(PG8_SB(1, 1), b3 + hstep, voffB); PG8_STAGE(PG8_SA(1, 0), a3, voffA);
            PG8_WAIT_V(8); PG8_WAIT_L(0); PG8_BAR; PG8_MMA(1, 0, At, B0); PG8_MMA(1, 1, At, B1); PG8_BAR; PG8_SCHED;
            } else {
            PG8_LDB(B0, 0, 0); PG8_SCHED; PG8_LDA(At, 0, 0); PG8_STAGE(PG8_SA(1, 1), a1 + hstep, voffA);
            PG8_WAIT_L(8); PG8_BAR; PG8_WAIT_L(0); PG8_MMA(0, 0, At, B0); PG8_BAR; PG8_SCHED;
            PG8_LDB(B1, 0, 1); PG8_STAGE(PG8_SB(0, 0), b2, voffB);
            PG8_BAR; PG8_WAIT_L(0); PG8_MMA(0, 1, At, B1); PG8_BAR;
            PG8_LDA(At, 0, 1); PG8_STAGE(PG8_SA(0, 0), a2, voffA);
            PG8_BAR; PG8_WAIT_L(0); PG8_MMA(1, 0, At, B0); PG8_BAR; PG8_SCHED;
            PG8_STAGE(PG8_SB(0, 1), b2 + hstep, voffB);
            PG8_WAIT_V(6); PG8_BAR; PG8_MMA(1, 1, At, B1); PG8_BAR;
            PG8_LDB(B0, 1, 0); PG8_SCHED; PG8_LDA(At, 1, 0); PG8_STAGE(PG8_SA(0, 1), a2 + hstep, voffA);
            PG8_WAIT_L(8); PG8_BAR; PG8_WAIT_L(0); PG8_MMA(0, 0, At, B0); PG8_BAR; PG8_SCHED;
            PG8_LDB(B1, 1, 1); PG8_STAGE(PG8_SB(1, 0), b3, voffB);
            PG8_BAR; PG8_WAIT_L(0); PG8_MMA(0, 1, At, B1); PG8_BAR;
            PG8_LDA(At, 1, 1); PG8_STAGE(PG8_SA(1, 0), a3, voffA);
            PG8_BAR; PG8_WAIT_L(0); PG8_MMA(1, 0, At, B0); PG8_BAR; PG8_SCHED;
            PG8_STAGE(PG8_SB(1, 1), b3 + hstep, voffB);
            PG8_WAIT_V(6); PG8_BAR; PG8_MMA(1, 1, At, B1); PG8_BAR;
            }
        }
        if constexpr (ALIGN_EPI) { if (wr == 0) PG8_BAR; }
        if constexpr (!Epi::AFTER_DRAIN) { if (Sched::SPLIT && cur.kind == 1) S.put_partial(acc, tid, lane); else { E(acc, cur, wr, wc, fr, fq);
#if EPI_TWICE
            if (Epi::TWICE_OK) { asm volatile("" ::: "memory"); E(acc, cur, wr, wc, fr, fq); }
#endif
            } S.done(cur); }
        if (!has_next) break;
        if (Sched::SPLIT && nxt.kind == 2) S.load_partial(acc, tid, lane);
        else {
#pragma unroll
        for (int a = 0; a < 2; ++a)
#pragma unroll
            for (int b = 0; b < 2; ++b)
#pragma unroll
                for (int m = 0; m < 4; ++m)
#pragma unroll
                    for (int n = 0; n < 2; ++n) acc[a][b][m][n] = (f32x4){0.f, 0.f, 0.f, 0.f};
        }
        cur = nxt; cA = nA; cB = nB; ++ui;
        if constexpr (ALIGN_EPI) { if (wr == 1) PG8_BAR; }
    }
    PG8_WAIT_V(0);
    if constexpr (!ALIGN_EPI) { if (wr == 0) PG8_BAR; }
    PG8_BAR;
    if constexpr (Epi::AFTER_DRAIN) { E.fused(acc, cur, wr, wc, fr, fq, lds, wid, lane); S.done(cur); }
#undef PG8_SA
#undef PG8_SB
#undef PG8_STAGE
#undef PG8_LDA
#undef PG8_LDB
#undef PG8_MMA
#undef PG8_WAIT_V
#undef PG8_WAIT_L
#undef PG8_BAR
#undef PG8_SCHED
}
}

constexpr size_t MiB = 1u << 20;
constexpr size_t WS_CTL = 0, CTL_ZERO_BYTES = 64 * 1024;
constexpr size_t WS_W1GU = 1 * MiB, WS_W1D = 12 * MiB, WS_W2GU = 18 * MiB, WS_W2D = 29 * MiB, WS_WIN = 35 * MiB, WS_WOUT = 40 * MiB;
constexpr size_t WS_GATEW = 42 * MiB;
constexpr size_t WS_SP8 = WS_GATEW + 256 * 1024;
constexpr size_t WS_RSTD0 = 43 * MiB;
constexpr size_t WS_SSQ1 = 44 * MiB, WS_SSQ2 = 47 * MiB;
constexpr size_t WS_LSUM = 50 * MiB;
constexpr size_t WS_XB = 53 * MiB;
constexpr size_t WS_H = 121 * MiB;
constexpr size_t WS_Q = WS_H, WS_KVP = WS_H + 34 * MiB, WS_KVS = WS_H + 98 * MiB, WS_XR = WS_H + 102 * MiB, WS_XG = WS_H + 136 * MiB;
constexpr size_t WS_CAT = 308 * MiB;
constexpr size_t WS_CK = 376 * MiB, WS_CV = 440 * MiB;
constexpr size_t WS_END = 504 * MiB;
static_assert(OFF_SSQ1 == WS_SSQ1 && OFF_Q == WS_Q && OFF_KVP == WS_KVP && OFF_KVS == WS_KVS && OFF_XR == WS_XR && OFF_XG == WS_XG, "epilogue offsets");
static_assert(WS_H + (size_t)TT * FF * 2 <= WS_CAT && WS_XB + (size_t)TT * DM * 2 <= WS_H && WS_XG + (size_t)TT * 512 * 2 <= WS_CAT, "d_ws map");
constexpr int CW_BAR = 1024;
constexpr int CW_SK = 12288;
constexpr int CW_QUEUE = 8192;

constexpr int RING_BYTES = 131072;
constexpr int MISC_OFF = RING_BYTES;
constexpr int LDS_BYTES = 147456;

#define GAS __attribute__((address_space(1)))
#define LAS __attribute__((address_space(3)))
typedef unsigned short bf16;
typedef unsigned v4u __attribute__((ext_vector_type(4)));
typedef unsigned v2u __attribute__((ext_vector_type(2)));
typedef float f32x4 __attribute__((ext_vector_type(4)));
typedef float f32x16 __attribute__((ext_vector_type(16)));
typedef short bf16x8 __attribute__((ext_vector_type(8)));
typedef short s16x4 __attribute__((ext_vector_type(4)));
#define LDS_WAIT() asm volatile("s_waitcnt lgkmcnt(0)" ::: "memory")
#define VM_WAIT() asm volatile("s_waitcnt vmcnt(0)" ::: "memory")
__device__ __forceinline__ unsigned f2bf(float f) { unsigned u = __builtin_bit_cast(unsigned, f); return (u + 0x7fffu + ((u >> 16) & 1u)) >> 16; }
__device__ __forceinline__ unsigned pk2(float lo, float hi) { return f2bf(lo) | (f2bf(hi) << 16); }
__device__ __forceinline__ float bf2f(unsigned short b) { return __builtin_bit_cast(float, (unsigned)b << 16); }
__device__ __forceinline__ float bflo(unsigned w) { return __builtin_bit_cast(float, w << 16); }
__device__ __forceinline__ float bfhi(unsigned w) { return __builtin_bit_cast(float, w & 0xffff0000u); }
__device__ __forceinline__ float wave_sum(float v) {
#pragma unroll
    for (int o = 1; o < 64; o <<= 1) v += __shfl_xor(v, o);
    return v;
}

#define XB_TMO      128
#define XB_XCNT(j)  (256  + 64 * (j))
#define XB_XSUB(j)  (1280 + 64 * (j))
#define XB_XGEN(j)  (2304 + 64 * (j))
#define XB_TOP      3328
#define XB_TOPGEN   3392
#define XCD_BAR_WORDS 3456
#define XB_SPIN_CAP (1u << 18)

__device__ __forceinline__ unsigned xb_ld(unsigned* p)              { return __hip_atomic_load(p, __ATOMIC_RELAXED, __HIP_MEMORY_SCOPE_AGENT); }
__device__ __forceinline__ unsigned xb_add(unsigned* p, unsigned v) { return __hip_atomic_fetch_add(p, v, __ATOMIC_RELAXED, __HIP_MEMORY_SCOPE_AGENT); }
__device__ __forceinline__ unsigned xb_xcc_id() { return (unsigned)__builtin_amdgcn_s_getreg((3 << 11) | 20) & 0xFu; }
#define XB_SPIN(cond, bar) do { unsigned _sp = 0; while (cond) { __builtin_amdgcn_s_sleep(1); \
    if ((++_sp & 255u) == 0u) { if (xb_ld(&(bar)[XB_TMO])) break; if (_sp > XB_SPIN_CAP) { atomicAdd(&(bar)[XB_TMO], 1u); break; } } } } while (0)

struct XcdBarrier {
    unsigned* bar; unsigned x;
    volatile LAS unsigned* st;
};

__device__ __forceinline__ XcdBarrier xcd_barrier_post(unsigned* bar, volatile LAS unsigned* st) {
    XcdBarrier b; b.bar = bar; b.x = xb_xcc_id(); b.st = st;
    if (threadIdx.x == 0) (void)xb_add(&bar[XB_XCNT(b.x)], 1u);
    return b;
}
__device__ __forceinline__ void xcd_barrier_complete(unsigned* bar, unsigned x, unsigned& nloc, unsigned& nx) {
    const unsigned G = gridDim.x * gridDim.y * gridDim.z;
    unsigned sum, cnt, mine, sp = 0u;
    for (;;) {
        sum = 0u; cnt = 0u; mine = 0u;
#pragma unroll
        for (unsigned j = 0; j < 16; ++j) { const unsigned c = xb_ld(&bar[XB_XCNT(j)]); sum += c; cnt += (c > 0u) ? 1u : 0u; mine = (j == x) ? c : mine; }
        if (sum == G) break;
        __builtin_amdgcn_s_sleep(1);
        if ((++sp & 255u) == 0u) { if (xb_ld(&bar[XB_TMO])) break; if (sp > XB_SPIN_CAP) { atomicAdd(&bar[XB_TMO], 1u); break; } }
    }
    nloc = mine > 0u ? mine : 1u; nx = cnt > 0u ? cnt : 1u;
}

__device__ __forceinline__ void xcd_barrier(const XcdBarrier& b) {
    asm volatile("s_waitcnt vmcnt(0)" ::: "memory");
    __syncthreads();
    if (threadIdx.x == 0) {
        unsigned* bar = b.bar;
        __builtin_amdgcn_s_waitcnt(0);
        unsigned nloc = b.st[0], nx = b.st[1];
        if (nloc == 0u) { xcd_barrier_complete(bar, b.x, nloc, nx); b.st[0] = nloc; b.st[1] = nx; }
        const unsigned old = xb_add(&bar[XB_XSUB(b.x)], 1u);
        const unsigned gen = old / nloc;
        if (old + 1u == (gen + 1u) * nloc) {
            __builtin_amdgcn_fence(__ATOMIC_RELEASE, "agent");
            asm volatile("s_waitcnt vmcnt(0)" ::: "memory");
            const unsigned og = xb_add(&bar[XB_TOP], 1u);
            const unsigned tg = og / nx;
            if (og + 1u == (tg + 1u) * nx) xb_add(&bar[XB_TOPGEN], 1u);
            else XB_SPIN(xb_ld(&bar[XB_TOPGEN]) == tg, bar);
            __builtin_amdgcn_fence(__ATOMIC_ACQUIRE, "agent");
            xb_add(&bar[XB_XGEN(b.x)], 1u);
            asm volatile("s_waitcnt vmcnt(0)" ::: "memory");
        } else {
            XB_SPIN(xb_ld(&bar[XB_XGEN(b.x)]) == gen, bar);
            __builtin_amdgcn_fence(__ATOMIC_ACQUIRE, "agent");
            asm volatile("s_waitcnt vmcnt(0)" ::: "memory");
        }
    }
    __syncthreads();
}

typedef __attribute__((address_space(4))) const unsigned char* kptr_t;
struct Frame {
    LAS unsigned char* lds;
    int tid, lane, wave, G, bx;
    kptr_t ka; int z;
    float* out; unsigned char* ws;
};
__device__ __forceinline__ const float* fin(const Frame& F, int k) { typedef const float* cfp; return *(const __attribute__((address_space(4))) cfp*)(F.ka + (k * 8 + F.z)); }
#define NEW_PHASE() do { int z_ = 0; asm volatile("" : "+s"(z_)); F.z = z_; } while (0)

__device__ __forceinline__ void p0_transpose_item(const float* W, int K, int N, bf16* WT, int kb, int n0, int drow0, const float* gain, LAS float* scr, int lane) {
    const int k0 = 64 * kb;
#pragma unroll 8
    for (int i = 0; i < 32; ++i) { const int kk = 2 * i + (lane >> 5); float w = W[(size_t)(k0 + kk) * N + n0 + (lane & 31)]; if (gain) w *= gain[k0 + kk]; scr[kk * 33 + (lane & 31)] = w; }
    LDS_WAIT(); asm volatile("" ::: "memory");
    const int c = lane & 7;
#pragma unroll
    for (int j = 0; j < 4; ++j) { const int n = (lane >> 3) + 8 * j; const LAS float* s = scr + (8 * c) * 33 + n;
        v4u o; o.x = pk2(s[0 * 33], s[1 * 33]); o.y = pk2(s[2 * 33], s[3 * 33]); o.z = pk2(s[4 * 33], s[5 * 33]); o.w = pk2(s[6 * 33], s[7 * 33]);
        *(GAS v4u*)(WT + (size_t)(drow0 + n) * K + k0 + 8 * c) = o; }
    LDS_WAIT(); asm volatile("" ::: "memory");
}
constexpr int I_GU = 16 * 88, I_DN = 44 * 32, I_IN = 16 * 80, I_OUT = 16 * 32, I_FFN = 2 * I_GU + I_DN, NITEMS = 2 * I_FFN + I_IN + I_OUT;
__device__ __forceinline__ void weight_item(Frame& F, int it, LAS float* scr) {
    unsigned char* ws = F.ws; int r = it;
    if (r < 2 * I_FFN) {
        const int f = r >= I_FFN; r -= f * I_FFN;
        const float* Wg = f == 0 ? fin(F, 8) : fin(F, 30); const float* Wu = f == 0 ? fin(F, 9) : fin(F, 31); const float* Wd = f == 0 ? fin(F, 10) : fin(F, 32); const float* gn = f == 0 ? fin(F, 7) : fin(F, 29);
        bf16* GU = (bf16*)(ws + (f == 0 ? WS_W1GU : WS_W2GU)); bf16* DN = (bf16*)(ws + (f == 0 ? WS_W1D : WS_W2D));
        if (r < 2 * I_GU) { const int up = r >= I_GU; const int q = up ? r - I_GU : r; const int kb = q / 88, nb = q % 88, n0 = 32 * nb;
            p0_transpose_item(up ? Wu : Wg, 1024, FF, GU, kb, n0, 256 * (n0 >> 7) + (n0 & 127) + (up ? 128 : 0), gn, scr, F.lane); }
        else { r -= 2 * I_GU; const int kb = r / 32, nb = r % 32; p0_transpose_item(Wd, FF, 1024, DN, kb, 32 * nb, 32 * nb, nullptr, scr, F.lane); }
        return;
    }
    r -= 2 * I_FFN;
    if (r < I_IN) { const int kb = r / 80, nb = r % 80, n0 = 32 * nb; int dr = n0;
        if (n0 < 1024) { const int oc = n0 & 255, wc = oc >> 6, bj = (oc >> 5) & 1; dr = (n0 & ~255) + 128 * bj + 32 * wc; }
        p0_transpose_item(fin(F, 12), 1024, INW, (bf16*)(ws + WS_WIN), kb, n0, dr, fin(F, 11), scr, F.lane); return; }
    r -= I_IN;
    { const int kb = r / 32, nb = r % 32; p0_transpose_item(fin(F, 28), 1024, 1024, (bf16*)(ws + WS_WOUT), kb, 32 * nb, 32 * nb, nullptr, scr, F.lane); }
}
__device__ __forceinline__ void convert_in_tail(Frame& F, int nunits, int group) {
    const int W = F.G / 8, q = nunits / 8, rl = (q + W - 1) / W - 1, busy = q - rl * W, w = F.bx / 8, x = F.bx % 8;
    int widx, nwork;
    if (busy < W) { if (w < busy) return; widx = ((w - busy) * 8 + x) * 8 + F.wave; nwork = (W - busy) * 64; } else { widx = F.bx * 8 + F.wave; nwork = F.G * 8; }
    LAS float* scr = (LAS float*)(F.lds + F.wave * 16384);
    if (group == 1) { for (int k = widx; k < I_DN + I_IN; k += nwork) weight_item(F, k < I_DN ? 2 * I_GU + k : 2 * I_FFN + (k - I_DN), scr); }
    else { for (int k = widx; k < I_FFN + I_OUT; k += nwork) weight_item(F, k < I_FFN ? I_FFN + k : 2 * I_FFN + I_IN + (k - I_FFN), scr); }
}
__device__ __forceinline__ void p0_prologue(Frame& F) {
    LAS float* scr = (LAS float*)(F.lds + F.wave * 16384);
    const int gw = F.bx * 8 + F.wave, NGW = F.G * 8;
    unsigned char* ws = F.ws;
    for (int it = gw; it < 2 * I_GU; it += NGW) weight_item(F, it, scr);
    {   bf16* XB = (bf16*)(ws + WS_XB); float* rstd0 = (float*)(ws + WS_RSTD0);
        for (int m = gw; m < TT; m += NGW) {
            const float* xrow = m < TP ? fin(F, 0) + (size_t)m * DM : fin(F, 1) + (size_t)(m - TP) * DM;
            const GAS f32x4* xr = (const GAS f32x4*)xrow + F.lane;
            f32x4 v[4]; float s = 0.f;
#pragma unroll
            for (int j = 0; j < 4; ++j) { v[j] = xr[64 * j]; s += (v[j].x * v[j].x + v[j].y * v[j].y) + (v[j].z * v[j].z + v[j].w * v[j].w); }
            s = wave_sum(s);
            if (F.lane == 0) rstd0[m] = __builtin_amdgcn_rsqf(s * (1.0f / DM) + EPS);
            GAS unsigned long long* o8 = (GAS unsigned long long*)(XB + (size_t)m * DM) + F.lane;
#pragma unroll
            for (int j = 0; j < 4; ++j) o8[64 * j] = (unsigned long long)pk2(v[j].x, v[j].y) | ((unsigned long long)pk2(v[j].z, v[j].w) << 32);
        }
    }
    {   bf16* GW = (bf16*)(ws + WS_GATEW); float* sp8 = (float*)(ws + WS_SP8);
        const int gt = F.bx * 512 + F.tid, NT = F.G * 512;
        for (int i = gt; i < 2 * 8 * 64 * 64; i += NT) { const int g = i >> 15, n = (i >> 12) & 7, j = (i >> 6) & 63, c = i & 63;
            GW[i] = (bf16)f2bf((g == 0 ? fin(F, 22) : fin(F, 24))[(n * 64 + c) * 64 + j]); }
        for (int i = gt; i < 512; i += NT) { const float L = fin(F, 26)[i]; sp8[i] = 8.0f * (L > 20.f ? __expf(-L) : log1pf(__expf(-L))); }
    }
}

namespace lru {
constexpr int L_XC = 0;
constexpr int L_HIN = 65536;
constexpr int L_PART = 65536 + 2048;
constexpr int L_PAR = 135168;
constexpr int L_O0 = 65536 + 4096;
__device__ __forceinline__ int crow(int r, int hi) { return (r & 3) + 8 * (r >> 2) + 4 * hi; }
__device__ __forceinline__ float sigmoid_f(float x) { return __builtin_amdgcn_rcpf(1.0f + __builtin_amdgcn_exp2f(-x * LOG2E)); }

template <int CTRL, int RM> __device__ __forceinline__ float dpp_f(float oldv, float src) {
    return __builtin_bit_cast(float, __builtin_amdgcn_update_dpp(__builtin_bit_cast(int, oldv), __builtin_bit_cast(int, src), CTRL, RM, 0xF, false)); }
#define LRU_SCAN_STEP(CTRL, RM) do { const float ap_ = dpp_f<CTRL, RM>(1.0f, a), bp_ = dpp_f<CTRL, RM>(0.0f, b); b = a * bp_ + b; a = a * ap_; } while (0)
__device__ __forceinline__ float rl_half(float v, int hi) {
    return __builtin_bit_cast(float, __builtin_amdgcn_ds_bpermute((hi * 32 + 31) * 4, __builtin_bit_cast(int, v))); }
template <int PASS> __device__ __forceinline__ void lru_unit(Frame& F, int u) {
    int tid_ = F.tid; asm volatile("" : "+v"(tid_));
    const int tid = tid_, lane = tid & 63, wid = F.wave, r32 = lane & 31, hi = lane >> 5;
    const bool smp = u >= 512; const int sb = u - 512, pb = u >> 7, ck = smp ? 0 : (u & 127);
    const int row0 = smp ? TP + sb * 64 : pb * SEQ + ck * 64;
    const bf16* XR = (const bf16*)(F.ws + WS_XR); const bf16* XG = (const bf16*)(F.ws + WS_XG);
    LAS unsigned char* lds = F.lds;
    if (PASS == 2) {
        float h = 0.f;
        if (smp) h = fin(F, 4)[sb * 512 + tid];
        else { const float* S = (const float*)(F.ws + WS_LSUM) + ((size_t)(pb * 128) * 512 + tid) * 2;
            int c = 0;
            for (; c + 32 <= ck; c += 32) { float2 v[32];
#pragma unroll
                for (int k = 0; k < 32; ++k) v[k] = *(const float2*)(S + (size_t)(c + k) * 1024);
#pragma unroll
                for (int k = 0; k < 32; ++k) h = v[k].x * h + v[k].y; }
            for (; c + 8 <= ck; c += 8) { float2 v[8];
#pragma unroll
                for (int k = 0; k < 8; ++k) v[k] = *(const float2*)(S + (size_t)(c + k) * 1024);
#pragma unroll
                for (int k = 0; k < 8; ++k) h = v[k].x * h + v[k].y; }
            for (; c < ck; ++c) { const float2 v = *(const float2*)(S + (size_t)c * 1024); h = v.x * h + v.y; } }
        ((LAS float*)(lds + L_HIN))[tid] = h;
    }
    {   LAS float* par = (LAS float*)(lds + L_PAR);
        par[tid] = fin(F, 23)[tid]; par[512 + tid] = fin(F, 25)[tid]; par[1024 + tid] = ((const float*)(F.ws + WS_SP8))[tid]; if (PASS == 2) par[1536 + tid] = fin(F, 27)[tid]; }
    {   const int cg = tid & 63, tg = tid >> 6, c0 = 8 * cg;
        float xw[11][8];
#pragma unroll
        for (int i = 0; i < 11; ++i) { const int tt = 8 * tg + i - 3;
            if (tt >= 0 || ck > 0) { const v4u w = *(const GAS v4u*)(XR + (size_t)(row0 + tt) * 512 + c0);
                xw[i][0] = bflo(w.x); xw[i][1] = bfhi(w.x); xw[i][2] = bflo(w.y); xw[i][3] = bfhi(w.y); xw[i][4] = bflo(w.z); xw[i][5] = bfhi(w.z); xw[i][6] = bflo(w.w); xw[i][7] = bfhi(w.w); }
            else if (smp) { const float* sc = fin(F, 5) + (size_t)(sb * 3 + (tt + 3)) * 512 + c0; const f32x4 a = *(const f32x4*)sc, b = *(const f32x4*)(sc + 4);
                xw[i][0] = a[0]; xw[i][1] = a[1]; xw[i][2] = a[2]; xw[i][3] = a[3]; xw[i][4] = b[0]; xw[i][5] = b[1]; xw[i][6] = b[2]; xw[i][7] = b[3]; }
            else {
#pragma unroll
                for (int e = 0; e < 8; ++e) xw[i][e] = 0.f; } }
        float cw[4][8], cb[8];
#pragma unroll
        for (int j = 0; j < 4; ++j) { const f32x4 a = *(const f32x4*)(fin(F, 20) + j * 512 + c0), b = *(const f32x4*)(fin(F, 20) + j * 512 + c0 + 4);
            cw[j][0] = a[0]; cw[j][1] = a[1]; cw[j][2] = a[2]; cw[j][3] = a[3]; cw[j][4] = b[0]; cw[j][5] = b[1]; cw[j][6] = b[2]; cw[j][7] = b[3]; }
        { const f32x4 a = *(const f32x4*)(fin(F, 21) + c0), b = *(const f32x4*)(fin(F, 21) + c0 + 4); cb[0] = a[0]; cb[1] = a[1]; cb[2] = a[2]; cb[3] = a[3]; cb[4] = b[0]; cb[5] = b[1]; cb[6] = b[2]; cb[7] = b[3]; }
#pragma unroll
        for (int i = 0; i < 8; ++i) { const int t = 8 * tg + i; float xc[8];
#pragma unroll
            for (int e = 0; e < 8; ++e) xc[e] = cb[e] + cw[0][e] * xw[i][e] + cw[1][e] * xw[i + 1][e] + cw[2][e] * xw[i + 2][e] + cw[3][e] * xw[i + 3][e];
            v4u o; o.x = pk2(xc[0], xc[1]); o.y = pk2(xc[2], xc[3]); o.z = pk2(xc[4], xc[5]); o.w = pk2(xc[6], xc[7]);
            *(LAS v4u*)(lds + L_XC + t * 1024 + ((cg ^ (t & 15)) << 4)) = o; }
    }
    LDS_WAIT(); __syncthreads();
    const int n = wid;
    const bf16* GW = (const bf16*)(F.ws + WS_GATEW);
    float ssq_t[2] = {0.f, 0.f};
    float outv[2][16];
#pragma unroll
    for (int jb = 0; jb < 2; ++jb) {
        v2u gwv[4][2];
        if (PASS == 2) {
#pragma unroll
            for (int q4 = 0; q4 < 4; ++q4)
#pragma unroll
                for (int tb = 0; tb < 2; ++tb) gwv[q4][tb] = *(const GAS v2u*)(XG + (size_t)(row0 + tb * 32 + r32) * 512 + 64 * n + 32 * jb + 8 * q4 + 4 * hi); }
        f32x16 accr[2], acci[2];
#pragma unroll
        for (int tb = 0; tb < 2; ++tb) { accr[tb] = f32x16{}; acci[tb] = f32x16{}; }
#pragma unroll
        for (int ks = 0; ks < 4; ++ks) {
            const bf16x8 ar = *(const GAS bf16x8*)(GW + ((size_t)((0 * 8 + n) * 64 + jb * 32 + r32) * 64 + ks * 16 + hi * 8));
            const bf16x8 ax = *(const GAS bf16x8*)(GW + ((size_t)((1 * 8 + n) * 64 + jb * 32 + r32) * 64 + ks * 16 + hi * 8));
#pragma unroll
            for (int tb = 0; tb < 2; ++tb) { const int t = tb * 32 + r32; const int chunk = 8 * n + 2 * ks + hi;
                const bf16x8 bfr = *(const LAS bf16x8*)(lds + L_XC + t * 1024 + ((chunk ^ (t & 15)) << 4));
                accr[tb] = __builtin_amdgcn_mfma_f32_32x32x16_bf16(ar, bfr, accr[tb], 0, 0, 0);
                acci[tb] = __builtin_amdgcn_mfma_f32_32x32x16_bf16(ax, bfr, acci[tb], 0, 0, 0); }
        }
        float av[2][16], bv[2][16];
#pragma unroll
        for (int q4 = 0; q4 < 4; ++q4) {
            const int chb = 64 * n + 32 * jb + 8 * q4 + 4 * hi;
            const f32x4 ba = *(const LAS f32x4*)(lds + L_PAR + chb * 4), bx = *(const LAS f32x4*)(lds + L_PAR + 2048 + chb * 4), sp = *(const LAS f32x4*)(lds + L_PAR + 4096 + chb * 4);
#pragma unroll
            for (int tb = 0; tb < 2; ++tb) { const int t = tb * 32 + r32;
                const v2u xw = *(const LAS v2u*)(lds + L_XC + t * 1024 + ((((chb >> 3) ^ (t & 15)) << 4) | ((chb & 7) << 1)));
                const float xc[4] = {bflo(xw.x), bfhi(xw.x), bflo(xw.y), bfhi(xw.y)};
#pragma unroll
                for (int e = 0; e < 4; ++e) { const int r = 4 * q4 + e;
                    const float rg = sigmoid_f(accr[tb][r] + ba[e]), ig = sigmoid_f(acci[tb][r] + bx[e]);
                    const float a = __builtin_amdgcn_exp2f(-rg * sp[e] * LOG2E);
                    av[tb][r] = a; bv[tb][r] = __builtin_amdgcn_sqrtf(fmaxf(1.0f - a * a, 0.f)) * (ig * xc[e]); } }
        }
#pragma unroll
        for (int r = 0; r < 16; ++r) {
#pragma unroll
            for (int tb = 0; tb < 2; ++tb) {
                float a = av[tb][r], b = bv[tb][r];
                LRU_SCAN_STEP(0x111, 0xF); LRU_SCAN_STEP(0x112, 0xF); LRU_SCAN_STEP(0x114, 0xF); LRU_SCAN_STEP(0x118, 0xF);
                LRU_SCAN_STEP(0x142, 0xA);
                av[tb][r] = a; bv[tb][r] = b; }
            const float A0 = rl_half(av[0][r], hi), B0 = rl_half(bv[0][r], hi);
            bv[1][r] = av[1][r] * B0 + bv[1][r]; av[1][r] = av[1][r] * A0;
        }
        if (PASS == 1) {
            if (r32 == 31) { float* S = (float*)(F.ws + WS_LSUM) + (size_t)u * 1024;
#pragma unroll
                for (int r = 0; r < 16; ++r) { const int ch = 64 * n + 32 * jb + crow(r, hi); *(float2*)(S + 2 * ch) = make_float2(av[1][r], bv[1][r]); } }
        } else {
#pragma unroll
            for (int q4 = 0; q4 < 4; ++q4) { const int chb = 64 * n + 32 * jb + 8 * q4 + 4 * hi;
                const f32x4 hin = *(const LAS f32x4*)(lds + L_HIN + chb * 4);
#pragma unroll
                for (int tb = 0; tb < 2; ++tb) { const int t = tb * 32 + r32;
                    const v2u gw = gwv[q4][tb];
                    const float xg[4] = {bflo(gw.x), bfhi(gw.x), bflo(gw.y), bfhi(gw.y)};
#pragma unroll
                    for (int e = 0; e < 4; ++e) { const int r = 4 * q4 + e; const float h = av[tb][r] * hin[e] + bv[tb][r];
                        const float x = xg[e], uu = 0.7978845608028654f * (x + 0.044715f * x * x * x);
                        const float ge = x * __builtin_amdgcn_rcpf(1.0f + __builtin_amdgcn_exp2f(-2.0f * LOG2E * uu));
                        const float o = h * ge; ssq_t[tb] += o * o;
                        if (jb == 0) ((LAS float*)(lds + L_O0))[(wid * 32 + tb * 16 + r) * 64 + lane] = o; else outv[tb][r] = o;
                        if (tb == 1 && r32 == 31 && (smp || ck == 127)) { float* dst = smp ? F.out + O_LS + sb * 512 : F.out + O_LP + pb * 512; dst[chb + e] = h; } } } }
        }
        __builtin_amdgcn_sched_barrier(0);
    }
    if (PASS == 2) {
        LAS float* part = (LAS float*)(lds + L_PART);
#pragma unroll
        for (int tb = 0; tb < 2; ++tb) { float s = ssq_t[tb]; s += __shfl_xor(s, 32); if (hi == 0) part[wid * 64 + tb * 32 + r32] = s; }
        LDS_WAIT(); __syncthreads();
        bf16* CAT = (bf16*)(F.ws + WS_CAT);
#pragma unroll
        for (int tb = 0; tb < 2; ++tb) { const int t = tb * 32 + r32; float tot = 0.f;
#pragma unroll
            for (int w = 0; w < 8; ++w) tot += part[w * 64 + t];
            const float rn = __builtin_amdgcn_rsqf(tot * (1.0f / 512.0f) + EPS);
#pragma unroll
            for (int jb = 0; jb < 2; ++jb)
#pragma unroll
                for (int q4 = 0; q4 < 4; ++q4) { const int chb = 64 * n + 32 * jb + 8 * q4 + 4 * hi; const f32x4 gn = *(const LAS f32x4*)(lds + L_PAR + 6144 + chb * 4);
                    float ov[4];
#pragma unroll
                    for (int e = 0; e < 4; ++e) ov[e] = jb == 0 ? ((const LAS float*)(lds + L_O0))[(wid * 32 + tb * 16 + 4 * q4 + e) * 64 + lane] : outv[tb][4 * q4 + e];
                    v2u o; o.x = pk2(ov[0] * rn * gn[0], ov[1] * rn * gn[1]); o.y = pk2(ov[2] * rn * gn[2], ov[3] * rn * gn[3]);
                    *(GAS v2u*)(CAT + (size_t)(row0 + t) * 1024 + 512 + chb) = o; } }
    }
    LDS_WAIT(); __syncthreads();
}
}

#ifndef ATT_PROBE
#define ATT_PROBE 0
#endif
namespace att {
constexpr int SLOT = 32768, NSLOT = 4;
constexpr int A_RING = 0;
constexpr int A_EX = 0;
constexpr int A_TAB = 131072;
constexpr int A_WSF = 131072 + 1024;
constexpr int A_MISC = 143360;
__device__ __forceinline__ int crow(int r, int hi) { return (r & 3) + 8 * (r >> 2) + 4 * hi; }
__device__ __forceinline__ void glds16(const void* gsrc, unsigned lds_dst) { unsigned keep;
    asm volatile("s_mov_b32 %0, m0\n\ts_mov_b32 m0, %2\n\ts_nop 0\n\tglobal_load_lds_dwordx4 %1, off\n\ts_mov_b32 m0, %0" : "=&s"(keep) : "v"(gsrc), "s"(lds_dst) : "memory"); }
typedef __attribute__((address_space(3))) const char* lds_cptr;
typedef short v4i16_t __attribute__((ext_vector_type(4)));
__device__ __forceinline__ s16x4 vtr(lds_cptr p) { return __builtin_bit_cast(s16x4, __builtin_amdgcn_ds_read_tr16_b64_v4i16((__attribute__((address_space(3))) v4i16_t*)p)); }
__device__ __forceinline__ unsigned cvtpk(float lo, float hi) { typedef float f2 __attribute__((ext_vector_type(2))); typedef __bf16 b2 __attribute__((ext_vector_type(2)));
    f2 v = {lo, hi}; b2 b = __builtin_convertvector(v, b2); return __builtin_bit_cast(unsigned, b); }
#define ATT_WAIT_BAR(N) asm volatile("s_waitcnt vmcnt(" #N ") lgkmcnt(0)\n\ts_barrier" ::: "memory")

template <bool SMP, bool DESC> __device__ __forceinline__ void attn_unit(Frame& F, int sidx, int h, int qb, float lam) {
    int tid_ = F.tid; asm volatile("" : "+v"(tid_));
    const int tid = tid_, lane = tid & 63, wid = F.wave, r32 = lane & 31, hi = lane >> 5;
    const int comp = wid >> 2, g = wid & 3;
    LAS unsigned char* lds = F.lds;
    const unsigned lds0 = (unsigned)(uintptr_t)lds;
    const bf16* Qb = (const bf16*)(F.ws + WS_Q);
    const int qrow0 = SMP ? TP + sidx * 64 : sidx * SEQ + qb * 128;
    const int qpos0 = SMP ? PAST : qb * 128;
    const int NT = SMP ? 33 : 2 * qb + 2;
    const bool active = SMP ? (g < 2) : true;
    const int gq = SMP ? (g & 1) : g;
    const int qw = qpos0 + 32 * gq;
    const int t_last = active ? (qw >> 6) : -1;
    const int t_near0 = (qw - 90) > 0 ? ((qw - 90) >> 6) : 0;
    if (tid < 256) { float v = 0.f;
        if (tid >= 97 && tid <= 250) { const int delta = tid - 187; const int rel = delta < 0 ? -delta : delta; int bk;
            if (rel < 8) bk = rel; else { bk = 2 + (31 - __builtin_clz((unsigned)(rel * rel))); bk = bk > 15 ? 15 : bk; }
            if (delta > 0) bk += 16;
            v = (fin(F, 6)[bk * 4 + h] - fin(F, 6)[15 * 4 + h]) * LOG2E; }
        ((LAS float*)(lds + A_TAB))[tid] = v; }
    const unsigned char* img0 = F.ws + WS_KVP + (size_t)((SMP ? 0 : (sidx * 4 + h)) * 128) * 32768;
    const unsigned char* imgn = F.ws + WS_KVS + (size_t)(sidx * 4 + h) * 32768;
    const unsigned poff = (unsigned)(wid * 1024 + lane * 16);
    const unsigned pdst = lds0 + A_RING + wid * 1024;
#define ATT_TILE(i) (DESC ? NT - 1 - (i) : (i))
#define ATT_ISSUE(i) do { const int i_ = (i); const int t_ = ATT_TILE(i_); const unsigned so_ = (unsigned)((i_ % NSLOT) * SLOT); \
        if (SMP && t_ != 32) break;                                                 \
        const unsigned char* src_ = (SMP ? imgn : img0 + (size_t)t_ * 32768) + poff; \
        glds16(src_, (unsigned)__builtin_amdgcn_readfirstlane(pdst + so_)); \
        glds16(src_ + 8192, (unsigned)__builtin_amdgcn_readfirstlane(pdst + so_ + 8192)); \
        glds16(src_ + 16384, (unsigned)__builtin_amdgcn_readfirstlane(pdst + so_ + 16384)); \
        glds16(src_ + 24576, (unsigned)__builtin_amdgcn_readfirstlane(pdst + so_ + 24576)); } while (0)
    bf16x8 qr[4];
    { const bf16* Qw = Qb + (size_t)(qrow0 + 32 * gq + r32) * 512 + h * 128 + comp * 64;
#pragma unroll
      for (int d0 = 0; d0 < 4; ++d0) qr[d0] = *(const GAS bf16x8*)(Qw + d0 * 16 + hi * 8); }
    VM_WAIT();
    asm volatile("" : "+v"(qr[0]), "+v"(qr[1]), "+v"(qr[2]), "+v"(qr[3]));
#ifdef ATT_PRIO
    if (comp == ATT_PRIO - 1) __builtin_amdgcn_s_setprio(1);
#endif
    const bool loader = SMP && !active;
    const int wl = (wid & 1) | ((wid >> 2) << 1);
#define ATT_LOAD_TILE(tt, slot_) do { const int t_ = (tt); LAS unsigned char* sl_ = lds + A_RING + (slot_) * SLOT; \
        const float* ck_ = fin(F, 2) + ((size_t)(sidx * PAST + t_ * 64 + wl * 16) * 4 + h) * 128; const float* cv_ = fin(F, 3) + ((size_t)(sidx * PAST + t_ * 64 + wl * 16) * 4 + h) * 128; \
        f32x4 ka_[4][2], va_[4][2]; \
        _Pragma("unroll") for (int u = 0; u < 4; ++u) { const int cj = u * 4 + (lane >> 4); const float* s_ = ck_ + (size_t)(lane & 15) * 512 + cj * 8; \
            ka_[u][0] = __builtin_nontemporal_load((const f32x4*)s_); ka_[u][1] = __builtin_nontemporal_load((const f32x4*)s_ + 1); } \
        _Pragma("unroll") for (int u = 0; u < 4; ++u) { const float* s_ = cv_ + (size_t)(lane >> 2) * 512 + u * 32 + (lane & 3) * 8; \
            va_[u][0] = __builtin_nontemporal_load((const f32x4*)s_); va_[u][1] = __builtin_nontemporal_load((const f32x4*)s_ + 1); } \
        _Pragma("unroll") for (int u = 0; u < 4; ++u) { const int cj = u * 4 + (lane >> 4); v4u o_; o_.x = pk2(ka_[u][0].x, ka_[u][0].y); o_.y = pk2(ka_[u][0].z, ka_[u][0].w); o_.z = pk2(ka_[u][1].x, ka_[u][1].y); o_.w = pk2(ka_[u][1].z, ka_[u][1].w); \
            *(LAS v4u*)(sl_ + (cj >> 3) * 8192 + (cj & 7) * 1024 + (wl * 16 + (lane & 15)) * 16) = o_; } \
        _Pragma("unroll") for (int u = 0; u < 4; ++u) { v4u o_; o_.x = pk2(va_[u][0].x, va_[u][0].y); o_.y = pk2(va_[u][0].z, va_[u][0].w); o_.z = pk2(va_[u][1].x, va_[u][1].y); o_.w = pk2(va_[u][1].z, va_[u][1].w); \
            *(LAS v4u*)(sl_ + 16384 + u * 4096 + (wl * 16 + (lane >> 2)) * 64 + (lane & 3) * 16) = o_; } } while (0)
    if (loader) { ATT_LOAD_TILE(0, 0); ATT_LOAD_TILE(1, 1); VM_WAIT(); }
    ATT_ISSUE(0); if (NT > 1) ATT_ISSUE(1);
    f32x16 o[4]; o[0] = f32x16{}; o[1] = f32x16{}; o[2] = f32x16{}; o[3] = f32x16{};
    float lsum = 0.f;
    const lds_cptr l3 = (lds_cptr)lds;
    const int kfo = A_RING + comp * 8192 + hi * 1024 + r32 * 16;
    const int vfo = A_RING + 16384 + ((lane >> 4) & 1) * 32 + (lane & 3) * 8 + (4 * hi + ((lane & 15) >> 2)) * 64;
    const int qposl = qw + r32;
    v4u pw[4]; bool have_p = false;
    int so_prev = 0;
#define ATT_VRD(j) do { vlo[j] = vtr(vp + ((j) >> 2) * 4096 + ((j) & 3) * 1024); vhi[j] = vtr(vp + ((j) >> 2) * 4096 + ((j) & 3) * 1024 + 512); } while (0)
#define ATT_VFR(j) (bf16x8){vlo[j][0], vlo[j][1], vlo[j][2], vlo[j][3], vhi[j][0], vhi[j][1], vhi[j][2], vhi[j][3]}
#define ATT_G2(j) do { if ((j) + 3 < 16) ATT_VRD((j) + 3); \
        o[(j) >> 2] = __builtin_amdgcn_mfma_f32_32x32x16_bf16(__builtin_bit_cast(bf16x8, pw[(j) & 3]), ATT_VFR(j), o[(j) >> 2], 0, 0, 0); __builtin_amdgcn_sched_barrier(0); } while (0)
#define ATT_QKEXP(t_, so_) do { f32x16 p0, p1; \
        if ((t_) >= t_near0) { const LAS float* tb = (const LAS float*)(lds + A_TAB) + (64 * (t_) + 4 * hi - qposl + 187);     \
            _Pragma("unroll") for (int r = 0; r < 16; ++r) { p0[r] = tb[(r & 3) + 8 * (r >> 2)]; p1[r] = tb[(r & 3) + 8 * (r >> 2) + 32]; } } \
        else { p0 = f32x16{}; p1 = f32x16{}; } \
        const lds_cptr kp = l3 + kfo + (so_); \
        _Pragma("unroll") for (int d0 = 0; d0 < 4; ++d0) { \
            const bf16x8 k0 = *(const __attribute__((address_space(3))) bf16x8*)(kp + d0 * 2048); \
            const bf16x8 k1 = *(const __attribute__((address_space(3))) bf16x8*)(kp + d0 * 2048 + 512); \
            p0 = __builtin_amdgcn_mfma_f32_32x32x16_bf16(k0, qr[d0], p0, 0, 0, 0); \
            p1 = __builtin_amdgcn_mfma_f32_32x32x16_bf16(k1, qr[d0], p1, 0, 0, 0); } \
        float sacc = 0.f; \
        _Pragma("unroll") for (int r = 0; r < 16; ++r) { p0[r] = __builtin_amdgcn_exp2f(p0[r]); p1[r] = __builtin_amdgcn_exp2f(p1[r]); sacc += p0[r] + p1[r]; } \
        lsum += sacc; \
        _Pragma("unroll") for (int k = 0; k < 2; ++k) { pw[k] = (v4u){cvtpk(p0[8 * k], p0[8 * k + 1]), cvtpk(p0[8 * k + 2], p0[8 * k + 3]), cvtpk(p0[8 * k + 4], p0[8 * k + 5]), cvtpk(p0[8 * k + 6], p0[8 * k + 7])}; \
                                      pw[2 + k] = (v4u){cvtpk(p1[8 * k], p1[8 * k + 1]), cvtpk(p1[8 * k + 2], p1[8 * k + 3]), cvtpk(p1[8 * k + 4], p1[8 * k + 5]), cvtpk(p1[8 * k + 6], p1[8 * k + 7])}; } } while (0)
#define ATT_PV(so_) do { const lds_cptr vp = l3 + vfo + (so_); s16x4 vlo[16], vhi[16]; ATT_VRD(0); ATT_VRD(1); ATT_VRD(2); __builtin_amdgcn_sched_barrier(0); \
        ATT_G2(0); ATT_G2(1); ATT_G2(2); ATT_G2(3); ATT_G2(4); ATT_G2(5); ATT_G2(6); ATT_G2(7); ATT_G2(8); ATT_G2(9); ATT_G2(10); ATT_G2(11); ATT_G2(12); ATT_G2(13); ATT_G2(14); ATT_G2(15); } while (0)
#define ATT_SYNC(it_) do { if ((it_) + 1 < NT) ATT_WAIT_BAR(4); else ATT_WAIT_BAR(0);     \
        if ((it_) + 2 < NT) ATT_ISSUE((it_) + 2); } while (0)
    const bool skew = comp == 1;
    for (int it = 0; it < NT; ++it) {
        const int t = ATT_TILE(it);
        if (skew) ATT_SYNC(it);
        if (have_p) { ATT_PV(so_prev); __builtin_amdgcn_sched_barrier(0); }
        if (!skew) ATT_SYNC(it);
        const int so = (it % NSLOT) * SLOT;
        have_p = (t <= t_last);
        if (have_p) { ATT_QKEXP(t, so); so_prev = so; }
        if (loader && it + 2 < 32) { ATT_LOAD_TILE(it + 2, (it + 2) % NSLOT); VM_WAIT(); }
    }
    if (have_p) { ATT_PV(so_prev); }
#undef ATT_SYNC
#undef ATT_VRD
#undef ATT_VFR
#undef ATT_G2
#undef ATT_QKEXP
#undef ATT_PV
#ifdef ATT_PRIO
    __builtin_amdgcn_s_setprio(0);
#endif
    int lane_e = lane; asm volatile("" : "+v"(lane_e));
    const int r32e = lane_e & 31, hie = lane_e >> 5;
    { auto rr = __builtin_amdgcn_permlane32_swap(__float_as_uint(lsum), __float_as_uint(lsum), false, false); lsum = __uint_as_float(rr[0]) + __uint_as_float(rr[1]); }
    LAS float* wsf = (LAS float*)(lds + A_WSF) + wid * 32;
    if (hie == 0) wsf[r32e] = lsum;
    ATT_WAIT_BAR(0);
    float rli[16];
#pragma unroll
    for (int r = 0; r < 16; ++r) rli[r] = __builtin_amdgcn_rcpf(wsf[crow(r, hie)]);
    LAS float* ex = (LAS float*)(lds + A_EX) + g * 4096;
    if (comp == 1) {
#pragma unroll
        for (int db = 0; db < 4; ++db)
#pragma unroll
            for (int r = 0; r < 16; ++r) ex[crow(r, hie) * 128 + db * 32 + r32e] = o[db][r] * (rli[r] * lam);
    }
    LDS_WAIT(); __syncthreads();
    if (comp == 0 && active) {
        float ss[16];
#pragma unroll
        for (int r = 0; r < 16; ++r) ss[r] = 0.f;
#pragma unroll
        for (int db = 0; db < 4; ++db)
#pragma unroll
            for (int r = 0; r < 16; ++r) { const float v = o[db][r] * rli[r] - ex[crow(r, hie) * 128 + db * 32 + r32e]; o[db][r] = v; ss[r] += v * v; }
#pragma unroll
        for (int r = 0; r < 16; ++r) { float s = ss[r];
#pragma unroll
            for (int m = 1; m < 32; m <<= 1) s += __shfl_xor(s, m);
            ss[r] = __builtin_amdgcn_rsqf(s * (1.0f / 128.0f) + EPS) * 0.8f; }
        LDS_WAIT();
        LAS unsigned short* stg = (LAS unsigned short*)ex;
#pragma unroll
        for (int db = 0; db < 4; ++db) { const float gn = fin(F, 19)[db * 32 + r32e];
#pragma unroll
            for (int r = 0; r < 16; ++r) stg[crow(r, hie) * 128 + db * 32 + r32e] = (unsigned short)f2bf(o[db][r] * ss[r] * gn); }
        LDS_WAIT();
        bf16* CAT = (bf16*)(F.ws + WS_CAT);
#pragma unroll
        for (int i = 0; i < 8; ++i) { const int row = i * 4 + (lane_e >> 4), ch = lane_e & 15;
            const v4u v = *(const LAS v4u*)(stg + row * 128 + ch * 8);
            *(GAS v4u*)(CAT + (size_t)(qrow0 + 32 * g + row) * 1024 + h * 128 + ch * 8) = v; }
    }
    VM_WAIT(); LDS_WAIT(); __syncthreads();
#undef ATT_ISSUE
#undef ATT_LOAD_TILE
#undef ATT_TILE
}
#undef ATT_WAIT_BAR
}

#ifndef SKM_G1
#define SKM_G1 0
#endif
#ifndef SKM_G2
#define SKM_G2 0
#endif
#ifndef SKM_G3
#define SKM_G3 0
#endif
#ifndef SKM_G5
#define SKM_G5 0
#endif
#ifndef SKM_G6
#define SKM_G6 0
#endif
#ifndef SKM_G7
#define SKM_G7 0
#endif
__device__ __forceinline__ void phase_p0(Frame& F) {
    unsigned char* ws = F.ws; (void)ws;
#ifndef NO_P0
    p0_prologue(F);
#endif
}

__device__ __forceinline__ void phase_g1(Frame& F) {
    unsigned char* ws = F.ws; (void)ws;
#ifndef NO_G1
    {   pg8::Gemm g{(const pg8::bf16_t*)(ws + WS_XB), (const pg8::bf16_t*)(ws + WS_W1GU), TT, 2 * FF, DM}; pg8::StreamK<SKM_G1> S; S.init(TT, 2 * FF, DM, F.G, F.bx, (float*)(ws + WS_CAT), (unsigned*)(ws + WS_CTL) + CW_SK + 0 * 512);
        pg8::EpiSwiGLU<0> E{(pg8::bf16_t*)(ws + WS_H), (const float*)(ws + WS_RSTD0)};
        pg8::gemm_phase<pg8::EpiSwiGLU<0>, pg8::StreamK<SKM_G1>, true, true>(F.lds, g, S, E); }
    convert_in_tail(F, (TT / 256) * (2 * FF / 256), 1);
#endif
}

__device__ __forceinline__ void phase_g2(Frame& F) {
    unsigned char* ws = F.ws; (void)ws;
#ifndef NO_G2
    {   pg8::Gemm g{(const pg8::bf16_t*)(ws + WS_H), (const pg8::bf16_t*)(ws + WS_W1D), TT, DM, FF}; pg8::StreamK<SKM_G2> S; S.init(TT, DM, FF, F.G, F.bx, (float*)(ws + WS_CAT), (unsigned*)(ws + WS_CTL) + CW_SK + 1 * 512);
        pg8::EpiResid<0> E{(pg8::bf16_t*)(ws + WS_XB), F.out, (float*)(ws + WS_SSQ1)};
        pg8::gemm_phase<pg8::EpiResid<0>, pg8::StreamK<SKM_G2>, true, true>(F.lds, g, S, E); }
    convert_in_tail(F, (TT / 256) * (DM / 256), 2);
#endif
}

__device__ __forceinline__ void phase_g3(Frame& F) {
    unsigned char* ws = F.ws; (void)ws;
#ifndef NO_G3
    {   pg8::Gemm g{(const pg8::bf16_t*)(ws + WS_XB), (const pg8::bf16_t*)(ws + WS_WIN), TT, INW, DM}; pg8::StreamK<SKM_G3> S; S.init(TT, INW, DM, F.G, F.bx, (float*)(ws + WS_CAT), (unsigned*)(ws + WS_CTL) + CW_SK + 2 * 512);
        pg8::EpiWin E{ws, F.out, fin(F, 13), fin(F, 14)};
        pg8::gemm_phase<pg8::EpiWin, pg8::StreamK<SKM_G3>, true, true>(F.lds, g, S, E); }
#endif
}

__device__ __forceinline__ void phase_l1(Frame& F) {
    unsigned char* ws = F.ws; (void)ws;
#ifndef NO_L1
    for (int u = F.bx; u < 544; u += F.G) lru::lru_unit<1>(F, u);
#endif
}

__device__ __forceinline__ void phase_g5(Frame& F) {
    unsigned char* ws = F.ws; (void)ws;
#ifndef NO_G5
    {   pg8::Gemm g{(const pg8::bf16_t*)(ws + WS_CAT), (const pg8::bf16_t*)(ws + WS_WOUT), TT, DM, DM}; pg8::StreamK<SKM_G5> S; S.init(TT, DM, DM, F.G, F.bx, (float*)(ws + WS_CK), (unsigned*)(ws + WS_CTL) + CW_SK + 3 * 512);
        pg8::EpiResid<1> E{(pg8::bf16_t*)(ws + WS_XB), F.out, (float*)(ws + WS_SSQ2)};
        pg8::gemm_phase<pg8::EpiResid<1>, pg8::StreamK<SKM_G5>, true, true>(F.lds, g, S, E); }
#endif
}

__device__ __forceinline__ void phase_g6(Frame& F) {
    unsigned char* ws = F.ws; (void)ws;
#ifndef NO_G6
    {   pg8::Gemm g{(const pg8::bf16_t*)(ws + WS_XB), (const pg8::bf16_t*)(ws + WS_W2GU), TT, 2 * FF, DM}; pg8::StreamK<SKM_G6> S; S.init(TT, 2 * FF, DM, F.G, F.bx, (float*)(ws + WS_CK), (unsigned*)(ws + WS_CTL) + CW_SK + 4 * 512);
        pg8::EpiSwiGLU<1> E{(pg8::bf16_t*)(ws + WS_H), (const float*)(ws + WS_SSQ2)};
        pg8::gemm_phase<pg8::EpiSwiGLU<1>, pg8::StreamK<SKM_G6>, true, true>(F.lds, g, S, E); }
#endif
}

__device__ __forceinline__ void phase_g7(Frame& F) {
    unsigned char* ws = F.ws; (void)ws;
#ifndef NO_G7
    {   pg8::Gemm g{(const pg8::bf16_t*)(ws + WS_H), (const pg8::bf16_t*)(ws + WS_W2D), TT, DM, FF}; pg8::StreamK<SKM_G7> S; S.init(TT, DM, FF, F.G, F.bx, (float*)(ws + WS_CK), (unsigned*)(ws + WS_CTL) + CW_SK + 5 * 512);
        pg8::EpiResid<2> E{(pg8::bf16_t*)(ws + WS_XB), F.out, nullptr};
        pg8::gemm_phase<pg8::EpiResid<2>, pg8::StreamK<SKM_G7>, true, true>(F.lds, g, S, E); }
#endif
}

struct Args { const float* in[33]; float* out; unsigned char* ws; int pad0, pad1; };
__global__ void __launch_bounds__(512, 2) hymba_fwd(Args args) {
    extern __shared__ __attribute__((aligned(16))) unsigned char lds_raw[];
    cg::grid_group grid = cg::this_grid();
    Frame F;
    F.lds = (LAS unsigned char*)lds_raw;
    F.tid = threadIdx.x; F.lane = F.tid & 63; F.wave = __builtin_amdgcn_readfirstlane(F.tid >> 6);
    F.G = gridDim.x; F.bx = blockIdx.x;
    F.ka = (kptr_t)__builtin_amdgcn_kernarg_segment_ptr(); F.z = 0;
    F.out = args.out; F.ws = args.ws;
    unsigned char* ws = F.ws;
    unsigned* ctl = (unsigned*)(ws + WS_CTL);
    volatile LAS unsigned* MISCW = (volatile LAS unsigned*)(F.lds + 144384);
    if (F.tid < 16) MISCW[F.tid] = 0u;
    __syncthreads();
    XcdBarrier bar = xcd_barrier_post(ctl + CW_BAR, MISCW + 8);
#define GRID_BAR() do { xcd_barrier(bar); NEW_PHASE(); } while (0)
#define GRID_BAR_CG() do { __threadfence(); grid.sync(); NEW_PHASE(); } while (0)

    phase_p0(F);
#if defined(REP_P0)
    GRID_BAR(); phase_p0(F);
#endif
#ifdef USE_CG_SYNC
    GRID_BAR_CG();
#else
    GRID_BAR();
#endif
    phase_g1(F);
#if defined(REP_G1)
    GRID_BAR(); phase_g1(F);
#endif
    GRID_BAR();
    phase_g2(F);
#if defined(REP_G2)
    GRID_BAR(); phase_g2(F);
#endif
    GRID_BAR();
    phase_g3(F);
#if defined(REP_G3)
    GRID_BAR(); phase_g3(F);
#endif
    GRID_BAR();
    phase_l1(F);
#if defined(REP_L1)
    GRID_BAR(); phase_l1(F);
#endif
    GRID_BAR();
    {
        LAS float* misc = (LAS float*)(F.lds + att::A_MISC);
        if (F.wave == 0) { const float a = wave_sum(fin(F, 15)[F.lane] * fin(F, 16)[F.lane]), b = wave_sum(fin(F, 17)[F.lane] * fin(F, 18)[F.lane]);
            if (F.lane == 0) misc[0] = __expf(a) - __expf(b) + 0.2f; }
        __syncthreads();
        const float lam = misc[0];
        const int grp = F.bx & 7;
#ifdef ATT_TWICE
        for (int rep = 0; rep < 2; ++rep) {
        unsigned* head = ctl + CW_QUEUE + 64 * grp + 1024 * rep;
#else
        unsigned* head = ctl + CW_QUEUE + 64 * grp;
#endif
        const int wq = F.bx >> 3;
        if (F.G == 256) {
#ifndef NO_ATT
#pragma unroll 1
            for (int k = 0; k < 2; ++k) { const int st = grp + 8 * k;
                att::attn_unit<false, false>(F, st >> 2, st & 3, wq, lam);
                att::attn_unit<false, true>(F, st >> 2, st & 3, 63 - wq, lam); }
#endif
        }
        const int qbase = (F.G == 256) ? 128 : 0;
        for (;;) {
            if (F.tid == 0) ((LAS int*)misc)[1] = qbase + (int)atomicAdd(head, 1u);
            __syncthreads();
            const int it = ((LAS int*)misc)[1];
            __syncthreads();
            if (it >= 212) break;
#ifndef NO_ATT
            if (it < 128) { const int st = grp + 8 * (it >> 6), qb = 63 - (it & 63); att::attn_unit<false, false>(F, st >> 2, st & 3, qb, lam); }
            else if (it < 144) { const int su = grp * 16 + (it - 128); att::attn_unit<true, false>(F, su >> 2, su & 3, 0, lam); }
            else
#endif
#ifndef NO_L2
            { lru::lru_unit<2>(F, grp * 68 + (it - 144));
#ifdef L2_TWICE
              lru::lru_unit<2>(F, grp * 68 + (it - 144));
#endif
            }
#else
            {}
#endif
        }
#ifdef ATT_TWICE
        __syncthreads(); }
#endif
    }
    GRID_BAR();
    phase_g5(F);
#if defined(REP_G5)
    GRID_BAR(); phase_g5(F);
#endif
    GRID_BAR();
    phase_g6(F);
#if defined(REP_G6)
    GRID_BAR(); phase_g6(F);
#endif
    GRID_BAR();
    phase_g7(F);
#if defined(REP_G7)
    GRID_BAR(); phase_g7(F);
#endif
}

extern "C" void kernel_launch(void* const* d_in, const int* in_sizes, int n_in, void* d_out, int out_size, void* d_ws, size_t ws_size, hipStream_t stream) {
    static int grid = 0;
    if (grid == 0) {
        if (n_in != 33 || out_size != (int)O_END || ws_size < WS_END) { fprintf(stderr, "kernel_launch: unexpected shapes: n_in %d out %d ws %zu (need %zu)\n", n_in, out_size, ws_size, (size_t)WS_END); grid = -1; return; }
        int dev = 0, cus = 0, per_cu = 0;
        hipGetDevice(&dev); hipDeviceGetAttribute(&cus, hipDeviceAttributeMultiprocessorCount, dev);
        if (hipFuncSetAttribute((const void*)hymba_fwd, hipFuncAttributeMaxDynamicSharedMemorySize, LDS_BYTES) != hipSuccess) { fprintf(stderr, "kernel_launch: hipFuncSetAttribute failed\n"); grid = -1; return; }
        if (hipOccupancyMaxActiveBlocksPerMultiprocessor(&per_cu, (const void*)hymba_fwd, 512, LDS_BYTES) != hipSuccess || per_cu < 1) { fprintf(stderr, "kernel_launch: occupancy query says %d\n", per_cu); per_cu = 1; }
        (void)hipGetLastError();
        grid = cus * 1;
        if (grid % 8 != 0 || grid < 8) { fprintf(stderr, "kernel_launch: grid %d not a multiple of 8\n", grid); }
    }
    if (grid < 0) return;
    (void)hipMemsetAsync((char*)d_ws + WS_CTL, 0, CTL_ZERO_BYTES, stream);
    Args a{};
    for (int i = 0; i < 33; ++i) a.in[i] = (const float*)d_in[i];
    a.out = (float*)d_out; a.ws = (unsigned char*)d_ws;
    void* kargs[] = {&a};
    hipError_t e = hipLaunchCooperativeKernel((const void*)hymba_fwd, dim3(grid), dim3(512), kargs, LDS_BYTES, stream);
    if (e != hipSuccess) fprintf(stderr, "kernel_launch: cooperative launch failed: %s (grid %d)\n", hipGetErrorString(e), grid);
}
```

```cpp
#include <hip/hip_runtime.h>
#include <hip/hip_cooperative_groups.h>
#include <hip/hip_bf16.h>
#include <cstdio>
#include <cstdint>
namespace cg = cooperative_groups;

constexpr int DM = 1024, NBP = 4, SEQ = 8192, NBS = 32, DSQ = 64, PAST = 2048;
constexpr int TP = NBP * SEQ, TS = NBS * DSQ, TT = TP + TS;
constexpr int FF = 2816, AW = 512, LW = 512, INW = 2560, NH = 4, HD = 64, VD = 128;
constexpr float EPS = 1e-6f;
constexpr float LOG2E = 1.4426950408889634f;
constexpr float QSCALE = 0.125f * LOG2E;
constexpr size_t O_Y = 0, O_KP = (size_t)TT * DM, O_VP = O_KP + (size_t)TP * 512, O_LP = O_VP + (size_t)TP * 512, O_CP = O_LP + NBP * 512,
                 O_KS = O_CP + NBP * 3 * 512, O_VS = O_KS + (size_t)TS * 512, O_LS = O_VS + (size_t)TS * 512, O_CS = O_LS + NBS * 512, O_END = O_CS + NBS * 3 * 512;
static_assert(O_END == 71376896, "output size");
constexpr size_t OFF_SSQ1 = 44u << 20, OFF_KVP = 376u << 20, OFF_KVS = 440u << 20;
constexpr size_t OB_Q = 0, OB_XR = 34u << 20, OB_XG = 68u << 20;
#ifndef PG8_WGM
#define PG8_WGM 4
#endif
namespace pg8 {
#define PG8_LAS __attribute__((address_space(3)))
typedef unsigned short bf16_t;
typedef short bf16x8 __attribute__((ext_vector_type(8)));
typedef float f32x4 __attribute__((ext_vector_type(4)));
typedef float f32x2 __attribute__((ext_vector_type(2)));
typedef unsigned u32x4 __attribute__((ext_vector_type(4)));
constexpr int BM = 256, BK = 64, HALF = 128, HTB = HALF * BK * 2  , STAGE_BYTES = 8 * HTB, NXCD = 8, WGM = PG8_WGM;

__host__ __device__ __forceinline__ int lds_byte(int r, int c) { const int st = (r >> 4) * 2 + (c >> 5), rr = r & 15, cc = c & 31, ob = rr * 64 + cc * 2; return st * 1024 + (ob ^ (((ob >> 9) & 1) << 5)); }
__host__ __device__ __forceinline__ void stage_rc(int b, int& R, int& C) { const int st = b / 1024, sb = b % 1024, swz = sb ^ (((sb >> 9) & 1) << 5); R = (st >> 1) * 16 + swz / 64; C = (st & 1) * 32 + (swz % 64) / 2; }
__host__ __device__ __forceinline__ int perm32(int rho) { const int n = rho >> 4, i = rho & 15; return 8 * (i >> 2) + 4 * n + (i & 3); }

struct Unit { int pm, pn, kt0, nkt, kind; };
struct Gemm { const bf16_t* A; const bf16_t* Bt; int M, N, K; };

template <int MODE  , int DEP = 0  > struct StreamK {
    static constexpr bool SPLIT = MODE != 0; static constexpr int DEPF = DEP;
    const unsigned* dep_in; unsigned* dep_out; unsigned dep_target;
    int nM, nN, P, W, x, w, q, R1, Dq; long lo, hi; int v; float* slab; unsigned* flag;
    int pm0;
    __device__ void init(int M, int N, int K, int G_, int bx, float* slab_, unsigned* flag_, int pm0_ = 0, int rot = 0) { pm0 = pm0_; nM = M / BM; nN = N / BM; P = K / (2 * BK); W = G_ / NXCD; x = bx % NXCD; w = (bx / NXCD + W - rot % W) % W;
        const int nwg = nM * nN; q = nwg / NXCD;
        if (!SPLIT) { R1 = (nwg + G_ - 1) / G_; Dq = q; } else { R1 = nwg / G_ - 1; Dq = R1 * W; }
        const long tot = (long)(q - Dq) * P; lo = tot * w / W; hi = tot * (w + 1) / W; v = x * W + w; slab = slab_; flag = flag_; }
    __device__ bool next(int i, Unit& u) const {
        int L; int j = i, k = -1;
        if (MODE == 2 && (lo % P) != 0) { if (i == 0) k = 0; else j = i - 1; }
        if (k < 0 && j >= R1) { if (!SPLIT) return false; k = j - R1 + ((MODE == 2 && (lo % P) != 0) ? 1 : 0); }
        if (k < 0) { L = j * W + w; u.kt0 = 0; u.nkt = 2 * P; u.kind = 0; if (!SPLIT && L >= q) return false; }
        else { const long u0 = lo / P; const long base = (u0 + k) * P; const long start = (k == 0) ? lo - base : 0; if (base + start >= hi) return false;
            const long end = (hi - base) < P ? (hi - base) : P;
            L = Dq + (int)(u0 + k); u.kt0 = (int)(2 * start); u.nkt = (int)(2 * (end - start)); u.kind = start > 0 ? 1 : (end < P ? 2 : 0); }
        const int ppx = nM / NXCD, nig = WGM * nN, gid = L / nig, fm = gid * WGM, gsz = (ppx - fm) < WGM ? (ppx - fm) : WGM;
        u.pm = pm0 + x * ppx + fm + ((L % nig) % gsz); u.pn = (L % nig) / gsz; return true;
    }
    __device__ __forceinline__ unsigned poll(const Unit& u) const {
#ifdef NO_POLL
        return 0xffffu;
#else
        if constexpr ((DEP & 1) != 0) return __hip_atomic_load(dep_in + u.pm * 4, __ATOMIC_RELAXED, __HIP_MEMORY_SCOPE_AGENT); else return 0u;
#endif
    }
    __device__ __forceinline__ void a_ready(const Unit& u, unsigned pv) const {
        if constexpr ((DEP & 1) != 0) { unsigned spins = 0;
            while ((unsigned)__builtin_amdgcn_readfirstlane(pv) < dep_target) { __builtin_amdgcn_s_sleep(4); pv = poll(u); if (++spins > (1u << 21)) break; }
#ifdef DEP_INV
            asm volatile("buffer_inv sc1" ::: "memory");
#endif
        }
    }
    __device__ __forceinline__ void done(const Unit& u) const {
        if constexpr ((DEP & 2) != 0) { asm volatile("s_waitcnt vmcnt(0)" ::: "memory");
            if ((threadIdx.x & 63) == 0) __hip_atomic_fetch_add(dep_out + u.pm * 4, 1u, __ATOMIC_RELAXED, __HIP_MEMORY_SCOPE_AGENT); }
    }
    __device__ __forceinline__ void put_partial(const f32x4 (&acc)[2][2][4][2], int tid, int lane) const {
        f32x4* dst = (f32x4*)slab + (size_t)v * (32 * 512) + tid;
#pragma unroll
        for (int ai = 0; ai < 2; ++ai)
#pragma unroll
            for (int bj = 0; bj < 2; ++bj)
#pragma unroll
                for (int m = 0; m < 4; ++m)
#pragma unroll
                    for (int n = 0; n < 2; ++n) { const f32x4 val = acc[ai][bj][m][n];
                        asm volatile("global_store_dwordx4 %0, %1, off sc1\n\ts_nop 1" :: "v"(dst), "v"(val) : "memory");
                        dst += 512; asm volatile("" : "+v"(dst)); }
        asm volatile("s_waitcnt vmcnt(0)" ::: "memory");
        if (lane == 0) __hip_atomic_fetch_add(flag + v, 1u, __ATOMIC_RELAXED, __HIP_MEMORY_SCOPE_AGENT);
    }
    __device__ __forceinline__ void load_partial(f32x4 (&acc)[2][2][4][2], int tid, int lane) const {
        unsigned spins = 0;
        while ((unsigned)__builtin_amdgcn_readfirstlane(__hip_atomic_load(flag + v + 1, __ATOMIC_RELAXED, __HIP_MEMORY_SCOPE_AGENT)) < 8u) { __builtin_amdgcn_s_sleep(2); if (++spins > (1u << 22)) break; }
        __builtin_amdgcn_fence(__ATOMIC_ACQUIRE, "agent");
        const f32x4* src = (const f32x4*)slab + (size_t)(v + 1) * (32 * 512) + tid;
#pragma unroll
        for (int ai = 0; ai < 2; ++ai)
#pragma unroll
            for (int bj = 0; bj < 2; ++bj)
#pragma unroll
                for (int m = 0; m < 4; ++m)
#pragma unroll
                    for (int n = 0; n < 2; ++n) { acc[ai][bj][m][n] = *src; src += 512; asm volatile("" : "+v"(src)); }
    }
};

__device__ __forceinline__ unsigned cvt_pk_bf16(float lo, float hi) { unsigned r; asm volatile("v_cvt_pk_bf16_f32 %0, %1, %2" : "=v"(r) : "v"(lo), "v"(hi)); return r; }
__device__ __forceinline__ u32x4 pack8(const f32x4& a, const f32x4& b) { u32x4 w; w.x = cvt_pk_bf16(a[0], a[1]); w.y = cvt_pk_bf16(a[2], a[3]); w.z = cvt_pk_bf16(b[0], b[1]); w.w = cvt_pk_bf16(b[2], b[3]); return w; }
#ifdef WT_OFF
__device__ __forceinline__ void st16_wt(void* p, const u32x4& v) { *(u32x4*)p = v; }
#else
__device__ __forceinline__ void st16_wt(void* p, const u32x4& v) { asm volatile("global_store_dwordx4 %0, %1, off sc1\n\ts_nop 1" :: "v"(p), "v"(v)); }
#endif
__device__ __forceinline__ float silu_f(float g) { return g * __builtin_amdgcn_rcpf(1.0f + __builtin_amdgcn_exp2f(-g * 1.4426950408889634f)); }
__device__ __forceinline__ float rstd_from_ssq(const float* ssq, int row, int fq) {
    const f32x4 p = *(const f32x4*)(ssq + (size_t)row * 16 + 4 * fq);
    float s = (p[0] + p[1]) + (p[2] + p[3]); s += __shfl_xor(s, 16); s += __shfl_xor(s, 32);
    return __builtin_amdgcn_rsqf(s * (1.0f / 1024.0f) + 1e-6f);
}
#ifndef EPI_TWICE
#define EPI_TWICE 0
#endif
template <int RSMODE  > struct EpiSwiGLU {
    static constexpr bool PERM = true, AFTER_DRAIN = false, TWICE_OK = (EPI_TWICE == 1);
    bf16_t* H; const float* rs;
    __device__ __forceinline__ void operator()(const f32x4 (&acc)[2][2][4][2], const Unit& u, int wr, int wc, int fr, int fq) const {
        const int row0 = u.pm * BM + wr * 64 + fr, col0 = u.pn * 128 + wc * 32 + 8 * fq;
#pragma unroll
        for (int ai = 0; ai < 2; ++ai)
#pragma unroll
            for (int m = 0; m < 4; ++m) { const int row = row0 + ai * HALF + m * 16;
                const float s = RSMODE == 0 ? rs[row] : rstd_from_ssq(rs, row, fq);
                const float s2 = s * -1.4426950408889634f, ss = s * s;
                f32x4 h0, h1;
#pragma unroll
                for (int e = 0; e < 4; e += 2) {
                    { const f32x2 g = {acc[ai][0][m][0][e], acc[ai][0][m][0][e + 1]}, u = {acc[ai][1][m][0][e], acc[ai][1][m][0][e + 1]}; const f32x2 t = g * s2;
                      const f32x2 den = (f32x2){__builtin_amdgcn_exp2f(t.x), __builtin_amdgcn_exp2f(t.y)} + 1.0f; const f32x2 r = {__builtin_amdgcn_rcpf(den.x), __builtin_amdgcn_rcpf(den.y)};
                      const f32x2 h = (g * u) * (r * ss); h0[e] = h.x; h0[e + 1] = h.y; }
                    { const f32x2 g = {acc[ai][0][m][1][e], acc[ai][0][m][1][e + 1]}, u = {acc[ai][1][m][1][e], acc[ai][1][m][1][e + 1]}; const f32x2 t = g * s2;
                      const f32x2 den = (f32x2){__builtin_amdgcn_exp2f(t.x), __builtin_amdgcn_exp2f(t.y)} + 1.0f; const f32x2 r = {__builtin_amdgcn_rcpf(den.x), __builtin_amdgcn_rcpf(den.y)};
                      const f32x2 h = (g * u) * (r * ss); h1[e] = h.x; h1[e + 1] = h.y; } }
                st16_wt(H + (size_t)row * 2816 + col0, pack8(h0, h1)); }
    }
};
__device__ __forceinline__ f32x4 bf4lo(const u32x4& w) { f32x4 r; r[0] = __builtin_bit_cast(float, w.x << 16); r[1] = __builtin_bit_cast(float, w.x & 0xffff0000u); r[2] = __builtin_bit_cast(float, w.y << 16); r[3] = __builtin_bit_cast(float, w.y & 0xffff0000u); return r; }
__device__ __forceinline__ f32x4 bf4hi(const u32x4& w) { f32x4 r; r[0] = __builtin_bit_cast(float, w.z << 16); r[1] = __builtin_bit_cast(float, w.z & 0xffff0000u); r[2] = __builtin_bit_cast(float, w.w << 16); r[3] = __builtin_bit_cast(float, w.w & 0xffff0000u); return r; }
template <int KIND> struct EpiResid {
    static constexpr bool PERM = true, AFTER_DRAIN = false, TWICE_OK = (EPI_TWICE == 3 && KIND == 2);
    bf16_t* xb; float* out; float* ssq; bf16_t* xo;
    __device__ __forceinline__ void operator()(const f32x4 (&acc)[2][2][4][2], const Unit& u, int wr, int wc, int fr, int fq) const {
        const int row0 = u.pm * BM + wr * 64 + fr, col0 = u.pn * BM + wc * 32 + 8 * fq;
        const float sc = KIND == 1 ? 1.0f : 0.5f;
        u32x4 r0 = *(const u32x4*)(xb + (size_t)row0 * 1024 + col0), r1 = *(const u32x4*)(xb + (size_t)row0 * 1024 + col0 + HALF);
#pragma unroll
        for (int ai = 0; ai < 2; ++ai)
#pragma unroll
            for (int m = 0; m < 4; ++m) { const int row = row0 + ai * HALF + m * 16;
                const u32x4 c0 = r0, c1 = r1;
                if (ai * 4 + m < 7) { const int nrow = row0 + ((ai * 4 + m + 1) >> 2) * HALF + ((ai * 4 + m + 1) & 3) * 16;
                    r0 = *(const u32x4*)(xb + (size_t)nrow * 1024 + col0); r1 = *(const u32x4*)(xb + (size_t)nrow * 1024 + col0 + HALF); }
                const f32x4 v00 = bf4lo(c0) + acc[ai][0][m][0] * sc, v01 = bf4hi(c0) + acc[ai][0][m][1] * sc, v10 = bf4lo(c1) + acc[ai][1][m][0] * sc, v11 = bf4hi(c1) + acc[ai][1][m][1] * sc;
                if (KIND < 2) {
                    st16_wt(xo + (size_t)row * 1024 + col0, pack8(v00, v01)); st16_wt(xo + (size_t)row * 1024 + col0 + HALF, pack8(v10, v11));
                    float ss = (v00[0] * v00[0] + v00[1] * v00[1]) + (v00[2] * v00[2] + v00[3] * v00[3]) + (v01[0] * v01[0] + v01[1] * v01[1]) + (v01[2] * v01[2] + v01[3] * v01[3]);
                    ss += (v10[0] * v10[0] + v10[1] * v10[1]) + (v10[2] * v10[2] + v10[3] * v10[3]) + (v11[0] * v11[0] + v11[1] * v11[1]) + (v11[2] * v11[2] + v11[3] * v11[3]);
                    ss += __shfl_xor(ss, 16); ss += __shfl_xor(ss, 32); if (fq == 0) __hip_atomic_store(ssq + (size_t)row * 16 + u.pn * 4 + wc, ss, __ATOMIC_RELAXED, __HIP_MEMORY_SCOPE_AGENT);
                } else { float* orow = out + (size_t)row * 1024 + col0;
                    __builtin_nontemporal_store(v00, (f32x4*)orow); __builtin_nontemporal_store(v01, (f32x4*)(orow + 4)); __builtin_nontemporal_store(v10, (f32x4*)(orow + HALF)); __builtin_nontemporal_store(v11, (f32x4*)(orow + HALF + 4)); } }
    }
};
struct EpiWinPtrs { const float* ssq1; bf16_t* Q; unsigned char *KVP, *KVS; bf16_t *XR, *XG; float* out; const float *gq, *gk; };
template <class T> __device__ __forceinline__ T* uoff(const void* ub, unsigned off) { return (T*)((unsigned char*)ub + off); }
__device__ __forceinline__ float rstd_from_p(const f32x4* pp) { const f32x4 p = *pp; float s = (p[0] + p[1]) + (p[2] + p[3]); s += __shfl_xor(s, 16); s += __shfl_xor(s, 32); return __builtin_amdgcn_rsqf(s * (1.0f / 1024.0f) + 1e-6f); }
__device__ __forceinline__ unsigned char* tile_u(const EpiWinPtrs& P, bool prm, int rt, int h) {
    return prm ? P.KVP + (size_t)((((rt >> 13) * 4 + h) * 128) + ((rt & 8191) >> 6)) * 32768 : P.KVS + (size_t)(((rt - 32768) >> 6) * 4 + h) * 32768; }
template <int KIND> __device__ __forceinline__ void win_qk(const EpiWinPtrs P, const f32x4 (&acc)[2][2][4][2], const Unit& u, int wr, int wc, int fr, int fq) {
    const int rowb = u.pm * BM + wr * 64, half = u.pn & 1; const bool prm = u.pm < 128;
    const float* gp = KIND == 0 ? P.gq : P.gk; const float qs = KIND == 0 ? 0.125f * 1.4426950408889634f : 1.0f;
    const f32x4 g00 = *(const f32x4*)(gp + 8 * fq) * qs, g01 = *(const f32x4*)(gp + 8 * fq + 4) * qs, g10 = *(const f32x4*)(gp + 32 + 8 * fq) * qs, g11 = *(const f32x4*)(gp + 32 + 8 * fq + 4) * qs;
    const int cbase = 256 * half + 64 * wc + 8 * fq;
    const float* sp = P.ssq1 + (size_t)rowb * 16; const unsigned sl = (unsigned)(fr * 16 + 4 * fq) * 4u;
    const bf16_t* qb = P.Q + (size_t)rowb * 512; const unsigned ql = (unsigned)(fr * 512 + cbase) * 2u;
    const float* ob = prm ? P.out + 35651584 + (size_t)rowb * 512 : P.out + 69214208 + (size_t)(rowb - 32768) * 512; const unsigned ol = (unsigned)(fr * 512 + cbase) * 4u;
    const unsigned il = (unsigned)((wc & 1) * 8192 + fq * 1024 + fr * 16);
#pragma unroll
    for (int ai = 0; ai < 2; ++ai) {
        const unsigned char* tbu = KIND == 1 ? tile_u(P, prm, rowb + ai * HALF, 2 * half + (wc >> 1)) : nullptr;
#pragma unroll
        for (int m = 0; m < 4; ++m) { constexpr int dummy = 0; (void)dummy; const int ro = ai * HALF + m * 16;
            const float rs = rstd_from_p(uoff<const f32x4>(sp + ro * 16, sl));
            const f32x4 &c00 = acc[ai][0][m][0], &c01 = acc[ai][0][m][1], &c10 = acc[ai][1][m][0], &c11 = acc[ai][1][m][1];
            const f32x4 q = c00 * c00 + c01 * c01 + c10 * c10 + c11 * c11;
            float ss = (q[0] + q[1]) + (q[2] + q[3]);
            ss += __shfl_xor(ss, 16); ss += __shfl_xor(ss, 32);
            const float rn = rs * __builtin_amdgcn_rsqf(ss * (rs * rs) * (1.0f / 64.0f) + 1e-6f);
            const f32x4 a0 = c00 * rn * g00, b0 = c01 * rn * g01, a1 = c10 * rn * g10, b1 = c11 * rn * g11;
            if (KIND == 0) { *uoff<u32x4>(qb + ro * 512, ql) = pack8(a0, b0); *uoff<u32x4>(qb + ro * 512, ql + 64u) = pack8(a1, b1); }
            else { const float* o = ob + ro * 512;
                __builtin_nontemporal_store(a0, uoff<f32x4>(o, ol)); __builtin_nontemporal_store(b0, uoff<f32x4>(o, ol + 16u)); __builtin_nontemporal_store(a1, uoff<f32x4>(o, ol + 128u)); __builtin_nontemporal_store(b1, uoff<f32x4>(o, ol + 144u));
                *uoff<u32x4>(tbu, il + m * 256u) = pack8(a0, b0); *uoff<u32x4>(tbu, il + m * 256u + 4096u) = pack8(a1, b1); }
            asm volatile("" ::: "memory"); }
    }
}
template <int KIND> __device__ __forceinline__ void win_plain(const EpiWinPtrs P, const f32x4 (&acc)[2][2][4][2], const Unit& u, int wr, int wc, int fr, int fq) {
    const int rowb = u.pm * BM + wr * 64, half = u.pn & 1; const bool prm = u.pm < 128;
    const int cbase = 256 * half + 32 * wc + 8 * fq;
    const float* sp = P.ssq1 + (size_t)rowb * 16; const unsigned sl = (unsigned)(fr * 16 + 4 * fq) * 4u;
    const bf16_t* db = (KIND == 3 ? P.XR : P.XG) + (size_t)rowb * 512; const unsigned dl = (unsigned)(fr * 512 + cbase) * 2u;
    const float* ob = prm ? P.out + 52428800 + (size_t)rowb * 512 : P.out + 70262784 + (size_t)(rowb - 32768) * 512; const unsigned ol = (unsigned)(fr * 512 + cbase) * 4u;
    const unsigned il = (unsigned)(16384 + wc * 4096 + fr * 64 + fq * 16);
#pragma unroll
    for (int ai = 0; ai < 2; ++ai) {
        const unsigned char* tb0 = KIND == 2 ? tile_u(P, prm, rowb + ai * HALF, 2 * half) : nullptr;
        const size_t hstride = prm ? (size_t)128 * 32768 : (size_t)32768;
        const bool tailblk = KIND == 3 && (prm ? ((rowb + ai * HALF) & 8191) == 8128 : true);
#pragma unroll
        for (int m = 0; m < 4; ++m) { const int ro = ai * HALF + m * 16;
            const float rs = rstd_from_p(uoff<const f32x4>(sp + ro * 16, sl));
#pragma unroll
            for (int bj = 0; bj < 2; ++bj) { const f32x4 a = acc[ai][bj][m][0] * rs, b = acc[ai][bj][m][1] * rs;
                if (KIND == 2) { *uoff<u32x4>(tb0 + bj * hstride, il + m * 1024u) = pack8(a, b);
                    const float* o = ob + ro * 512 + 128 * bj; __builtin_nontemporal_store(a, uoff<f32x4>(o, ol)); __builtin_nontemporal_store(b, uoff<f32x4>(o, ol + 16u)); }
                else *uoff<u32x4>(db + ro * 512 + 128 * bj, dl) = pack8(a, b);
                if (KIND == 3 && m == 3) { if (tailblk && fr >= 13) { const int row = rowb + ro + fr;
                    float* o = (prm ? P.out + 69208064 + (size_t)((row >> 13) * 3 + ((row & 8191) - 8189)) * 512 : P.out + 71327744 + (size_t)(((row - 32768) >> 6) * 3 + (((row - 32768) & 63) - 61)) * 512) + cbase + 128 * bj;
                    *(f32x4*)o = a; *(f32x4*)(o + 4) = b; } } }
            asm volatile("" ::: "memory"); }
    }
}
struct EpiWin {
    static constexpr bool PERM = true, AFTER_DRAIN = false, TWICE_OK = (EPI_TWICE == 2);
    unsigned char* wsb; float* out; const float *gq, *gk;
    __device__ __forceinline__ void operator()(const f32x4 (&acc)[2][2][4][2], const Unit& u, int wr, int wc, int fr, int fq) const {
        unsigned char* w = wsb; asm volatile("" : "+s"(w));
        const EpiWinPtrs P{(const float*)(w + OFF_SSQ1), (bf16_t*)((unsigned char*)out + OB_Q), w + OFF_KVP, w + OFF_KVS, (bf16_t*)((unsigned char*)out + OB_XR), (bf16_t*)((unsigned char*)out + OB_XG), out, gq, gk};
        const int kind = u.pn >> 1;
        if (kind == 0) win_qk<0>(P, acc, u, wr, wc, fr, fq);
        else if (kind == 1) win_qk<1>(P, acc, u, wr, wc, fr, fq);
        else if (kind == 2) win_plain<2>(P, acc, u, wr, wc, fr, fq);
        else if (kind == 3) win_plain<3>(P, acc, u, wr, wc, fr, fq);
        else win_plain<4>(P, acc, u, wr, wc, fr, fq);
    }
};
template <class Epi, class Sched, bool ALIGN_EPI = false, bool SP2 = false>
__device__ __forceinline__ void gemm_phase(PG8_LAS unsigned char* lds, const Gemm g, const Sched& S, const Epi& E, int tid_in) {
    int tid_ = threadIdx.x; (void)tid_in; asm volatile("" : "+v"(tid_));
    const int tid = tid_, wid = __builtin_amdgcn_readfirstlane(tid >> 6), lane = tid & 63, wr = wid >> 2, wc = wid & 3, fr = lane & 15, fq = lane >> 4;
    const int K = g.K;
    unsigned voffA[2], voffB[2];
#pragma unroll
    for (int i = 0; i < 2; ++i) { int R, C; stage_rc(tid * 16 + i * 8192, R, C); const int Rb = Epi::PERM ? ((R & ~31) + perm32(R & 31)) : R;
        voffA[i] = (unsigned)(R * K + C) * 2u; voffB[i] = (unsigned)(Rb * K + C) * 2u; }
    const size_t kstep = (size_t)(BK * 2);
    const size_t hstep = (size_t)HALF * K * 2;
    const size_t tstep = 2 * hstep;
    const unsigned ldsw = (unsigned)wid * 1024u;
    const int aoff = lds_byte(wr * 64 + fr, fq * 8), boff = lds_byte(wc * 32 + fr, fq * 8);
#define PG8_SA(b, h) (((b) * 2 + (h)) * HTB)
#define PG8_SB(b, h) ((4 + (b) * 2 + (h)) * HTB)
#define PG8_STAGE(bufoff, gbase, voff) do { _Pragma("unroll") for (int _i = 0; _i < 2; ++_i) \
        __builtin_amdgcn_global_load_lds((const unsigned*)((const char*)(gbase) + (voff)[_i]), (PG8_LAS unsigned*)(lds + (bufoff) + ldsw + _i * 8192), 16, 0, 0); } while (0)
#define PG8_LDA(dst, b, h) do { _Pragma("unroll") for (int m = 0; m < 4; ++m) _Pragma("unroll") for (int k = 0; k < 2; ++k) dst[m][k] = *(const PG8_LAS bf16x8*)(lds + PG8_SA(b, h) + aoff + m * 2048 + k * 1024); } while (0)
#define PG8_LDB(dst, b, h) do { _Pragma("unroll") for (int n = 0; n < 2; ++n) _Pragma("unroll") for (int k = 0; k < 2; ++k) dst[n][k] = *(const PG8_LAS bf16x8*)(lds + PG8_SB(b, h) + boff + n * 2048 + k * 1024); } while (0)
#define PG8_MMA(ai, bj, At, Bt) do { __builtin_amdgcn_s_setprio(1); _Pragma("unroll") for (int m = 0; m < 4; ++m) _Pragma("unroll") for (int n = 0; n < 2; ++n) _Pragma("unroll") for (int k = 0; k < 2; ++k) \
        acc[ai][bj][m][n] = __builtin_amdgcn_mfma_f32_16x16x32_bf16(Bt[n][k], At[m][k], acc[ai][bj][m][n], 0, 0, 0); __builtin_amdgcn_s_setprio(0); } while (0)
#define PG8_WAIT_V(n) asm volatile("s_waitcnt vmcnt(" #n ")" ::: "memory")
#define PG8_WAIT_L(n) asm volatile("s_waitcnt lgkmcnt(" #n ")" ::: "memory")
#define PG8_BAR __builtin_amdgcn_s_barrier()
#define PG8_SCHED __builtin_amdgcn_sched_barrier(0)
    Unit cur, nxt; int ui = 0;
    if (!S.next(0, cur)) return;
    f32x4 acc[2][2][4][2];
#pragma unroll
    for (int a = 0; a < 2; ++a)
#pragma unroll
        for (int b = 0; b < 2; ++b)
#pragma unroll
            for (int m = 0; m < 4; ++m)
#pragma unroll
                for (int n = 0; n < 2; ++n) acc[a][b][m][n] = (f32x4){0.f, 0.f, 0.f, 0.f};
    bf16x8 At[4][2], B0[2][2], B1[2][2];
    const char* cA = (const char*)g.A + (size_t)cur.pm * tstep + (Sched::SPLIT ? (size_t)cur.kt0 * kstep : (size_t)0); const char* cB = (const char*)g.Bt + (size_t)cur.pn * tstep + (Sched::SPLIT ? (size_t)cur.kt0 * kstep : (size_t)0);
    S.a_ready(cur, S.poll(cur));
    unsigned pv = 0u;
    if constexpr (SP2) {
        PG8_STAGE(PG8_SB(0, 0), cB, voffB); PG8_STAGE(PG8_SB(0, 1), cB + hstep, voffB); PG8_STAGE(PG8_SA(0, 0), cA, voffA); PG8_STAGE(PG8_SA(0, 1), cA + hstep, voffA);
        if (wr == 1) PG8_BAR;
        PG8_WAIT_V(2); PG8_BAR;
        PG8_STAGE(PG8_SB(1, 0), cB + kstep, voffB); PG8_STAGE(PG8_SA(1, 0), cA + kstep, voffA); PG8_STAGE(PG8_SB(1, 1), cB + hstep + kstep, voffB);
        PG8_WAIT_V(6); PG8_BAR;
    } else {
        PG8_STAGE(PG8_SB(0, 0), cB, voffB); PG8_STAGE(PG8_SA(0, 0), cA, voffA); PG8_STAGE(PG8_SB(0, 1), cB + hstep, voffB); PG8_STAGE(PG8_SA(0, 1), cA + hstep, voffA);
        if (wr == 1) PG8_BAR;
        PG8_WAIT_V(4); PG8_BAR;
        PG8_STAGE(PG8_SB(1, 0), cB + kstep, voffB); PG8_STAGE(PG8_SA(1, 0), cA + kstep, voffA); PG8_STAGE(PG8_SB(1, 1), cB + hstep + kstep, voffB);
        PG8_WAIT_V(6); PG8_BAR;
    }
    for (;;) {
        const bool has_next = S.next(ui + 1, nxt);
        const char* nA = has_next ? (const char*)g.A + (size_t)nxt.pm * tstep + (Sched::SPLIT ? (size_t)nxt.kt0 * kstep : (size_t)0) : cA; const char* nB = has_next ? (const char*)g.Bt + (size_t)nxt.pn * tstep + (Sched::SPLIT ? (size_t)nxt.kt0 * kstep : (size_t)0) : cB;
        const int nt = Sched::SPLIT ? cur.nkt : K / BK;
        for (int t = 0; t < nt; t += 2) {
            const bool last = (t == nt - 2);
            const char* a1 = cA + (size_t)(t + 1) * kstep;
            const char* a2 = last ? nA : cA + (size_t)(t + 2) * kstep; const char* b2 = last ? nB : cB + (size_t)(t + 2) * kstep;
            const char* a3 = a2 + kstep; const char* b3 = b2 + kstep;
            if constexpr ((Sched::DEPF & 1) != 0) { if (has_next && t == nt - 4) pv = S.poll(nxt); }
            if (last && has_next) { S.a_ready(nxt, pv); pv = 0u; }
            if constexpr (SP2) {
            PG8_LDB(B0, 0, 0); PG8_LDB(B1, 0, 1); PG8_SCHED; PG8_LDA(At, 0, 0); PG8_STAGE(PG8_SA(1, 1), a1 + hstep, voffA);
            PG8_WAIT_V(8); PG8_WAIT_L(0); PG8_BAR; PG8_MMA(0, 0, At, B0); PG8_MMA(0, 1, At, B1); PG8_BAR; PG8_SCHED;
            PG8_LDA(At, 0, 1); PG8_STAGE(PG8_SB(0, 0), b2, voffB); PG8_STAGE(PG8_SB(0, 1), b2 + hstep, voffB); PG8_STAGE(PG8_SA(0, 0), a2, voffA);
            PG8_WAIT_V(8); PG8_WAIT_L(0); PG8_BAR; PG8_MMA(1, 0, At, B0); PG8_MMA(1, 1, At, B1); PG8_BAR; PG8_SCHED;
            PG8_LDB(B0, 1, 0); PG8_LDB(B1, 1, 1); PG8_SCHED; PG8_LDA(At, 1, 0); PG8_STAGE(PG8_SA(0, 1), a2 + hstep, voffA);
            PG8_WAIT_V(8); PG8_WAIT_L(0); PG8_BAR; PG8_MMA(0, 0, At, B0); PG8_MMA(0, 1, At, B1); PG8_BAR; PG8_SCHED;
            PG8_LDA(At, 1, 1); PG8_STAGE(PG8_SB(1, 0), b3, voffB); PG8_STAGE(PG8_SB(1, 1), b3 + hstep, voffB); PG8_STAGE(PG8_SA(1, 0), a3, voffA);
            PG8_WAIT_V(8); PG8_WAIT_L(0); PG8_BAR; PG8_MMA(1, 0, At, B0); PG8_MMA(1, 1, At, B1); PG8_BAR; PG8_SCHED;
            } else {
            PG8_LDB(B0, 0, 0); PG8_SCHED; PG8_LDA(At, 0, 0); PG8_STAGE(PG8_SA(1, 1), a1 + hstep, voffA);
            PG8_WAIT_L(8); PG8_BAR; PG8_WAIT_L(0); PG8_MMA(0, 0, At, B0); PG8_BAR; PG8_SCHED;
            PG8_LDB(B1, 0, 1); PG8_STAGE(PG8_SB(0, 0), b2, voffB);
            PG8_BAR; PG8_WAIT_L(0); PG8_MMA(0, 1, At, B1); PG8_BAR;
            PG8_LDA(At, 0, 1); PG8_STAGE(PG8_SA(0, 0), a2, voffA);
            PG8_BAR; PG8_WAIT_L(0); PG8_MMA(1, 0, At, B0); PG8_BAR; PG8_SCHED;
            PG8_STAGE(PG8_SB(0, 1), b2 + hstep, voffB);
            PG8_WAIT_V(6); PG8_BAR; PG8_MMA(1, 1, At, B1); PG8_BAR;
            PG8_LDB(B0, 1, 0); PG8_SCHED; PG8_LDA(At, 1, 0); PG8_STAGE(PG8_SA(0, 1), a2 + hstep, voffA);
            PG8_WAIT_L(8); PG8_BAR; PG8_WAIT_L(0); PG8_MMA(0, 0, At, B0); PG8_BAR; PG8_SCHED;
            PG8_LDB(B1, 1, 1); PG8_STAGE(PG8_SB(1, 0), b3, voffB);
            PG8_BAR; PG8_WAIT_L(0); PG8_MMA(0, 1, At, B1); PG8_BAR;
            PG8_LDA(At, 1, 1); PG8_STAGE(PG8_SA(1, 0), a3, voffA);
            PG8_BAR; PG8_WAIT_L(0); PG8_MMA(1, 0, At, B0); PG8_BAR; PG8_SCHED;
            PG8_STAGE(PG8_SB(1, 1), b3 + hstep, voffB);
            PG8_WAIT_V(6); PG8_BAR; PG8_MMA(1, 1, At, B1); PG8_BAR;
            }
        }
        if constexpr (ALIGN_EPI) { if (wr == 0) PG8_BAR; }
        if constexpr (!Epi::AFTER_DRAIN) { if (Sched::SPLIT && cur.kind == 1) S.put_partial(acc, tid, lane); else { E(acc, cur, wr, wc, fr, fq);
#if EPI_TWICE
            if (Epi::TWICE_OK) { asm volatile("" ::: "memory"); E(acc, cur, wr, wc, fr, fq); }
#endif
            } S.done(cur); }
        if (!has_next) break;
        if (Sched::SPLIT && nxt.kind == 2) S.load_partial(acc, tid, lane);
        else {
#pragma unroll
        for (int a = 0; a < 2; ++a)
#pragma unroll
            for (int b = 0; b < 2; ++b)
#pragma unroll
                for (int m = 0; m < 4; ++m)
#pragma unroll
                    for (int n = 0; n < 2; ++n) acc[a][b][m][n] = (f32x4){0.f, 0.f, 0.f, 0.f};
        }
        cur = nxt; cA = nA; cB = nB; ++ui;
        if constexpr (ALIGN_EPI) { if (wr == 1) PG8_BAR; }
    }
    PG8_WAIT_V(0);
    if constexpr (!ALIGN_EPI) { if (wr == 0) PG8_BAR; }
    PG8_BAR;
    if constexpr (Epi::AFTER_DRAIN) { E.fused(acc, cur, wr, wc, fr, fq, lds, wid, lane); S.done(cur); }
#undef PG8_SA
#undef PG8_SB
#undef PG8_STAGE
#undef PG8_LDA
#undef PG8_LDB
#undef PG8_MMA
#undef PG8_WAIT_V
#undef PG8_WAIT_L
#undef PG8_BAR
#undef PG8_SCHED
}
}

constexpr size_t MiB = 1u << 20;
constexpr size_t WS_CTL = 0, CTL_ZERO_BYTES = 64 * 1024;
constexpr size_t WS_W1GU = 1 * MiB, WS_W1D = 12 * MiB, WS_W2GU = 18 * MiB, WS_W2D = 29 * MiB, WS_WIN = 35 * MiB, WS_WOUT = 40 * MiB;
constexpr size_t WS_GATEW = 42 * MiB;
constexpr size_t WS_SP8 = WS_GATEW + 256 * 1024;
constexpr size_t WS_RSTD0 = 43 * MiB;
constexpr size_t WS_SSQ1 = 44 * MiB, WS_SSQ2 = 47 * MiB;
constexpr size_t WS_LSUM = 50 * MiB;
constexpr size_t WS_XB = 53 * MiB;
constexpr size_t WS_XB1 = 444 * MiB;
constexpr size_t WS_H = 121 * MiB;
constexpr size_t WS_KVP = 376 * MiB, WS_KVS = 440 * MiB;
constexpr size_t WS_CAT = 308 * MiB;
constexpr size_t WS_END = 512 * MiB;
static_assert(OFF_SSQ1 == WS_SSQ1 && OFF_KVP == WS_KVP && OFF_KVS == WS_KVS, "epilogue offsets");
static_assert(WS_H + (size_t)TT * FF * 2 <= WS_CAT && WS_XB + (size_t)TT * DM * 2 <= WS_H && OB_XG + (size_t)TT * 512 * 2 <= (size_t)TT * DM * 4, "d_ws map");
constexpr int CW_BAR = 1024;
constexpr int CW_SK = 12288;
constexpr int CW_QUEUE = 8192;
constexpr int CW_DEP = 4608;
constexpr int CW_CONVQ = 7936;
static_assert(CW_BAR + 3456 <= CW_DEP && CW_DEP + 6 * 136 * 4 <= CW_CONVQ && CW_CONVQ < CW_QUEUE, "control words");

constexpr int RING_BYTES = 131072;
constexpr int MISC_OFF = RING_BYTES;
constexpr int LDS_BYTES = 147456;

#define GAS __attribute__((address_space(1)))
#define LAS __attribute__((address_space(3)))
typedef unsigned short bf16;
typedef unsigned v4u __attribute__((ext_vector_type(4)));
typedef unsigned v2u __attribute__((ext_vector_type(2)));
typedef float f32x4 __attribute__((ext_vector_type(4)));
typedef float f32x16 __attribute__((ext_vector_type(16)));
typedef short bf16x8 __attribute__((ext_vector_type(8)));
typedef short s16x4 __attribute__((ext_vector_type(4)));
#define LDS_WAIT() asm volatile("s_waitcnt lgkmcnt(0)" ::: "memory")
#define VM_WAIT() asm volatile("s_waitcnt vmcnt(0)" ::: "memory")
__device__ __forceinline__ unsigned f2bf(float f) { unsigned u = __builtin_bit_cast(unsigned, f); return (u + 0x7fffu + ((u >> 16) & 1u)) >> 16; }
__device__ __forceinline__ unsigned pk2(float lo, float hi) { return f2bf(lo) | (f2bf(hi) << 16); }
__device__ __forceinline__ float bf2f(unsigned short b) { return __builtin_bit_cast(float, (unsigned)b << 16); }
__device__ __forceinline__ float bflo(unsigned w) { return __builtin_bit_cast(float, w << 16); }
__device__ __forceinline__ float bfhi(unsigned w) { return __builtin_bit_cast(float, w & 0xffff0000u); }
__device__ __forceinline__ int lane_id() { return (int)__builtin_amdgcn_mbcnt_hi(~0u, __builtin_amdgcn_mbcnt_lo(~0u, 0u)); }
__device__ __forceinline__ float wave_sum(float v) {
#pragma unroll
    for (int o = 1; o < 64; o <<= 1) v += __shfl_xor(v, o);
    return v;
}

#define XB_TMO      128
#define XB_XCNT(j)  (256  + 64 * (j))
#define XB_XSUB(j)  (1280 + 64 * (j))
#define XB_XGEN(j)  (2304 + 64 * (j))
#define XB_TOP      3328
#define XB_TOPGEN   3392
#define XCD_BAR_WORDS 3456
#define XB_SPIN_CAP (1u << 18)

__device__ __forceinline__ unsigned xb_ld(unsigned* p)              { return __hip_atomic_load(p, __ATOMIC_RELAXED, __HIP_MEMORY_SCOPE_AGENT); }
__device__ __forceinline__ unsigned xb_add(unsigned* p, unsigned v) { return __hip_atomic_fetch_add(p, v, __ATOMIC_RELAXED, __HIP_MEMORY_SCOPE_AGENT); }
__device__ __forceinline__ unsigned xb_xcc_id() { return (unsigned)__builtin_amdgcn_s_getreg((3 << 11) | 20) & 0xFu; }
#define XB_SPIN(cond, bar) do { unsigned _sp = 0; while (cond) { __builtin_amdgcn_s_sleep(1); \
    if ((++_sp & 255u) == 0u) { if (xb_ld(&(bar)[XB_TMO])) break; if (_sp > XB_SPIN_CAP) { atomicAdd(&(bar)[XB_TMO], 1u); break; } } } } while (0)

struct XcdBarrier {
    unsigned* bar; unsigned x; int wv;
    volatile LAS unsigned* st;
};

__device__ __forceinline__ XcdBarrier xcd_barrier_post(unsigned* bar, volatile LAS unsigned* st, int wv) {
    XcdBarrier b; b.bar = bar; b.x = xb_xcc_id(); b.st = st; b.wv = wv;
    if (threadIdx.x == 0) (void)xb_add(&bar[XB_XCNT(b.x)], 1u);
    return b;
}
__device__ __forceinline__ void xcd_barrier_complete(unsigned* bar, unsigned x, unsigned& nloc, unsigned& nx) {
    const unsigned G = gridDim.x * gridDim.y * gridDim.z;
    unsigned sum, cnt, mine, sp = 0u;
    for (;;) {
        sum = 0u; cnt = 0u; mine = 0u;
#pragma unroll
        for (unsigned j = 0; j < 16; ++j) { const unsigned c = xb_ld(&bar[XB_XCNT(j)]); sum += c; cnt += (c > 0u) ? 1u : 0u; mine = (j == x) ? c : mine; }
        if (sum == G) break;
        __builtin_amdgcn_s_sleep(1);
        if ((++sp & 255u) == 0u) { if (xb_ld(&bar[XB_TMO])) break; if (sp > XB_SPIN_CAP) { atomicAdd(&bar[XB_TMO], 1u); break; } }
    }
    nloc = mine > 0u ? mine : 1u; nx = cnt > 0u ? cnt : 1u;
}

__device__ __forceinline__ void xcd_barrier(const XcdBarrier& b) {
    asm volatile("s_waitcnt vmcnt(0)" ::: "memory");
    __syncthreads();
    if (threadIdx.x == 0) {
        unsigned* bar = b.bar;
        __builtin_amdgcn_s_waitcnt(0);
        unsigned nloc = b.st[0], nx = b.st[1];
        if (nloc == 0u) { xcd_barrier_complete(bar, b.x, nloc, nx); b.st[0] = nloc; b.st[1] = nx; }
        const unsigned old = xb_add(&bar[XB_XSUB(b.x)], 1u);
        const unsigned gen = old / nloc;
        if (old + 1u == (gen + 1u) * nloc) {
            __builtin_amdgcn_fence(__ATOMIC_RELEASE, "agent");
            asm volatile("s_waitcnt vmcnt(0)" ::: "memory");
            const unsigned og = xb_add(&bar[XB_TOP], 1u);
            const unsigned tg = og / nx;
            if (og + 1u == (tg + 1u) * nx) xb_add(&bar[XB_TOPGEN], 1u);
            else XB_SPIN(xb_ld(&bar[XB_TOPGEN]) == tg, bar);
            __builtin_amdgcn_fence(__ATOMIC_ACQUIRE, "agent");
            xb_add(&bar[XB_XGEN(b.x)], 1u);
            asm volatile("s_waitcnt vmcnt(0)" ::: "memory");
        } else {
            XB_SPIN(xb_ld(&bar[XB_XGEN(b.x)]) == gen, bar);
            __builtin_amdgcn_fence(__ATOMIC_ACQUIRE, "agent");
            asm volatile("s_waitcnt vmcnt(0)" ::: "memory");
        }
    }
    __syncthreads();
}

typedef __attribute__((address_space(4))) const unsigned char* kptr_t;
struct Frame {
    LAS unsigned char* lds;
    int tid, lane, wave, G, bx;
    kptr_t ka; int z;
    float* out; unsigned char* ws;
};
__device__ __forceinline__ const float* fin(const Frame& F, int k) { typedef const float* cfp; return *(const __attribute__((address_space(4))) cfp*)(F.ka + (k * 8 + F.z)); }
#define NEW_PHASE() do { int z_ = 0; asm volatile("" : "+s"(z_)); F.z = z_; } while (0)

__device__ __forceinline__ void p0_transpose_item(const float* W, int K, int N, bf16* WT, int kb, int n0, int drow0, const float* gain, LAS float* scr, int lane) {
    const int k0 = 64 * kb;
#pragma unroll 8
    for (int i = 0; i < 32; ++i) { const int kk = 2 * i + (lane >> 5); float w = __builtin_nontemporal_load(&W[(size_t)(k0 + kk) * N + n0 + (lane & 31)]); if (gain) w *= gain[k0 + kk]; scr[kk * 33 + (lane & 31)] = w; }
    LDS_WAIT(); asm volatile("" ::: "memory");
    const int c = lane & 7;
#pragma unroll
    for (int j = 0; j < 4; ++j) { const int n = (lane >> 3) + 8 * j; const LAS float* s = scr + (8 * c) * 33 + n;
        v4u o; o.x = pk2(s[0 * 33], s[1 * 33]); o.y = pk2(s[2 * 33], s[3 * 33]); o.z = pk2(s[4 * 33], s[5 * 33]); o.w = pk2(s[6 * 33], s[7 * 33]);
        *(GAS v4u*)(WT + (size_t)(drow0 + n) * K + k0 + 8 * c) = o; }
    LDS_WAIT(); asm volatile("" ::: "memory");
}
constexpr int I_GU = 16 * 88, I_DN = 44 * 32, I_IN = 16 * 80, I_OUT = 16 * 32, I_FFN = 2 * I_GU + I_DN, NITEMS = 2 * I_FFN + I_IN + I_OUT;
__device__ __forceinline__ void weight_item(Frame& F, int it, LAS float* scr) {
    unsigned char* ws = F.ws; int r = it;
    if (r < 2 * I_FFN) {
        const int f = r >= I_FFN; r -= f * I_FFN;
        const float* Wg = f == 0 ? fin(F, 8) : fin(F, 30); const float* Wu = f == 0 ? fin(F, 9) : fin(F, 31); const float* Wd = f == 0 ? fin(F, 10) : fin(F, 32); const float* gn = f == 0 ? fin(F, 7) : fin(F, 29);
        bf16* GU = (bf16*)(ws + (f == 0 ? WS_W1GU : WS_W2GU)); bf16* DN = (bf16*)(ws + (f == 0 ? WS_W1D : WS_W2D));
        if (r < 2 * I_GU) { const int up = r >= I_GU; const int q = up ? r - I_GU : r; const int kb = q / 88, nb = q % 88, n0 = 32 * nb;
            p0_transpose_item(up ? Wu : Wg, 1024, FF, GU, kb, n0, 256 * (n0 >> 7) + (n0 & 127) + (up ? 128 : 0), gn, scr, F.lane); }
        else { r -= 2 * I_GU; const int kb = r / 32, nb = r % 32; p0_transpose_item(Wd, FF, 1024, DN, kb, 32 * nb, 32 * nb, nullptr, scr, F.lane); }
        return;
    }
    r -= 2 * I_FFN;
    if (r < I_IN) { const int kb = r / 80, nb = r % 80, n0 = 32 * nb; int dr = n0;
        if (n0 < 1024) { const int oc = n0 & 255, wc = oc >> 6, bj = (oc >> 5) & 1; dr = (n0 & ~255) + 128 * bj + 32 * wc; }
        p0_transpose_item(fin(F, 12), 1024, INW, (bf16*)(ws + WS_WIN), kb, n0, dr, fin(F, 11), scr, F.lane); return; }
    r -= I_IN;
    { const int kb = r / 32, nb = r % 32; p0_transpose_item(fin(F, 28), 1024, 1024, (bf16*)(ws + WS_WOUT), kb, 32 * nb, 32 * nb, nullptr, scr, F.lane); }
}
__device__ __forceinline__ void convert_queue(Frame& F, unsigned* head, LAS int* qi) {
    LAS float* scr = (LAS float*)(F.lds + F.wave * 16384);
    for (;;) {
        if (F.tid == 0) *qi = (int)atomicAdd(head, 1u);
        __syncthreads();
        const int k = *qi * 8 + F.wave;
        __syncthreads();
        if (k - F.wave >= I_FFN + I_OUT) break;
        if (k < I_FFN + I_OUT) weight_item(F, k < I_FFN ? I_FFN + k : 2 * I_FFN + I_IN + (k - I_FFN), scr);
    }
}
__device__ __forceinline__ void kv_expand_in_tail(Frame& F, int nunits) {
    const int W = F.G / 8, q = nunits / 8, rl = (q + W - 1) / W - 1, busy = q - rl * W, w = F.bx / 8, x = F.bx % 8;
    int bidx, nblk;
    if (busy < W) { if (w < busy) return; bidx = (w - busy) * 8 + x; nblk = (W - busy) * 8; } else { bidx = F.bx; nblk = F.G; }
    const int lane = F.lane, wv = F.wave;
    for (int tl = bidx; tl < 2048 + 128; tl += nblk) {
        const unsigned char* img; float* ok; float* ov;
        if (tl < 2048) { const int bh = tl >> 7, t = tl & 127, b = bh >> 2, h = bh & 3; img = F.ws + WS_KVP + (size_t)tl * 32768;
            ok = F.out + O_KP + ((size_t)(b * SEQ + t * 64)) * 512 + h * 128; ov = F.out + O_VP + ((size_t)(b * SEQ + t * 64)) * 512 + h * 128; }
        else { const int u = tl - 2048, sb = u >> 2, h = u & 3; img = F.ws + WS_KVS + (size_t)u * 32768;
            ok = F.out + O_KS + ((size_t)(sb * 64)) * 512 + h * 128; ov = F.out + O_VS + ((size_t)(sb * 64)) * 512 + h * 128; }
#pragma unroll
        for (int r = 0; r < 2; ++r) {
            const int key = 8 * wv + 4 * r + (lane >> 4), cj = lane & 15;
            const v4u kw = *(const GAS v4u*)(img + (cj >> 3) * 8192 + (cj & 7) * 1024 + key * 16);
            const v4u vw = *(const GAS v4u*)(img + 16384 + (cj >> 2) * 4096 + key * 64 + (cj & 3) * 16);
            float* dk = ok + (size_t)key * 512 + cj * 8; float* dv = ov + (size_t)key * 512 + cj * 8;
            *(f32x4*)dk = (f32x4){bflo(kw.x), bfhi(kw.x), bflo(kw.y), bfhi(kw.y)}; *(f32x4*)(dk + 4) = (f32x4){bflo(kw.z), bfhi(kw.z), bflo(kw.w), bfhi(kw.w)};
            *(f32x4*)dv = (f32x4){bflo(vw.x), bfhi(vw.x), bflo(vw.y), bfhi(vw.y)}; *(f32x4*)(dv + 4) = (f32x4){bflo(vw.z), bfhi(vw.z), bflo(vw.w), bfhi(vw.w)};
        }
    }
}
__device__ __forceinline__ void p0_prologue(Frame& F) {
    LAS float* scr = (LAS float*)(F.lds + F.wave * 16384);
    const int gw = F.bx * 8 + F.wave, NGW = F.G * 8;
    unsigned char* ws = F.ws;
    for (int it = gw; it < I_FFN + I_IN; it += NGW) weight_item(F, it < I_FFN ? it : 2 * I_FFN + (it - I_FFN), scr);
    {   bf16* XB = (bf16*)(ws + WS_XB); float* rstd0 = (float*)(ws + WS_RSTD0);
        for (int m0 = gw; m0 < TT; m0 += 4 * NGW) {
            f32x4 v[4][4]; float s[4];
#pragma unroll
            for (int u = 0; u < 4; ++u) { const int m = m0 + u * NGW; s[u] = 0.f;
                if (m < TT) { const float* xrow = m < TP ? fin(F, 0) + (size_t)m * DM : fin(F, 1) + (size_t)(m - TP) * DM; const GAS f32x4* xr = (const GAS f32x4*)xrow + 2 * F.lane;
                    v[u][0] = __builtin_nontemporal_load(xr); v[u][1] = __builtin_nontemporal_load(xr + 1); v[u][2] = __builtin_nontemporal_load(xr + 128); v[u][3] = __builtin_nontemporal_load(xr + 129); } }
#pragma unroll
            for (int u = 0; u < 4; ++u) { const int m = m0 + u * NGW;
                if (m < TT) {
#pragma unroll
                    for (int j = 0; j < 4; ++j) s[u] += (v[u][j].x * v[u][j].x + v[u][j].y * v[u][j].y) + (v[u][j].z * v[u][j].z + v[u][j].w * v[u][j].w);
                    s[u] = wave_sum(s[u]);
                    if (F.lane == 0) rstd0[m] = __builtin_amdgcn_rsqf(s[u] * (1.0f / DM) + EPS);
                    GAS v4u* o16 = (GAS v4u*)(XB + (size_t)m * DM) + F.lane;
                    v4u w0, w1; w0.x = pk2(v[u][0].x, v[u][0].y); w0.y = pk2(v[u][0].z, v[u][0].w); w0.z = pk2(v[u][1].x, v[u][1].y); w0.w = pk2(v[u][1].z, v[u][1].w);
                    w1.x = pk2(v[u][2].x, v[u][2].y); w1.y = pk2(v[u][2].z, v[u][2].w); w1.z = pk2(v[u][3].x, v[u][3].y); w1.w = pk2(v[u][3].z, v[u][3].w);
                    o16[0] = w0; o16[64] = w1; } }
        }
    }
    {   bf16* GW = (bf16*)(ws + WS_GATEW); float* sp8 = (float*)(ws + WS_SP8);
        const int gt = F.bx * 512 + F.tid, NT = F.G * 512;
        for (int i = gt; i < 2 * 8 * 64 * 64; i += NT) { const int g = i >> 15, n = (i >> 12) & 7, j = (i >> 6) & 63, c = i & 63;
            GW[i] = (bf16)f2bf(-LOG2E * (g == 0 ? fin(F, 22) : fin(F, 24))[(n * 64 + c) * 64 + j]); }
        for (int i = gt; i < 512; i += NT) { const float L = fin(F, 26)[i]; sp8[i] = -LOG2E * 8.0f * (L > 20.f ? __expf(-L) : log1pf(__expf(-L))); }
    }
}

namespace lru {
constexpr int L_XC = 0;
constexpr int L_HIN = 65536;
constexpr int L_PART = 65536 + 2048;
constexpr int L_PAR = 135168;
constexpr int L_O0 = 65536 + 4096;
__device__ __forceinline__ int crow(int r, int hi) { return (r & 3) + 8 * (r >> 2) + 4 * hi; }
__device__ __forceinline__ float sigmoid_f(float x) { return __builtin_amdgcn_rcpf(1.0f + __builtin_amdgcn_exp2f(-x * LOG2E)); }

template <int CTRL, int RM> __device__ __forceinline__ float dpp_f(float oldv, float src) {
    return __builtin_bit_cast(float, __builtin_amdgcn_update_dpp(__builtin_bit_cast(int, oldv), __builtin_bit_cast(int, src), CTRL, RM, 0xF, false)); }
#define LRU_SCAN4_STEP(C) \
    "v_fmac_f32_dpp %1, %1, %0 " C "\n\tv_fmac_f32_dpp %3, %3, %2 " C "\n\tv_fmac_f32_dpp %5, %5, %4 " C "\n\tv_fmac_f32_dpp %7, %7, %6 " C "\n\t" \
    "v_mul_f32_dpp %0, %0, %0 " C "\n\tv_mul_f32_dpp %2, %2, %2 " C "\n\tv_mul_f32_dpp %4, %4, %4 " C "\n\tv_mul_f32_dpp %6, %6, %6 " C "\n\t"
#define LRU_SCAN4(a0, b0, a1, b1, a2, b2, a3, b3) asm volatile("s_nop 1\n\t" \
    LRU_SCAN4_STEP("row_shr:1 row_mask:0xf bank_mask:0xf") LRU_SCAN4_STEP("row_shr:2 row_mask:0xf bank_mask:0xf") LRU_SCAN4_STEP("row_shr:4 row_mask:0xf bank_mask:0xf") \
    LRU_SCAN4_STEP("row_shr:8 row_mask:0xf bank_mask:0xf") LRU_SCAN4_STEP("row_bcast:15 row_mask:0xa bank_mask:0xf") \
    : "+v"(a0), "+v"(b0), "+v"(a1), "+v"(b1), "+v"(a2), "+v"(b2), "+v"(a3), "+v"(b3))
#define LRU_SCAN_STEP(CTRL, RM) do { const float ap_ = dpp_f<CTRL, RM>(1.0f, a), bp_ = dpp_f<CTRL, RM>(0.0f, b); b = a * bp_ + b; a = a * ap_; } while (0)
__device__ __forceinline__ float rl_half(float v, int hi) {
    return __builtin_bit_cast(float, __builtin_amdgcn_ds_bpermute((hi * 32 + 31) * 4, __builtin_bit_cast(int, v))); }
template <int PASS> __device__ __forceinline__ void lru_unit(Frame& F, int u) {
    int tid_ = F.tid; asm volatile("" : "+v"(tid_));
    const int tid = tid_, lane = tid & 63, wid = F.wave, r32 = lane & 31, hi = lane >> 5;
    const bool smp = u >= 512; const int sb = u - 512, pb = u >> 7, ck = smp ? 0 : (u & 127);
    const int row0 = smp ? TP + sb * 64 : pb * SEQ + ck * 64;
    const bf16* XR = (const bf16*)((const unsigned char*)F.out + OB_XR); const bf16* XG = (const bf16*)((const unsigned char*)F.out + OB_XG);
    LAS unsigned char* lds = F.lds;
    if (PASS == 2) {
        float h = 0.f;
        if (smp) h = fin(F, 4)[sb * 512 + tid];
        else { const float* S = (const float*)(F.ws + WS_LSUM) + ((size_t)(pb * 128) * 512 + tid) * 2;
            int c = 0;
            for (; c + 32 <= ck; c += 32) { float2 v[32];
#pragma unroll
                for (int k = 0; k < 32; ++k) v[k] = *(const float2*)(S + (size_t)(c + k) * 1024);
#pragma unroll
                for (int k = 0; k < 32; ++k) h = v[k].x * h + v[k].y; }
            for (; c + 8 <= ck; c += 8) { float2 v[8];
#pragma unroll
                for (int k = 0; k < 8; ++k) v[k] = *(const float2*)(S + (size_t)(c + k) * 1024);
#pragma unroll
                for (int k = 0; k < 8; ++k) h = v[k].x * h + v[k].y; }
            for (; c < ck; ++c) { const float2 v = *(const float2*)(S + (size_t)c * 1024); h = v.x * h + v.y; } }
        ((LAS float*)(lds + L_HIN))[tid] = h;
    }
    {   LAS float* par = (LAS float*)(lds + L_PAR);
        par[tid] = -LOG2E * fin(F, 23)[tid]; par[512 + tid] = -LOG2E * fin(F, 25)[tid]; par[1024 + tid] = ((const float*)(F.ws + WS_SP8))[tid]; if (PASS == 2) par[1536 + tid] = fin(F, 27)[tid]; }
    {   const int cg = tid & 63, tg = tid >> 6, c0 = 8 * cg;
        float xw[11][8];
#pragma unroll
        for (int i = 0; i < 11; ++i) { const int tt = 8 * tg + i - 3;
            if (tt >= 0 || ck > 0) { const v4u w = *(const GAS v4u*)(XR + (size_t)(row0 + tt) * 512 + c0);
                xw[i][0] = bflo(w.x); xw[i][1] = bfhi(w.x); xw[i][2] = bflo(w.y); xw[i][3] = bfhi(w.y); xw[i][4] = bflo(w.z); xw[i][5] = bfhi(w.z); xw[i][6] = bflo(w.w); xw[i][7] = bfhi(w.w); }
            else if (smp) { const float* sc = fin(F, 5) + (size_t)(sb * 3 + (tt + 3)) * 512 + c0; const f32x4 a = *(const f32x4*)sc, b = *(const f32x4*)(sc + 4);
                xw[i][0] = a[0]; xw[i][1] = a[1]; xw[i][2] = a[2]; xw[i][3] = a[3]; xw[i][4] = b[0]; xw[i][5] = b[1]; xw[i][6] = b[2]; xw[i][7] = b[3]; }
            else {
#pragma unroll
                for (int e = 0; e < 8; ++e) xw[i][e] = 0.f; } }
        float cw[4][8], cb[8];
#pragma unroll
        for (int j = 0; j < 4; ++j) { const f32x4 a = *(const f32x4*)(fin(F, 20) + j * 512 + c0), b = *(const f32x4*)(fin(F, 20) + j * 512 + c0 + 4);
            cw[j][0] = a[0]; cw[j][1] = a[1]; cw[j][2] = a[2]; cw[j][3] = a[3]; cw[j][4] = b[0]; cw[j][5] = b[1]; cw[j][6] = b[2]; cw[j][7] = b[3]; }
        { const f32x4 a = *(const f32x4*)(fin(F, 21) + c0), b = *(const f32x4*)(fin(F, 21) + c0 + 4); cb[0] = a[0]; cb[1] = a[1]; cb[2] = a[2]; cb[3] = a[3]; cb[4] = b[0]; cb[5] = b[1]; cb[6] = b[2]; cb[7] = b[3]; }
#pragma unroll
        for (int i = 0; i < 8; ++i) { const int t = 8 * tg + i; float xc[8];
#pragma unroll
            for (int e = 0; e < 8; ++e) xc[e] = cb[e] + cw[0][e] * xw[i][e] + cw[1][e] * xw[i + 1][e] + cw[2][e] * xw[i + 2][e] + cw[3][e] * xw[i + 3][e];
            v4u o; o.x = pk2(xc[0], xc[1]); o.y = pk2(xc[2], xc[3]); o.z = pk2(xc[4], xc[5]); o.w = pk2(xc[6], xc[7]);
            *(LAS v4u*)(lds + L_XC + t * 1024 + ((cg ^ (t & 15)) << 4)) = o; }
    }
    LDS_WAIT(); __syncthreads();
    const int n = wid;
    const bf16* GW = (const bf16*)(F.ws + WS_GATEW);
    float ssq_t[2] = {0.f, 0.f};
    float outv[2][16];
#pragma unroll
    for (int jb = 0; jb < 2; ++jb) {
        v2u gwv[4][2];
        if (PASS == 2) {
#pragma unroll
            for (int q4 = 0; q4 < 4; ++q4)
#pragma unroll
                for (int tb = 0; tb < 2; ++tb) gwv[q4][tb] = *(const GAS v2u*)(XG + (size_t)(row0 + tb * 32 + r32) * 512 + 64 * n + 32 * jb + 8 * q4 + 4 * hi); }
        f32x16 accr[2], acci[2];
#pragma unroll
        for (int tb = 0; tb < 2; ++tb) { accr[tb] = f32x16{}; acci[tb] = f32x16{}; }
#pragma unroll
        for (int ks = 0; ks < 4; ++ks) {
            const bf16x8 ar = *(const GAS bf16x8*)(GW + ((size_t)((0 * 8 + n) * 64 + jb * 32 + r32) * 64 + ks * 16 + hi * 8));
            const bf16x8 ax = *(const GAS bf16x8*)(GW + ((size_t)((1 * 8 + n) * 64 + jb * 32 + r32) * 64 + ks * 16 + hi * 8));
#pragma unroll
            for (int tb = 0; tb < 2; ++tb) { const int t = tb * 32 + r32; const int chunk = 8 * n + 2 * ks + hi;
                const bf16x8 bfr = *(const LAS bf16x8*)(lds + L_XC + t * 1024 + ((chunk ^ (t & 15)) << 4));
                accr[tb] = __builtin_amdgcn_mfma_f32_32x32x16_bf16(ar, bfr, accr[tb], 0, 0, 0);
                acci[tb] = __builtin_amdgcn_mfma_f32_32x32x16_bf16(ax, bfr, acci[tb], 0, 0, 0); }
        }
        float av[2][16], bv[2][16];
#pragma unroll
        for (int q4 = 0; q4 < 4; ++q4) {
            const int chb = 64 * n + 32 * jb + 8 * q4 + 4 * hi;
            const f32x4 ba = *(const LAS f32x4*)(lds + L_PAR + chb * 4), bx = *(const LAS f32x4*)(lds + L_PAR + 2048 + chb * 4), sp = *(const LAS f32x4*)(lds + L_PAR + 4096 + chb * 4);
#pragma unroll
            for (int tb = 0; tb < 2; ++tb) { const int t = tb * 32 + r32;
                const v2u xw = *(const LAS v2u*)(lds + L_XC + t * 1024 + ((((chb >> 3) ^ (t & 15)) << 4) | ((chb & 7) << 1)));
                const float xc[4] = {bflo(xw.x), bfhi(xw.x), bflo(xw.y), bfhi(xw.y)};
#pragma unroll
                for (int e = 0; e < 4; ++e) { const int r = 4 * q4 + e;
                    const float rg = __builtin_amdgcn_rcpf(1.0f + __builtin_amdgcn_exp2f(accr[tb][r] + ba[e])), ig = __builtin_amdgcn_rcpf(1.0f + __builtin_amdgcn_exp2f(acci[tb][r] + bx[e]));
                    const float a = __builtin_amdgcn_exp2f(rg * sp[e]);
                    av[tb][r] = a; bv[tb][r] = __builtin_amdgcn_sqrtf(__builtin_fmaf(-a, a, 1.0f)) * (ig * xc[e]); } }
        }
#pragma unroll
        for (int tb = 0; tb < 2; ++tb)
#pragma unroll
            for (int r = 0; r < 16; r += 4) LRU_SCAN4(av[tb][r], bv[tb][r], av[tb][r + 1], bv[tb][r + 1], av[tb][r + 2], bv[tb][r + 2], av[tb][r + 3], bv[tb][r + 3]);
#pragma unroll
        for (int r = 0; r < 16; ++r) {
            const float A0 = rl_half(av[0][r], hi), B0 = rl_half(bv[0][r], hi);
            bv[1][r] = av[1][r] * B0 + bv[1][r]; av[1][r] = av[1][r] * A0;
        }
        if (PASS == 1) {
            if (r32 == 31) { float* S = (float*)(F.ws + WS_LSUM) + (size_t)u * 1024;
#pragma unroll
                for (int r = 0; r < 16; ++r) { const int ch = 64 * n + 32 * jb + crow(r, hi); *(float2*)(S + 2 * ch) = make_float2(av[1][r], bv[1][r]); } }
        } else {
#pragma unroll
            for (int q4 = 0; q4 < 4; ++q4) { const int chb = 64 * n + 32 * jb + 8 * q4 + 4 * hi;
                const f32x4 hin = *(const LAS f32x4*)(lds + L_HIN + chb * 4);
#pragma unroll
                for (int tb = 0; tb < 2; ++tb) { const int t = tb * 32 + r32;
                    const v2u gw = gwv[q4][tb];
                    const float xg[4] = {bflo(gw.x), bfhi(gw.x), bflo(gw.y), bfhi(gw.y)};
#pragma unroll
                    for (int e = 0; e < 4; ++e) { const int r = 4 * q4 + e; const float h = av[tb][r] * hin[e] + bv[tb][r];
                        const float x = xg[e], uu = 0.7978845608028654f * (x + 0.044715f * x * x * x);
                        const float ge = x * __builtin_amdgcn_rcpf(1.0f + __builtin_amdgcn_exp2f(-2.0f * LOG2E * uu));
                        const float o = h * ge; ssq_t[tb] += o * o;
                        if (jb == 0) ((LAS float*)(lds + L_O0))[(wid * 32 + tb * 16 + r) * 64 + lane] = o; else outv[tb][r] = o;
                        if (tb == 1 && r32 == 31 && (smp || ck == 127)) { float* dst = smp ? F.out + O_LS + sb * 512 : F.out + O_LP + pb * 512; dst[chb + e] = h; } } } }
        }
        __builtin_amdgcn_sched_barrier(0);
    }
    if (PASS == 2) {
        LAS float* part = (LAS float*)(lds + L_PART);
#pragma unroll
        for (int tb = 0; tb < 2; ++tb) { float s = ssq_t[tb]; s += __shfl_xor(s, 32); if (hi == 0) part[wid * 64 + tb * 32 + r32] = s; }
        LDS_WAIT(); __syncthreads();
        bf16* CAT = (bf16*)(F.ws + WS_CAT);
#pragma unroll
        for (int tb = 0; tb < 2; ++tb) { const int t = tb * 32 + r32; float tot = 0.f;
#pragma unroll
            for (int w = 0; w < 8; ++w) tot += part[w * 64 + t];
            const float rn = __builtin_amdgcn_rsqf(tot * (1.0f / 512.0f) + EPS);
#pragma unroll
            for (int jb = 0; jb < 2; ++jb)
#pragma unroll
                for (int q4 = 0; q4 < 4; ++q4) { const int chb = 64 * n + 32 * jb + 8 * q4 + 4 * hi; const f32x4 gn = *(const LAS f32x4*)(lds + L_PAR + 6144 + chb * 4);
                    float ov[4];
#pragma unroll
                    for (int e = 0; e < 4; ++e) ov[e] = jb == 0 ? ((const LAS float*)(lds + L_O0))[(wid * 32 + tb * 16 + 4 * q4 + e) * 64 + lane] : outv[tb][4 * q4 + e];
                    v2u o; o.x = pk2(ov[0] * rn * gn[0], ov[1] * rn * gn[1]); o.y = pk2(ov[2] * rn * gn[2], ov[3] * rn * gn[3]);
#ifdef NT_CAT
                    __builtin_nontemporal_store(o, (GAS v2u*)(CAT + (size_t)(row0 + t) * 1024 + 512 + chb)); } }
#else
                    *(GAS v2u*)(CAT + (size_t)(row0 + t) * 1024 + 512 + chb) = o; } }
#endif
    }
    LDS_WAIT(); __syncthreads();
}
}

#ifndef ATT_RSTAGE
#define ATT_RSTAGE 0
#endif
#ifndef ATT_PROBE
#define ATT_PROBE 0
#endif
#if ATT_PROBE == 1
#define ATT_PROBE_CODE(kp) { f32x16 q0 = f32x16{}, q1 = f32x16{}; _Pragma("unroll") for (int d0 = 0; d0 < 4; ++d0) { const bf16x8 k0 = *(const __attribute__((address_space(3))) bf16x8*)(kp + d0 * 2048), k1 = *(const __attribute__((address_space(3))) bf16x8*)(kp + d0 * 2048 + 512); \
        q0 = __builtin_amdgcn_mfma_f32_32x32x16_bf16(k0, qr[d0], q0, 0, 0, 0); q1 = __builtin_amdgcn_mfma_f32_32x32x16_bf16(k1, qr[d0], q1, 0, 0, 0); } asm volatile("" :: "v"(q0), "v"(q1)); }
#elif ATT_PROBE == 2
#define ATT_PROBE_CODE(kp) { f32x16 q0 = p0, q1 = p1; _Pragma("unroll") for (int r = 0; r < 16; ++r) { q0[r] = __builtin_amdgcn_exp2f(q0[r] + 1.0f); q1[r] = __builtin_amdgcn_exp2f(q1[r] + 1.0f); } asm volatile("" :: "v"(q0), "v"(q1)); }
#else
#define ATT_PROBE_CODE(kp)
#endif
namespace att {
constexpr int SLOT = 32768, NSLOT = 4;
constexpr int A_RING = 0;
constexpr int A_EX = 0;
constexpr int A_TAB = 131072;
constexpr int A_WSF = 131072 + 1024;
constexpr int A_MISC = 143360;
__device__ __forceinline__ int crow(int r, int hi) { return (r & 3) + 8 * (r >> 2) + 4 * hi; }
__device__ __forceinline__ void glds16(const void* gsrc, unsigned lds_dst) { unsigned keep;
    asm volatile("s_mov_b32 %0, m0\n\ts_mov_b32 m0, %2\n\ts_nop 0\n\tglobal_load_lds_dwordx4 %1, off\n\ts_mov_b32 m0, %0" : "=&s"(keep) : "v"(gsrc), "s"(lds_dst) : "memory"); }
typedef __attribute__((address_space(3))) const char* lds_cptr;
typedef short v4i16_t __attribute__((ext_vector_type(4)));
__device__ __forceinline__ s16x4 vtr(lds_cptr p) { return __builtin_bit_cast(s16x4, __builtin_amdgcn_ds_read_tr16_b64_v4i16((__attribute__((address_space(3))) v4i16_t*)p)); }
__device__ __forceinline__ unsigned cvtpk(float lo, float hi) { typedef float f2 __attribute__((ext_vector_type(2))); typedef __bf16 b2 __attribute__((ext_vector_type(2)));
    f2 v = {lo, hi}; b2 b = __builtin_convertvector(v, b2); return __builtin_bit_cast(unsigned, b); }
#ifdef ATT_QPRIO
#define ATT_PRIO_QK_ON() __builtin_amdgcn_s_setprio(1)
#define ATT_PRIO_QK_OFF() __builtin_amdgcn_s_setprio(0)
#else
#define ATT_PRIO_QK_ON() do {} while (0)
#define ATT_PRIO_QK_OFF() do {} while (0)
#endif
#ifndef ATT_NO_MPRIO
#define ATT_PRIO_ON() __builtin_amdgcn_s_setprio(1)
#define ATT_PRIO_OFF() __builtin_amdgcn_s_setprio(0)
#else
#define ATT_PRIO_ON() do {} while (0)
#define ATT_PRIO_OFF() do {} while (0)
#endif
#define ATT_WAIT_BAR(N) asm volatile("s_waitcnt vmcnt(" #N ") lgkmcnt(0)\n\ts_barrier" ::: "memory")

template <bool SMP, bool DESC> __device__ __forceinline__ void attn_unit(Frame& F, int sidx, int h, int qb, float lam) {
    int tid_ = F.tid; asm volatile("" : "+v"(tid_));
    const int tid = tid_, lane = tid & 63, wid = F.wave, r32 = lane & 31, hi = lane >> 5;
    const int comp = SMP ? (wid >> 1) & 1 : wid >> 2, g = SMP ? ((wid & 1) | ((wid >> 2) << 1)) : (wid & 3);
    LAS unsigned char* lds = F.lds;
    const unsigned lds0 = (unsigned)(uintptr_t)lds;
    const bf16* Qb = (const bf16*)((const unsigned char*)F.out + OB_Q);
    const int qrow0 = SMP ? TP + sidx * 64 : sidx * SEQ + qb * 128;
    const int qpos0 = SMP ? PAST : qb * 128;
    const int NT = SMP ? 33 : 2 * qb + 2;
    const bool active = SMP ? (g < 2) : true;
    const int gq = SMP ? (g & 1) : g;
    const int qw = qpos0 + 32 * gq;
    const int t_last = active ? (qw >> 6) : -1;
    const int t_near0 = (qw - 90) > 0 ? ((qw - 90) >> 6) : 0;
    if (tid < 256) { float v = 0.f;
        if (tid >= 97 && tid <= 250) { const int delta = tid - 187; const int rel = delta < 0 ? -delta : delta; int bk;
            if (rel < 8) bk = rel; else { bk = 2 + (31 - __builtin_clz((unsigned)(rel * rel))); bk = bk > 15 ? 15 : bk; }
            if (delta > 0) bk += 16;
            v = (fin(F, 6)[bk * 4 + h] - fin(F, 6)[15 * 4 + h]) * LOG2E; }
        ((LAS float*)(lds + A_TAB))[tid] = v; }
    const unsigned char* img0 = F.ws + WS_KVP + (size_t)((SMP ? 0 : (sidx * 4 + h)) * 128) * 32768;
    const unsigned char* imgn = F.ws + WS_KVS + (size_t)(sidx * 4 + h) * 32768;
    const unsigned poff = (unsigned)(wid * 1024 + lane * 16);
    const unsigned pdst = lds0 + A_RING + wid * 1024;
#define ATT_TILE(i) (DESC ? NT - 1 - (i) : (i))
#define ATT_ISSUE(i) do { const int i_ = (i); const int t_ = ATT_TILE(i_); const unsigned so_ = (unsigned)((i_ % NSLOT) * SLOT); \
        if (SMP && t_ != 32) break;                                                 \
        const unsigned char* src_ = (SMP ? imgn : img0 + (size_t)t_ * 32768) + poff; \
        glds16(src_, (unsigned)__builtin_amdgcn_readfirstlane(pdst + so_)); \
        glds16(src_ + 8192, (unsigned)__builtin_amdgcn_readfirstlane(pdst + so_ + 8192)); \
        glds16(src_ + 16384, (unsigned)__builtin_amdgcn_readfirstlane(pdst + so_ + 16384)); \
        glds16(src_ + 24576, (unsigned)__builtin_amdgcn_readfirstlane(pdst + so_ + 24576)); } while (0)
    ATT_ISSUE(0); if (NT > 1) ATT_ISSUE(1);
    bf16x8 qr[4];
    { const bf16* Qw = Qb + (size_t)(qrow0 + 32 * gq + r32) * 512 + h * 128 + comp * 64;
#pragma unroll
      for (int d0 = 0; d0 < 4; ++d0) qr[d0] = *(const GAS bf16x8*)(Qw + d0 * 16 + hi * 8); }
    VM_WAIT();
    asm volatile("" : "+v"(qr[0]), "+v"(qr[1]), "+v"(qr[2]), "+v"(qr[3]));
#ifdef ATT_PRIO
    if (comp == ATT_PRIO - 1) __builtin_amdgcn_s_setprio(1);
#endif
    const bool loader = SMP && !active;
    const int wl = wid & 3;
#define ATT_LOAD_TILE(tt, slot_) do { const int t_ = (tt); LAS unsigned char* sl_ = lds + A_RING + (slot_) * SLOT; \
        const float* ck_ = fin(F, 2) + ((size_t)(sidx * PAST + t_ * 64 + wl * 16) * 4 + h) * 128; const float* cv_ = fin(F, 3) + ((size_t)(sidx * PAST + t_ * 64 + wl * 16) * 4 + h) * 128; \
        f32x4 ka_[4][2], va_[4][2]; \
        _Pragma("unroll") for (int u = 0; u < 4; ++u) { const int cj = u * 4 + (lane >> 4); const float* s_ = ck_ + (size_t)(lane & 15) * 512 + cj * 8; \
            ka_[u][0] = __builtin_nontemporal_load((const f32x4*)s_); ka_[u][1] = __builtin_nontemporal_load((const f32x4*)s_ + 1); } \
        _Pragma("unroll") for (int u = 0; u < 4; ++u) { const float* s_ = cv_ + (size_t)(lane >> 2) * 512 + u * 32 + (lane & 3) * 8; \
            va_[u][0] = __builtin_nontemporal_load((const f32x4*)s_); va_[u][1] = __builtin_nontemporal_load((const f32x4*)s_ + 1); } \
        _Pragma("unroll") for (int u = 0; u < 4; ++u) { const int cj = u * 4 + (lane >> 4); v4u o_; o_.x = pk2(ka_[u][0].x, ka_[u][0].y); o_.y = pk2(ka_[u][0].z, ka_[u][0].w); o_.z = pk2(ka_[u][1].x, ka_[u][1].y); o_.w = pk2(ka_[u][1].z, ka_[u][1].w); \
            *(LAS v4u*)(sl_ + (cj >> 3) * 8192 + (cj & 7) * 1024 + (wl * 16 + (lane & 15)) * 16) = o_; } \
        _Pragma("unroll") for (int u = 0; u < 4; ++u) { v4u o_; o_.x = pk2(va_[u][0].x, va_[u][0].y); o_.y = pk2(va_[u][0].z, va_[u][0].w); o_.z = pk2(va_[u][1].x, va_[u][1].y); o_.w = pk2(va_[u][1].z, va_[u][1].w); \
            *(LAS v4u*)(sl_ + 16384 + u * 4096 + (wl * 16 + (lane >> 2)) * 64 + (lane & 3) * 16) = o_; } } while (0)
    if (loader) { ATT_LOAD_TILE(0, 0); ATT_LOAD_TILE(1, 1); VM_WAIT(); }
    f32x16 o[4]; o[0] = f32x16{}; o[1] = f32x16{}; o[2] = f32x16{}; o[3] = f32x16{};
    float lsum = 0.f;
    const lds_cptr l3 = (lds_cptr)lds;
    const int kfo = A_RING + comp * 8192 + hi * 1024 + r32 * 16;
    const int vfo = A_RING + 16384 + ((lane >> 4) & 1) * 32 + (lane & 3) * 8 + (4 * hi + ((lane & 15) >> 2)) * 64;
    const int qposl = qw + r32;
    v4u pw[4]; bool have_p = false;
    int so_prev = 0;
#define ATT_VRD(j) do { vlo[j] = vtr(vp + ((j) >> 2) * 4096 + ((j) & 3) * 1024); vhi[j] = vtr(vp + ((j) >> 2) * 4096 + ((j) & 3) * 1024 + 512); } while (0)
#define ATT_VFR(j) (bf16x8){vlo[j][0], vlo[j][1], vlo[j][2], vlo[j][3], vhi[j][0], vhi[j][1], vhi[j][2], vhi[j][3]}
#define ATT_G2(j) do { if ((j) + 3 < 16) ATT_VRD((j) + 3); \
        o[(j) >> 2] = __builtin_amdgcn_mfma_f32_32x32x16_bf16(__builtin_bit_cast(bf16x8, pw[(j) & 3]), ATT_VFR(j), o[(j) >> 2], 0, 0, 0); __builtin_amdgcn_sched_barrier(0); } while (0)
#define ATT_QKEXP(t_, so_) do { f32x16 p0, p1; \
        if ((t_) >= t_near0) { const LAS float* tb = (const LAS float*)(lds + A_TAB) + (64 * (t_) + 4 * hi - qposl + 187);     \
            _Pragma("unroll") for (int r = 0; r < 16; ++r) { p0[r] = tb[(r & 3) + 8 * (r >> 2)]; p1[r] = tb[(r & 3) + 8 * (r >> 2) + 32]; } } \
        else { p0 = f32x16{}; p1 = f32x16{}; } \
        const lds_cptr kp = l3 + kfo + (so_); ATT_PRIO_QK_ON(); \
        _Pragma("unroll") for (int d0 = 0; d0 < 4; ++d0) { \
            const bf16x8 k0 = *(const __attribute__((address_space(3))) bf16x8*)(kp + d0 * 2048); \
            const bf16x8 k1 = *(const __attribute__((address_space(3))) bf16x8*)(kp + d0 * 2048 + 512); \
            p0 = __builtin_amdgcn_mfma_f32_32x32x16_bf16(k0, qr[d0], p0, 0, 0, 0); \
            p1 = __builtin_amdgcn_mfma_f32_32x32x16_bf16(k1, qr[d0], p1, 0, 0, 0); } ATT_PRIO_QK_OFF(); \
        ATT_PROBE_CODE(kp) \
        float sacc = 0.f; \
        _Pragma("unroll") for (int r = 0; r < 16; ++r) { p0[r] = __builtin_amdgcn_exp2f(p0[r]); p1[r] = __builtin_amdgcn_exp2f(p1[r]); sacc += p0[r] + p1[r]; } \
        lsum += sacc; \
        _Pragma("unroll") for (int k = 0; k < 2; ++k) { pw[k] = (v4u){cvtpk(p0[8 * k], p0[8 * k + 1]), cvtpk(p0[8 * k + 2], p0[8 * k + 3]), cvtpk(p0[8 * k + 4], p0[8 * k + 5]), cvtpk(p0[8 * k + 6], p0[8 * k + 7])}; \
                                      pw[2 + k] = (v4u){cvtpk(p1[8 * k], p1[8 * k + 1]), cvtpk(p1[8 * k + 2], p1[8 * k + 3]), cvtpk(p1[8 * k + 4], p1[8 * k + 5]), cvtpk(p1[8 * k + 6], p1[8 * k + 7])}; } } while (0)
#define ATT_PV(so_) do { const lds_cptr vp = l3 + vfo + (so_); s16x4 vlo[16], vhi[16]; ATT_VRD(0); ATT_VRD(1); ATT_VRD(2); __builtin_amdgcn_sched_barrier(0); ATT_PRIO_ON(); \
        ATT_G2(0); ATT_G2(1); ATT_G2(2); ATT_G2(3); ATT_G2(4); ATT_G2(5); ATT_G2(6); ATT_G2(7); ATT_G2(8); ATT_G2(9); ATT_G2(10); ATT_G2(11); ATT_G2(12); ATT_G2(13); ATT_G2(14); ATT_G2(15); ATT_PRIO_OFF(); } while (0)
#define ATT_SYNC(it_) do { if ((it_) + 1 < NT) ATT_WAIT_BAR(4); else ATT_WAIT_BAR(0);     \
        if ((it_) + 2 < NT) ATT_ISSUE((it_) + 2); } while (0)
    if (!SMP && ATT_RSTAGE) {
        asm volatile("s_waitcnt vmcnt(0)" ::: "memory");
        const unsigned char* gsrc = img0 + poff;
        LAS unsigned char* ldst = lds + A_RING + wid * 1024 + lane * 16;
        v4u st[8];
#define ATT_RLOAD(i_, k_) do { const unsigned char* s_ = gsrc + (size_t)ATT_TILE(i_) * 32768; \
        st[4 * (k_)] = *(const GAS v4u*)(s_); st[4 * (k_) + 1] = *(const GAS v4u*)(s_ + 8192); st[4 * (k_) + 2] = *(const GAS v4u*)(s_ + 16384); st[4 * (k_) + 3] = *(const GAS v4u*)(s_ + 24576); } while (0)
#define ATT_RWRITE(i_, k_) do { LAS unsigned char* d_ = ldst + ((i_) % NSLOT) * SLOT; \
        *(LAS v4u*)(d_) = st[4 * (k_)]; *(LAS v4u*)(d_ + 8192) = st[4 * (k_) + 1]; *(LAS v4u*)(d_ + 16384) = st[4 * (k_) + 2]; *(LAS v4u*)(d_ + 24576) = st[4 * (k_) + 3]; } while (0)
        if (NT > 2) { ATT_RLOAD(2, 0); ATT_RLOAD(3, 1); }
        asm volatile("s_waitcnt lgkmcnt(0)\n\ts_barrier" ::: "memory");
        for (int it = 0; it < NT; it += 2) {
            if (it + 2 < NT) { ATT_RWRITE(it + 2, 0); ATT_RWRITE(it + 3, 1); }
            if (it + 4 < NT) { ATT_RLOAD(it + 4, 0); ATT_RLOAD(it + 5, 1); }
#pragma unroll
            for (int k = 0; k < 2; ++k) { const int t = ATT_TILE(it + k); const int so = ((it + k) % NSLOT) * SLOT;
                if (t <= t_last) { ATT_QKEXP(t, so); __builtin_amdgcn_sched_barrier(0); ATT_PV(so); } }
            asm volatile("s_waitcnt lgkmcnt(0)\n\ts_barrier" ::: "memory");
        }
#undef ATT_RLOAD
#undef ATT_RWRITE
    } else {
    const bool skew = comp == 1;
    for (int it = 0; it < NT; ++it) {
        const int t = ATT_TILE(it);
        if (skew) ATT_SYNC(it);
        if (have_p) { ATT_PV(so_prev); __builtin_amdgcn_sched_barrier(0); }
        if (!skew) ATT_SYNC(it);
        const int so = (it % NSLOT) * SLOT;
        have_p = (t <= t_last);
        if (have_p) { ATT_QKEXP(t, so); so_prev = so; }
        if (loader && it + 2 < 32) { ATT_LOAD_TILE(it + 2, (it + 2) % NSLOT); VM_WAIT(); }
    }
    if (have_p) { ATT_PV(so_prev); }
    }
#undef ATT_SYNC
#undef ATT_VRD
#undef ATT_VFR
#undef ATT_G2
#undef ATT_QKEXP
#undef ATT_PV
#ifdef ATT_PRIO
    __builtin_amdgcn_s_setprio(0);
#endif
    int lane_e = lane; asm volatile("" : "+v"(lane_e));
    const int r32e = lane_e & 31, hie = lane_e >> 5;
    { auto rr = __builtin_amdgcn_permlane32_swap(__float_as_uint(lsum), __float_as_uint(lsum), false, false); lsum = __uint_as_float(rr[0]) + __uint_as_float(rr[1]); }
    LAS float* wsf = (LAS float*)(lds + A_WSF) + wid * 32;
    if (hie == 0) wsf[r32e] = lsum;
    ATT_WAIT_BAR(0);
    float rli[16];
#pragma unroll
    for (int r = 0; r < 16; ++r) rli[r] = __builtin_amdgcn_rcpf(wsf[crow(r, hie)]);
    LAS float* ex = (LAS float*)(lds + A_EX) + g * 4096;
    if (comp == 1) {
#pragma unroll
        for (int db = 0; db < 4; ++db)
#pragma unroll
            for (int r = 0; r < 16; ++r) ex[crow(r, hie) * 128 + db * 32 + r32e] = o[db][r] * (rli[r] * lam);
    }
    LDS_WAIT(); __syncthreads();
    if (comp == 0 && active) {
        float ss[16];
#pragma unroll
        for (int r = 0; r < 16; ++r) ss[r] = 0.f;
#pragma unroll
        for (int db = 0; db < 4; ++db)
#pragma unroll
            for (int r = 0; r < 16; ++r) { const float v = o[db][r] * rli[r] - ex[crow(r, hie) * 128 + db * 32 + r32e]; o[db][r] = v; ss[r] += v * v; }
#pragma unroll
        for (int r = 0; r < 16; ++r) { float s = ss[r];
#pragma unroll
            for (int m = 1; m < 32; m <<= 1) s += __shfl_xor(s, m);
            ss[r] = __builtin_amdgcn_rsqf(s * (1.0f / 128.0f) + EPS) * 0.8f; }
        LDS_WAIT();
        LAS unsigned short* stg = (LAS unsigned short*)ex;
#pragma unroll
        for (int db = 0; db < 4; ++db) { const float gn = fin(F, 19)[db * 32 + r32e];
#pragma unroll
            for (int r = 0; r < 16; ++r) stg[crow(r, hie) * 128 + db * 32 + r32e] = (unsigned short)f2bf(o[db][r] * ss[r] * gn); }
        LDS_WAIT();
        bf16* CAT = (bf16*)(F.ws + WS_CAT);
#pragma unroll
        for (int i = 0; i < 8; ++i) { const int row = i * 4 + (lane_e >> 4), ch = lane_e & 15;
            const v4u v = *(const LAS v4u*)(stg + row * 128 + ch * 8);
#ifdef NT_CAT
            __builtin_nontemporal_store(v, (GAS v4u*)(CAT + (size_t)(qrow0 + 32 * g + row) * 1024 + h * 128 + ch * 8)); }
#else
            *(GAS v4u*)(CAT + (size_t)(qrow0 + 32 * g + row) * 1024 + h * 128 + ch * 8) = v; }
#endif
    }
    LDS_WAIT(); __syncthreads();
#undef ATT_ISSUE
#undef ATT_LOAD_TILE
#undef ATT_TILE
}
#undef ATT_WAIT_BAR
}

#ifndef PG8_ALIGN
#define PG8_ALIGN true
#endif
#ifndef PG8_SP2
#define PG8_SP2 true
#endif
#ifndef SKM_G1
#define SKM_G1 0
#endif
#ifndef SKM_G2
#define SKM_G2 0
#endif
#ifndef SKM_G3
#define SKM_G3 0
#endif
#ifndef SKM_G5
#define SKM_G5 0
#endif
#ifndef SKM_G6
#define SKM_G6 0
#endif
#ifndef SKM_G7
#define SKM_G7 0
#endif
__device__ __forceinline__ void phase_p0(Frame& F) {
    unsigned char* ws = F.ws; (void)ws;
#ifndef NO_P0
    p0_prologue(F);
#endif
}

#ifdef DEP_OFF
#define DEPM(k) 0
#else
#ifndef DEP_MASK
#define DEP_MASK 3
#endif
#define DEPM(k) ((k) & DEP_MASK)
#endif
constexpr int UPX(int N) { return (TT / 256 / 8) * (N / 256); }
#define DEPC(k) ((unsigned*)(ws + WS_CTL) + CW_DEP + ((k) + cs) * 136 * 4)
__device__ __forceinline__ void phase_g1(Frame& F, int cs = 0  ) {
    unsigned char* ws = F.ws; (void)ws;
#ifndef NO_G1
    {   pg8::Gemm g{(const pg8::bf16_t*)(ws + WS_XB), (const pg8::bf16_t*)(ws + WS_W1GU), TT, 2 * FF, DM}; typedef pg8::StreamK<0, DEPM(2)> SK; SK S; S.init(TT, 2 * FF, DM, F.G, F.bx, nullptr, nullptr, 0, 0);
        S.dep_in = nullptr; S.dep_target = 0u; S.dep_out = DEPC(0);
        pg8::EpiSwiGLU<0> E{(pg8::bf16_t*)(ws + WS_H), (const float*)(ws + WS_RSTD0)};
        pg8::gemm_phase<pg8::EpiSwiGLU<0>, SK, PG8_ALIGN, PG8_SP2>(F.lds, g, S, E, F.tid); }
#endif
}

__device__ __forceinline__ void phase_g2(Frame& F, int cs = 0  ) {
    unsigned char* ws = F.ws; (void)ws;
#ifndef NO_G2
    {   pg8::Gemm g{(const pg8::bf16_t*)(ws + WS_H), (const pg8::bf16_t*)(ws + WS_W1D), TT, DM, FF}; typedef pg8::StreamK<0, DEPM(3)> SK; SK S; S.init(TT, DM, FF, F.G, F.bx, nullptr, nullptr, 0, UPX(2 * FF));
        S.dep_in = DEPC(0); S.dep_target = 8u * (2 * FF / 256); S.dep_out = DEPC(1);
        pg8::EpiResid<0> E{(pg8::bf16_t*)(ws + WS_XB), F.out, (float*)(ws + WS_SSQ1), (pg8::bf16_t*)(ws + WS_XB1)};
        pg8::gemm_phase<pg8::EpiResid<0>, SK, PG8_ALIGN, PG8_SP2>(F.lds, g, S, E, F.tid); }
#endif
}

__device__ __forceinline__ void phase_g3(Frame& F, int cs = 0  ) {
    unsigned char* ws = F.ws; (void)ws;
#ifndef NO_G3
    {   pg8::Gemm g{(const pg8::bf16_t*)(ws + WS_XB1), (const pg8::bf16_t*)(ws + WS_WIN), TT, INW, DM}; typedef pg8::StreamK<0, DEPM(1)> SK; SK S; S.init(TT, INW, DM, F.G, F.bx, nullptr, nullptr, 0, UPX(2 * FF) + UPX(DM));
        S.dep_in = DEPC(1); S.dep_target = 8u * (DM / 256); S.dep_out = nullptr;
        pg8::EpiWin E{ws, F.out, fin(F, 13), fin(F, 14)};
        pg8::gemm_phase<pg8::EpiWin, SK, PG8_ALIGN, PG8_SP2>(F.lds, g, S, E, F.tid); }
#ifndef CONV_IN_ATT
    if (cs == 0) convert_queue(F, (unsigned*)(ws + WS_CTL) + CW_CONVQ, (LAS int*)(F.lds + att::A_MISC) + 1);
#endif
#endif
}

__device__ __forceinline__ void phase_l1(Frame& F) {
    unsigned char* ws = F.ws; (void)ws;
#ifndef NO_L1
#ifdef L1_DYN
    {   unsigned* ctl = (unsigned*)(F.ws + WS_CTL); const int grp = F.bx & 7; unsigned* head1 = ctl + CW_QUEUE + 64 * grp + 2048;
        LAS int* qi = (LAS int*)(F.lds + att::A_MISC) + 1;
        for (;;) {
            if (F.tid == 0) *qi = (int)atomicAdd(head1, 1u);
            __syncthreads();
            const int it = *qi;
            __syncthreads();
            if (it >= 68) break;
            lru::lru_unit<1>(F, grp * 68 + it);
#if L1_DYN >= 2
            if (F.tid == 0) { asm volatile("s_waitcnt vmcnt(0)" ::: "memory");
#if L1_DYN >= 3
                __builtin_amdgcn_fence(__ATOMIC_RELEASE, "agent"); asm volatile("s_waitcnt vmcnt(0)" ::: "memory");
#endif
                __hip_atomic_fetch_add(ctl + 100, 1u, __ATOMIC_RELAXED, __HIP_MEMORY_SCOPE_AGENT); }
#endif
        }
    }
#else
    for (int u = F.bx; u < 512; u += F.G) if ((u & 127) != 127) lru::lru_unit<1>(F, u);
#endif
#endif
}

__device__ __forceinline__ void phase_g5(Frame& F, int cs = 0  ) {
    unsigned char* ws = F.ws; (void)ws;
#ifndef NO_G5
    {   pg8::Gemm g{(const pg8::bf16_t*)(ws + WS_CAT), (const pg8::bf16_t*)(ws + WS_WOUT), TT, DM, DM}; typedef pg8::StreamK<0, DEPM(2)> SK; SK S; S.init(TT, DM, DM, F.G, F.bx, nullptr, nullptr, 0, 0);
        S.dep_in = nullptr; S.dep_target = 0u; S.dep_out = DEPC(2);
        pg8::EpiResid<1> E{(pg8::bf16_t*)(ws + WS_XB1), F.out, (float*)(ws + WS_SSQ2), (pg8::bf16_t*)(ws + WS_XB)};
        pg8::gemm_phase<pg8::EpiResid<1>, SK, PG8_ALIGN, PG8_SP2>(F.lds, g, S, E, F.tid); }
#endif
}

__device__ __forceinline__ void phase_g6(Frame& F, int cs = 0  ) {
    unsigned char* ws = F.ws; (void)ws;
#ifndef NO_G6
    {   pg8::Gemm g{(const pg8::bf16_t*)(ws + WS_XB), (const pg8::bf16_t*)(ws + WS_W2GU), TT, 2 * FF, DM}; typedef pg8::StreamK<0, DEPM(3)> SK; SK S; S.init(TT, 2 * FF, DM, F.G, F.bx, nullptr, nullptr, 0, UPX(DM));
        S.dep_in = DEPC(2); S.dep_target = 8u * (DM / 256); S.dep_out = DEPC(3);
        pg8::EpiSwiGLU<1> E{(pg8::bf16_t*)(ws + WS_H), (const float*)(ws + WS_SSQ2)};
        pg8::gemm_phase<pg8::EpiSwiGLU<1>, SK, PG8_ALIGN, PG8_SP2>(F.lds, g, S, E, F.tid); }
#endif
}

__device__ __forceinline__ void phase_g7(Frame& F, int cs = 0  ) {
    unsigned char* ws = F.ws; (void)ws;
#ifndef NO_G7
    {   pg8::Gemm g{(const pg8::bf16_t*)(ws + WS_H), (const pg8::bf16_t*)(ws + WS_W2D), TT, DM, FF}; typedef pg8::StreamK<0, DEPM(1)> SK; SK S; S.init(TT, DM, FF, F.G, F.bx, nullptr, nullptr, 0, UPX(DM) + UPX(2 * FF));
        S.dep_in = DEPC(3); S.dep_target = 8u * (2 * FF / 256); S.dep_out = nullptr;
        pg8::EpiResid<2> E{(pg8::bf16_t*)(ws + WS_XB), F.out, nullptr, nullptr};
        pg8::gemm_phase<pg8::EpiResid<2>, SK, PG8_ALIGN, PG8_SP2>(F.lds, g, S, E, F.tid); }
#endif
}

struct Args { const float* in[33]; float* out; unsigned char* ws; int pad0, pad1; };
__global__ void __launch_bounds__(512, 2) hymba_fwd(Args args) {
    extern __shared__ __attribute__((aligned(16))) unsigned char lds_raw[];
    cg::grid_group grid = cg::this_grid();
    Frame F;
    F.lds = (LAS unsigned char*)lds_raw;
    F.tid = threadIdx.x; F.lane = F.tid & 63; F.wave = __builtin_amdgcn_readfirstlane(F.tid >> 6);
    F.G = gridDim.x; F.bx = blockIdx.x;
    F.ka = (kptr_t)__builtin_amdgcn_kernarg_segment_ptr(); F.z = 0;
    F.out = args.out; F.ws = args.ws;
    unsigned char* ws = F.ws;
    unsigned* ctl = (unsigned*)(ws + WS_CTL);
    volatile LAS unsigned* MISCW = (volatile LAS unsigned*)(F.lds + 144384);
    if (F.tid < 16) MISCW[F.tid] = 0u;
    __syncthreads();
    XcdBarrier bar = xcd_barrier_post(ctl + CW_BAR, MISCW + 8, F.wave);
#define GRID_BAR() do { xcd_barrier(bar); NEW_PHASE(); } while (0)
#define GRID_BAR_CG() do { __threadfence(); grid.sync(); NEW_PHASE(); } while (0)

    phase_p0(F);
#if defined(REP_P0)
    GRID_BAR(); phase_p0(F);
#endif
#ifdef USE_CG_SYNC
    GRID_BAR_CG();
#else
    GRID_BAR();
#endif
    phase_g1(F);
#ifdef CHAIN_BARS
    GRID_BAR();
#endif
    phase_g2(F);
#ifdef CHAIN_BARS
    GRID_BAR();
#endif
    phase_g3(F);
    GRID_BAR();
#ifdef REP_C1
    phase_g1(F, 4); phase_g2(F, 4); phase_g3(F, 4); GRID_BAR();
#endif
    phase_l1(F);
#if defined(REP_L1)
    GRID_BAR(); phase_l1(F);
#endif
    GRID_BAR();
    {
        LAS float* misc = (LAS float*)(F.lds + att::A_MISC);
        if (F.wave == 0) { const float a = wave_sum(fin(F, 15)[F.lane] * fin(F, 16)[F.lane]), b = wave_sum(fin(F, 17)[F.lane] * fin(F, 18)[F.lane]);
            if (F.lane == 0) misc[0] = __expf(a) - __expf(b) + 0.2f; }
        __syncthreads();
        const float lam = misc[0];
        const int grp = F.bx & 7;
#ifdef ATT_TWICE
        for (int rep = 0; rep < 2; ++rep) {
        unsigned* head = ctl + CW_QUEUE + 64 * grp + 1024 * rep;
#else
        unsigned* head = ctl + CW_QUEUE + 64 * grp;
#endif
        const int wq = F.bx >> 3;
        if (F.G == 256) {
#ifndef NO_ATT
#pragma unroll 1
            for (int k = 0; k < 2; ++k) { const int st = grp + 8 * k;
                att::attn_unit<false, false>(F, st >> 2, st & 3, wq, lam);
                att::attn_unit<false, true>(F, st >> 2, st & 3, 63 - wq, lam); }
#endif
        }
        const int qbase = (F.G == 256) ? 128 : 0;
        for (;;) {
            if (F.tid == 0) ((LAS int*)misc)[1] = qbase + (int)atomicAdd(head, 1u);
            __syncthreads();
            const int it = ((LAS int*)misc)[1];
            __syncthreads();
            if (it >= 212) break;
#ifndef NO_ATT
            if (it < 128) { const int st = grp + 8 * (it >> 6), qb = 63 - (it & 63); att::attn_unit<false, false>(F, st >> 2, st & 3, qb, lam); }
            else if (it < 144) { const int su = grp * 16 + (it - 128); att::attn_unit<true, false>(F, su >> 2, su & 3, 0, lam); }
            else
#endif
#ifndef NO_L2
            { lru::lru_unit<2>(F, grp * 68 + (it - 144));
#ifdef L2_TWICE
              lru::lru_unit<2>(F, grp * 68 + (it - 144));
#endif
            }
#else
            {}
#endif
        }
#ifdef ATT_TWICE
        __syncthreads(); }
#endif
#ifdef CONV_IN_ATT
        convert_queue(F, ctl + CW_CONVQ, (LAS int*)misc + 1);
#endif
    }
    GRID_BAR();
#ifdef REP_C2
    phase_g5(F, 2); phase_g6(F, 2); phase_g7(F, 2); GRID_BAR();
#endif
    phase_g5(F);
#ifdef CHAIN_BARS
    GRID_BAR();
#endif
    phase_g6(F);
#ifdef CHAIN_BARS
    GRID_BAR();
#endif
    phase_g7(F);
}

extern "C" void kernel_launch(void* const* d_in, const int* in_sizes, int n_in, void* d_out, int out_size, void* d_ws, size_t ws_size, hipStream_t stream) {
    static int grid = 0;
    if (grid == 0) {
        if (n_in != 33 || out_size != (int)O_END || ws_size < WS_END) { fprintf(stderr, "kernel_launch: unexpected shapes: n_in %d out %d ws %zu (need %zu)\n", n_in, out_size, ws_size, (size_t)WS_END); grid = -1; return; }
        int dev = 0, cus = 0, per_cu = 0;
        hipGetDevice(&dev); hipDeviceGetAttribute(&cus, hipDeviceAttributeMultiprocessorCount, dev);
        if (hipFuncSetAttribute((const void*)hymba_fwd, hipFuncAttributeMaxDynamicSharedMemorySize, LDS_BYTES) != hipSuccess) { fprintf(stderr, "kernel_launch: hipFuncSetAttribute failed\n"); grid = -1; return; }
        if (hipOccupancyMaxActiveBlocksPerMultiprocessor(&per_cu, (const void*)hymba_fwd, 512, LDS_BYTES) != hipSuccess || per_cu < 1) { fprintf(stderr, "kernel_launch: occupancy query says %d\n", per_cu); per_cu = 1; }
        (void)hipGetLastError();
        grid = cus * 1;
        if (grid % 8 != 0 || grid < 8) { fprintf(stderr, "kernel_launch: grid %d not a multiple of 8\n", grid); }
    }
    if (grid < 0) return;
    (void)hipMemsetAsync((char*)d_ws + WS_CTL, 0, CTL_ZERO_BYTES, stream);
    Args a{};
    for (int i = 0; i < 33; ++i) a.in[i] = (const float*)d_in[i];
    a.out = (float*)d_out; a.ws = (unsigned char*)d_ws;
    void* kargs[] = {&a};
    hipError_t e = hipLaunchCooperativeKernel((const void*)hymba_fwd, dim3(grid), dim3(512), kargs, LDS_BYTES, stream);
    if (e != hipSuccess) fprintf(stderr, "kernel_launch: cooperative launch failed: %s (grid %d)\n", hipGetErrorString(e), grid);
}
```

```cpp
#include <hip/hip_runtime.h>
#include <hip/hip_cooperative_groups.h>
#include <hip/hip_bf16.h>
#include <cstdio>
#include <cstdint>
namespace cg = cooperative_groups;

constexpr int DM = 1024, NBP = 4, SEQ = 8192, NBS = 32, DSQ = 64, PAST = 2048;
constexpr int TP = NBP * SEQ, TS = NBS * DSQ, TT = TP + TS;
constexpr int FF = 2816, AW = 512, LW = 512, INW = 2560, NH = 4, HD = 64, VD = 128;
constexpr float EPS = 1e-6f;
constexpr float LOG2E = 1.4426950408889634f;
constexpr float QSCALE = 0.125f * LOG2E;
constexpr size_t O_Y = 0, O_KP = (size_t)TT * DM, O_VP = O_KP + (size_t)TP * 512, O_LP = O_VP + (size_t)TP * 512, O_CP = O_LP + NBP * 512,
                 O_KS = O_CP + NBP * 3 * 512, O_VS = O_KS + (size_t)TS * 512, O_LS = O_VS + (size_t)TS * 512, O_CS = O_LS + NBS * 512, O_END = O_CS + NBS * 3 * 512;
static_assert(O_END == 71376896, "output size");
constexpr size_t OFF_SSQ1 = 44u << 20, OFF_KVP = 376u << 20, OFF_KVS = 440u << 20;
constexpr size_t OB_Q = 0, OB_XR = 34u << 20, OB_XG = 68u << 20;
#ifndef PG8_WGM
#define PG8_WGM 4
#endif
namespace pg8 {
#define PG8_LAS __attribute__((address_space(3)))
typedef unsigned short bf16_t;
typedef short bf16x8 __attribute__((ext_vector_type(8)));
typedef float f32x4 __attribute__((ext_vector_type(4)));
typedef float f32x2 __attribute__((ext_vector_type(2)));
typedef unsigned u32x4 __attribute__((ext_vector_type(4)));
constexpr int BM = 256, BK = 64, HALF = 128, HTB = HALF * BK * 2  , STAGE_BYTES = 8 * HTB, NXCD = 8, WGM = PG8_WGM;

__host__ __device__ __forceinline__ int lds_byte(int r, int c) { const int st = (r >> 4) * 2 + (c >> 5), rr = r & 15, cc = c & 31, ob = rr * 64 + cc * 2; return st * 1024 + (ob ^ (((ob >> 9) & 1) << 5)); }
__host__ __device__ __forceinline__ void stage_rc(int b, int& R, int& C) { const int st = b / 1024, sb = b % 1024, swz = sb ^ (((sb >> 9) & 1) << 5); R = (st >> 1) * 16 + swz / 64; C = (st & 1) * 32 + (swz % 64) / 2; }
__host__ __device__ __forceinline__ int perm32(int rho) { const int n = rho >> 4, i = rho & 15; return 8 * (i >> 2) + 4 * n + (i & 3); }

struct Unit { int pm, pn, kt0, nkt, kind; };
struct Gemm { const bf16_t* A; const bf16_t* Bt; int M, N, K; };

template <int MODE  , int DEP = 0  > struct StreamK {
    static constexpr bool SPLIT = MODE != 0; static constexpr int DEPF = DEP;
    const unsigned* dep_in; unsigned* dep_out; unsigned dep_target;
    int nM, nN, P, W, x, w, q, R1, Dq; long lo, hi; int v; float* slab; unsigned* flag;
    int pm0;
    __device__ void init(int M, int N, int K, int G_, int bx, float* slab_, unsigned* flag_, int pm0_ = 0, int rot = 0) { pm0 = pm0_; nM = M / BM; nN = N / BM; P = K / (2 * BK); W = G_ / NXCD; x = bx % NXCD; w = (bx / NXCD + W - rot % W) % W;
        const int nwg = nM * nN; q = nwg / NXCD;
        if (!SPLIT) { R1 = (nwg + G_ - 1) / G_; Dq = q; } else { R1 = nwg / G_ - 1; Dq = R1 * W; }
        const long tot = (long)(q - Dq) * P; lo = tot * w / W; hi = tot * (w + 1) / W; v = x * W + w; slab = slab_; flag = flag_; }
    __device__ bool next(int i, Unit& u) const {
        int L; int j = i, k = -1;
        if (MODE == 2 && (lo % P) != 0) { if (i == 0) k = 0; else j = i - 1; }
        if (k < 0 && j >= R1) { if (!SPLIT) return false; k = j - R1 + ((MODE == 2 && (lo % P) != 0) ? 1 : 0); }
        if (k < 0) { L = j * W + w; u.kt0 = 0; u.nkt = 2 * P; u.kind = 0; if (!SPLIT && L >= q) return false; }
        else { const long u0 = lo / P; const long base = (u0 + k) * P; const long start = (k == 0) ? lo - base : 0; if (base + start >= hi) return false;
            const long end = (hi - base) < P ? (hi - base) : P;
            L = Dq + (int)(u0 + k); u.kt0 = (int)(2 * start); u.nkt = (int)(2 * (end - start)); u.kind = start > 0 ? 1 : (end < P ? 2 : 0); }
        const int ppx = nM / NXCD, nig = WGM * nN, gid = L / nig, fm = gid * WGM, gsz = (ppx - fm) < WGM ? (ppx - fm) : WGM;
        u.pm = pm0 + x * ppx + fm + ((L % nig) % gsz); u.pn = (L % nig) / gsz; return true;
    }
    __device__ __forceinline__ unsigned poll(const Unit& u) const {
#ifdef NO_POLL
        return 0xffffu;
#else
        if constexpr ((DEP & 1) != 0) return __hip_atomic_load(dep_in + u.pm * 4, __ATOMIC_RELAXED, __HIP_MEMORY_SCOPE_AGENT); else return 0u;
#endif
    }
    __device__ __forceinline__ void a_ready(const Unit& u, unsigned pv) const {
        if constexpr ((DEP & 1) != 0) { unsigned spins = 0;
            while ((unsigned)__builtin_amdgcn_readfirstlane(pv) < dep_target) { __builtin_amdgcn_s_sleep(4); pv = poll(u); if (++spins > (1u << 21)) break; }
#ifdef DEP_INV
            asm volatile("buffer_inv sc1" ::: "memory");
#endif
        }
    }
    __device__ __forceinline__ void done(const Unit& u) const {
        if constexpr ((DEP & 2) != 0) { asm volatile("s_waitcnt vmcnt(0)" ::: "memory");
            if ((threadIdx.x & 63) == 0) __hip_atomic_fetch_add(dep_out + u.pm * 4, 1u, __ATOMIC_RELAXED, __HIP_MEMORY_SCOPE_AGENT); }
    }
    __device__ __forceinline__ void put_partial(const f32x4 (&acc)[2][2][4][2], int tid, int lane) const {
        f32x4* dst = (f32x4*)slab + (size_t)v * (32 * 512) + tid;
#pragma unroll
        for (int ai = 0; ai < 2; ++ai)
#pragma unroll
            for (int bj = 0; bj < 2; ++bj)
#pragma unroll
                for (int m = 0; m < 4; ++m)
#pragma unroll
                    for (int n = 0; n < 2; ++n) { const f32x4 val = acc[ai][bj][m][n];
                        asm volatile("global_store_dwordx4 %0, %1, off sc1\n\ts_nop 1" :: "v"(dst), "v"(val) : "memory");
                        dst += 512; asm volatile("" : "+v"(dst)); }
        asm volatile("s_waitcnt vmcnt(0)" ::: "memory");
        if (lane == 0) __hip_atomic_fetch_add(flag + v, 1u, __ATOMIC_RELAXED, __HIP_MEMORY_SCOPE_AGENT);
    }
    __device__ __forceinline__ void load_partial(f32x4 (&acc)[2][2][4][2], int tid, int lane) const {
        unsigned spins = 0;
        while ((unsigned)__builtin_amdgcn_readfirstlane(__hip_atomic_load(flag + v + 1, __ATOMIC_RELAXED, __HIP_MEMORY_SCOPE_AGENT)) < 8u) { __builtin_amdgcn_s_sleep(2); if (++spins > (1u << 22)) break; }
        __builtin_amdgcn_fence(__ATOMIC_ACQUIRE, "agent");
        const f32x4* src = (const f32x4*)slab + (size_t)(v + 1) * (32 * 512) + tid;
#pragma unroll
        for (int ai = 0; ai < 2; ++ai)
#pragma unroll
            for (int bj = 0; bj < 2; ++bj)
#pragma unroll
                for (int m = 0; m < 4; ++m)
#pragma unroll
                    for (int n = 0; n < 2; ++n) { acc[ai][bj][m][n] = *src; src += 512; asm volatile("" : "+v"(src)); }
    }
};

__device__ __forceinline__ unsigned cvt_pk_bf16(float lo, float hi) { unsigned r; asm volatile("v_cvt_pk_bf16_f32 %0, %1, %2" : "=v"(r) : "v"(lo), "v"(hi)); return r; }
__device__ __forceinline__ u32x4 pack8(const f32x4& a, const f32x4& b) { u32x4 w; w.x = cvt_pk_bf16(a[0], a[1]); w.y = cvt_pk_bf16(a[2], a[3]); w.z = cvt_pk_bf16(b[0], b[1]); w.w = cvt_pk_bf16(b[2], b[3]); return w; }
#ifdef WT_OFF
__device__ __forceinline__ void st16_wt(void* p, const u32x4& v) { *(u32x4*)p = v; }
#else
__device__ __forceinline__ void st16_wt(void* p, const u32x4& v) { asm volatile("global_store_dwordx4 %0, %1, off sc1\n\ts_nop 1" :: "v"(p), "v"(v)); }
#endif
__device__ __forceinline__ float silu_f(float g) { return g * __builtin_amdgcn_rcpf(1.0f + __builtin_amdgcn_exp2f(-g * 1.4426950408889634f)); }
__device__ __forceinline__ float rstd_from_ssq(const float* ssq, int row, int fq) {
    const f32x4 p = *(const f32x4*)(ssq + (size_t)row * 16 + 4 * fq);
    float s = (p[0] + p[1]) + (p[2] + p[3]); s += __shfl_xor(s, 16); s += __shfl_xor(s, 32);
    return __builtin_amdgcn_rsqf(s * (1.0f / 1024.0f) + 1e-6f);
}
#ifndef EPI_TWICE
#define EPI_TWICE 0
#endif
template <int RSMODE  > struct EpiSwiGLU {
    static constexpr bool PERM = true, AFTER_DRAIN = false, TWICE_OK = (EPI_TWICE == 1);
    bf16_t* H; const float* rs;
    __device__ __forceinline__ void operator()(const f32x4 (&acc)[2][2][4][2], const Unit& u, int wr, int wc, int fr, int fq) const {
        const int row0 = u.pm * BM + wr * 64 + fr, col0 = u.pn * 128 + wc * 32 + 8 * fq;
#pragma unroll
        for (int ai = 0; ai < 2; ++ai)
#pragma unroll
            for (int m = 0; m < 4; ++m) { const int row = row0 + ai * HALF + m * 16;
                const float s = RSMODE == 0 ? rs[row] : rstd_from_ssq(rs, row, fq);
                const float s2 = s * -1.4426950408889634f, ss = s * s;
                f32x4 h0, h1;
#pragma unroll
                for (int e = 0; e < 4; e += 2) {
                    { const f32x2 g = {acc[ai][0][m][0][e], acc[ai][0][m][0][e + 1]}, u = {acc[ai][1][m][0][e], acc[ai][1][m][0][e + 1]}; const f32x2 t = g * s2;
                      const f32x2 den = (f32x2){__builtin_amdgcn_exp2f(t.x), __builtin_amdgcn_exp2f(t.y)} + 1.0f; const f32x2 r = {__builtin_amdgcn_rcpf(den.x), __builtin_amdgcn_rcpf(den.y)};
                      const f32x2 h = (g * u) * (r * ss); h0[e] = h.x; h0[e + 1] = h.y; }
                    { const f32x2 g = {acc[ai][0][m][1][e], acc[ai][0][m][1][e + 1]}, u = {acc[ai][1][m][1][e], acc[ai][1][m][1][e + 1]}; const f32x2 t = g * s2;
                      const f32x2 den = (f32x2){__builtin_amdgcn_exp2f(t.x), __builtin_amdgcn_exp2f(t.y)} + 1.0f; const f32x2 r = {__builtin_amdgcn_rcpf(den.x), __builtin_amdgcn_rcpf(den.y)};
                      const f32x2 h = (g * u) * (r * ss); h1[e] = h.x; h1[e + 1] = h.y; } }
                st16_wt(H + (size_t)row * 2816 + col0, pack8(h0, h1)); }
    }
};
__device__ __forceinline__ f32x4 bf4lo(const u32x4& w) { f32x4 r; r[0] = __builtin_bit_cast(float, w.x << 16); r[1] = __builtin_bit_cast(float, w.x & 0xffff0000u); r[2] = __builtin_bit_cast(float, w.y << 16); r[3] = __builtin_bit_cast(float, w.y & 0xffff0000u); return r; }
__device__ __forceinline__ f32x4 bf4hi(const u32x4& w) { f32x4 r; r[0] = __builtin_bit_cast(float, w.z << 16); r[1] = __builtin_bit_cast(float, w.z & 0xffff0000u); r[2] = __builtin_bit_cast(float, w.w << 16); r[3] = __builtin_bit_cast(float, w.w & 0xffff0000u); return r; }
template <int KIND> struct EpiResid {
    static constexpr bool PERM = true, AFTER_DRAIN = false, TWICE_OK = (EPI_TWICE == 3 && KIND == 2);
    bf16_t* xb; float* out; float* ssq; bf16_t* xo;
    __device__ __forceinline__ void operator()(const f32x4 (&acc)[2][2][4][2], const Unit& u, int wr, int wc, int fr, int fq) const {
        const int row0 = u.pm * BM + wr * 64 + fr, col0 = u.pn * BM + wc * 32 + 8 * fq;
        const float sc = KIND == 1 ? 1.0f : 0.5f;
        u32x4 r0 = *(const u32x4*)(xb + (size_t)row0 * 1024 + col0), r1 = *(const u32x4*)(xb + (size_t)row0 * 1024 + col0 + HALF);
#pragma unroll
        for (int ai = 0; ai < 2; ++ai)
#pragma unroll
            for (int m = 0; m < 4; ++m) { const int row = row0 + ai * HALF + m * 16;
                const u32x4 c0 = r0, c1 = r1;
                if (ai * 4 + m < 7) { const int nrow = row0 + ((ai * 4 + m + 1) >> 2) * HALF + ((ai * 4 + m + 1) & 3) * 16;
                    r0 = *(const u32x4*)(xb + (size_t)nrow * 1024 + col0); r1 = *(const u32x4*)(xb + (size_t)nrow * 1024 + col0 + HALF); }
                const f32x4 v00 = bf4lo(c0) + acc[ai][0][m][0] * sc, v01 = bf4hi(c0) + acc[ai][0][m][1] * sc, v10 = bf4lo(c1) + acc[ai][1][m][0] * sc, v11 = bf4hi(c1) + acc[ai][1][m][1] * sc;
                if (KIND < 2) {
                    st16_wt(xo + (size_t)row * 1024 + col0, pack8(v00, v01)); st16_wt(xo + (size_t)row * 1024 + col0 + HALF, pack8(v10, v11));
                    float ss = (v00[0] * v00[0] + v00[1] * v00[1]) + (v00[2] * v00[2] + v00[3] * v00[3]) + (v01[0] * v01[0] + v01[1] * v01[1]) + (v01[2] * v01[2] + v01[3] * v01[3]);
                    ss += (v10[0] * v10[0] + v10[1] * v10[1]) + (v10[2] * v10[2] + v10[3] * v10[3]) + (v11[0] * v11[0] + v11[1] * v11[1]) + (v11[2] * v11[2] + v11[3] * v11[3]);
                    ss += __shfl_xor(ss, 16); ss += __shfl_xor(ss, 32); if (fq == 0) __hip_atomic_store(ssq + (size_t)row * 16 + u.pn * 4 + wc, ss, __ATOMIC_RELAXED, __HIP_MEMORY_SCOPE_AGENT);
                } else { float* orow = out + (size_t)row * 1024 + col0;
                    __builtin_nontemporal_store(v00, (f32x4*)orow); __builtin_nontemporal_store(v01, (f32x4*)(orow + 4)); __builtin_nontemporal_store(v10, (f32x4*)(orow + HALF)); __builtin_nontemporal_store(v11, (f32x4*)(orow + HALF + 4)); } }
    }
};
struct EpiWinPtrs { const float* ssq1; bf16_t* Q; unsigned char *KVP, *KVS; bf16_t *XR, *XG; float* out; const float *gq, *gk; };
template <class T> __device__ __forceinline__ T* uoff(const void* ub, unsigned off) { return (T*)((unsigned char*)ub + off); }
__device__ __forceinline__ float rstd_from_p(const f32x4* pp) { const f32x4 p = *pp; float s = (p[0] + p[1]) + (p[2] + p[3]); s += __shfl_xor(s, 16); s += __shfl_xor(s, 32); return __builtin_amdgcn_rsqf(s * (1.0f / 1024.0f) + 1e-6f); }
__device__ __forceinline__ unsigned char* tile_u(const EpiWinPtrs& P, bool prm, int rt, int h) {
    return prm ? P.KVP + (size_t)((((rt >> 13) * 4 + h) * 128) + ((rt & 8191) >> 6)) * 32768 : P.KVS + (size_t)(((rt - 32768) >> 6) * 4 + h) * 32768; }
template <int KIND> __device__ __forceinline__ void win_qk(const EpiWinPtrs P, const f32x4 (&acc)[2][2][4][2], const Unit& u, int wr, int wc, int fr, int fq) {
    const int rowb = u.pm * BM + wr * 64, half = u.pn & 1; const bool prm = u.pm < 128;
    const float* gp = KIND == 0 ? P.gq : P.gk; const float qs = KIND == 0 ? 0.125f * 1.4426950408889634f : 1.0f;
    const f32x4 g00 = *(const f32x4*)(gp + 8 * fq) * qs, g01 = *(const f32x4*)(gp + 8 * fq + 4) * qs, g10 = *(const f32x4*)(gp + 32 + 8 * fq) * qs, g11 = *(const f32x4*)(gp + 32 + 8 * fq + 4) * qs;
    const int cbase = 256 * half + 64 * wc + 8 * fq;
    const float* sp = P.ssq1 + (size_t)rowb * 16; const unsigned sl = (unsigned)(fr * 16 + 4 * fq) * 4u;
    const bf16_t* qb = P.Q + (size_t)rowb * 512; const unsigned ql = (unsigned)(fr * 512 + cbase) * 2u;
    const float* ob = prm ? P.out + 35651584 + (size_t)rowb * 512 : P.out + 69214208 + (size_t)(rowb - 32768) * 512; const unsigned ol = (unsigned)(fr * 512 + cbase) * 4u;
    const unsigned il = (unsigned)((wc & 1) * 8192 + fq * 1024 + fr * 16);
#pragma unroll
    for (int ai = 0; ai < 2; ++ai) {
        const unsigned char* tbu = KIND == 1 ? tile_u(P, prm, rowb + ai * HALF, 2 * half + (wc >> 1)) : nullptr;
#pragma unroll
        for (int m = 0; m < 4; ++m) { constexpr int dummy = 0; (void)dummy; const int ro = ai * HALF + m * 16;
            const float rs = rstd_from_p(uoff<const f32x4>(sp + ro * 16, sl));
            const f32x4 &c00 = acc[ai][0][m][0], &c01 = acc[ai][0][m][1], &c10 = acc[ai][1][m][0], &c11 = acc[ai][1][m][1];
            const f32x4 q = c00 * c00 + c01 * c01 + c10 * c10 + c11 * c11;
            float ss = (q[0] + q[1]) + (q[2] + q[3]);
            ss += __shfl_xor(ss, 16); ss += __shfl_xor(ss, 32);
            const float rn = rs * __builtin_amdgcn_rsqf(ss * (rs * rs) * (1.0f / 64.0f) + 1e-6f);
            const f32x4 a0 = c00 * rn * g00, b0 = c01 * rn * g01, a1 = c10 * rn * g10, b1 = c11 * rn * g11;
            if (KIND == 0) { *uoff<u32x4>(qb + ro * 512, ql) = pack8(a0, b0); *uoff<u32x4>(qb + ro * 512, ql + 64u) = pack8(a1, b1); }
            else { const float* o = ob + ro * 512;
                __builtin_nontemporal_store(a0, uoff<f32x4>(o, ol)); __builtin_nontemporal_store(b0, uoff<f32x4>(o, ol + 16u)); __builtin_nontemporal_store(a1, uoff<f32x4>(o, ol + 128u)); __builtin_nontemporal_store(b1, uoff<f32x4>(o, ol + 144u));
                *uoff<u32x4>(tbu, il + m * 256u) = pack8(a0, b0); *uoff<u32x4>(tbu, il + m * 256u + 4096u) = pack8(a1, b1); }
            asm volatile("" ::: "memory"); }
    }
}
template <int KIND> __device__ __forceinline__ void win_plain(const EpiWinPtrs P, const f32x4 (&acc)[2][2][4][2], const Unit& u, int wr, int wc, int fr, int fq) {
    const int rowb = u.pm * BM + wr * 64, half = u.pn & 1; const bool prm = u.pm < 128;
    const int cbase = 256 * half + 32 * wc + 8 * fq;
    const float* sp = P.ssq1 + (size_t)rowb * 16; const unsigned sl = (unsigned)(fr * 16 + 4 * fq) * 4u;
    const bf16_t* db = (KIND == 3 ? P.XR : P.XG) + (size_t)rowb * 512; const unsigned dl = (unsigned)(fr * 512 + cbase) * 2u;
    const float* ob = prm ? P.out + 52428800 + (size_t)rowb * 512 : P.out + 70262784 + (size_t)(rowb - 32768) * 512; const unsigned ol = (unsigned)(fr * 512 + cbase) * 4u;
    const unsigned il = (unsigned)(16384 + wc * 4096 + fr * 64 + fq * 16);
#pragma unroll
    for (int ai = 0; ai < 2; ++ai) {
        const unsigned char* tb0 = KIND == 2 ? tile_u(P, prm, rowb + ai * HALF, 2 * half) : nullptr;
        const size_t hstride = prm ? (size_t)128 * 32768 : (size_t)32768;
        const bool tailblk = KIND == 3 && (prm ? ((rowb + ai * HALF) & 8191) == 8128 : true);
#pragma unroll
        for (int m = 0; m < 4; ++m) { const int ro = ai * HALF + m * 16;
            const float rs = rstd_from_p(uoff<const f32x4>(sp + ro * 16, sl));
#pragma unroll
            for (int bj = 0; bj < 2; ++bj) { const f32x4 a = acc[ai][bj][m][0] * rs, b = acc[ai][bj][m][1] * rs;
                if (KIND == 2) { *uoff<u32x4>(tb0 + bj * hstride, il + m * 1024u) = pack8(a, b);
                    const float* o = ob + ro * 512 + 128 * bj; __builtin_nontemporal_store(a, uoff<f32x4>(o, ol)); __builtin_nontemporal_store(b, uoff<f32x4>(o, ol + 16u)); }
                else *uoff<u32x4>(db + ro * 512 + 128 * bj, dl) = pack8(a, b);
                if (KIND == 3 && m == 3) { if (tailblk && fr >= 13) { const int row = rowb + ro + fr;
                    float* o = (prm ? P.out + 69208064 + (size_t)((row >> 13) * 3 + ((row & 8191) - 8189)) * 512 : P.out + 71327744 + (size_t)(((row - 32768) >> 6) * 3 + (((row - 32768) & 63) - 61)) * 512) + cbase + 128 * bj;
                    *(f32x4*)o = a; *(f32x4*)(o + 4) = b; } } }
            asm volatile("" ::: "memory"); }
    }
}
struct EpiWin {
    static constexpr bool PERM = true, AFTER_DRAIN = false, TWICE_OK = (EPI_TWICE == 2);
    unsigned char* wsb; float* out; const float *gq, *gk;
    __device__ __forceinline__ void operator()(const f32x4 (&acc)[2][2][4][2], const Unit& u, int wr, int wc, int fr, int fq) const {
        unsigned char* w = wsb; asm volatile("" : "+s"(w));
        const EpiWinPtrs P{(const float*)(w + OFF_SSQ1), (bf16_t*)((unsigned char*)out + OB_Q), w + OFF_KVP, w + OFF_KVS, (bf16_t*)((unsigned char*)out + OB_XR), (bf16_t*)((unsigned char*)out + OB_XG), out, gq, gk};
        const int kind = u.pn >> 1;
        if (kind == 0) win_qk<0>(P, acc, u, wr, wc, fr, fq);
        else if (kind == 1) win_qk<1>(P, acc, u, wr, wc, fr, fq);
        else if (kind == 2) win_plain<2>(P, acc, u, wr, wc, fr, fq);
        else if (kind == 3) win_plain<3>(P, acc, u, wr, wc, fr, fq);
        else win_plain<4>(P, acc, u, wr, wc, fr, fq);
    }
};
template <class Epi, class Sched, bool ALIGN_EPI = false, bool SP2 = false>
__device__ __forceinline__ void gemm_phase(PG8_LAS unsigned char* lds, const Gemm g, const Sched& S, const Epi& E, int tid_in) {
    int tid_ = threadIdx.x; (void)tid_in; asm volatile("" : "+v"(tid_));
    const int tid = tid_, wid = __builtin_amdgcn_readfirstlane(tid >> 6), lane = tid & 63, wr = wid >> 2, wc = wid & 3, fr = lane & 15, fq = lane >> 4;
    const int K = g.K;
    unsigned voffA[2], voffB[2];
#pragma unroll
    for (int i = 0; i < 2; ++i) { int R, C; stage_rc(tid * 16 + i * 8192, R, C); const int Rb = Epi::PERM ? ((R & ~31) + perm32(R & 31)) : R;
        voffA[i] = (unsigned)(R * K + C) * 2u; voffB[i] = (unsigned)(Rb * K + C) * 2u; }
    const size_t kstep = (size_t)(BK * 2);
    const size_t hstep = (size_t)HALF * K * 2;
    const size_t tstep = 2 * hstep;
    const unsigned ldsw = (unsigned)wid * 1024u;
    const int aoff = lds_byte(wr * 64 + fr, fq * 8), boff = lds_byte(wc * 32 + fr, fq * 8);
#define PG8_SA(b, h) (((b) * 2 + (h)) * HTB)
#define PG8_SB(b, h) ((4 + (b) * 2 + (h)) * HTB)
#define PG8_STAGE(bufoff, gbase, voff) do { _Pragma("unroll") for (int _i = 0; _i < 2; ++_i) \
        __builtin_amdgcn_global_load_lds((const unsigned*)((const char*)(gbase) + (voff)[_i]), (PG8_LAS unsigned*)(lds + (bufoff) + ldsw + _i * 8192), 16, 0, 0); } while (0)
#define PG8_LDA(dst, b, h) do { _Pragma("unroll") for (int m = 0; m < 4; ++m) _Pragma("unroll") for (int k = 0; k < 2; ++k) dst[m][k] = *(const PG8_LAS bf16x8*)(lds + PG8_SA(b, h) + aoff + m * 2048 + k * 1024); } while (0)
#define PG8_LDB(dst, b, h) do { _Pragma("unroll") for (int n = 0; n < 2; ++n) _Pragma("unroll") for (int k = 0; k < 2; ++k) dst[n][k] = *(const PG8_LAS bf16x8*)(lds + PG8_SB(b, h) + boff + n * 2048 + k * 1024); } while (0)
#define PG8_MMA(ai, bj, At, Bt) do { __builtin_amdgcn_s_setprio(1); _Pragma("unroll") for (int m = 0; m < 4; ++m) _Pragma("unroll") for (int n = 0; n < 2; ++n) _Pragma("unroll") for (int k = 0; k < 2; ++k) \
        acc[ai][bj][m][n] = __builtin_amdgcn_mfma_f32_16x16x32_bf16(Bt[n][k], At[m][k], acc[ai][bj][m][n], 0, 0, 0); __builtin_amdgcn_s_setprio(0); } while (0)
#define PG8_WAIT_V(n) asm volatile("s_waitcnt vmcnt(" #n ")" ::: "memory")
#define PG8_WAIT_L(n) asm volatile("s_waitcnt lgkmcnt(" #n ")" ::: "memory")
#define PG8_BAR __builtin_amdgcn_s_barrier()
#define PG8_SCHED __builtin_amdgcn_sched_barrier(0)
    Unit cur, nxt; int ui = 0;
    if (!S.next(0, cur)) return;
    f32x4 acc[2][2][4][2];
#pragma unroll
    for (int a = 0; a < 2; ++a)
#pragma unroll
        for (int b = 0; b < 2; ++b)
#pragma unroll
            for (int m = 0; m < 4; ++m)
#pragma unroll
                for (int n = 0; n < 2; ++n) acc[a][b][m][n] = (f32x4){0.f, 0.f, 0.f, 0.f};
    bf16x8 At[4][2], B0[2][2], B1[2][2];
    const char* cA = (const char*)g.A + (size_t)cur.pm * tstep + (Sched::SPLIT ? (size_t)cur.kt0 * kstep : (size_t)0); const char* cB = (const char*)g.Bt + (size_t)cur.pn * tstep + (Sched::SPLIT ? (size_t)cur.kt0 * kstep : (size_t)0);
    S.a_ready(cur, S.poll(cur));
    unsigned pv = 0u;
    if constexpr (SP2) {
        PG8_STAGE(PG8_SB(0, 0), cB, voffB); PG8_STAGE(PG8_SB(0, 1), cB + hstep, voffB); PG8_STAGE(PG8_SA(0, 0), cA, voffA); PG8_STAGE(PG8_SA(0, 1), cA + hstep, voffA);
        if (wr == 1) PG8_BAR;
        PG8_WAIT_V(2); PG8_BAR;
        PG8_STAGE(PG8_SB(1, 0), cB + kstep, voffB); PG8_STAGE(PG8_SA(1, 0), cA + kstep, voffA); PG8_STAGE(PG8_SB(1, 1), cB + hstep + kstep, voffB);
        PG8_WAIT_V(6); PG8_BAR;
    } else {
        PG8_STAGE(PG8_SB(0, 0), cB, voffB); PG8_STAGE(PG8_SA(0, 0), cA, voffA); PG8_STAGE(PG8_SB(0, 1), cB + hstep, voffB); PG8_STAGE(PG8_SA(0, 1), cA + hstep, voffA);
        if (wr == 1) PG8_BAR;
        PG8_WAIT_V(4); PG8_BAR;
        PG8_STAGE(PG8_SB(1, 0), cB + kstep, voffB); PG8_STAGE(PG8_SA(1, 0), cA + kstep, voffA); PG8_STAGE(PG8_SB(1, 1), cB + hstep + kstep, voffB);
        PG8_WAIT_V(6); PG8_BAR;
    }
    for (;;) {
        const bool has_next = S.next(ui + 1, nxt);
        const char* nA = has_next ? (const char*)g.A + (size_t)nxt.pm * tstep + (Sched::SPLIT ? (size_t)nxt.kt0 * kstep : (size_t)0) : cA; const char* nB = has_next ? (const char*)g.Bt + (size_t)nxt.pn * tstep + (Sched::SPLIT ? (size_t)nxt.kt0 * kstep : (size_t)0) : cB;
        const int nt = Sched::SPLIT ? cur.nkt : K / BK;
        for (int t = 0; t < nt; t += 2) {
            const bool last = (t == nt - 2);
            const char* a1 = cA + (size_t)(t + 1) * kstep;
            const char* a2 = last ? nA : cA + (size_t)(t + 2) * kstep; const char* b2 = last ? nB : cB + (size_t)(t + 2) * kstep;
            const char* a3 = a2 + kstep; const char* b3 = b2 + kstep;
            if constexpr ((Sched::DEPF & 1) != 0) { if (has_next && t == nt - 4) pv = S.poll(nxt); }
            if (last && has_next) { S.a_ready(nxt, pv); pv = 0u; }
            if constexpr (SP2) {
            PG8_LDB(B0, 0, 0); PG8_LDB(B1, 0, 1); PG8_SCHED; PG8_LDA(At, 0, 0); PG8_STAGE(PG8_SA(1, 1), a1 + hstep, voffA);
            PG8_WAIT_V(8); PG8_WAIT_L(0); PG8_BAR; PG8_MMA(0, 0, At, B0); PG8_MMA(0, 1, At, B1); PG8_BAR; PG8_SCHED;
            PG8_LDA(At, 0, 1); PG8_STAGE(PG8_SB(0, 0), b2, voffB); PG8_STAGE(PG8_SB(0, 1), b2 + hstep, voffB); PG8_STAGE(PG8_SA(0, 0), a2, voffA);
            PG8_WAIT_V(8); PG8_WAIT_L(0); PG8_BAR; PG8_MMA(1, 0, At, B0); PG8_MMA(1, 1, At, B1); PG8_BAR; PG8_SCHED;
            PG8_LDB(B0, 1, 0); PG8_LDB(B1, 1, 1); PG8_SCHED; PG8_LDA(At, 1, 0); PG8_STAGE(PG8_SA(0, 1), a2 + hstep, voffA);
            PG8_WAIT_V(8); PG8_WAIT_L(0); PG8_BAR; PG8_MMA(0, 0, At, B0); PG8_MMA(0, 1, At, B1); PG8_BAR; PG8_SCHED;
            PG8_LDA(At, 1, 1); PG8_STAGE(PG8_SB(1, 0), b3, voffB); PG8_STAGE(PG8_SB(1, 1), b3 + hstep, voffB); PG8_STAGE(PG8_SA(1, 0), a3, voffA);
            PG8_WAIT_V(8); PG8_WAIT_L(0); PG8_BAR; PG8_MMA(1, 0, At, B0); PG8_MMA(1, 1, At, B1); PG8_BAR; PG8_SCHED;
            } else {
            PG8_LDB(B0, 0, 0); PG8_SCHED; PG8_LDA(At, 0, 0); PG8_STAGE(PG8_SA(1, 1), a1 + hstep, voffA);
            PG8_WAIT_L(8); PG8_BAR; PG8_WAIT_L(0); PG8_MMA(0, 0, At, B0); PG8_BAR; PG8_SCHED;
            PG8_LDB(B1, 0, 1); PG8_STAGE(PG8_SB(0, 0), b2, voffB);
            PG8_BAR; PG8_WAIT_L(0); PG8_MMA(0, 1, At, B1); PG8_BAR;
            PG8_LDA(At, 0, 1); PG8_STAGE(PG8_SA(0, 0), a2, voffA);
            PG8_BAR; PG8_WAIT_L(0); PG8_MMA(1, 0, At, B0); PG8_BAR; PG8_SCHED;
            PG8_STAGE(PG8_SB(0, 1), b2 + hstep, voffB);
            PG8_WAIT_V(6); PG8_BAR; PG8_MMA(1, 1, At, B1); PG8_BAR;
            PG8_LDB(B0, 1, 0); PG8_SCHED; PG8_LDA(At, 1, 0); PG8_STAGE(PG8_SA(0, 1), a2 + hstep, voffA);
            PG8_WAIT_L(8); PG8_BAR; PG8_WAIT_L(0); PG8_MMA(0, 0, At, B0); PG8_BAR; PG8_SCHED;
            PG8_LDB(B1, 1, 1); PG8_STAGE(PG8_SB(1, 0), b3, voffB);
            PG8_BAR; PG8_WAIT_L(0); PG8_MMA(0, 1, At, B1); PG8_BAR;
            PG8_LDA(At, 1, 1); PG8_STAGE(PG8_SA(1, 0), a3, voffA);
            PG8_BAR; PG8_WAIT_L(0); PG8_MMA(1, 0, At, B0); PG8_BAR; PG8_SCHED;
            PG8_STAGE(PG8_SB(1, 1), b3 + hstep, voffB);
            PG8_WAIT_V(6); PG8_BAR; PG8_MMA(1, 1, At, B1); PG8_BAR;
            }
        }
        if constexpr (ALIGN_EPI) { if (wr == 0) PG8_BAR; }
        if constexpr (!Epi::AFTER_DRAIN) { if (Sched::SPLIT && cur.kind == 1) S.put_partial(acc, tid, lane); else { E(acc, cur, wr, wc, fr, fq);
#if EPI_TWICE
            if (Epi::TWICE_OK) { asm volatile("" ::: "memory"); E(acc, cur, wr, wc, fr, fq); }
#endif
            } S.done(cur); }
        if (!has_next) break;
        if (Sched::SPLIT && nxt.kind == 2) S.load_partial(acc, tid, lane);
        else {
#pragma unroll
        for (int a = 0; a < 2; ++a)
#pragma unroll
            for (int b = 0; b < 2; ++b)
#pragma unroll
                for (int m = 0; m < 4; ++m)
#pragma unroll
                    for (int n = 0; n < 2; ++n) acc[a][b][m][n] = (f32x4){0.f, 0.f, 0.f, 0.f};
        }
        cur = nxt; cA = nA; cB = nB; ++ui;
        if constexpr (ALIGN_EPI) { if (wr == 1) PG8_BAR; }
    }
    PG8_WAIT_V(0);
    if constexpr (!ALIGN_EPI) { if (wr == 0) PG8_BAR; }
    PG8_BAR;
    if constexpr (Epi::AFTER_DRAIN) { E.fused(acc, cur, wr, wc, fr, fq, lds, wid, lane); S.done(cur); }
#undef PG8_SA
#undef PG8_SB
#undef PG8_STAGE
#undef PG8_LDA
#undef PG8_LDB
#undef PG8_MMA
#undef PG8_WAIT_V
#undef PG8_WAIT_L
#undef PG8_BAR
#undef PG8_SCHED
}
}

constexpr size_t MiB = 1u << 20;
constexpr size_t WS_CTL = 0, CTL_ZERO_BYTES = 64 * 1024;
constexpr size_t WS_W1GU = 1 * MiB, WS_W1D = 12 * MiB, WS_W2GU = 18 * MiB, WS_W2D = 29 * MiB, WS_WIN = 35 * MiB, WS_WOUT = 40 * MiB;
constexpr size_t WS_GATEW = 42 * MiB;
constexpr size_t WS_SP8 = WS_GATEW + 256 * 1024;
constexpr size_t WS_RSTD0 = 43 * MiB;
constexpr size_t WS_SSQ1 = 44 * MiB, WS_SSQ2 = 47 * MiB;
constexpr size_t WS_LSUM = 50 * MiB;
constexpr size_t WS_XB = 53 * MiB;
constexpr size_t WS_XB1 = 444 * MiB;
constexpr size_t WS_H = 121 * MiB;
constexpr size_t WS_KVP = 376 * MiB, WS_KVS = 440 * MiB;
constexpr size_t WS_CAT = 308 * MiB;
constexpr size_t WS_END = 512 * MiB;
static_assert(OFF_SSQ1 == WS_SSQ1 && OFF_KVP == WS_KVP && OFF_KVS == WS_KVS, "epilogue offsets");
static_assert(WS_H + (size_t)TT * FF * 2 <= WS_CAT && WS_XB + (size_t)TT * DM * 2 <= WS_H && OB_XG + (size_t)TT * 512 * 2 <= (size_t)TT * DM * 4, "d_ws map");
constexpr int CW_BAR = 1024;
constexpr int CW_SK = 12288;
constexpr int CW_QUEUE = 8192;
constexpr int CW_DEP = 4608;
constexpr int CW_CONVQ = 7936;
static_assert(CW_BAR + 3456 <= CW_DEP && CW_DEP + 6 * 136 * 4 <= CW_CONVQ && CW_CONVQ < CW_QUEUE, "control words");

constexpr int RING_BYTES = 131072;
constexpr int MISC_OFF = RING_BYTES;
constexpr int LDS_BYTES = 147456;

#define GAS __attribute__((address_space(1)))
#define LAS __attribute__((address_space(3)))
typedef unsigned short bf16;
typedef unsigned v4u __attribute__((ext_vector_type(4)));
typedef unsigned v2u __attribute__((ext_vector_type(2)));
typedef float f32x4 __attribute__((ext_vector_type(4)));
typedef float f32x16 __attribute__((ext_vector_type(16)));
typedef short bf16x8 __attribute__((ext_vector_type(8)));
typedef short s16x4 __attribute__((ext_vector_type(4)));
#define LDS_WAIT() asm volatile("s_waitcnt lgkmcnt(0)" ::: "memory")
#define VM_WAIT() asm volatile("s_waitcnt vmcnt(0)" ::: "memory")
__device__ __forceinline__ unsigned f2bf(float f) { unsigned u = __builtin_bit_cast(unsigned, f); return (u + 0x7fffu + ((u >> 16) & 1u)) >> 16; }
__device__ __forceinline__ unsigned pk2(float lo, float hi) { return f2bf(lo) | (f2bf(hi) << 16); }
__device__ __forceinline__ float bf2f(unsigned short b) { return __builtin_bit_cast(float, (unsigned)b << 16); }
__device__ __forceinline__ float bflo(unsigned w) { return __builtin_bit_cast(float, w << 16); }
__device__ __forceinline__ float bfhi(unsigned w) { return __builtin_bit_cast(float, w & 0xffff0000u); }
__device__ __forceinline__ int lane_id() { return (int)__builtin_amdgcn_mbcnt_hi(~0u, __builtin_amdgcn_mbcnt_lo(~0u, 0u)); }
__device__ __forceinline__ float wave_sum(float v) {
#pragma unroll
    for (int o = 1; o < 64; o <<= 1) v += __shfl_xor(v, o);
    return v;
}

#define XB_TMO      128
#define XB_XCNT(j)  (256  + 64 * (j))
#define XB_XSUB(j)  (1280 + 64 * (j))
#define XB_XGEN(j)  (2304 + 64 * (j))
#define XB_TOP      3328
#define XB_TOPGEN   3392
#define XCD_BAR_WORDS 3456
#define XB_SPIN_CAP (1u << 18)

__device__ __forceinline__ unsigned xb_ld(unsigned* p)              { return __hip_atomic_load(p, __ATOMIC_RELAXED, __HIP_MEMORY_SCOPE_AGENT); }
__device__ __forceinline__ unsigned xb_add(unsigned* p, unsigned v) { return __hip_atomic_fetch_add(p, v, __ATOMIC_RELAXED, __HIP_MEMORY_SCOPE_AGENT); }
__device__ __forceinline__ unsigned xb_xcc_id() { return (unsigned)__builtin_amdgcn_s_getreg((3 << 11) | 20) & 0xFu; }
#define XB_SPIN(cond, bar) do { unsigned _sp = 0; while (cond) { __builtin_amdgcn_s_sleep(1); \
    if ((++_sp & 255u) == 0u) { if (xb_ld(&(bar)[XB_TMO])) break; if (_sp > XB_SPIN_CAP) { atomicAdd(&(bar)[XB_TMO], 1u); break; } } } } while (0)

struct XcdBarrier {
    unsigned* bar; unsigned x; int wv;
    volatile LAS unsigned* st;
};

__device__ __forceinline__ XcdBarrier xcd_barrier_post(unsigned* bar, volatile LAS unsigned* st, int wv) {
    XcdBarrier b; b.bar = bar; b.x = xb_xcc_id(); b.st = st; b.wv = wv;
    if (threadIdx.x == 0) (void)xb_add(&bar[XB_XCNT(b.x)], 1u);
    return b;
}
__device__ __forceinline__ void xcd_barrier_complete(unsigned* bar, unsigned x, unsigned& nloc, unsigned& nx) {
    const unsigned G = gridDim.x * gridDim.y * gridDim.z;
    unsigned sum, cnt, mine, sp = 0u;
    for (;;) {
        sum = 0u; cnt = 0u; mine = 0u;
#pragma unroll
        for (unsigned j = 0; j < 16; ++j) { const unsigned c = xb_ld(&bar[XB_XCNT(j)]); sum += c; cnt += (c > 0u) ? 1u : 0u; mine = (j == x) ? c : mine; }
        if (sum == G) break;
        __builtin_amdgcn_s_sleep(1);
        if ((++sp & 255u) == 0u) { if (xb_ld(&bar[XB_TMO])) break; if (sp > XB_SPIN_CAP) { atomicAdd(&bar[XB_TMO], 1u); break; } }
    }
    nloc = mine > 0u ? mine : 1u; nx = cnt > 0u ? cnt : 1u;
}

__device__ __forceinline__ void xcd_barrier(const XcdBarrier& b) {
    asm volatile("s_waitcnt vmcnt(0)" ::: "memory");
    __syncthreads();
    if (threadIdx.x == 0) {
        unsigned* bar = b.bar;
        __builtin_amdgcn_s_waitcnt(0);
        unsigned nloc = b.st[0], nx = b.st[1];
        if (nloc == 0u) { xcd_barrier_complete(bar, b.x, nloc, nx); b.st[0] = nloc; b.st[1] = nx; }
        const unsigned old = xb_add(&bar[XB_XSUB(b.x)], 1u);
        const unsigned gen = old / nloc;
        if (old + 1u == (gen + 1u) * nloc) {
            __builtin_amdgcn_fence(__ATOMIC_RELEASE, "agent");
            asm volatile("s_waitcnt vmcnt(0)" ::: "memory");
            const unsigned og = xb_add(&bar[XB_TOP], 1u);
            const unsigned tg = og / nx;
            if (og + 1u == (tg + 1u) * nx) xb_add(&bar[XB_TOPGEN], 1u);
            else XB_SPIN(xb_ld(&bar[XB_TOPGEN]) == tg, bar);
            __builtin_amdgcn_fence(__ATOMIC_ACQUIRE, "agent");
            xb_add(&bar[XB_XGEN(b.x)], 1u);
            asm volatile("s_waitcnt vmcnt(0)" ::: "memory");
        } else {
            XB_SPIN(xb_ld(&bar[XB_XGEN(b.x)]) == gen, bar);
            __builtin_amdgcn_fence(__ATOMIC_ACQUIRE, "agent");
            asm volatile("s_waitcnt vmcnt(0)" ::: "memory");
        }
    }
    __syncthreads();
}

typedef __attribute__((address_space(4))) const unsigned char* kptr_t;
struct Frame {
    LAS unsigned char* lds;
    int tid, lane, wave, G, bx;
    kptr_t ka; int z;
    float* out; unsigned char* ws;
};
__device__ __forceinline__ const float* fin(const Frame& F, int k) { typedef const float* cfp; return *(const __attribute__((address_space(4))) cfp*)(F.ka + (k * 8 + F.z)); }
#define NEW_PHASE() do { int z_ = 0; asm volatile("" : "+s"(z_)); F.z = z_; } while (0)

__device__ __forceinline__ void p0_transpose_item(const float* W, int K, int N, bf16* WT, int kb, int n0, int drow0, const float* gain, LAS float* scr, int lane) {
    const int k0 = 64 * kb;
#pragma unroll 8
    for (int i = 0; i < 32; ++i) { const int kk = 2 * i + (lane >> 5); float w = __builtin_nontemporal_load(&W[(size_t)(k0 + kk) * N + n0 + (lane & 31)]); if (gain) w *= gain[k0 + kk]; scr[kk * 33 + (lane & 31)] = w; }
    LDS_WAIT(); asm volatile("" ::: "memory");
    const int c = lane & 7;
#pragma unroll
    for (int j = 0; j < 4; ++j) { const int n = (lane >> 3) + 8 * j; const LAS float* s = scr + (8 * c) * 33 + n;
        v4u o; o.x = pk2(s[0 * 33], s[1 * 33]); o.y = pk2(s[2 * 33], s[3 * 33]); o.z = pk2(s[4 * 33], s[5 * 33]); o.w = pk2(s[6 * 33], s[7 * 33]);
        *(GAS v4u*)(WT + (size_t)(drow0 + n) * K + k0 + 8 * c) = o; }
    LDS_WAIT(); asm volatile("" ::: "memory");
}
constexpr int I_GU = 16 * 88, I_DN = 44 * 32, I_IN = 16 * 80, I_OUT = 16 * 32, I_FFN = 2 * I_GU + I_DN, NITEMS = 2 * I_FFN + I_IN + I_OUT;
__device__ __forceinline__ void weight_item(Frame& F, int it, LAS float* scr) {
    unsigned char* ws = F.ws; int r = it;
    if (r < 2 * I_FFN) {
        const int f = r >= I_FFN; r -= f * I_FFN;
        const float* Wg = f == 0 ? fin(F, 8) : fin(F, 30); const float* Wu = f == 0 ? fin(F, 9) : fin(F, 31); const float* Wd = f == 0 ? fin(F, 10) : fin(F, 32); const float* gn = f == 0 ? fin(F, 7) : fin(F, 29);
        bf16* GU = (bf16*)(ws + (f == 0 ? WS_W1GU : WS_W2GU)); bf16* DN = (bf16*)(ws + (f == 0 ? WS_W1D : WS_W2D));
        if (r < 2 * I_GU) { const int up = r >= I_GU; const int q = up ? r - I_GU : r; const int kb = q / 88, nb = q % 88, n0 = 32 * nb;
            p0_transpose_item(up ? Wu : Wg, 1024, FF, GU, kb, n0, 256 * (n0 >> 7) + (n0 & 127) + (up ? 128 : 0), gn, scr, F.lane); }
        else { r -= 2 * I_GU; const int kb = r / 32, nb = r % 32; p0_transpose_item(Wd, FF, 1024, DN, kb, 32 * nb, 32 * nb, nullptr, scr, F.lane); }
        return;
    }
    r -= 2 * I_FFN;
    if (r < I_IN) { const int kb = r / 80, nb = r % 80, n0 = 32 * nb; int dr = n0;
        if (n0 < 1024) { const int oc = n0 & 255, wc = oc >> 6, bj = (oc >> 5) & 1; dr = (n0 & ~255) + 128 * bj + 32 * wc; }
        p0_transpose_item(fin(F, 12), 1024, INW, (bf16*)(ws + WS_WIN), kb, n0, dr, fin(F, 11), scr, F.lane); return; }
    r -= I_IN;
    { const int kb = r / 32, nb = r % 32; p0_transpose_item(fin(F, 28), 1024, 1024, (bf16*)(ws + WS_WOUT), kb, 32 * nb, 32 * nb, nullptr, scr, F.lane); }
}
__device__ __forceinline__ void convert_queue(Frame& F, unsigned* head, LAS int* qi) {
    LAS float* scr = (LAS float*)(F.lds + F.wave * 16384);
    for (;;) {
        if (F.tid == 0) *qi = (int)atomicAdd(head, 1u);
        __syncthreads();
        const int k = *qi * 8 + F.wave;
        __syncthreads();
        if (k - F.wave >= I_FFN + I_OUT) break;
        if (k < I_FFN + I_OUT) weight_item(F, k < I_FFN ? I_FFN + k : 2 * I_FFN + I_IN + (k - I_FFN), scr);
    }
}
__device__ __forceinline__ void kv_expand_in_tail(Frame& F, int nunits) {
    const int W = F.G / 8, q = nunits / 8, rl = (q + W - 1) / W - 1, busy = q - rl * W, w = F.bx / 8, x = F.bx % 8;
    int bidx, nblk;
    if (busy < W) { if (w < busy) return; bidx = (w - busy) * 8 + x; nblk = (W - busy) * 8; } else { bidx = F.bx; nblk = F.G; }
    const int lane = F.lane, wv = F.wave;
    for (int tl = bidx; tl < 2048 + 128; tl += nblk) {
        const unsigned char* img; float* ok; float* ov;
        if (tl < 2048) { const int bh = tl >> 7, t = tl & 127, b = bh >> 2, h = bh & 3; img = F.ws + WS_KVP + (size_t)tl * 32768;
            ok = F.out + O_KP + ((size_t)(b * SEQ + t * 64)) * 512 + h * 128; ov = F.out + O_VP + ((size_t)(b * SEQ + t * 64)) * 512 + h * 128; }
        else { const int u = tl - 2048, sb = u >> 2, h = u & 3; img = F.ws + WS_KVS + (size_t)u * 32768;
            ok = F.out + O_KS + ((size_t)(sb * 64)) * 512 + h * 128; ov = F.out + O_VS + ((size_t)(sb * 64)) * 512 + h * 128; }
#pragma unroll
        for (int r = 0; r < 2; ++r) {
            const int key = 8 * wv + 4 * r + (lane >> 4), cj = lane & 15;
            const v4u kw = *(const GAS v4u*)(img + (cj >> 3) * 8192 + (cj & 7) * 1024 + key * 16);
            const v4u vw = *(const GAS v4u*)(img + 16384 + (cj >> 2) * 4096 + key * 64 + (cj & 3) * 16);
            float* dk = ok + (size_t)key * 512 + cj * 8; float* dv = ov + (size_t)key * 512 + cj * 8;
            *(f32x4*)dk = (f32x4){bflo(kw.x), bfhi(kw.x), bflo(kw.y), bfhi(kw.y)}; *(f32x4*)(dk + 4) = (f32x4){bflo(kw.z), bfhi(kw.z), bflo(kw.w), bfhi(kw.w)};
            *(f32x4*)dv = (f32x4){bflo(vw.x), bfhi(vw.x), bflo(vw.y), bfhi(vw.y)}; *(f32x4*)(dv + 4) = (f32x4){bflo(vw.z), bfhi(vw.z), bflo(vw.w), bfhi(vw.w)};
        }
    }
}
__device__ __forceinline__ void p0_prologue(Frame& F) {
    LAS float* scr = (LAS float*)(F.lds + F.wave * 16384);
    const int gw = F.bx * 8 + F.wave, NGW = F.G * 8;
    unsigned char* ws = F.ws;
    for (int it = gw; it < I_FFN + I_IN; it += NGW) weight_item(F, it < I_FFN ? it : 2 * I_FFN + (it - I_FFN), scr);
    {   bf16* XB = (bf16*)(ws + WS_XB); float* rstd0 = (float*)(ws + WS_RSTD0);
        for (int m0 = gw; m0 < TT; m0 += 4 * NGW) {
            f32x4 v[4][4]; float s[4];
#pragma unroll
            for (int u = 0; u < 4; ++u) { const int m = m0 + u * NGW; s[u] = 0.f;
                if (m < TT) { const float* xrow = m < TP ? fin(F, 0) + (size_t)m * DM : fin(F, 1) + (size_t)(m - TP) * DM; const GAS f32x4* xr = (const GAS f32x4*)xrow + 2 * F.lane;
                    v[u][0] = __builtin_nontemporal_load(xr); v[u][1] = __builtin_nontemporal_load(xr + 1); v[u][2] = __builtin_nontemporal_load(xr + 128); v[u][3] = __builtin_nontemporal_load(xr + 129); } }
#pragma unroll
            for (int u = 0; u < 4; ++u) { const int m = m0 + u * NGW;
                if (m < TT) {
#pragma unroll
                    for (int j = 0; j < 4; ++j) s[u] += (v[u][j].x * v[u][j].x + v[u][j].y * v[u][j].y) + (v[u][j].z * v[u][j].z + v[u][j].w * v[u][j].w);
                    s[u] = wave_sum(s[u]);
                    if (F.lane == 0) rstd0[m] = __builtin_amdgcn_rsqf(s[u] * (1.0f / DM) + EPS);
                    GAS v4u* o16 = (GAS v4u*)(XB + (size_t)m * DM) + F.lane;
                    v4u w0, w1; w0.x = pk2(v[u][0].x, v[u][0].y); w0.y = pk2(v[u][0].z, v[u][0].w); w0.z = pk2(v[u][1].x, v[u][1].y); w0.w = pk2(v[u][1].z, v[u][1].w);
                    w1.x = pk2(v[u][2].x, v[u][2].y); w1.y = pk2(v[u][2].z, v[u][2].w); w1.z = pk2(v[u][3].x, v[u][3].y); w1.w = pk2(v[u][3].z, v[u][3].w);
                    o16[0] = w0; o16[64] = w1; } }
        }
    }
    {   bf16* GW = (bf16*)(ws + WS_GATEW); float* sp8 = (float*)(ws + WS_SP8);
        const int gt = F.bx * 512 + F.tid, NT = F.G * 512;
        for (int i = gt; i < 2 * 8 * 64 * 64; i += NT) { const int g = i >> 15, n = (i >> 12) & 7, j = (i >> 6) & 63, c = i & 63;
            GW[i] = (bf16)f2bf(-LOG2E * (g == 0 ? fin(F, 22) : fin(F, 24))[(n * 64 + c) * 64 + j]); }
        for (int i = gt; i < 512; i += NT) { const float L = fin(F, 26)[i]; sp8[i] = -LOG2E * 8.0f * (L > 20.f ? __expf(-L) : log1pf(__expf(-L))); }
    }
}

namespace lru {
constexpr int L_XC = 0;
constexpr int L_HIN = 65536;
constexpr int L_PART = 65536 + 2048;
constexpr int L_PAR = 135168;
constexpr int L_O0 = 65536 + 4096;
__device__ __forceinline__ int crow(int r, int hi) { return (r & 3) + 8 * (r >> 2) + 4 * hi; }
__device__ __forceinline__ float sigmoid_f(float x) { return __builtin_amdgcn_rcpf(1.0f + __builtin_amdgcn_exp2f(-x * LOG2E)); }

template <int CTRL, int RM> __device__ __forceinline__ float dpp_f(float oldv, float src) {
    return __builtin_bit_cast(float, __builtin_amdgcn_update_dpp(__builtin_bit_cast(int, oldv), __builtin_bit_cast(int, src), CTRL, RM, 0xF, false)); }
#define LRU_SCAN4_STEP(C) \
    "v_fmac_f32_dpp %1, %1, %0 " C "\n\tv_fmac_f32_dpp %3, %3, %2 " C "\n\tv_fmac_f32_dpp %5, %5, %4 " C "\n\tv_fmac_f32_dpp %7, %7, %6 " C "\n\t" \
    "v_mul_f32_dpp %0, %0, %0 " C "\n\tv_mul_f32_dpp %2, %2, %2 " C "\n\tv_mul_f32_dpp %4, %4, %4 " C "\n\tv_mul_f32_dpp %6, %6, %6 " C "\n\t"
#define LRU_SCAN4(a0, b0, a1, b1, a2, b2, a3, b3) asm volatile("s_nop 1\n\t" \
    LRU_SCAN4_STEP("row_shr:1 row_mask:0xf bank_mask:0xf") LRU_SCAN4_STEP("row_shr:2 row_mask:0xf bank_mask:0xf") LRU_SCAN4_STEP("row_shr:4 row_mask:0xf bank_mask:0xf") \
    LRU_SCAN4_STEP("row_shr:8 row_mask:0xf bank_mask:0xf") LRU_SCAN4_STEP("row_bcast:15 row_mask:0xa bank_mask:0xf") \
    : "+v"(a0), "+v"(b0), "+v"(a1), "+v"(b1), "+v"(a2), "+v"(b2), "+v"(a3), "+v"(b3))
#define LRU_SCAN_STEP(CTRL, RM) do { const float ap_ = dpp_f<CTRL, RM>(1.0f, a), bp_ = dpp_f<CTRL, RM>(0.0f, b); b = a * bp_ + b; a = a * ap_; } while (0)
__device__ __forceinline__ float rl_half(float v, int hi) {
    return __builtin_bit_cast(float, __builtin_amdgcn_ds_bpermute((hi * 32 + 31) * 4, __builtin_bit_cast(int, v))); }
template <int PASS> __device__ __forceinline__ void lru_unit(Frame& F, int u) {
    int tid_ = F.tid; asm volatile("" : "+v"(tid_));
    const int tid = tid_, lane = tid & 63, wid = F.wave, r32 = lane & 31, hi = lane >> 5;
    const bool smp = u >= 512; const int sb = u - 512, pb = u >> 7, ck = smp ? 0 : (u & 127);
    const int row0 = smp ? TP + sb * 64 : pb * SEQ + ck * 64;
    const bf16* XR = (const bf16*)((const unsigned char*)F.out + OB_XR); const bf16* XG = (const bf16*)((const unsigned char*)F.out + OB_XG);
    LAS unsigned char* lds = F.lds;
    if (PASS == 2) {
        float h = 0.f;
        if (smp) h = fin(F, 4)[sb * 512 + tid];
        else { const float* S = (const float*)(F.ws + WS_LSUM) + ((size_t)(pb * 128) * 512 + tid) * 2;
            int c = 0;
            for (; c + 32 <= ck; c += 32) { float2 v[32];
#pragma unroll
                for (int k = 0; k < 32; ++k) v[k] = *(const float2*)(S + (size_t)(c + k) * 1024);
#pragma unroll
                for (int k = 0; k < 32; ++k) h = v[k].x * h + v[k].y; }
            for (; c + 8 <= ck; c += 8) { float2 v[8];
#pragma unroll
                for (int k = 0; k < 8; ++k) v[k] = *(const float2*)(S + (size_t)(c + k) * 1024);
#pragma unroll
                for (int k = 0; k < 8; ++k) h = v[k].x * h + v[k].y; }
            for (; c < ck; ++c) { const float2 v = *(const float2*)(S + (size_t)c * 1024); h = v.x * h + v.y; } }
        ((LAS float*)(lds + L_HIN))[tid] = h;
    }
    {   LAS float* par = (LAS float*)(lds + L_PAR);
        par[tid] = -LOG2E * fin(F, 23)[tid]; par[512 + tid] = -LOG2E * fin(F, 25)[tid]; par[1024 + tid] = ((const float*)(F.ws + WS_SP8))[tid]; if (PASS == 2) par[1536 + tid] = fin(F, 27)[tid]; }
    {   const int cg = tid & 63, tg = tid >> 6, c0 = 8 * cg;
        float xw[11][8];
#pragma unroll
        for (int i = 0; i < 11; ++i) { const int tt = 8 * tg + i - 3;
            if (tt >= 0 || ck > 0) { const v4u w = *(const GAS v4u*)(XR + (size_t)(row0 + tt) * 512 + c0);
                xw[i][0] = bflo(w.x); xw[i][1] = bfhi(w.x); xw[i][2] = bflo(w.y); xw[i][3] = bfhi(w.y); xw[i][4] = bflo(w.z); xw[i][5] = bfhi(w.z); xw[i][6] = bflo(w.w); xw[i][7] = bfhi(w.w); }
            else if (smp) { const float* sc = fin(F, 5) + (size_t)(sb * 3 + (tt + 3)) * 512 + c0; const f32x4 a = *(const f32x4*)sc, b = *(const f32x4*)(sc + 4);
                xw[i][0] = a[0]; xw[i][1] = a[1]; xw[i][2] = a[2]; xw[i][3] = a[3]; xw[i][4] = b[0]; xw[i][5] = b[1]; xw[i][6] = b[2]; xw[i][7] = b[3]; }
            else {
#pragma unroll
                for (int e = 0; e < 8; ++e) xw[i][e] = 0.f; } }
        float cw[4][8], cb[8];
#pragma unroll
        for (int j = 0; j < 4; ++j) { const f32x4 a = *(const f32x4*)(fin(F, 20) + j * 512 + c0), b = *(const f32x4*)(fin(F, 20) + j * 512 + c0 + 4);
            cw[j][0] = a[0]; cw[j][1] = a[1]; cw[j][2] = a[2]; cw[j][3] = a[3]; cw[j][4] = b[0]; cw[j][5] = b[1]; cw[j][6] = b[2]; cw[j][7] = b[3]; }
        { const f32x4 a = *(const f32x4*)(fin(F, 21) + c0), b = *(const f32x4*)(fin(F, 21) + c0 + 4); cb[0] = a[0]; cb[1] = a[1]; cb[2] = a[2]; cb[3] = a[3]; cb[4] = b[0]; cb[5] = b[1]; cb[6] = b[2]; cb[7] = b[3]; }
#pragma unroll
        for (int i = 0; i < 8; ++i) { const int t = 8 * tg + i; float xc[8];
#pragma unroll
            for (int e = 0; e < 8; ++e) xc[e] = cb[e] + cw[0][e] * xw[i][e] + cw[1][e] * xw[i + 1][e] + cw[2][e] * xw[i + 2][e] + cw[3][e] * xw[i + 3][e];
            v4u o; o.x = pk2(xc[0], xc[1]); o.y = pk2(xc[2], xc[3]); o.z = pk2(xc[4], xc[5]); o.w = pk2(xc[6], xc[7]);
            *(LAS v4u*)(lds + L_XC + t * 1024 + ((cg ^ (t & 15)) << 4)) = o; }
    }
    LDS_WAIT(); __syncthreads();
    const int n = wid;
    const bf16* GW = (const bf16*)(F.ws + WS_GATEW);
    float ssq_t[2] = {0.f, 0.f};
    float outv[2][16];
#pragma unroll
    for (int jb = 0; jb < 2; ++jb) {
        v2u gwv[4][2];
        if (PASS == 2) {
#pragma unroll
            for (int q4 = 0; q4 < 4; ++q4)
#pragma unroll
                for (int tb = 0; tb < 2; ++tb) gwv[q4][tb] = *(const GAS v2u*)(XG + (size_t)(row0 + tb * 32 + r32) * 512 + 64 * n + 32 * jb + 8 * q4 + 4 * hi); }
        f32x16 accr[2], acci[2];
#pragma unroll
        for (int tb = 0; tb < 2; ++tb) { accr[tb] = f32x16{}; acci[tb] = f32x16{}; }
#pragma unroll
        for (int ks = 0; ks < 4; ++ks) {
            const bf16x8 ar = *(const GAS bf16x8*)(GW + ((size_t)((0 * 8 + n) * 64 + jb * 32 + r32) * 64 + ks * 16 + hi * 8));
            const bf16x8 ax = *(const GAS bf16x8*)(GW + ((size_t)((1 * 8 + n) * 64 + jb * 32 + r32) * 64 + ks * 16 + hi * 8));
#pragma unroll
            for (int tb = 0; tb < 2; ++tb) { const int t = tb * 32 + r32; const int chunk = 8 * n + 2 * ks + hi;
                const bf16x8 bfr = *(const LAS bf16x8*)(lds + L_XC + t * 1024 + ((chunk ^ (t & 15)) << 4));
                accr[tb] = __builtin_amdgcn_mfma_f32_32x32x16_bf16(ar, bfr, accr[tb], 0, 0, 0);
                acci[tb] = __builtin_amdgcn_mfma_f32_32x32x16_bf16(ax, bfr, acci[tb], 0, 0, 0); }
        }
        float av[2][16], bv[2][16];
#pragma unroll
        for (int q4 = 0; q4 < 4; ++q4) {
            const int chb = 64 * n + 32 * jb + 8 * q4 + 4 * hi;
            const f32x4 ba = *(const LAS f32x4*)(lds + L_PAR + chb * 4), bx = *(const LAS f32x4*)(lds + L_PAR + 2048 + chb * 4), sp = *(const LAS f32x4*)(lds + L_PAR + 4096 + chb * 4);
#pragma unroll
            for (int tb = 0; tb < 2; ++tb) { const int t = tb * 32 + r32;
                const v2u xw = *(const LAS v2u*)(lds + L_XC + t * 1024 + ((((chb >> 3) ^ (t & 15)) << 4) | ((chb & 7) << 1)));
                const float xc[4] = {bflo(xw.x), bfhi(xw.x), bflo(xw.y), bfhi(xw.y)};
#pragma unroll
                for (int e = 0; e < 4; ++e) { const int r = 4 * q4 + e;
                    const float rg = __builtin_amdgcn_rcpf(1.0f + __builtin_amdgcn_exp2f(accr[tb][r] + ba[e])), ig = __builtin_amdgcn_rcpf(1.0f + __builtin_amdgcn_exp2f(acci[tb][r] + bx[e]));
                    const float a = __builtin_amdgcn_exp2f(rg * sp[e]);
                    av[tb][r] = a; bv[tb][r] = __builtin_amdgcn_sqrtf(__builtin_fmaf(-a, a, 1.0f)) * (ig * xc[e]); } }
        }
#pragma unroll
        for (int tb = 0; tb < 2; ++tb)
#pragma unroll
            for (int r = 0; r < 16; r += 4) LRU_SCAN4(av[tb][r], bv[tb][r], av[tb][r + 1], bv[tb][r + 1], av[tb][r + 2], bv[tb][r + 2], av[tb][r + 3], bv[tb][r + 3]);
#pragma unroll
        for (int r = 0; r < 16; ++r) {
            const float A0 = rl_half(av[0][r], hi), B0 = rl_half(bv[0][r], hi);
            bv[1][r] = av[1][r] * B0 + bv[1][r]; av[1][r] = av[1][r] * A0;
        }
        if (PASS == 1) {
            if (r32 == 31) { float* S = (float*)(F.ws + WS_LSUM) + (size_t)u * 1024;
#pragma unroll
                for (int r = 0; r < 16; ++r) { const int ch = 64 * n + 32 * jb + crow(r, hi); *(float2*)(S + 2 * ch) = make_float2(av[1][r], bv[1][r]); } }
        } else {
#pragma unroll
            for (int q4 = 0; q4 < 4; ++q4) { const int chb = 64 * n + 32 * jb + 8 * q4 + 4 * hi;
                const f32x4 hin = *(const LAS f32x4*)(lds + L_HIN + chb * 4);
#pragma unroll
                for (int tb = 0; tb < 2; ++tb) { const int t = tb * 32 + r32;
                    const v2u gw = gwv[q4][tb];
                    const float xg[4] = {bflo(gw.x), bfhi(gw.x), bflo(gw.y), bfhi(gw.y)};
#pragma unroll
                    for (int e = 0; e < 4; ++e) { const int r = 4 * q4 + e; const float h = av[tb][r] * hin[e] + bv[tb][r];
                        const float x = xg[e], uu = 0.7978845608028654f * (x + 0.044715f * x * x * x);
                        const float ge = x * __builtin_amdgcn_rcpf(1.0f + __builtin_amdgcn_exp2f(-2.0f * LOG2E * uu));
                        const float o = h * ge; ssq_t[tb] += o * o;
                        if (jb == 0) ((LAS float*)(lds + L_O0))[(wid * 32 + tb * 16 + r) * 64 + lane] = o; else outv[tb][r] = o;
                        if (tb == 1 && r32 == 31 && (smp || ck == 127)) { float* dst = smp ? F.out + O_LS + sb * 512 : F.out + O_LP + pb * 512; dst[chb + e] = h; } } } }
        }
        __builtin_amdgcn_sched_barrier(0);
    }
    if (PASS == 2) {
        LAS float* part = (LAS float*)(lds + L_PART);
#pragma unroll
        for (int tb = 0; tb < 2; ++tb) { float s = ssq_t[tb]; s += __shfl_xor(s, 32); if (hi == 0) part[wid * 64 + tb * 32 + r32] = s; }
        LDS_WAIT(); __syncthreads();
        bf16* CAT = (bf16*)(F.ws + WS_CAT);
#pragma unroll
        for (int tb = 0; tb < 2; ++tb) { const int t = tb * 32 + r32; float tot = 0.f;
#pragma unroll
            for (int w = 0; w < 8; ++w) tot += part[w * 64 + t];
            const float rn = __builtin_amdgcn_rsqf(tot * (1.0f / 512.0f) + EPS);
#pragma unroll
            for (int jb = 0; jb < 2; ++jb)
#pragma unroll
                for (int q4 = 0; q4 < 4; ++q4) { const int chb = 64 * n + 32 * jb + 8 * q4 + 4 * hi; const f32x4 gn = *(const LAS f32x4*)(lds + L_PAR + 6144 + chb * 4);
                    float ov[4];
#pragma unroll
                    for (int e = 0; e < 4; ++e) ov[e] = jb == 0 ? ((const LAS float*)(lds + L_O0))[(wid * 32 + tb * 16 + 4 * q4 + e) * 64 + lane] : outv[tb][4 * q4 + e];
                    v2u o; o.x = pk2(ov[0] * rn * gn[0], ov[1] * rn * gn[1]); o.y = pk2(ov[2] * rn * gn[2], ov[3] * rn * gn[3]);
#ifdef NT_CAT
                    __builtin_nontemporal_store(o, (GAS v2u*)(CAT + (size_t)(row0 + t) * 1024 + 512 + chb)); } }
#else
                    *(GAS v2u*)(CAT + (size_t)(row0 + t) * 1024 + 512 + chb) = o; } }
#endif
    }
    LDS_WAIT(); __syncthreads();
}
}

#ifndef ATT_RSTAGE
#define ATT_RSTAGE 0
#endif
#ifndef ATT_PROBE
#define ATT_PROBE 0
#endif
#if ATT_PROBE == 1
#define ATT_PROBE_CODE(kp) { f32x16 q0 = f32x16{}, q1 = f32x16{}; _Pragma("unroll") for (int d0 = 0; d0 < 4; ++d0) { const bf16x8 k0 = *(const __attribute__((address_space(3))) bf16x8*)(kp + d0 * 2048), k1 = *(const __attribute__((address_space(3))) bf16x8*)(kp + d0 * 2048 + 512); \
        q0 = __builtin_amdgcn_mfma_f32_32x32x16_bf16(k0, qr[d0], q0, 0, 0, 0); q1 = __builtin_amdgcn_mfma_f32_32x32x16_bf16(k1, qr[d0], q1, 0, 0, 0); } asm volatile("" :: "v"(q0), "v"(q1)); }
#elif ATT_PROBE == 2
#define ATT_PROBE_CODE(kp) { f32x16 q0 = p0, q1 = p1; _Pragma("unroll") for (int r = 0; r < 16; ++r) { q0[r] = __builtin_amdgcn_exp2f(q0[r] + 1.0f); q1[r] = __builtin_amdgcn_exp2f(q1[r] + 1.0f); } asm volatile("" :: "v"(q0), "v"(q1)); }
#else
#define ATT_PROBE_CODE(kp)
#endif
namespace att {
constexpr int SLOT = 32768, NSLOT = 4;
constexpr int A_RING = 0;
constexpr int A_EX = 0;
constexpr int A_TAB = 131072;
constexpr int A_WSF = 131072 + 1024;
constexpr int A_MISC = 143360;
__device__ __forceinline__ int crow(int r, int hi) { return (r & 3) + 8 * (r >> 2) + 4 * hi; }
__device__ __forceinline__ void glds16(const void* gsrc, unsigned lds_dst) { unsigned keep;
    asm volatile("s_mov_b32 %0, m0\n\ts_mov_b32 m0, %2\n\ts_nop 0\n\tglobal_load_lds_dwordx4 %1, off\n\ts_mov_b32 m0, %0" : "=&s"(keep) : "v"(gsrc), "s"(lds_dst) : "memory"); }
typedef __attribute__((address_space(3))) const char* lds_cptr;
typedef short v4i16_t __attribute__((ext_vector_type(4)));
__device__ __forceinline__ s16x4 vtr(lds_cptr p) { return __builtin_bit_cast(s16x4, __builtin_amdgcn_ds_read_tr16_b64_v4i16((__attribute__((address_space(3))) v4i16_t*)p)); }
__device__ __forceinline__ unsigned cvtpk(float lo, float hi) { typedef float f2 __attribute__((ext_vector_type(2))); typedef __bf16 b2 __attribute__((ext_vector_type(2)));
    f2 v = {lo, hi}; b2 b = __builtin_convertvector(v, b2); return __builtin_bit_cast(unsigned, b); }
#ifdef ATT_QPRIO
#define ATT_PRIO_QK_ON() __builtin_amdgcn_s_setprio(1)
#define ATT_PRIO_QK_OFF() __builtin_amdgcn_s_setprio(0)
#else
#define ATT_PRIO_QK_ON() do {} while (0)
#define ATT_PRIO_QK_OFF() do {} while (0)
#endif
#ifndef ATT_NO_MPRIO
#define ATT_PRIO_ON() __builtin_amdgcn_s_setprio(1)
#define ATT_PRIO_OFF() __builtin_amdgcn_s_setprio(0)
#else
#define ATT_PRIO_ON() do {} while (0)
#define ATT_PRIO_OFF() do {} while (0)
#endif
#define ATT_WAIT_BAR(N) asm volatile("s_waitcnt vmcnt(" #N ") lgkmcnt(0)\n\ts_barrier" ::: "memory")

template <bool SMP, bool DESC> __device__ __forceinline__ void attn_unit(Frame& F, int sidx, int h, int qb, float lam) {
    int tid_ = F.tid; asm volatile("" : "+v"(tid_));
    const int tid = tid_, lane = tid & 63, wid = F.wave, r32 = lane & 31, hi = lane >> 5;
    const int comp = SMP ? (wid >> 1) & 1 : wid >> 2, g = SMP ? ((wid & 1) | ((wid >> 2) << 1)) : (wid & 3);
    LAS unsigned char* lds = F.lds;
    const unsigned lds0 = (unsigned)(uintptr_t)lds;
    const bf16* Qb = (const bf16*)((const unsigned char*)F.out + OB_Q);
    const int qrow0 = SMP ? TP + sidx * 64 : sidx * SEQ + qb * 128;
    const int qpos0 = SMP ? PAST : qb * 128;
    const int NT = SMP ? 33 : 2 * qb + 2;
    const bool active = SMP ? (g < 2) : true;
    const int gq = SMP ? (g & 1) : g;
    const int qw = qpos0 + 32 * gq;
    const int t_last = active ? (qw >> 6) : -1;
    const int t_near0 = (qw - 90) > 0 ? ((qw - 90) >> 6) : 0;
    if (tid < 256) { float v = 0.f;
        if (tid >= 97 && tid <= 250) { const int delta = tid - 187; const int rel = delta < 0 ? -delta : delta; int bk;
            if (rel < 8) bk = rel; else { bk = 2 + (31 - __builtin_clz((unsigned)(rel * rel))); bk = bk > 15 ? 15 : bk; }
            if (delta > 0) bk += 16;
            v = (fin(F, 6)[bk * 4 + h] - fin(F, 6)[15 * 4 + h]) * LOG2E; }
        ((LAS float*)(lds + A_TAB))[tid] = v; }
    const unsigned char* img0 = F.ws + WS_KVP + (size_t)((SMP ? 0 : (sidx * 4 + h)) * 128) * 32768;
    const unsigned char* imgn = F.ws + WS_KVS + (size_t)(sidx * 4 + h) * 32768;
    const unsigned poff = (unsigned)(wid * 1024 + lane * 16);
    const unsigned pdst = lds0 + A_RING + wid * 1024;
#define ATT_TILE(i) (DESC ? NT - 1 - (i) : (i))
#define ATT_ISSUE(i) do { const int i_ = (i); const int t_ = ATT_TILE(i_); const unsigned so_ = (unsigned)((i_ % NSLOT) * SLOT); \
        if (SMP && t_ != 32) break;                                                 \
        const unsigned char* src_ = (SMP ? imgn : img0 + (size_t)t_ * 32768) + poff; \
        glds16(src_, (unsigned)__builtin_amdgcn_readfirstlane(pdst + so_)); \
        glds16(src_ + 8192, (unsigned)__builtin_amdgcn_readfirstlane(pdst + so_ + 8192)); \
        glds16(src_ + 16384, (unsigned)__builtin_amdgcn_readfirstlane(pdst + so_ + 16384)); \
        glds16(src_ + 24576, (unsigned)__builtin_amdgcn_readfirstlane(pdst + so_ + 24576)); } while (0)
    ATT_ISSUE(0); if (NT > 1) ATT_ISSUE(1);
    bf16x8 qr[4];
    { const bf16* Qw = Qb + (size_t)(qrow0 + 32 * gq + r32) * 512 + h * 128 + comp * 64;
#pragma unroll
      for (int d0 = 0; d0 < 4; ++d0) qr[d0] = *(const GAS bf16x8*)(Qw + d0 * 16 + hi * 8); }
    VM_WAIT();
    asm volatile("" : "+v"(qr[0]), "+v"(qr[1]), "+v"(qr[2]), "+v"(qr[3]));
#ifdef ATT_PRIO
    if (comp == ATT_PRIO - 1) __builtin_amdgcn_s_setprio(1);
#endif
    const bool loader = SMP && !active;
    const int wl = wid & 3;
#define ATT_LOAD_TILE(tt, slot_) do { const int t_ = (tt); LAS unsigned char* sl_ = lds + A_RING + (slot_) * SLOT; \
        const float* ck_ = fin(F, 2) + ((size_t)(sidx * PAST + t_ * 64 + wl * 16) * 4 + h) * 128; const float* cv_ = fin(F, 3) + ((size_t)(sidx * PAST + t_ * 64 + wl * 16) * 4 + h) * 128; \
        f32x4 ka_[4][2], va_[4][2]; \
        _Pragma("unroll") for (int u = 0; u < 4; ++u) { const int cj = u * 4 + (lane >> 4); const float* s_ = ck_ + (size_t)(lane & 15) * 512 + cj * 8; \
            ka_[u][0] = __builtin_nontemporal_load((const f32x4*)s_); ka_[u][1] = __builtin_nontemporal_load((const f32x4*)s_ + 1); } \
        _Pragma("unroll") for (int u = 0; u < 4; ++u) { const float* s_ = cv_ + (size_t)(lane >> 2) * 512 + u * 32 + (lane & 3) * 8; \
            va_[u][0] = __builtin_nontemporal_load((const f32x4*)s_); va_[u][1] = __builtin_nontemporal_load((const f32x4*)s_ + 1); } \
        _Pragma("unroll") for (int u = 0; u < 4; ++u) { const int cj = u * 4 + (lane >> 4); v4u o_; o_.x = pk2(ka_[u][0].x, ka_[u][0].y); o_.y = pk2(ka_[u][0].z, ka_[u][0].w); o_.z = pk2(ka_[u][1].x, ka_[u][1].y); o_.w = pk2(ka_[u][1].z, ka_[u][1].w); \
            *(LAS v4u*)(sl_ + (cj >> 3) * 8192 + (cj & 7) * 1024 + (wl * 16 + (lane & 15)) * 16) = o_; } \
        _Pragma("unroll") for (int u = 0; u < 4; ++u) { v4u o_; o_.x = pk2(va_[u][0].x, va_[u][0].y); o_.y = pk2(va_[u][0].z, va_[u][0].w); o_.z = pk2(va_[u][1].x, va_[u][1].y); o_.w = pk2(va_[u][1].z, va_[u][1].w); \
            *(LAS v4u*)(sl_ + 16384 + u * 4096 + (wl * 16 + (lane >> 2)) * 64 + (lane & 3) * 16) = o_; } } while (0)
    if (loader) { ATT_LOAD_TILE(0, 0); ATT_LOAD_TILE(1, 1); VM_WAIT(); }
    f32x16 o[4]; o[0] = f32x16{}; o[1] = f32x16{}; o[2] = f32x16{}; o[3] = f32x16{};
    float lsum = 0.f;
    const lds_cptr l3 = (lds_cptr)lds;
    const int kfo = A_RING + comp * 8192 + hi * 1024 + r32 * 16;
    const int vfo = A_RING + 16384 + ((lane >> 4) & 1) * 32 + (lane & 3) * 8 + (4 * hi + ((lane & 15) >> 2)) * 64;
    const int qposl = qw + r32;
    v4u pw[4]; bool have_p = false;
    int so_prev = 0;
#define ATT_VRD(j) do { vlo[j] = vtr(vp + ((j) >> 2) * 4096 + ((j) & 3) * 1024); vhi[j] = vtr(vp + ((j) >> 2) * 4096 + ((j) & 3) * 1024 + 512); } while (0)
#define ATT_VFR(j) (bf16x8){vlo[j][0], vlo[j][1], vlo[j][2], vlo[j][3], vhi[j][0], vhi[j][1], vhi[j][2], vhi[j][3]}
#define ATT_G2(j) do { if ((j) + 3 < 16) ATT_VRD((j) + 3); \
        o[(j) >> 2] = __builtin_amdgcn_mfma_f32_32x32x16_bf16(__builtin_bit_cast(bf16x8, pw[(j) & 3]), ATT_VFR(j), o[(j) >> 2], 0, 0, 0); __builtin_amdgcn_sched_barrier(0); } while (0)
#define ATT_QKEXP(t_, so_) do { f32x16 p0, p1; \
        const lds_cptr kp = l3 + kfo + (so_); \
        bf16x8 kf[8];                                                               \
        _Pragma("unroll") for (int d0 = 0; d0 < 4; ++d0) { kf[2 * d0] = *(const __attribute__((address_space(3))) bf16x8*)(kp + d0 * 2048); kf[2 * d0 + 1] = *(const __attribute__((address_space(3))) bf16x8*)(kp + d0 * 2048 + 512); } \
        __builtin_amdgcn_sched_barrier(0); ATT_PRIO_QK_ON(); \
        if ((t_) >= t_near0) { const LAS float* tb = (const LAS float*)(lds + A_TAB) + (64 * (t_) + 4 * hi - qposl + 187);     \
            _Pragma("unroll") for (int r = 0; r < 16; ++r) { p0[r] = tb[(r & 3) + 8 * (r >> 2)]; p1[r] = tb[(r & 3) + 8 * (r >> 2) + 32]; } \
            p0 = __builtin_amdgcn_mfma_f32_32x32x16_bf16(kf[0], qr[0], p0, 0, 0, 0); p1 = __builtin_amdgcn_mfma_f32_32x32x16_bf16(kf[1], qr[0], p1, 0, 0, 0); } \
        else { p0 = __builtin_amdgcn_mfma_f32_32x32x16_bf16(kf[0], qr[0], f32x16{}, 0, 0, 0); p1 = __builtin_amdgcn_mfma_f32_32x32x16_bf16(kf[1], qr[0], f32x16{}, 0, 0, 0); }     \
        _Pragma("unroll") for (int d0 = 1; d0 < 4; ++d0) { \
            p0 = __builtin_amdgcn_mfma_f32_32x32x16_bf16(kf[2 * d0], qr[d0], p0, 0, 0, 0); \
            p1 = __builtin_amdgcn_mfma_f32_32x32x16_bf16(kf[2 * d0 + 1], qr[d0], p1, 0, 0, 0); } ATT_PRIO_QK_OFF(); \
        ATT_PROBE_CODE(kp) \
        float sacc = 0.f; \
        _Pragma("unroll") for (int r = 0; r < 16; ++r) { p0[r] = __builtin_amdgcn_exp2f(p0[r]); p1[r] = __builtin_amdgcn_exp2f(p1[r]); sacc += p0[r] + p1[r]; } \
        lsum += sacc; \
        _Pragma("unroll") for (int k = 0; k < 2; ++k) { pw[k] = (v4u){cvtpk(p0[8 * k], p0[8 * k + 1]), cvtpk(p0[8 * k + 2], p0[8 * k + 3]), cvtpk(p0[8 * k + 4], p0[8 * k + 5]), cvtpk(p0[8 * k + 6], p0[8 * k + 7])}; \
                                      pw[2 + k] = (v4u){cvtpk(p1[8 * k], p1[8 * k + 1]), cvtpk(p1[8 * k + 2], p1[8 * k + 3]), cvtpk(p1[8 * k + 4], p1[8 * k + 5]), cvtpk(p1[8 * k + 6], p1[8 * k + 7])}; } } while (0)
#define ATT_PV(so_) do { const lds_cptr vp = l3 + vfo + (so_); s16x4 vlo[16], vhi[16]; ATT_VRD(0); ATT_VRD(1); ATT_VRD(2); __builtin_amdgcn_sched_barrier(0); ATT_PRIO_ON(); \
        ATT_G2(0); ATT_G2(1); ATT_G2(2); ATT_G2(3); ATT_G2(4); ATT_G2(5); ATT_G2(6); ATT_G2(7); ATT_G2(8); ATT_G2(9); ATT_G2(10); ATT_G2(11); ATT_G2(12); ATT_G2(13); ATT_G2(14); ATT_G2(15); ATT_PRIO_OFF(); } while (0)
#define ATT_SYNC(it_) do { if ((it_) + 1 < NT) ATT_WAIT_BAR(4); else ATT_WAIT_BAR(0);     \
        if ((it_) + 2 < NT) ATT_ISSUE((it_) + 2); } while (0)
    if (!SMP && ATT_RSTAGE) {
        asm volatile("s_waitcnt vmcnt(0)" ::: "memory");
        const unsigned char* gsrc = img0 + poff;
        LAS unsigned char* ldst = lds + A_RING + wid * 1024 + lane * 16;
        v4u st[8];
#define ATT_RLOAD(i_, k_) do { const unsigned char* s_ = gsrc + (size_t)ATT_TILE(i_) * 32768; \
        st[4 * (k_)] = *(const GAS v4u*)(s_); st[4 * (k_) + 1] = *(const GAS v4u*)(s_ + 8192); st[4 * (k_) + 2] = *(const GAS v4u*)(s_ + 16384); st[4 * (k_) + 3] = *(const GAS v4u*)(s_ + 24576); } while (0)
#define ATT_RWRITE(i_, k_) do { LAS unsigned char* d_ = ldst + ((i_) % NSLOT) * SLOT; \
        *(LAS v4u*)(d_) = st[4 * (k_)]; *(LAS v4u*)(d_ + 8192) = st[4 * (k_) + 1]; *(LAS v4u*)(d_ + 16384) = st[4 * (k_) + 2]; *(LAS v4u*)(d_ + 24576) = st[4 * (k_) + 3]; } while (0)
        if (NT > 2) { ATT_RLOAD(2, 0); ATT_RLOAD(3, 1); }
        asm volatile("s_waitcnt lgkmcnt(0)\n\ts_barrier" ::: "memory");
        for (int it = 0; it < NT; it += 2) {
            if (it + 2 < NT) { ATT_RWRITE(it + 2, 0); ATT_RWRITE(it + 3, 1); }
            if (it + 4 < NT) { ATT_RLOAD(it + 4, 0); ATT_RLOAD(it + 5, 1); }
#pragma unroll
            for (int k = 0; k < 2; ++k) { const int t = ATT_TILE(it + k); const int so = ((it + k) % NSLOT) * SLOT;
                if (t <= t_last) { ATT_QKEXP(t, so); __builtin_amdgcn_sched_barrier(0); ATT_PV(so); } }
            asm volatile("s_waitcnt lgkmcnt(0)\n\ts_barrier" ::: "memory");
        }
#undef ATT_RLOAD
#undef ATT_RWRITE
    } else {
    const bool skew = comp == 1;
    for (int it = 0; it < NT; ++it) {
        const int t = ATT_TILE(it);
        if (skew) ATT_SYNC(it);
        if (have_p) { ATT_PV(so_prev); __builtin_amdgcn_sched_barrier(0); }
        if (!skew) ATT_SYNC(it);
        const int so = (it % NSLOT) * SLOT;
        have_p = (t <= t_last);
        if (have_p) { ATT_QKEXP(t, so); so_prev = so; }
        if (loader && it + 2 < 32) { ATT_LOAD_TILE(it + 2, (it + 2) % NSLOT); VM_WAIT(); }
    }
    if (have_p) { ATT_PV(so_prev); }
    }
#undef ATT_SYNC
#undef ATT_VRD
#undef ATT_VFR
#undef ATT_G2
#undef ATT_QKEXP
#undef ATT_PV
#ifdef ATT_PRIO
    __builtin_amdgcn_s_setprio(0);
#endif
    int lane_e = lane; asm volatile("" : "+v"(lane_e));
    const int r32e = lane_e & 31, hie = lane_e >> 5;
    { auto rr = __builtin_amdgcn_permlane32_swap(__float_as_uint(lsum), __float_as_uint(lsum), false, false); lsum = __uint_as_float(rr[0]) + __uint_as_float(rr[1]); }
    LAS float* wsf = (LAS float*)(lds + A_WSF) + wid * 32;
    if (hie == 0) wsf[r32e] = lsum;
    ATT_WAIT_BAR(0);
    float rli[16];
#pragma unroll
    for (int r = 0; r < 16; ++r) rli[r] = __builtin_amdgcn_rcpf(wsf[crow(r, hie)]);
    LAS float* ex = (LAS float*)(lds + A_EX) + g * 4096;
    if (comp == 1) {
#pragma unroll
        for (int db = 0; db < 4; ++db)
#pragma unroll
            for (int r = 0; r < 16; ++r) ex[crow(r, hie) * 128 + db * 32 + r32e] = o[db][r] * (rli[r] * lam);
    }
    LDS_WAIT(); __syncthreads();
    if (comp == 0 && active) {
        float ss[16];
#pragma unroll
        for (int r = 0; r < 16; ++r) ss[r] = 0.f;
#pragma unroll
        for (int db = 0; db < 4; ++db)
#pragma unroll
            for (int r = 0; r < 16; ++r) { const float v = o[db][r] * rli[r] - ex[crow(r, hie) * 128 + db * 32 + r32e]; o[db][r] = v; ss[r] += v * v; }
#pragma unroll
        for (int r = 0; r < 16; ++r) { float s = ss[r];
#pragma unroll
            for (int m = 1; m < 32; m <<= 1) s += __shfl_xor(s, m);
            ss[r] = __builtin_amdgcn_rsqf(s * (1.0f / 128.0f) + EPS) * 0.8f; }
        LDS_WAIT();
        LAS unsigned short* stg = (LAS unsigned short*)ex;
#pragma unroll
        for (int db = 0; db < 4; ++db) { const float gn = fin(F, 19)[db * 32 + r32e];
#pragma unroll
            for (int r = 0; r < 16; ++r) stg[crow(r, hie) * 128 + db * 32 + r32e] = (unsigned short)f2bf(o[db][r] * ss[r] * gn); }
        LDS_WAIT();
        bf16* CAT = (bf16*)(F.ws + WS_CAT);
#pragma unroll
        for (int i = 0; i < 8; ++i) { const int row = i * 4 + (lane_e >> 4), ch = lane_e & 15;
            const v4u v = *(const LAS v4u*)(stg + row * 128 + ch * 8);
#ifdef NT_CAT
            __builtin_nontemporal_store(v, (GAS v4u*)(CAT + (size_t)(qrow0 + 32 * g + row) * 1024 + h * 128 + ch * 8)); }
#else
            *(GAS v4u*)(CAT + (size_t)(qrow0 + 32 * g + row) * 1024 + h * 128 + ch * 8) = v; }
#endif
    }
    LDS_WAIT(); __syncthreads();
#undef ATT_ISSUE
#undef ATT_LOAD_TILE
#undef ATT_TILE
}
#undef ATT_WAIT_BAR
}

#ifndef PG8_ALIGN
#define PG8_ALIGN true
#endif
#ifndef PG8_SP2
#define PG8_SP2 true
#endif
#ifndef SKM_G1
#define SKM_G1 0
#endif
#ifndef SKM_G2
#define SKM_G2 0
#endif
#ifndef SKM_G3
#define SKM_G3 0
#endif
#ifndef SKM_G5
#define SKM_G5 0
#endif
#ifndef SKM_G6
#define SKM_G6 0
#endif
#ifndef SKM_G7
#define SKM_G7 0
#endif
__device__ __forceinline__ void phase_p0(Frame& F) {
    unsigned char* ws = F.ws; (void)ws;
#ifndef NO_P0
    p0_prologue(F);
#endif
}

#ifdef DEP_OFF
#define DEPM(k) 0
#else
#ifndef DEP_MASK
#define DEP_MASK 3
#endif
#define DEPM(k) ((k) & DEP_MASK)
#endif
constexpr int UPX(int N) { return (TT / 256 / 8) * (N / 256); }
#define DEPC(k) ((unsigned*)(ws + WS_CTL) + CW_DEP + ((k) + cs) * 136 * 4)
__device__ __forceinline__ void phase_g1(Frame& F, int cs = 0  ) {
    unsigned char* ws = F.ws; (void)ws;
#ifndef NO_G1
    {   pg8::Gemm g{(const pg8::bf16_t*)(ws + WS_XB), (const pg8::bf16_t*)(ws + WS_W1GU), TT, 2 * FF, DM}; typedef pg8::StreamK<0, DEPM(2)> SK; SK S; S.init(TT, 2 * FF, DM, F.G, F.bx, nullptr, nullptr, 0, 0);
        S.dep_in = nullptr; S.dep_target = 0u; S.dep_out = DEPC(0);
        pg8::EpiSwiGLU<0> E{(pg8::bf16_t*)(ws + WS_H), (const float*)(ws + WS_RSTD0)};
        pg8::gemm_phase<pg8::EpiSwiGLU<0>, SK, PG8_ALIGN, PG8_SP2>(F.lds, g, S, E, F.tid); }
#endif
}

__device__ __forceinline__ void phase_g2(Frame& F, int cs = 0  ) {
    unsigned char* ws = F.ws; (void)ws;
#ifndef NO_G2
    {   pg8::Gemm g{(const pg8::bf16_t*)(ws + WS_H), (const pg8::bf16_t*)(ws + WS_W1D), TT, DM, FF}; typedef pg8::StreamK<0, DEPM(3)> SK; SK S; S.init(TT, DM, FF, F.G, F.bx, nullptr, nullptr, 0, UPX(2 * FF));
        S.dep_in = DEPC(0); S.dep_target = 8u * (2 * FF / 256); S.dep_out = DEPC(1);
        pg8::EpiResid<0> E{(pg8::bf16_t*)(ws + WS_XB), F.out, (float*)(ws + WS_SSQ1), (pg8::bf16_t*)(ws + WS_XB1)};
        pg8::gemm_phase<pg8::EpiResid<0>, SK, PG8_ALIGN, PG8_SP2>(F.lds, g, S, E, F.tid); }
#endif
}

__device__ __forceinline__ void phase_g3(Frame& F, int cs = 0  ) {
    unsigned char* ws = F.ws; (void)ws;
#ifndef NO_G3
    {   pg8::Gemm g{(const pg8::bf16_t*)(ws + WS_XB1), (const pg8::bf16_t*)(ws + WS_WIN), TT, INW, DM}; typedef pg8::StreamK<0, DEPM(1)> SK; SK S; S.init(TT, INW, DM, F.G, F.bx, nullptr, nullptr, 0, UPX(2 * FF) + UPX(DM));
        S.dep_in = DEPC(1); S.dep_target = 8u * (DM / 256); S.dep_out = nullptr;
        pg8::EpiWin E{ws, F.out, fin(F, 13), fin(F, 14)};
        pg8::gemm_phase<pg8::EpiWin, SK, PG8_ALIGN, PG8_SP2>(F.lds, g, S, E, F.tid); }
#ifndef CONV_IN_ATT
    if (cs == 0) convert_queue(F, (unsigned*)(ws + WS_CTL) + CW_CONVQ, (LAS int*)(F.lds + att::A_MISC) + 1);
#endif
#endif
}

__device__ __forceinline__ void phase_l1(Frame& F) {
    unsigned char* ws = F.ws; (void)ws;
#ifndef NO_L1
#ifdef L1_DYN
    {   unsigned* ctl = (unsigned*)(F.ws + WS_CTL); const int grp = F.bx & 7; unsigned* head1 = ctl + CW_QUEUE + 64 * grp + 2048;
        LAS int* qi = (LAS int*)(F.lds + att::A_MISC) + 1;
        for (;;) {
            if (F.tid == 0) *qi = (int)atomicAdd(head1, 1u);
            __syncthreads();
            const int it = *qi;
            __syncthreads();
            if (it >= 68) break;
            lru::lru_unit<1>(F, grp * 68 + it);
#if L1_DYN >= 2
            if (F.tid == 0) { asm volatile("s_waitcnt vmcnt(0)" ::: "memory");
#if L1_DYN >= 3
                __builtin_amdgcn_fence(__ATOMIC_RELEASE, "agent"); asm volatile("s_waitcnt vmcnt(0)" ::: "memory");
#endif
                __hip_atomic_fetch_add(ctl + 100, 1u, __ATOMIC_RELAXED, __HIP_MEMORY_SCOPE_AGENT); }
#endif
        }
    }
#else
    for (int u = F.bx; u < 512; u += F.G) if ((u & 127) != 127) lru::lru_unit<1>(F, u);
#endif
#endif
}

__device__ __forceinline__ void phase_g5(Frame& F, int cs = 0  ) {
    unsigned char* ws = F.ws; (void)ws;
#ifndef NO_G5
    {   pg8::Gemm g{(const pg8::bf16_t*)(ws + WS_CAT), (const pg8::bf16_t*)(ws + WS_WOUT), TT, DM, DM}; typedef pg8::StreamK<0, DEPM(2)> SK; SK S; S.init(TT, DM, DM, F.G, F.bx, nullptr, nullptr, 0, 0);
        S.dep_in = nullptr; S.dep_target = 0u; S.dep_out = DEPC(2);
        pg8::EpiResid<1> E{(pg8::bf16_t*)(ws + WS_XB1), F.out, (float*)(ws + WS_SSQ2), (pg8::bf16_t*)(ws + WS_XB)};
        pg8::gemm_phase<pg8::EpiResid<1>, SK, PG8_ALIGN, PG8_SP2>(F.lds, g, S, E, F.tid); }
#endif
}

__device__ __forceinline__ void phase_g6(Frame& F, int cs = 0  ) {
    unsigned char* ws = F.ws; (void)ws;
#ifndef NO_G6
    {   pg8::Gemm g{(const pg8::bf16_t*)(ws + WS_XB), (const pg8::bf16_t*)(ws + WS_W2GU), TT, 2 * FF, DM}; typedef pg8::StreamK<0, DEPM(3)> SK; SK S; S.init(TT, 2 * FF, DM, F.G, F.bx, nullptr, nullptr, 0, UPX(DM));
        S.dep_in = DEPC(2); S.dep_target = 8u * (DM / 256); S.dep_out = DEPC(3);
        pg8::EpiSwiGLU<1> E{(pg8::bf16_t*)(ws + WS_H), (const float*)(ws + WS_SSQ2)};
        pg8::gemm_phase<pg8::EpiSwiGLU<1>, SK, PG8_ALIGN, PG8_SP2>(F.lds, g, S, E, F.tid); }
#endif
}

__device__ __forceinline__ void phase_g7(Frame& F, int cs = 0  ) {
    unsigned char* ws = F.ws; (void)ws;
#ifndef NO_G7
    {   pg8::Gemm g{(const pg8::bf16_t*)(ws + WS_H), (const pg8::bf16_t*)(ws + WS_W2D), TT, DM, FF}; typedef pg8::StreamK<0, DEPM(1)> SK; SK S; S.init(TT, DM, FF, F.G, F.bx, nullptr, nullptr, 0, UPX(DM) + UPX(2 * FF));
        S.dep_in = DEPC(3); S.dep_target = 8u * (2 * FF / 256); S.dep_out = nullptr;
        pg8::EpiResid<2> E{(pg8::bf16_t*)(ws + WS_XB), F.out, nullptr, nullptr};
        pg8::gemm_phase<pg8::EpiResid<2>, SK, PG8_ALIGN, PG8_SP2>(F.lds, g, S, E, F.tid); }
#endif
}

struct Args { const float* in[33]; float* out; unsigned char* ws; int pad0, pad1; };
__global__ void __launch_bounds__(512, 2) hymba_fwd(Args args) {
    extern __shared__ __attribute__((aligned(16))) unsigned char lds_raw[];
    cg::grid_group grid = cg::this_grid();
    Frame F;
    F.lds = (LAS unsigned char*)lds_raw;
    F.tid = threadIdx.x; F.lane = F.tid & 63; F.wave = __builtin_amdgcn_readfirstlane(F.tid >> 6);
    F.G = gridDim.x; F.bx = blockIdx.x;
    F.ka = (kptr_t)__builtin_amdgcn_kernarg_segment_ptr(); F.z = 0;
    F.out = args.out; F.ws = args.ws;
    unsigned char* ws = F.ws;
    unsigned* ctl = (unsigned*)(ws + WS_CTL);
    volatile LAS unsigned* MISCW = (volatile LAS unsigned*)(F.lds + 144384);
    if (F.tid < 16) MISCW[F.tid] = 0u;
    __syncthreads();
    XcdBarrier bar = xcd_barrier_post(ctl + CW_BAR, MISCW + 8, F.wave);
#define GRID_BAR() do { xcd_barrier(bar); NEW_PHASE(); } while (0)
#define GRID_BAR_CG() do { __threadfence(); grid.sync(); NEW_PHASE(); } while (0)

    phase_p0(F);
#if defined(REP_P0)
    GRID_BAR(); phase_p0(F);
#endif
#ifdef USE_CG_SYNC
    GRID_BAR_CG();
#else
    GRID_BAR();
#endif
    phase_g1(F);
#ifdef CHAIN_BARS
    GRID_BAR();
#endif
    phase_g2(F);
#ifdef CHAIN_BARS
    GRID_BAR();
#endif
    phase_g3(F);
    GRID_BAR();
#ifdef REP_C1
    phase_g1(F, 4); phase_g2(F, 4); phase_g3(F, 4); GRID_BAR();
#endif
    phase_l1(F);
#if defined(REP_L1)
    GRID_BAR(); phase_l1(F);
#endif
    GRID_BAR();
    {
        LAS float* misc = (LAS float*)(F.lds + att::A_MISC);
        if (F.wave == 0) { const float a = wave_sum(fin(F, 15)[F.lane] * fin(F, 16)[F.lane]), b = wave_sum(fin(F, 17)[F.lane] * fin(F, 18)[F.lane]);
            if (F.lane == 0) misc[0] = __expf(a) - __expf(b) + 0.2f; }
        __syncthreads();
        const float lam = misc[0];
        const int grp = F.bx & 7;
#ifdef ATT_TWICE
        for (int rep = 0; rep < 2; ++rep) {
        unsigned* head = ctl + CW_QUEUE + 64 * grp + 1024 * rep;
#else
        unsigned* head = ctl + CW_QUEUE + 64 * grp;
#endif
        const int wq = F.bx >> 3;
        if (F.G == 256) {
#ifndef NO_ATT
#pragma unroll 1
            for (int k = 0; k < 2; ++k) { const int st = grp + 8 * k;
                att::attn_unit<false, false>(F, st >> 2, st & 3, wq, lam);
                att::attn_unit<false, true>(F, st >> 2, st & 3, 63 - wq, lam); }
#endif
        }
        const int qbase = (F.G == 256) ? 128 : 0;
        for (;;) {
            if (F.tid == 0) ((LAS int*)misc)[1] = qbase + (int)atomicAdd(head, 1u);
            __syncthreads();
            const int it = ((LAS int*)misc)[1];
            __syncthreads();
            if (it >= 212) break;
#ifndef NO_ATT
            if (it < 128) { const int st = grp + 8 * (it >> 6), qb = 63 - (it & 63); att::attn_unit<false, false>(F, st >> 2, st & 3, qb, lam); }
            else if (it < 144) { const int su = grp * 16 + (it - 128); att::attn_unit<true, false>(F, su >> 2, su & 3, 0, lam); }
            else
#endif
#ifndef NO_L2
            { lru::lru_unit<2>(F, grp * 68 + (it - 144));
#ifdef L2_TWICE
              lru::lru_unit<2>(F, grp * 68 + (it - 144));
#endif
            }
#else
            {}
#endif
        }
#ifdef ATT_TWICE
        __syncthreads(); }
#endif
#ifdef CONV_IN_ATT
        convert_queue(F, ctl + CW_CONVQ, (LAS int*)misc + 1);
#endif
    }
    GRID_BAR();
#ifdef REP_C2
    phase_g5(F, 2); phase_g6(F, 2); phase_g7(F, 2); GRID_BAR();
#endif
    phase_g5(F);
#ifdef CHAIN_BARS
    GRID_BAR();
#endif
    phase_g6(F);
#ifdef CHAIN_BARS
    GRID_BAR();
#endif
    phase_g7(F);
}

extern "C" void kernel_launch(void* const* d_in, const int* in_sizes, int n_in, void* d_out, int out_size, void* d_ws, size_t ws_size, hipStream_t stream) {
    static int grid = 0;
    if (grid == 0) {
        if (n_in != 33 || out_size != (int)O_END || ws_size < WS_END) { fprintf(stderr, "kernel_launch: unexpected shapes: n_in %d out %d ws %zu (need %zu)\n", n_in, out_size, ws_size, (size_t)WS_END); grid = -1; return; }
        int dev = 0, cus = 0, per_cu = 0;
        hipGetDevice(&dev); hipDeviceGetAttribute(&cus, hipDeviceAttributeMultiprocessorCount, dev);
        if (hipFuncSetAttribute((const void*)hymba_fwd, hipFuncAttributeMaxDynamicSharedMemorySize, LDS_BYTES) != hipSuccess) { fprintf(stderr, "kernel_launch: hipFuncSetAttribute failed\n"); grid = -1; return; }
        if (hipOccupancyMaxActiveBlocksPerMultiprocessor(&per_cu, (const void*)hymba_fwd, 512, LDS_BYTES) != hipSuccess || per_cu < 1) { fprintf(stderr, "kernel_launch: occupancy query says %d\n", per_cu); per_cu = 1; }
        (void)hipGetLastError();
        grid = cus * 1;
        if (grid % 8 != 0 || grid < 8) { fprintf(stderr, "kernel_launch: grid %d not a multiple of 8\n", grid); }
    }
    if (grid < 0) return;
    (void)hipMemsetAsync((char*)d_ws + WS_CTL, 0, CTL_ZERO_BYTES, stream);
    Args a{};
    for (int i = 0; i < 33; ++i) a.in[i] = (const float*)d_in[i];
    a.out = (float*)d_out; a.ws = (unsigned char*)d_ws;
    void* kargs[] = {&a};
    hipError_t e = hipLaunchCooperativeKernel((const void*)hymba_fwd, dim3(grid), dim3(512), kargs, LDS_BYTES, stream);
    if (e != hipSuccess) fprintf(stderr, "kernel_launch: cooperative launch failed: %s (grid %d)\n", hipGetErrorString(e), grid);
}
```

```cpp
#include <hip/hip_runtime.h>
#include <hip/hip_cooperative_groups.h>
#include <hip/hip_bf16.h>
#include <cstdio>
#include <cstdint>
namespace cg = cooperative_groups;

constexpr int DM = 1024, NBP = 4, SEQ = 8192, NBS = 32, DSQ = 64, PAST = 2048;
constexpr int TP = NBP * SEQ, TS = NBS * DSQ, TT = TP + TS;
constexpr int FF = 2816, AW = 512, LW = 512, INW = 2560, NH = 4, HD = 64, VD = 128;
constexpr float EPS = 1e-6f;
constexpr float LOG2E = 1.4426950408889634f;
constexpr float QSCALE = 0.125f * LOG2E;
constexpr size_t O_Y = 0, O_KP = (size_t)TT * DM, O_VP = O_KP + (size_t)TP * 512, O_LP = O_VP + (size_t)TP * 512, O_CP = O_LP + NBP * 512,
                 O_KS = O_CP + NBP * 3 * 512, O_VS = O_KS + (size_t)TS * 512, O_LS = O_VS + (size_t)TS * 512, O_CS = O_LS + NBS * 512, O_END = O_CS + NBS * 3 * 512;
static_assert(O_END == 71376896, "output size");
constexpr size_t OFF_SSQ1 = 44u << 20, OFF_KVP = 376u << 20, OFF_KVS = 440u << 20;
constexpr size_t OB_Q = 0, OB_XR = 34u << 20, OB_XG = 68u << 20;
#ifndef PG8_WGM
#define PG8_WGM 4
#endif
namespace pg8 {
#define PG8_LAS __attribute__((address_space(3)))
typedef unsigned short bf16_t;
typedef short bf16x8 __attribute__((ext_vector_type(8)));
typedef float f32x4 __attribute__((ext_vector_type(4)));
typedef float f32x2 __attribute__((ext_vector_type(2)));
typedef unsigned u32x4 __attribute__((ext_vector_type(4)));
constexpr int BM = 256, BK = 64, HALF = 128, HTB = HALF * BK * 2  , STAGE_BYTES = 8 * HTB, NXCD = 8, WGM = PG8_WGM;

__host__ __device__ __forceinline__ int lds_byte(int r, int c) { const int st = (r >> 4) * 2 + (c >> 5), rr = r & 15, cc = c & 31, ob = rr * 64 + cc * 2; return st * 1024 + (ob ^ (((ob >> 9) & 1) << 5)); }
__host__ __device__ __forceinline__ void stage_rc(int b, int& R, int& C) { const int st = b / 1024, sb = b % 1024, swz = sb ^ (((sb >> 9) & 1) << 5); R = (st >> 1) * 16 + swz / 64; C = (st & 1) * 32 + (swz % 64) / 2; }
__host__ __device__ __forceinline__ int perm32(int rho) { const int n = rho >> 4, i = rho & 15; return 8 * (i >> 2) + 4 * n + (i & 3); }

struct Unit { int pm, pn, kt0, nkt, kind; };
struct Gemm { const bf16_t* A; const bf16_t* Bt; int M, N, K; };

template <int MODE  , int DEP = 0  > struct StreamK {
    static constexpr bool SPLIT = MODE != 0; static constexpr int DEPF = DEP;
    const unsigned* dep_in; unsigned* dep_out; unsigned dep_target;
    int nM, nN, P, W, x, w, q, R1, Dq; long lo, hi; int v; float* slab; unsigned* flag;
    int pm0;
    __device__ void init(int M, int N, int K, int G_, int bx, float* slab_, unsigned* flag_, int pm0_ = 0, int rot = 0) { pm0 = pm0_; nM = M / BM; nN = N / BM; P = K / (2 * BK); W = G_ / NXCD; x = bx % NXCD; w = (bx / NXCD + W - rot % W) % W;
        const int nwg = nM * nN; q = nwg / NXCD;
        if (!SPLIT) { R1 = (nwg + G_ - 1) / G_; Dq = q; } else { R1 = nwg / G_ - 1; Dq = R1 * W; }
        const long tot = (long)(q - Dq) * P; lo = tot * w / W; hi = tot * (w + 1) / W; v = x * W + w; slab = slab_; flag = flag_; }
    __device__ bool next(int i, Unit& u) const {
        int L; int j = i, k = -1;
        if (MODE == 2 && (lo % P) != 0) { if (i == 0) k = 0; else j = i - 1; }
        if (k < 0 && j >= R1) { if (!SPLIT) return false; k = j - R1 + ((MODE == 2 && (lo % P) != 0) ? 1 : 0); }
        if (k < 0) { L = j * W + w; u.kt0 = 0; u.nkt = 2 * P; u.kind = 0; if (!SPLIT && L >= q) return false; }
        else { const long u0 = lo / P; const long base = (u0 + k) * P; const long start = (k == 0) ? lo - base : 0; if (base + start >= hi) return false;
            const long end = (hi - base) < P ? (hi - base) : P;
            L = Dq + (int)(u0 + k); u.kt0 = (int)(2 * start); u.nkt = (int)(2 * (end - start)); u.kind = start > 0 ? 1 : (end < P ? 2 : 0); }
        const int ppx = nM / NXCD, nig = WGM * nN, gid = L / nig, fm = gid * WGM, gsz = (ppx - fm) < WGM ? (ppx - fm) : WGM;
        u.pm = pm0 + x * ppx + fm + ((L % nig) % gsz); u.pn = (L % nig) / gsz; return true;
    }
    __device__ __forceinline__ unsigned poll(const Unit& u) const {
#ifdef NO_POLL
        return 0xffffu;
#else
        if constexpr ((DEP & 1) != 0) return __hip_atomic_load(dep_in + u.pm * 4, __ATOMIC_RELAXED, __HIP_MEMORY_SCOPE_AGENT); else return 0u;
#endif
    }
    __device__ __forceinline__ void a_ready(const Unit& u, unsigned pv) const {
        if constexpr ((DEP & 1) != 0) { unsigned spins = 0;
            while ((unsigned)__builtin_amdgcn_readfirstlane(pv) < dep_target) { __builtin_amdgcn_s_sleep(4); pv = poll(u); if (++spins > (1u << 21)) break; }
#ifdef DEP_INV
            asm volatile("buffer_inv sc1" ::: "memory");
#endif
        }
    }
    __device__ __forceinline__ void done(const Unit& u) const {
        if constexpr ((DEP & 2) != 0) { asm volatile("s_waitcnt vmcnt(0)" ::: "memory");
            if ((threadIdx.x & 63) == 0) __hip_atomic_fetch_add(dep_out + u.pm * 4, 1u, __ATOMIC_RELAXED, __HIP_MEMORY_SCOPE_AGENT); }
    }
    __device__ __forceinline__ void put_partial(const f32x4 (&acc)[2][2][4][2], int tid, int lane) const {
        f32x4* dst = (f32x4*)slab + (size_t)v * (32 * 512) + tid;
#pragma unroll
        for (int ai = 0; ai < 2; ++ai)
#pragma unroll
            for (int bj = 0; bj < 2; ++bj)
#pragma unroll
                for (int m = 0; m < 4; ++m)
#pragma unroll
                    for (int n = 0; n < 2; ++n) { const f32x4 val = acc[ai][bj][m][n];
                        asm volatile("global_store_dwordx4 %0, %1, off sc1\n\ts_nop 1" :: "v"(dst), "v"(val) : "memory");
                        dst += 512; asm volatile("" : "+v"(dst)); }
        asm volatile("s_waitcnt vmcnt(0)" ::: "memory");
        if (lane == 0) __hip_atomic_fetch_add(flag + v, 1u, __ATOMIC_RELAXED, __HIP_MEMORY_SCOPE_AGENT);
    }
    __device__ __forceinline__ void load_partial(f32x4 (&acc)[2][2][4][2], int tid, int lane) const {
        unsigned spins = 0;
        while ((unsigned)__builtin_amdgcn_readfirstlane(__hip_atomic_load(flag + v + 1, __ATOMIC_RELAXED, __HIP_MEMORY_SCOPE_AGENT)) < 8u) { __builtin_amdgcn_s_sleep(2); if (++spins > (1u << 22)) break; }
        __builtin_amdgcn_fence(__ATOMIC_ACQUIRE, "agent");
        const f32x4* src = (const f32x4*)slab + (size_t)(v + 1) * (32 * 512) + tid;
#pragma unroll
        for (int ai = 0; ai < 2; ++ai)
#pragma unroll
            for (int bj = 0; bj < 2; ++bj)
#pragma unroll
                for (int m = 0; m < 4; ++m)
#pragma unroll
                    for (int n = 0; n < 2; ++n) { acc[ai][bj][m][n] = *src; src += 512; asm volatile("" : "+v"(src)); }
    }
};

__device__ __forceinline__ unsigned cvt_pk_bf16(float lo, float hi) { unsigned r; asm volatile("v_cvt_pk_bf16_f32 %0, %1, %2" : "=v"(r) : "v"(lo), "v"(hi)); return r; }
__device__ __forceinline__ u32x4 pack8(const f32x4& a, const f32x4& b) { u32x4 w; w.x = cvt_pk_bf16(a[0], a[1]); w.y = cvt_pk_bf16(a[2], a[3]); w.z = cvt_pk_bf16(b[0], b[1]); w.w = cvt_pk_bf16(b[2], b[3]); return w; }
#ifdef WT_OFF
__device__ __forceinline__ void st16_wt(void* p, const u32x4& v) { *(u32x4*)p = v; }
#else
__device__ __forceinline__ void st16_wt(void* p, const u32x4& v) { asm volatile("global_store_dwordx4 %0, %1, off sc1\n\ts_nop 1" :: "v"(p), "v"(v)); }
#endif
__device__ __forceinline__ float silu_f(float g) { return g * __builtin_amdgcn_rcpf(1.0f + __builtin_amdgcn_exp2f(-g * 1.4426950408889634f)); }
__device__ __forceinline__ float rstd_from_ssq(const float* ssq, int row, int fq) {
    const f32x4 p = *(const f32x4*)(ssq + (size_t)row * 16 + 4 * fq);
    float s = (p[0] + p[1]) + (p[2] + p[3]); s += __shfl_xor(s, 16); s += __shfl_xor(s, 32);
    return __builtin_amdgcn_rsqf(s * (1.0f / 1024.0f) + 1e-6f);
}
#ifndef EPI_TWICE
#define EPI_TWICE 0
#endif
template <int RSMODE  > struct EpiSwiGLU {
    static constexpr bool PERM = true, AFTER_DRAIN = false, TWICE_OK = (EPI_TWICE == 1);
    bf16_t* H; const float* rs;
    __device__ __forceinline__ void operator()(const f32x4 (&acc)[2][2][4][2], const Unit& u, int wr, int wc, int fr, int fq) const {
        const int row0 = u.pm * BM + wr * 64 + fr, col0 = u.pn * 128 + wc * 32 + 8 * fq;
#pragma unroll
        for (int ai = 0; ai < 2; ++ai)
#pragma unroll
            for (int m = 0; m < 4; ++m) { const int row = row0 + ai * HALF + m * 16;
                const float s = RSMODE == 0 ? rs[row] : rstd_from_ssq(rs, row, fq);
                const float s2 = s * -1.4426950408889634f, ss = s * s;
                f32x4 h0, h1;
#pragma unroll
                for (int e = 0; e < 4; e += 2) {
                    { const f32x2 g = {acc[ai][0][m][0][e], acc[ai][0][m][0][e + 1]}, u = {acc[ai][1][m][0][e], acc[ai][1][m][0][e + 1]}; const f32x2 t = g * s2;
                      const f32x2 den = (f32x2){__builtin_amdgcn_exp2f(t.x), __builtin_amdgcn_exp2f(t.y)} + 1.0f; const f32x2 r = {__builtin_amdgcn_rcpf(den.x), __builtin_amdgcn_rcpf(den.y)};
                      const f32x2 h = (g * u) * (r * ss); h0[e] = h.x; h0[e + 1] = h.y; }
                    { const f32x2 g = {acc[ai][0][m][1][e], acc[ai][0][m][1][e + 1]}, u = {acc[ai][1][m][1][e], acc[ai][1][m][1][e + 1]}; const f32x2 t = g * s2;
                      const f32x2 den = (f32x2){__builtin_amdgcn_exp2f(t.x), __builtin_amdgcn_exp2f(t.y)} + 1.0f; const f32x2 r = {__builtin_amdgcn_rcpf(den.x), __builtin_amdgcn_rcpf(den.y)};
                      const f32x2 h = (g * u) * (r * ss); h1[e] = h.x; h1[e + 1] = h.y; } }
                st16_wt(H + (size_t)row * 2816 + col0, pack8(h0, h1)); }
    }
};
__device__ __forceinline__ f32x4 bf4lo(const u32x4& w) { f32x4 r; r[0] = __builtin_bit_cast(float, w.x << 16); r[1] = __builtin_bit_cast(float, w.x & 0xffff0000u); r[2] = __builtin_bit_cast(float, w.y << 16); r[3] = __builtin_bit_cast(float, w.y & 0xffff0000u); return r; }
__device__ __forceinline__ f32x4 bf4hi(const u32x4& w) { f32x4 r; r[0] = __builtin_bit_cast(float, w.z << 16); r[1] = __builtin_bit_cast(float, w.z & 0xffff0000u); r[2] = __builtin_bit_cast(float, w.w << 16); r[3] = __builtin_bit_cast(float, w.w & 0xffff0000u); return r; }
template <int KIND> struct EpiResid {
    static constexpr bool PERM = true, AFTER_DRAIN = false, TWICE_OK = (EPI_TWICE == 3 && KIND == 2);
    bf16_t* xb; float* out; float* ssq; bf16_t* xo;
    __device__ __forceinline__ void operator()(const f32x4 (&acc)[2][2][4][2], const Unit& u, int wr, int wc, int fr, int fq) const {
        const int row0 = u.pm * BM + wr * 64 + fr, col0 = u.pn * BM + wc * 32 + 8 * fq;
        const float sc = KIND == 1 ? 1.0f : 0.5f;
        u32x4 r0 = *(const u32x4*)(xb + (size_t)row0 * 1024 + col0), r1 = *(const u32x4*)(xb + (size_t)row0 * 1024 + col0 + HALF);
#pragma unroll
        for (int ai = 0; ai < 2; ++ai)
#pragma unroll
            for (int m = 0; m < 4; ++m) { const int row = row0 + ai * HALF + m * 16;
                const u32x4 c0 = r0, c1 = r1;
                if (ai * 4 + m < 7) { const int nrow = row0 + ((ai * 4 + m + 1) >> 2) * HALF + ((ai * 4 + m + 1) & 3) * 16;
                    r0 = *(const u32x4*)(xb + (size_t)nrow * 1024 + col0); r1 = *(const u32x4*)(xb + (size_t)nrow * 1024 + col0 + HALF); }
                const f32x4 v00 = bf4lo(c0) + acc[ai][0][m][0] * sc, v01 = bf4hi(c0) + acc[ai][0][m][1] * sc, v10 = bf4lo(c1) + acc[ai][1][m][0] * sc, v11 = bf4hi(c1) + acc[ai][1][m][1] * sc;
                if (KIND < 2) {
                    st16_wt(xo + (size_t)row * 1024 + col0, pack8(v00, v01)); st16_wt(xo + (size_t)row * 1024 + col0 + HALF, pack8(v10, v11));
                    float ss = (v00[0] * v00[0] + v00[1] * v00[1]) + (v00[2] * v00[2] + v00[3] * v00[3]) + (v01[0] * v01[0] + v01[1] * v01[1]) + (v01[2] * v01[2] + v01[3] * v01[3]);
                    ss += (v10[0] * v10[0] + v10[1] * v10[1]) + (v10[2] * v10[2] + v10[3] * v10[3]) + (v11[0] * v11[0] + v11[1] * v11[1]) + (v11[2] * v11[2] + v11[3] * v11[3]);
                    ss += __shfl_xor(ss, 16); ss += __shfl_xor(ss, 32); if (fq == 0) __hip_atomic_store(ssq + (size_t)row * 16 + u.pn * 4 + wc, ss, __ATOMIC_RELAXED, __HIP_MEMORY_SCOPE_AGENT);
                } else { float* orow = out + (size_t)row * 1024 + col0;
                    __builtin_nontemporal_store(v00, (f32x4*)orow); __builtin_nontemporal_store(v01, (f32x4*)(orow + 4)); __builtin_nontemporal_store(v10, (f32x4*)(orow + HALF)); __builtin_nontemporal_store(v11, (f32x4*)(orow + HALF + 4)); } }
    }
};
struct EpiWinPtrs { const float* ssq1; bf16_t* Q; unsigned char *KVP, *KVS; bf16_t *XR, *XG; float* out; const float *gq, *gk; };
template <class T> __device__ __forceinline__ T* uoff(const void* ub, unsigned off) { return (T*)((unsigned char*)ub + off); }
__device__ __forceinline__ float rstd_from_p(const f32x4* pp) { const f32x4 p = *pp; float s = (p[0] + p[1]) + (p[2] + p[3]); s += __shfl_xor(s, 16); s += __shfl_xor(s, 32); return __builtin_amdgcn_rsqf(s * (1.0f / 1024.0f) + 1e-6f); }
__device__ __forceinline__ unsigned char* tile_u(const EpiWinPtrs& P, bool prm, int rt, int h) {
    return prm ? P.KVP + (size_t)((((rt >> 13) * 4 + h) * 128) + ((rt & 8191) >> 6)) * 32768 : P.KVS + (size_t)(((rt - 32768) >> 6) * 4 + h) * 32768; }
template <int KIND> __device__ __forceinline__ void win_qk(const EpiWinPtrs P, const f32x4 (&acc)[2][2][4][2], const Unit& u, int wr, int wc, int fr, int fq) {
    const int rowb = u.pm * BM + wr * 64, half = u.pn & 1; const bool prm = u.pm < 128;
    const float* gp = KIND == 0 ? P.gq : P.gk; const float qs = KIND == 0 ? 0.125f * 1.4426950408889634f : 1.0f;
    const f32x4 g00 = *(const f32x4*)(gp + 8 * fq) * qs, g01 = *(const f32x4*)(gp + 8 * fq + 4) * qs, g10 = *(const f32x4*)(gp + 32 + 8 * fq) * qs, g11 = *(const f32x4*)(gp + 32 + 8 * fq + 4) * qs;
    const int cbase = 256 * half + 64 * wc + 8 * fq;
    const float* sp = P.ssq1 + (size_t)rowb * 16; const unsigned sl = (unsigned)(fr * 16 + 4 * fq) * 4u;
    const bf16_t* qb = P.Q + (size_t)rowb * 512; const unsigned ql = (unsigned)(fr * 512 + cbase) * 2u;
    const float* ob = prm ? P.out + 35651584 + (size_t)rowb * 512 : P.out + 69214208 + (size_t)(rowb - 32768) * 512; const unsigned ol = (unsigned)(fr * 512 + cbase) * 4u;
    const unsigned il = (unsigned)((wc & 1) * 8192 + fq * 1024 + fr * 16);
#pragma unroll
    for (int ai = 0; ai < 2; ++ai) {
        const unsigned char* tbu = KIND == 1 ? tile_u(P, prm, rowb + ai * HALF, 2 * half + (wc >> 1)) : nullptr;
#pragma unroll
        for (int m = 0; m < 4; ++m) { constexpr int dummy = 0; (void)dummy; const int ro = ai * HALF + m * 16;
            const float rs = rstd_from_p(uoff<const f32x4>(sp + ro * 16, sl));
            const f32x4 &c00 = acc[ai][0][m][0], &c01 = acc[ai][0][m][1], &c10 = acc[ai][1][m][0], &c11 = acc[ai][1][m][1];
            const f32x4 q = c00 * c00 + c01 * c01 + c10 * c10 + c11 * c11;
            float ss = (q[0] + q[1]) + (q[2] + q[3]);
            ss += __shfl_xor(ss, 16); ss += __shfl_xor(ss, 32);
            const float rn = rs * __builtin_amdgcn_rsqf(ss * (rs * rs) * (1.0f / 64.0f) + 1e-6f);
            const f32x4 a0 = c00 * rn * g00, b0 = c01 * rn * g01, a1 = c10 * rn * g10, b1 = c11 * rn * g11;
            if (KIND == 0) { *uoff<u32x4>(qb + ro * 512, ql) = pack8(a0, b0); *uoff<u32x4>(qb + ro * 512, ql + 64u) = pack8(a1, b1); }
            else { const float* o = ob + ro * 512;
                __builtin_nontemporal_store(a0, uoff<f32x4>(o, ol)); __builtin_nontemporal_store(b0, uoff<f32x4>(o, ol + 16u)); __builtin_nontemporal_store(a1, uoff<f32x4>(o, ol + 128u)); __builtin_nontemporal_store(b1, uoff<f32x4>(o, ol + 144u));
                *uoff<u32x4>(tbu, il + m * 256u) = pack8(a0, b0); *uoff<u32x4>(tbu, il + m * 256u + 4096u) = pack8(a1, b1); }
            asm volatile("" ::: "memory"); }
    }
}
template <int KIND> __device__ __forceinline__ void win_plain(const EpiWinPtrs P, const f32x4 (&acc)[2][2][4][2], const Unit& u, int wr, int wc, int fr, int fq) {
    const int rowb = u.pm * BM + wr * 64, half = u.pn & 1; const bool prm = u.pm < 128;
    const int cbase = 256 * half + 32 * wc + 8 * fq;
    const float* sp = P.ssq1 + (size_t)rowb * 16; const unsigned sl = (unsigned)(fr * 16 + 4 * fq) * 4u;
    const bf16_t* db = (KIND == 3 ? P.XR : P.XG) + (size_t)rowb * 512; const unsigned dl = (unsigned)(fr * 512 + cbase) * 2u;
    const float* ob = prm ? P.out + 52428800 + (size_t)rowb * 512 : P.out + 70262784 + (size_t)(rowb - 32768) * 512; const unsigned ol = (unsigned)(fr * 512 + cbase) * 4u;
    const unsigned il = (unsigned)(16384 + wc * 4096 + fr * 64 + fq * 16);
#pragma unroll
    for (int ai = 0; ai < 2; ++ai) {
        const unsigned char* tb0 = KIND == 2 ? tile_u(P, prm, rowb + ai * HALF, 2 * half) : nullptr;
        const size_t hstride = prm ? (size_t)128 * 32768 : (size_t)32768;
        const bool tailblk = KIND == 3 && (prm ? ((rowb + ai * HALF) & 8191) == 8128 : true);
#pragma unroll
        for (int m = 0; m < 4; ++m) { const int ro = ai * HALF + m * 16;
            const float rs = rstd_from_p(uoff<const f32x4>(sp + ro * 16, sl));
#pragma unroll
            for (int bj = 0; bj < 2; ++bj) { const f32x4 a = acc[ai][bj][m][0] * rs, b = acc[ai][bj][m][1] * rs;
                if (KIND == 2) { *uoff<u32x4>(tb0 + bj * hstride, il + m * 1024u) = pack8(a, b);
                    const float* o = ob + ro * 512 + 128 * bj; __builtin_nontemporal_store(a, uoff<f32x4>(o, ol)); __builtin_nontemporal_store(b, uoff<f32x4>(o, ol + 16u)); }
                else *uoff<u32x4>(db + ro * 512 + 128 * bj, dl) = pack8(a, b);
                if (KIND == 3 && m == 3) { if (tailblk && fr >= 13) { const int row = rowb + ro + fr;
                    float* o = (prm ? P.out + 69208064 + (size_t)((row >> 13) * 3 + ((row & 8191) - 8189)) * 512 : P.out + 71327744 + (size_t)(((row - 32768) >> 6) * 3 + (((row - 32768) & 63) - 61)) * 512) + cbase + 128 * bj;
                    *(f32x4*)o = a; *(f32x4*)(o + 4) = b; } } }
            asm volatile("" ::: "memory"); }
    }
}
struct EpiWin {
    static constexpr bool PERM = true, AFTER_DRAIN = false, TWICE_OK = (EPI_TWICE == 2);
    unsigned char* wsb; float* out; const float *gq, *gk;
    __device__ __forceinline__ void operator()(const f32x4 (&acc)[2][2][4][2], const Unit& u, int wr, int wc, int fr, int fq) const {
        unsigned char* w = wsb; asm volatile("" : "+s"(w));
        const EpiWinPtrs P{(const float*)(w + OFF_SSQ1), (bf16_t*)((unsigned char*)out + OB_Q), w + OFF_KVP, w + OFF_KVS, (bf16_t*)((unsigned char*)out + OB_XR), (bf16_t*)((unsigned char*)out + OB_XG), out, gq, gk};
        const int kind = u.pn >> 1;
        if (kind == 0) win_qk<0>(P, acc, u, wr, wc, fr, fq);
        else if (kind == 1) win_qk<1>(P, acc, u, wr, wc, fr, fq);
        else if (kind == 2) win_plain<2>(P, acc, u, wr, wc, fr, fq);
        else if (kind == 3) win_plain<3>(P, acc, u, wr, wc, fr, fq);
        else win_plain<4>(P, acc, u, wr, wc, fr, fq);
    }
};
template <class Epi, class Sched, bool ALIGN_EPI = false, bool SP2 = false>
__device__ __forceinline__ void gemm_phase(PG8_LAS unsigned char* lds, const Gemm g, const Sched& S, const Epi& E, int tid_in) {
    int tid_ = threadIdx.x; (void)tid_in; asm volatile("" : "+v"(tid_));
    const int tid = tid_, wid = __builtin_amdgcn_readfirstlane(tid >> 6), lane = tid & 63, wr = wid >> 2, wc = wid & 3, fr = lane & 15, fq = lane >> 4;
    const int K = g.K;
    unsigned voffA[2], voffB[2];
#pragma unroll
    for (int i = 0; i < 2; ++i) { int R, C; stage_rc(tid * 16 + i * 8192, R, C); const int Rb = Epi::PERM ? ((R & ~31) + perm32(R & 31)) : R;
        voffA[i] = (unsigned)(R * K + C) * 2u; voffB[i] = (unsigned)(Rb * K + C) * 2u; }
    const size_t kstep = (size_t)(BK * 2);
    const size_t hstep = (size_t)HALF * K * 2;
    const size_t tstep = 2 * hstep;
    const unsigned ldsw = (unsigned)wid * 1024u;
    const int aoff = lds_byte(wr * 64 + fr, fq * 8), boff = lds_byte(wc * 32 + fr, fq * 8);
#define PG8_SA(b, h) (((b) * 2 + (h)) * HTB)
#define PG8_SB(b, h) ((4 + (b) * 2 + (h)) * HTB)
#define PG8_STAGE(bufoff, gbase, voff) do { _Pragma("unroll") for (int _i = 0; _i < 2; ++_i) \
        __builtin_amdgcn_global_load_lds((const unsigned*)((const char*)(gbase) + (voff)[_i]), (PG8_LAS unsigned*)(lds + (bufoff) + ldsw + _i * 8192), 16, 0, 0); } while (0)
#define PG8_LDA(dst, b, h) do { _Pragma("unroll") for (int m = 0; m < 4; ++m) _Pragma("unroll") for (int k = 0; k < 2; ++k) dst[m][k] = *(const PG8_LAS bf16x8*)(lds + PG8_SA(b, h) + aoff + m * 2048 + k * 1024); } while (0)
#define PG8_LDB(dst, b, h) do { _Pragma("unroll") for (int n = 0; n < 2; ++n) _Pragma("unroll") for (int k = 0; k < 2; ++k) dst[n][k] = *(const PG8_LAS bf16x8*)(lds + PG8_SB(b, h) + boff + n * 2048 + k * 1024); } while (0)
#define PG8_MMA(ai, bj, At, Bt) do { __builtin_amdgcn_s_setprio(1); _Pragma("unroll") for (int m = 0; m < 4; ++m) _Pragma("unroll") for (int n = 0; n < 2; ++n) _Pragma("unroll") for (int k = 0; k < 2; ++k) \
        acc[ai][bj][m][n] = __builtin_amdgcn_mfma_f32_16x16x32_bf16(Bt[n][k], At[m][k], acc[ai][bj][m][n], 0, 0, 0); __builtin_amdgcn_s_setprio(0); } while (0)
#define PG8_WAIT_V(n) asm volatile("s_waitcnt vmcnt(" #n ")" ::: "memory")
#define PG8_WAIT_L(n) asm volatile("s_waitcnt lgkmcnt(" #n ")" ::: "memory")
#define PG8_BAR __builtin_amdgcn_s_barrier()
#define PG8_SCHED __builtin_amdgcn_sched_barrier(0)
    Unit cur, nxt; int ui = 0;
    if (!S.next(0, cur)) return;
    f32x4 acc[2][2][4][2];
#pragma unroll
    for (int a = 0; a < 2; ++a)
#pragma unroll
        for (int b = 0; b < 2; ++b)
#pragma unroll
            for (int m = 0; m < 4; ++m)
#pragma unroll
                for (int n = 0; n < 2; ++n) acc[a][b][m][n] = (f32x4){0.f, 0.f, 0.f, 0.f};
    bf16x8 At[4][2], B0[2][2], B1[2][2];
    const char* cA = (const char*)g.A + (size_t)cur.pm * tstep + (Sched::SPLIT ? (size_t)cur.kt0 * kstep : (size_t)0); const char* cB = (const char*)g.Bt + (size_t)cur.pn * tstep + (Sched::SPLIT ? (size_t)cur.kt0 * kstep : (size_t)0);
    S.a_ready(cur, S.poll(cur));
    unsigned pv = 0u;
    if constexpr (SP2) {
        PG8_STAGE(PG8_SB(0, 0), cB, voffB); PG8_STAGE(PG8_SB(0, 1), cB + hstep, voffB); PG8_STAGE(PG8_SA(0, 0), cA, voffA); PG8_STAGE(PG8_SA(0, 1), cA + hstep, voffA);
        if (wr == 1) PG8_BAR;
        PG8_WAIT_V(2); PG8_BAR;
        PG8_STAGE(PG8_SB(1, 0), cB + kstep, voffB); PG8_STAGE(PG8_SA(1, 0), cA + kstep, voffA); PG8_STAGE(PG8_SB(1, 1), cB + hstep + kstep, voffB);
        PG8_WAIT_V(6); PG8_BAR;
    } else {
        PG8_STAGE(PG8_SB(0, 0), cB, voffB); PG8_STAGE(PG8_SA(0, 0), cA, voffA); PG8_STAGE(PG8_SB(0, 1), cB + hstep, voffB); PG8_STAGE(PG8_SA(0, 1), cA + hstep, voffA);
        if (wr == 1) PG8_BAR;
        PG8_WAIT_V(4); PG8_BAR;
        PG8_STAGE(PG8_SB(1, 0), cB + kstep, voffB); PG8_STAGE(PG8_SA(1, 0), cA + kstep, voffA); PG8_STAGE(PG8_SB(1, 1), cB + hstep + kstep, voffB);
        PG8_WAIT_V(6); PG8_BAR;
    }
    for (;;) {
        const bool has_next = S.next(ui + 1, nxt);
        const char* nA = has_next ? (const char*)g.A + (size_t)nxt.pm * tstep + (Sched::SPLIT ? (size_t)nxt.kt0 * kstep : (size_t)0) : cA; const char* nB = has_next ? (const char*)g.Bt + (size_t)nxt.pn * tstep + (Sched::SPLIT ? (size_t)nxt.kt0 * kstep : (size_t)0) : cB;
        const int nt = Sched::SPLIT ? cur.nkt : K / BK;
        for (int t = 0; t < nt; t += 2) {
            const bool last = (t == nt - 2);
            const char* a1 = cA + (size_t)(t + 1) * kstep;
            const char* a2 = last ? nA : cA + (size_t)(t + 2) * kstep; const char* b2 = last ? nB : cB + (size_t)(t + 2) * kstep;
            const char* a3 = a2 + kstep; const char* b3 = b2 + kstep;
            if constexpr ((Sched::DEPF & 1) != 0) { if (has_next && t == nt - 4) pv = S.poll(nxt); }
            if (last && has_next) { S.a_ready(nxt, pv); pv = 0u; }
            if constexpr (SP2) {
            PG8_LDB(B0, 0, 0); PG8_LDB(B1, 0, 1); PG8_SCHED; PG8_LDA(At, 0, 0); PG8_STAGE(PG8_SA(1, 1), a1 + hstep, voffA);
            PG8_WAIT_V(8); PG8_WAIT_L(0); PG8_BAR; PG8_MMA(0, 0, At, B0); PG8_MMA(0, 1, At, B1); PG8_BAR; PG8_SCHED;
            PG8_LDA(At, 0, 1); PG8_STAGE(PG8_SB(0, 0), b2, voffB); PG8_STAGE(PG8_SB(0, 1), b2 + hstep, voffB); PG8_STAGE(PG8_SA(0, 0), a2, voffA);
            PG8_WAIT_V(8); PG8_WAIT_L(0); PG8_BAR; PG8_MMA(1, 0, At, B0); PG8_MMA(1, 1, At, B1); PG8_BAR; PG8_SCHED;
            PG8_LDB(B0, 1, 0); PG8_LDB(B1, 1, 1); PG8_SCHED; PG8_LDA(At, 1, 0); PG8_STAGE(PG8_SA(0, 1), a2 + hstep, voffA);
            PG8_WAIT_V(8); PG8_WAIT_L(0); PG8_BAR; PG8_MMA(0, 0, At, B0); PG8_MMA(0, 1, At, B1); PG8_BAR; PG8_SCHED;
            PG8_LDA(At, 1, 1); PG8_STAGE(PG8_SB(1, 0), b3, voffB); PG8_STAGE(PG8_SB(1, 1), b3 + hstep, voffB); PG8_STAGE(PG8_SA(1, 0), a3, voffA);
            PG8_WAIT_V(8); PG8_WAIT_L(0); PG8_BAR; PG8_MMA(1, 0, At, B0); PG8_MMA(1, 1, At, B1); PG8_BAR; PG8_SCHED;
            } else {
            PG8_LDB(B0, 0, 0); PG8_SCHED; PG8_LDA(At, 0, 0); PG8_STAGE(PG8_SA(1, 1), a1 + hstep, voffA);
            PG8_WAIT_L(8); PG8_BAR; PG8_WAIT_L(0); PG8_MMA(0, 0, At, B0); PG8_BAR; PG8_SCHED;
            PG8_LDB(B1, 0, 1); PG8_STAGE(PG8_SB(0, 0), b2, voffB);
            PG8_BAR; PG8_WAIT_L(0); PG8_MMA(0, 1, At, B1); PG8_BAR;
            PG8_LDA(At, 0, 1); PG8_STAGE(PG8_SA(0, 0), a2, voffA);
            PG8_BAR; PG8_WAIT_L(0); PG8_MMA(1, 0, At, B0); PG8_BAR; PG8_SCHED;
            PG8_STAGE(PG8_SB(0, 1), b2 + hstep, voffB);
            PG8_WAIT_V(6); PG8_BAR; PG8_MMA(1, 1, At, B1); PG8_BAR;
            PG8_LDB(B0, 1, 0); PG8_SCHED; PG8_LDA(At, 1, 0); PG8_STAGE(PG8_SA(0, 1), a2 + hstep, voffA);
            PG8_WAIT_L(8); PG8_BAR; PG8_WAIT_L(0); PG8_MMA(0, 0, At, B0); PG8_BAR; PG8_SCHED;
            PG8_LDB(B1, 1, 1); PG8_STAGE(PG8_SB(1, 0), b3, voffB);
            PG8_BAR; PG8_WAIT_L(0); PG8_MMA(0, 1, At, B1); PG8_BAR;
            PG8_LDA(At, 1, 1); PG8_STAGE(PG8_SA(1, 0), a3, voffA);
            PG8_BAR; PG8_WAIT_L(0); PG8_MMA(1, 0, At, B0); PG8_BAR; PG8_SCHED;
            PG8_STAGE(PG8_SB(1, 1), b3 + hstep, voffB);
            PG8_WAIT_V(6); PG8_BAR; PG8_MMA(1, 1, At, B1); PG8_BAR;
            }
        }
        if constexpr (ALIGN_EPI) { if (wr == 0) PG8_BAR; }
        if constexpr (!Epi::AFTER_DRAIN) { if (Sched::SPLIT && cur.kind == 1) S.put_partial(acc, tid, lane); else { E(acc, cur, wr, wc, fr, fq);
#if EPI_TWICE
            if (Epi::TWICE_OK) { asm volatile("" ::: "memory"); E(acc, cur, wr, wc, fr, fq); }
#endif
            } S.done(cur); }
        if (!has_next) break;
        if (Sched::SPLIT && nxt.kind == 2) S.load_partial(acc, tid, lane);
        else {
#pragma unroll
        for (int a = 0; a < 2; ++a)
#pragma unroll
            for (int b = 0; b < 2; ++b)
#pragma unroll
                for (int m = 0; m < 4; ++m)
#pragma unroll
                    for (int n = 0; n < 2; ++n) acc[a][b][m][n] = (f32x4){0.f, 0.f, 0.f, 0.f};
        }
        cur = nxt; cA = nA; cB = nB; ++ui;
        if constexpr (ALIGN_EPI) { if (wr == 1) PG8_BAR; }
    }
    PG8_WAIT_V(0);
    if constexpr (!ALIGN_EPI) { if (wr == 0) PG8_BAR; }
    PG8_BAR;
    if constexpr (Epi::AFTER_DRAIN) { E.fused(acc, cur, wr, wc, fr, fq, lds, wid, lane); S.done(cur); }
#undef PG8_SA
#undef PG8_SB
#undef PG8_STAGE
#undef PG8_LDA
#undef PG8_LDB
#undef PG8_MMA
#undef PG8_WAIT_V
#undef PG8_WAIT_L
#undef PG8_BAR
#undef PG8_SCHED
}
}

constexpr size_t MiB = 1u << 20;
constexpr size_t WS_CTL = 0, CTL_ZERO_BYTES = 64 * 1024;
constexpr size_t WS_W1GU = 1 * MiB, WS_W1D = 12 * MiB, WS_W2GU = 18 * MiB, WS_W2D = 29 * MiB, WS_WIN = 35 * MiB, WS_WOUT = 40 * MiB;
constexpr size_t WS_GATEW = 42 * MiB;
constexpr size_t WS_SP8 = WS_GATEW + 256 * 1024;
constexpr size_t WS_RSTD0 = 43 * MiB;
constexpr size_t WS_SSQ1 = 44 * MiB, WS_SSQ2 = 47 * MiB;
constexpr size_t WS_LSUM = 50 * MiB;
constexpr size_t WS_XB = 53 * MiB;
constexpr size_t WS_XB1 = 444 * MiB;
constexpr size_t WS_H = 121 * MiB;
constexpr size_t WS_KVP = 376 * MiB, WS_KVS = 440 * MiB;
constexpr size_t WS_CAT = 308 * MiB;
constexpr size_t WS_END = 512 * MiB;
static_assert(OFF_SSQ1 == WS_SSQ1 && OFF_KVP == WS_KVP && OFF_KVS == WS_KVS, "epilogue offsets");
static_assert(WS_H + (size_t)TT * FF * 2 <= WS_CAT && WS_XB + (size_t)TT * DM * 2 <= WS_H && OB_XG + (size_t)TT * 512 * 2 <= (size_t)TT * DM * 4, "d_ws map");
constexpr int CW_BAR = 1024;
constexpr int CW_SK = 12288;
constexpr int CW_QUEUE = 8192;
constexpr int CW_DEP = 4608;
constexpr int CW_CONVQ = 7936;
static_assert(CW_BAR + 3456 <= CW_DEP && CW_DEP + 6 * 136 * 4 <= CW_CONVQ && CW_CONVQ < CW_QUEUE, "control words");

constexpr int RING_BYTES = 131072;
constexpr int MISC_OFF = RING_BYTES;
constexpr int LDS_BYTES = 147456;

#define GAS __attribute__((address_space(1)))
#define LAS __attribute__((address_space(3)))
typedef unsigned short bf16;
typedef unsigned v4u __attribute__((ext_vector_type(4)));
typedef unsigned v2u __attribute__((ext_vector_type(2)));
typedef float f32x4 __attribute__((ext_vector_type(4)));
typedef float f32x16 __attribute__((ext_vector_type(16)));
typedef short bf16x8 __attribute__((ext_vector_type(8)));
typedef short s16x4 __attribute__((ext_vector_type(4)));
#define LDS_WAIT() asm volatile("s_waitcnt lgkmcnt(0)" ::: "memory")
#define VM_WAIT() asm volatile("s_waitcnt vmcnt(0)" ::: "memory")
__device__ __forceinline__ unsigned f2bf(float f) { unsigned u = __builtin_bit_cast(unsigned, f); return (u + 0x7fffu + ((u >> 16) & 1u)) >> 16; }
__device__ __forceinline__ unsigned pk2(float lo, float hi) { return f2bf(lo) | (f2bf(hi) << 16); }
__device__ __forceinline__ float bf2f(unsigned short b) { return __builtin_bit_cast(float, (unsigned)b << 16); }
__device__ __forceinline__ float bflo(unsigned w) { return __builtin_bit_cast(float, w << 16); }
__device__ __forceinline__ float bfhi(unsigned w) { return __builtin_bit_cast(float, w & 0xffff0000u); }
__device__ __forceinline__ int lane_id() { return (int)__builtin_amdgcn_mbcnt_hi(~0u, __builtin_amdgcn_mbcnt_lo(~0u, 0u)); }
__device__ __forceinline__ float wave_sum(float v) {
#pragma unroll
    for (int o = 1; o < 64; o <<= 1) v += __shfl_xor(v, o);
    return v;
}

#define XB_TMO      128
#define XB_XCNT(j)  (256  + 64 * (j))
#define XB_XSUB(j)  (1280 + 64 * (j))
#define XB_XGEN(j)  (2304 + 64 * (j))
#define XB_TOP      3328
#define XB_TOPGEN   3392
#define XCD_BAR_WORDS 3456
#define XB_SPIN_CAP (1u << 18)

__device__ __forceinline__ unsigned xb_ld(unsigned* p)              { return __hip_atomic_load(p, __ATOMIC_RELAXED, __HIP_MEMORY_SCOPE_AGENT); }
__device__ __forceinline__ unsigned xb_add(unsigned* p, unsigned v) { return __hip_atomic_fetch_add(p, v, __ATOMIC_RELAXED, __HIP_MEMORY_SCOPE_AGENT); }
__device__ __forceinline__ unsigned xb_xcc_id() { return (unsigned)__builtin_amdgcn_s_getreg((3 << 11) | 20) & 0xFu; }
#define XB_SPIN(cond, bar) do { unsigned _sp = 0; while (cond) { __builtin_amdgcn_s_sleep(1); \
    if ((++_sp & 255u) == 0u) { if (xb_ld(&(bar)[XB_TMO])) break; if (_sp > XB_SPIN_CAP) { atomicAdd(&(bar)[XB_TMO], 1u); break; } } } } while (0)

struct XcdBarrier {
    unsigned* bar; unsigned x; int wv;
    volatile LAS unsigned* st;
};

__device__ __forceinline__ XcdBarrier xcd_barrier_post(unsigned* bar, volatile LAS unsigned* st, int wv) {
    XcdBarrier b; b.bar = bar; b.x = xb_xcc_id(); b.st = st; b.wv = wv;
    if (threadIdx.x == 0) (void)xb_add(&bar[XB_XCNT(b.x)], 1u);
    return b;
}
__device__ __forceinline__ void xcd_barrier_complete(unsigned* bar, unsigned x, unsigned& nloc, unsigned& nx) {
    const unsigned G = gridDim.x * gridDim.y * gridDim.z;
    unsigned sum, cnt, mine, sp = 0u;
    for (;;) {
        sum = 0u; cnt = 0u; mine = 0u;
#pragma unroll
        for (unsigned j = 0; j < 16; ++j) { const unsigned c = xb_ld(&bar[XB_XCNT(j)]); sum += c; cnt += (c > 0u) ? 1u : 0u; mine = (j == x) ? c : mine; }
        if (sum == G) break;
        __builtin_amdgcn_s_sleep(1);
        if ((++sp & 255u) == 0u) { if (xb_ld(&bar[XB_TMO])) break; if (sp > XB_SPIN_CAP) { atomicAdd(&bar[XB_TMO], 1u); break; } }
    }
    nloc = mine > 0u ? mine : 1u; nx = cnt > 0u ? cnt : 1u;
}

__device__ __forceinline__ void xcd_barrier(const XcdBarrier& b) {
    asm volatile("s_waitcnt vmcnt(0)" ::: "memory");
    __syncthreads();
    if (threadIdx.x == 0) {
        unsigned* bar = b.bar;
        __builtin_amdgcn_s_waitcnt(0);
        unsigned nloc = b.st[0], nx = b.st[1];
        if (nloc == 0u) { xcd_barrier_complete(bar, b.x, nloc, nx); b.st[0] = nloc; b.st[1] = nx; }
        const unsigned old = xb_add(&bar[XB_XSUB(b.x)], 1u);
        const unsigned gen = old / nloc;
        if (old + 1u == (gen + 1u) * nloc) {
            __builtin_amdgcn_fence(__ATOMIC_RELEASE, "agent");
            asm volatile("s_waitcnt vmcnt(0)" ::: "memory");
            const unsigned og = xb_add(&bar[XB_TOP], 1u);
            const unsigned tg = og / nx;
            if (og + 1u == (tg + 1u) * nx) xb_add(&bar[XB_TOPGEN], 1u);
            else XB_SPIN(xb_ld(&bar[XB_TOPGEN]) == tg, bar);
            __builtin_amdgcn_fence(__ATOMIC_ACQUIRE, "agent");
            xb_add(&bar[XB_XGEN(b.x)], 1u);
            asm volatile("s_waitcnt vmcnt(0)" ::: "memory");
        } else {
            XB_SPIN(xb_ld(&bar[XB_XGEN(b.x)]) == gen, bar);
            __builtin_amdgcn_fence(__ATOMIC_ACQUIRE, "agent");
            asm volatile("s_waitcnt vmcnt(0)" ::: "memory");
        }
    }
    __syncthreads();
}

typedef __attribute__((address_space(4))) const unsigned char* kptr_t;
struct Frame {
    LAS unsigned char* lds;
    int tid, lane, wave, G, bx;
    kptr_t ka; int z;
    float* out; unsigned char* ws;
};
__device__ __forceinline__ const float* fin(const Frame& F, int k) { typedef const float* cfp; return *(const __attribute__((address_space(4))) cfp*)(F.ka + (k * 8 + F.z)); }
#define NEW_PHASE() do { int z_ = 0; asm volatile("" : "+s"(z_)); F.z = z_; } while (0)

__device__ __forceinline__ void p0_transpose_item(const float* W, int K, int N, bf16* WT, int kb, int n0, int drow0, const float* gain, LAS float* scr, int lane) {
    const int k0 = 64 * kb, c4 = lane & 7, kr = lane >> 3;
    f32x4 v[8];
#pragma unroll
    for (int i = 0; i < 8; ++i) v[i] = __builtin_nontemporal_load((const f32x4*)&W[(size_t)(k0 + 8 * i + kr) * N + n0 + 4 * c4]);
#pragma unroll
    for (int i = 0; i < 8; ++i) { const int kk = 8 * i + kr; f32x4 w = v[i]; if (gain) w *= gain[k0 + kk]; LAS float* d = scr + kk * 33 + 4 * c4; d[0] = w.x; d[1] = w.y; d[2] = w.z; d[3] = w.w; }
    LDS_WAIT(); asm volatile("" ::: "memory");
    const int c = lane & 7;
#pragma unroll
    for (int j = 0; j < 4; ++j) { const int n = (lane >> 3) + 8 * j; const LAS float* s = scr + (8 * c) * 33 + n;
        v4u o; o.x = pk2(s[0 * 33], s[1 * 33]); o.y = pk2(s[2 * 33], s[3 * 33]); o.z = pk2(s[4 * 33], s[5 * 33]); o.w = pk2(s[6 * 33], s[7 * 33]);
        *(GAS v4u*)(WT + (size_t)(drow0 + n) * K + k0 + 8 * c) = o; }
    LDS_WAIT(); asm volatile("" ::: "memory");
}
constexpr int I_GU = 16 * 88, I_DN = 44 * 32, I_IN = 16 * 80, I_OUT = 16 * 32, I_FFN = 2 * I_GU + I_DN, NITEMS = 2 * I_FFN + I_IN + I_OUT;
__device__ __forceinline__ void weight_item(Frame& F, int it, LAS float* scr) {
    unsigned char* ws = F.ws; int r = it;
    if (r < 2 * I_FFN) {
        const int f = r >= I_FFN; r -= f * I_FFN;
        const float* Wg = f == 0 ? fin(F, 8) : fin(F, 30); const float* Wu = f == 0 ? fin(F, 9) : fin(F, 31); const float* Wd = f == 0 ? fin(F, 10) : fin(F, 32); const float* gn = f == 0 ? fin(F, 7) : fin(F, 29);
        bf16* GU = (bf16*)(ws + (f == 0 ? WS_W1GU : WS_W2GU)); bf16* DN = (bf16*)(ws + (f == 0 ? WS_W1D : WS_W2D));
        if (r < 2 * I_GU) { const int up = r >= I_GU; const int q = up ? r - I_GU : r; const int kb = q / 88, nb = q % 88, n0 = 32 * nb;
            p0_transpose_item(up ? Wu : Wg, 1024, FF, GU, kb, n0, 256 * (n0 >> 7) + (n0 & 127) + (up ? 128 : 0), gn, scr, F.lane); }
        else { r -= 2 * I_GU; const int kb = r / 32, nb = r % 32; p0_transpose_item(Wd, FF, 1024, DN, kb, 32 * nb, 32 * nb, nullptr, scr, F.lane); }
        return;
    }
    r -= 2 * I_FFN;
    if (r < I_IN) { const int kb = r / 80, nb = r % 80, n0 = 32 * nb; int dr = n0;
        if (n0 < 1024) { const int oc = n0 & 255, wc = oc >> 6, bj = (oc >> 5) & 1; dr = (n0 & ~255) + 128 * bj + 32 * wc; }
        p0_transpose_item(fin(F, 12), 1024, INW, (bf16*)(ws + WS_WIN), kb, n0, dr, fin(F, 11), scr, F.lane); return; }
    r -= I_IN;
    { const int kb = r / 32, nb = r % 32; p0_transpose_item(fin(F, 28), 1024, 1024, (bf16*)(ws + WS_WOUT), kb, 32 * nb, 32 * nb, nullptr, scr, F.lane); }
}
__device__ __forceinline__ void convert_queue(Frame& F, unsigned* head, LAS int* qi) {
    LAS float* scr = (LAS float*)(F.lds + F.wave * 16384);
    for (;;) {
        if (F.tid == 0) *qi = (int)atomicAdd(head, 1u);
        __syncthreads();
        const int k = *qi * 8 + F.wave;
        __syncthreads();
        if (k - F.wave >= I_FFN + I_OUT) break;
        if (k < I_FFN + I_OUT) weight_item(F, k < I_FFN ? I_FFN + k : 2 * I_FFN + I_IN + (k - I_FFN), scr);
    }
}
__device__ __forceinline__ void kv_expand_in_tail(Frame& F, int nunits) {
    const int W = F.G / 8, q = nunits / 8, rl = (q + W - 1) / W - 1, busy = q - rl * W, w = F.bx / 8, x = F.bx % 8;
    int bidx, nblk;
    if (busy < W) { if (w < busy) return; bidx = (w - busy) * 8 + x; nblk = (W - busy) * 8; } else { bidx = F.bx; nblk = F.G; }
    const int lane = F.lane, wv = F.wave;
    for (int tl = bidx; tl < 2048 + 128; tl += nblk) {
        const unsigned char* img; float* ok; float* ov;
        if (tl < 2048) { const int bh = tl >> 7, t = tl & 127, b = bh >> 2, h = bh & 3; img = F.ws + WS_KVP + (size_t)tl * 32768;
            ok = F.out + O_KP + ((size_t)(b * SEQ + t * 64)) * 512 + h * 128; ov = F.out + O_VP + ((size_t)(b * SEQ + t * 64)) * 512 + h * 128; }
        else { const int u = tl - 2048, sb = u >> 2, h = u & 3; img = F.ws + WS_KVS + (size_t)u * 32768;
            ok = F.out + O_KS + ((size_t)(sb * 64)) * 512 + h * 128; ov = F.out + O_VS + ((size_t)(sb * 64)) * 512 + h * 128; }
#pragma unroll
        for (int r = 0; r < 2; ++r) {
            const int key = 8 * wv + 4 * r + (lane >> 4), cj = lane & 15;
            const v4u kw = *(const GAS v4u*)(img + (cj >> 3) * 8192 + (cj & 7) * 1024 + key * 16);
            const v4u vw = *(const GAS v4u*)(img + 16384 + (cj >> 2) * 4096 + key * 64 + (cj & 3) * 16);
            float* dk = ok + (size_t)key * 512 + cj * 8; float* dv = ov + (size_t)key * 512 + cj * 8;
            *(f32x4*)dk = (f32x4){bflo(kw.x), bfhi(kw.x), bflo(kw.y), bfhi(kw.y)}; *(f32x4*)(dk + 4) = (f32x4){bflo(kw.z), bfhi(kw.z), bflo(kw.w), bfhi(kw.w)};
            *(f32x4*)dv = (f32x4){bflo(vw.x), bfhi(vw.x), bflo(vw.y), bfhi(vw.y)}; *(f32x4*)(dv + 4) = (f32x4){bflo(vw.z), bfhi(vw.z), bflo(vw.w), bfhi(vw.w)};
        }
    }
}
__device__ __forceinline__ void p0_prologue(Frame& F) {
    LAS float* scr = (LAS float*)(F.lds + F.wave * 16384);
    const int gw = F.bx * 8 + F.wave, NGW = F.G * 8;
    unsigned char* ws = F.ws;
    for (int it = gw; it < I_FFN + I_IN; it += NGW) weight_item(F, it < I_FFN ? it : 2 * I_FFN + (it - I_FFN), scr);
    {   bf16* XB = (bf16*)(ws + WS_XB); float* rstd0 = (float*)(ws + WS_RSTD0);
        for (int m0 = gw; m0 < TT; m0 += 4 * NGW) {
            f32x4 v[4][4]; float s[4];
#pragma unroll
            for (int u = 0; u < 4; ++u) { const int m = m0 + u * NGW; s[u] = 0.f;
                if (m < TT) { const float* xrow = m < TP ? fin(F, 0) + (size_t)m * DM : fin(F, 1) + (size_t)(m - TP) * DM; const GAS f32x4* xr = (const GAS f32x4*)xrow + 2 * F.lane;
                    v[u][0] = __builtin_nontemporal_load(xr); v[u][1] = __builtin_nontemporal_load(xr + 1); v[u][2] = __builtin_nontemporal_load(xr + 128); v[u][3] = __builtin_nontemporal_load(xr + 129); } }
#pragma unroll
            for (int u = 0; u < 4; ++u) { const int m = m0 + u * NGW;
                if (m < TT) {
#pragma unroll
                    for (int j = 0; j < 4; ++j) s[u] += (v[u][j].x * v[u][j].x + v[u][j].y * v[u][j].y) + (v[u][j].z * v[u][j].z + v[u][j].w * v[u][j].w);
                    s[u] = wave_sum(s[u]);
                    if (F.lane == 0) rstd0[m] = __builtin_amdgcn_rsqf(s[u] * (1.0f / DM) + EPS);
                    GAS v4u* o16 = (GAS v4u*)(XB + (size_t)m * DM) + F.lane;
                    v4u w0, w1; w0.x = pk2(v[u][0].x, v[u][0].y); w0.y = pk2(v[u][0].z, v[u][0].w); w0.z = pk2(v[u][1].x, v[u][1].y); w0.w = pk2(v[u][1].z, v[u][1].w);
                    w1.x = pk2(v[u][2].x, v[u][2].y); w1.y = pk2(v[u][2].z, v[u][2].w); w1.z = pk2(v[u][3].x, v[u][3].y); w1.w = pk2(v[u][3].z, v[u][3].w);
                    o16[0] = w0; o16[64] = w1; } }
        }
    }
    {   bf16* GW = (bf16*)(ws + WS_GATEW); float* sp8 = (float*)(ws + WS_SP8);
        const int gt = F.bx * 512 + F.tid, NT = F.G * 512;
        for (int i = gt; i < 2 * 8 * 64 * 64; i += NT) { const int g = i >> 15, n = (i >> 12) & 7, j = (i >> 6) & 63, c = i & 63;
            GW[i] = (bf16)f2bf(-LOG2E * (g == 0 ? fin(F, 22) : fin(F, 24))[(n * 64 + c) * 64 + j]); }
        for (int i = gt; i < 512; i += NT) { const float L = fin(F, 26)[i]; sp8[i] = -LOG2E * 8.0f * (L > 20.f ? __expf(-L) : log1pf(__expf(-L))); }
    }
}

namespace lru {
constexpr int L_XC = 0;
constexpr int L_HIN = 65536;
constexpr int L_PART = 65536 + 2048;
constexpr int L_PAR = 135168;
constexpr int L_O0 = 65536 + 4096;
__device__ __forceinline__ int crow(int r, int hi) { return (r & 3) + 8 * (r >> 2) + 4 * hi; }
__device__ __forceinline__ float sigmoid_f(float x) { return __builtin_amdgcn_rcpf(1.0f + __builtin_amdgcn_exp2f(-x * LOG2E)); }

template <int CTRL, int RM> __device__ __forceinline__ float dpp_f(float oldv, float src) {
    return __builtin_bit_cast(float, __builtin_amdgcn_update_dpp(__builtin_bit_cast(int, oldv), __builtin_bit_cast(int, src), CTRL, RM, 0xF, false)); }
#define LRU_SCAN4_STEP(C) \
    "v_fmac_f32_dpp %1, %1, %0 " C "\n\tv_fmac_f32_dpp %3, %3, %2 " C "\n\tv_fmac_f32_dpp %5, %5, %4 " C "\n\tv_fmac_f32_dpp %7, %7, %6 " C "\n\t" \
    "v_mul_f32_dpp %0, %0, %0 " C "\n\tv_mul_f32_dpp %2, %2, %2 " C "\n\tv_mul_f32_dpp %4, %4, %4 " C "\n\tv_mul_f32_dpp %6, %6, %6 " C "\n\t"
#define LRU_SCAN4(a0, b0, a1, b1, a2, b2, a3, b3) asm volatile("s_nop 1\n\t" \
    LRU_SCAN4_STEP("row_shr:1 row_mask:0xf bank_mask:0xf") LRU_SCAN4_STEP("row_shr:2 row_mask:0xf bank_mask:0xf") LRU_SCAN4_STEP("row_shr:4 row_mask:0xf bank_mask:0xf") \
    LRU_SCAN4_STEP("row_shr:8 row_mask:0xf bank_mask:0xf") LRU_SCAN4_STEP("row_bcast:15 row_mask:0xa bank_mask:0xf") \
    : "+v"(a0), "+v"(b0), "+v"(a1), "+v"(b1), "+v"(a2), "+v"(b2), "+v"(a3), "+v"(b3))
#define LRU_SCAN_STEP(CTRL, RM) do { const float ap_ = dpp_f<CTRL, RM>(1.0f, a), bp_ = dpp_f<CTRL, RM>(0.0f, b); b = a * bp_ + b; a = a * ap_; } while (0)
__device__ __forceinline__ float rl_half(float v, int hi) {
    return __builtin_bit_cast(float, __builtin_amdgcn_ds_bpermute((hi * 32 + 31) * 4, __builtin_bit_cast(int, v))); }
template <int PASS> __device__ __forceinline__ void lru_unit(Frame& F, int u) {
    int tid_ = F.tid; asm volatile("" : "+v"(tid_));
    const int tid = tid_, lane = tid & 63, wid = F.wave, r32 = lane & 31, hi = lane >> 5;
    const bool smp = u >= 512; const int sb = u - 512, pb = u >> 7, ck = smp ? 0 : (u & 127);
    const int row0 = smp ? TP + sb * 64 : pb * SEQ + ck * 64;
    const bf16* XR = (const bf16*)((const unsigned char*)F.out + OB_XR); const bf16* XG = (const bf16*)((const unsigned char*)F.out + OB_XG);
    LAS unsigned char* lds = F.lds;
    if (PASS == 2) {
        float h = 0.f;
        if (smp) h = fin(F, 4)[sb * 512 + tid];
        else { const float* S = (const float*)(F.ws + WS_LSUM) + ((size_t)(pb * 128) * 512 + tid) * 2;
            int c = 0;
            for (; c + 32 <= ck; c += 32) { float2 v[32];
#pragma unroll
                for (int k = 0; k < 32; ++k) v[k] = *(const float2*)(S + (size_t)(c + k) * 1024);
#pragma unroll
                for (int k = 0; k < 32; ++k) h = v[k].x * h + v[k].y; }
            for (; c + 8 <= ck; c += 8) { float2 v[8];
#pragma unroll
                for (int k = 0; k < 8; ++k) v[k] = *(const float2*)(S + (size_t)(c + k) * 1024);
#pragma unroll
                for (int k = 0; k < 8; ++k) h = v[k].x * h + v[k].y; }
            for (; c < ck; ++c) { const float2 v = *(const float2*)(S + (size_t)c * 1024); h = v.x * h + v.y; } }
        ((LAS float*)(lds + L_HIN))[tid] = h;
    }
    {   LAS float* par = (LAS float*)(lds + L_PAR);
        par[tid] = -LOG2E * fin(F, 23)[tid]; par[512 + tid] = -LOG2E * fin(F, 25)[tid]; par[1024 + tid] = ((const float*)(F.ws + WS_SP8))[tid]; if (PASS == 2) par[1536 + tid] = fin(F, 27)[tid]; }
    {   const int cg = tid & 63, tg = tid >> 6, c0 = 8 * cg;
        float xw[11][8];
#pragma unroll
        for (int i = 0; i < 11; ++i) { const int tt = 8 * tg + i - 3;
            if (tt >= 0 || ck > 0) { const v4u w = *(const GAS v4u*)(XR + (size_t)(row0 + tt) * 512 + c0);
                xw[i][0] = bflo(w.x); xw[i][1] = bfhi(w.x); xw[i][2] = bflo(w.y); xw[i][3] = bfhi(w.y); xw[i][4] = bflo(w.z); xw[i][5] = bfhi(w.z); xw[i][6] = bflo(w.w); xw[i][7] = bfhi(w.w); }
            else if (smp) { const float* sc = fin(F, 5) + (size_t)(sb * 3 + (tt + 3)) * 512 + c0; const f32x4 a = *(const f32x4*)sc, b = *(const f32x4*)(sc + 4);
                xw[i][0] = a[0]; xw[i][1] = a[1]; xw[i][2] = a[2]; xw[i][3] = a[3]; xw[i][4] = b[0]; xw[i][5] = b[1]; xw[i][6] = b[2]; xw[i][7] = b[3]; }
            else {
#pragma unroll
                for (int e = 0; e < 8; ++e) xw[i][e] = 0.f; } }
        float cw[4][8], cb[8];
#pragma unroll
        for (int j = 0; j < 4; ++j) { const f32x4 a = *(const f32x4*)(fin(F, 20) + j * 512 + c0), b = *(const f32x4*)(fin(F, 20) + j * 512 + c0 + 4);
            cw[j][0] = a[0]; cw[j][1] = a[1]; cw[j][2] = a[2]; cw[j][3] = a[3]; cw[j][4] = b[0]; cw[j][5] = b[1]; cw[j][6] = b[2]; cw[j][7] = b[3]; }
        { const f32x4 a = *(const f32x4*)(fin(F, 21) + c0), b = *(const f32x4*)(fin(F, 21) + c0 + 4); cb[0] = a[0]; cb[1] = a[1]; cb[2] = a[2]; cb[3] = a[3]; cb[4] = b[0]; cb[5] = b[1]; cb[6] = b[2]; cb[7] = b[3]; }
#pragma unroll
        for (int i = 0; i < 8; ++i) { const int t = 8 * tg + i; float xc[8];
#pragma unroll
            for (int e = 0; e < 8; ++e) xc[e] = cb[e] + cw[0][e] * xw[i][e] + cw[1][e] * xw[i + 1][e] + cw[2][e] * xw[i + 2][e] + cw[3][e] * xw[i + 3][e];
            v4u o; o.x = pk2(xc[0], xc[1]); o.y = pk2(xc[2], xc[3]); o.z = pk2(xc[4], xc[5]); o.w = pk2(xc[6], xc[7]);
            *(LAS v4u*)(lds + L_XC + t * 1024 + ((cg ^ (t & 15)) << 4)) = o; }
    }
    LDS_WAIT(); __syncthreads();
    const int n = wid;
    const bf16* GW = (const bf16*)(F.ws + WS_GATEW);
    float ssq_t[2] = {0.f, 0.f};
    float outv[2][16];
#pragma unroll
    for (int jb = 0; jb < 2; ++jb) {
        v2u gwv[4][2];
        if (PASS == 2) {
#pragma unroll
            for (int q4 = 0; q4 < 4; ++q4)
#pragma unroll
                for (int tb = 0; tb < 2; ++tb) gwv[q4][tb] = *(const GAS v2u*)(XG + (size_t)(row0 + tb * 32 + r32) * 512 + 64 * n + 32 * jb + 8 * q4 + 4 * hi); }
        f32x16 accr[2], acci[2];
#pragma unroll
        for (int tb = 0; tb < 2; ++tb) { accr[tb] = f32x16{}; acci[tb] = f32x16{}; }
#pragma unroll
        for (int ks = 0; ks < 4; ++ks) {
            const bf16x8 ar = *(const GAS bf16x8*)(GW + ((size_t)((0 * 8 + n) * 64 + jb * 32 + r32) * 64 + ks * 16 + hi * 8));
            const bf16x8 ax = *(const GAS bf16x8*)(GW + ((size_t)((1 * 8 + n) * 64 + jb * 32 + r32) * 64 + ks * 16 + hi * 8));
#pragma unroll
            for (int tb = 0; tb < 2; ++tb) { const int t = tb * 32 + r32; const int chunk = 8 * n + 2 * ks + hi;
                const bf16x8 bfr = *(const LAS bf16x8*)(lds + L_XC + t * 1024 + ((chunk ^ (t & 15)) << 4));
                accr[tb] = __builtin_amdgcn_mfma_f32_32x32x16_bf16(ar, bfr, accr[tb], 0, 0, 0);
                acci[tb] = __builtin_amdgcn_mfma_f32_32x32x16_bf16(ax, bfr, acci[tb], 0, 0, 0); }
        }
        float av[2][16], bv[2][16];
#pragma unroll
        for (int q4 = 0; q4 < 4; ++q4) {
            const int chb = 64 * n + 32 * jb + 8 * q4 + 4 * hi;
            const f32x4 ba = *(const LAS f32x4*)(lds + L_PAR + chb * 4), bx = *(const LAS f32x4*)(lds + L_PAR + 2048 + chb * 4), sp = *(const LAS f32x4*)(lds + L_PAR + 4096 + chb * 4);
#pragma unroll
            for (int tb = 0; tb < 2; ++tb) { const int t = tb * 32 + r32;
                const v2u xw = *(const LAS v2u*)(lds + L_XC + t * 1024 + ((((chb >> 3) ^ (t & 15)) << 4) | ((chb & 7) << 1)));
                const float xc[4] = {bflo(xw.x), bfhi(xw.x), bflo(xw.y), bfhi(xw.y)};
#pragma unroll
                for (int e = 0; e < 4; ++e) { const int r = 4 * q4 + e;
                    const float rg = __builtin_amdgcn_rcpf(1.0f + __builtin_amdgcn_exp2f(accr[tb][r] + ba[e])), ig = __builtin_amdgcn_rcpf(1.0f + __builtin_amdgcn_exp2f(acci[tb][r] + bx[e]));
                    const float a = __builtin_amdgcn_exp2f(rg * sp[e]);
                    av[tb][r] = a; bv[tb][r] = __builtin_amdgcn_sqrtf(__builtin_fmaf(-a, a, 1.0f)) * (ig * xc[e]); } }
        }
#pragma unroll
        for (int tb = 0; tb < 2; ++tb)
#pragma unroll
            for (int r = 0; r < 16; r += 4) LRU_SCAN4(av[tb][r], bv[tb][r], av[tb][r + 1], bv[tb][r + 1], av[tb][r + 2], bv[tb][r + 2], av[tb][r + 3], bv[tb][r + 3]);
#pragma unroll
        for (int r = 0; r < 16; ++r) {
            const float A0 = rl_half(av[0][r], hi), B0 = rl_half(bv[0][r], hi);
            bv[1][r] = av[1][r] * B0 + bv[1][r]; av[1][r] = av[1][r] * A0;
        }
        if (PASS == 1) {
            if (r32 == 31) { float* S = (float*)(F.ws + WS_LSUM) + (size_t)u * 1024;
#pragma unroll
                for (int r = 0; r < 16; ++r) { const int ch = 64 * n + 32 * jb + crow(r, hi); *(float2*)(S + 2 * ch) = make_float2(av[1][r], bv[1][r]); } }
        } else {
#pragma unroll
            for (int q4 = 0; q4 < 4; ++q4) { const int chb = 64 * n + 32 * jb + 8 * q4 + 4 * hi;
                const f32x4 hin = *(const LAS f32x4*)(lds + L_HIN + chb * 4);
#pragma unroll
                for (int tb = 0; tb < 2; ++tb) { const int t = tb * 32 + r32;
                    const v2u gw = gwv[q4][tb];
                    const float xg[4] = {bflo(gw.x), bfhi(gw.x), bflo(gw.y), bfhi(gw.y)};
#pragma unroll
                    for (int e = 0; e < 4; ++e) { const int r = 4 * q4 + e; const float h = av[tb][r] * hin[e] + bv[tb][r];
                        const float x = xg[e], uu = 0.7978845608028654f * (x + 0.044715f * x * x * x);
                        const float ge = x * __builtin_amdgcn_rcpf(1.0f + __builtin_amdgcn_exp2f(-2.0f * LOG2E * uu));
                        const float o = h * ge; ssq_t[tb] += o * o;
                        if (jb == 0) ((LAS float*)(lds + L_O0))[(wid * 32 + tb * 16 + r) * 64 + lane] = o; else outv[tb][r] = o;
                        if (tb == 1 && r32 == 31 && (smp || ck == 127)) { float* dst = smp ? F.out + O_LS + sb * 512 : F.out + O_LP + pb * 512; dst[chb + e] = h; } } } }
        }
        __builtin_amdgcn_sched_barrier(0);
    }
    if (PASS == 2) {
        LAS float* part = (LAS float*)(lds + L_PART);
#pragma unroll
        for (int tb = 0; tb < 2; ++tb) { float s = ssq_t[tb]; s += __shfl_xor(s, 32); if (hi == 0) part[wid * 64 + tb * 32 + r32] = s; }
        LDS_WAIT(); __syncthreads();
        bf16* CAT = (bf16*)(F.ws + WS_CAT);
#pragma unroll
        for (int tb = 0; tb < 2; ++tb) { const int t = tb * 32 + r32; float tot = 0.f;
#pragma unroll
            for (int w = 0; w < 8; ++w) tot += part[w * 64 + t];
            const float rn = __builtin_amdgcn_rsqf(tot * (1.0f / 512.0f) + EPS);
#pragma unroll
            for (int jb = 0; jb < 2; ++jb)
#pragma unroll
                for (int q4 = 0; q4 < 4; ++q4) { const int chb = 64 * n + 32 * jb + 8 * q4 + 4 * hi; const f32x4 gn = *(const LAS f32x4*)(lds + L_PAR + 6144 + chb * 4);
                    float ov[4];
#pragma unroll
                    for (int e = 0; e < 4; ++e) ov[e] = jb == 0 ? ((const LAS float*)(lds + L_O0))[(wid * 32 + tb * 16 + 4 * q4 + e) * 64 + lane] : outv[tb][4 * q4 + e];
                    v2u o; o.x = pk2(ov[0] * rn * gn[0], ov[1] * rn * gn[1]); o.y = pk2(ov[2] * rn * gn[2], ov[3] * rn * gn[3]);
#ifdef NT_CAT
                    __builtin_nontemporal_store(o, (GAS v2u*)(CAT + (size_t)(row0 + t) * 1024 + 512 + chb)); } }
#else
                    *(GAS v2u*)(CAT + (size_t)(row0 + t) * 1024 + 512 + chb) = o; } }
#endif
    }
    LDS_WAIT(); __syncthreads();
}
}

#ifndef ATT_RSTAGE
#define ATT_RSTAGE 0
#endif
#ifndef ATT_PROBE
#define ATT_PROBE 0
#endif
#if ATT_PROBE == 1
#define ATT_PROBE_CODE(kp) { f32x16 q0 = f32x16{}, q1 = f32x16{}; _Pragma("unroll") for (int d0 = 0; d0 < 4; ++d0) { const bf16x8 k0 = *(const __attribute__((address_space(3))) bf16x8*)(kp + d0 * 2048), k1 = *(const __attribute__((address_space(3))) bf16x8*)(kp + d0 * 2048 + 512); \
        q0 = __builtin_amdgcn_mfma_f32_32x32x16_bf16(k0, qr[d0], q0, 0, 0, 0); q1 = __builtin_amdgcn_mfma_f32_32x32x16_bf16(k1, qr[d0], q1, 0, 0, 0); } asm volatile("" :: "v"(q0), "v"(q1)); }
#elif ATT_PROBE == 2
#define ATT_PROBE_CODE(kp) { f32x16 q0 = p0, q1 = p1; _Pragma("unroll") for (int r = 0; r < 16; ++r) { q0[r] = __builtin_amdgcn_exp2f(q0[r] + 1.0f); q1[r] = __builtin_amdgcn_exp2f(q1[r] + 1.0f); } asm volatile("" :: "v"(q0), "v"(q1)); }
#else
#define ATT_PROBE_CODE(kp)
#endif
namespace att {
constexpr int SLOT = 32768, NSLOT = 4;
constexpr int A_RING = 0;
constexpr int A_EX = 0;
constexpr int A_TAB = 131072;
constexpr int A_WSF = 131072 + 1024;
constexpr int A_MISC = 143360;
__device__ __forceinline__ int crow(int r, int hi) { return (r & 3) + 8 * (r >> 2) + 4 * hi; }
__device__ __forceinline__ void glds16(const void* gsrc, unsigned lds_dst) { unsigned keep;
    asm volatile("s_mov_b32 %0, m0\n\ts_mov_b32 m0, %2\n\ts_nop 0\n\tglobal_load_lds_dwordx4 %1, off\n\ts_mov_b32 m0, %0" : "=&s"(keep) : "v"(gsrc), "s"(lds_dst) : "memory"); }
typedef __attribute__((address_space(3))) const char* lds_cptr;
typedef short v4i16_t __attribute__((ext_vector_type(4)));
__device__ __forceinline__ s16x4 vtr(lds_cptr p) { return __builtin_bit_cast(s16x4, __builtin_amdgcn_ds_read_tr16_b64_v4i16((__attribute__((address_space(3))) v4i16_t*)p)); }
__device__ __forceinline__ unsigned cvtpk(float lo, float hi) { typedef float f2 __attribute__((ext_vector_type(2))); typedef __bf16 b2 __attribute__((ext_vector_type(2)));
    f2 v = {lo, hi}; b2 b = __builtin_convertvector(v, b2); return __builtin_bit_cast(unsigned, b); }
#ifdef ATT_QPRIO
#define ATT_PRIO_QK_ON() __builtin_amdgcn_s_setprio(1)
#define ATT_PRIO_QK_OFF() __builtin_amdgcn_s_setprio(0)
#else
#define ATT_PRIO_QK_ON() do {} while (0)
#define ATT_PRIO_QK_OFF() do {} while (0)
#endif
#ifndef ATT_NO_MPRIO
#define ATT_PRIO_ON() __builtin_amdgcn_s_setprio(1)
#define ATT_PRIO_OFF() __builtin_amdgcn_s_setprio(0)
#else
#define ATT_PRIO_ON() do {} while (0)
#define ATT_PRIO_OFF() do {} while (0)
#endif
#define ATT_WAIT_BAR(N) asm volatile("s_waitcnt vmcnt(" #N ") lgkmcnt(0)\n\ts_barrier" ::: "memory")

template <bool SMP, bool DESC> __device__ __forceinline__ void attn_unit(Frame& F, int sidx, int h, int qb, float lam) {
    int tid_ = F.tid; asm volatile("" : "+v"(tid_));
    const int tid = tid_, lane = tid & 63, wid = F.wave, r32 = lane & 31, hi = lane >> 5;
    const int comp = SMP ? (wid >> 1) & 1 : wid >> 2, g = SMP ? ((wid & 1) | ((wid >> 2) << 1)) : (wid & 3);
    LAS unsigned char* lds = F.lds;
    const unsigned lds0 = (unsigned)(uintptr_t)lds;
    const bf16* Qb = (const bf16*)((const unsigned char*)F.out + OB_Q);
    const int qrow0 = SMP ? TP + sidx * 64 : sidx * SEQ + qb * 128;
    const int qpos0 = SMP ? PAST : qb * 128;
    const int NT = SMP ? 33 : 2 * qb + 2;
    const bool active = SMP ? (g < 2) : true;
    const int gq = SMP ? (g & 1) : g;
    const int qw = qpos0 + 32 * gq;
    const int t_last = active ? (qw >> 6) : -1;
    const int t_near0 = (qw - 90) > 0 ? ((qw - 90) >> 6) : 0;
    if (tid < 256) { float v = 0.f;
        if (tid >= 97 && tid <= 250) { const int delta = tid - 187; const int rel = delta < 0 ? -delta : delta; int bk;
            if (rel < 8) bk = rel; else { bk = 2 + (31 - __builtin_clz((unsigned)(rel * rel))); bk = bk > 15 ? 15 : bk; }
            if (delta > 0) bk += 16;
            v = (fin(F, 6)[bk * 4 + h] - fin(F, 6)[15 * 4 + h]) * LOG2E; }
        ((LAS float*)(lds + A_TAB))[tid] = v; }
    const unsigned char* img0 = F.ws + WS_KVP + (size_t)((SMP ? 0 : (sidx * 4 + h)) * 128) * 32768;
    const unsigned char* imgn = F.ws + WS_KVS + (size_t)(sidx * 4 + h) * 32768;
    const unsigned poff = (unsigned)(wid * 1024 + lane * 16);
    const unsigned pdst = lds0 + A_RING + wid * 1024;
#define ATT_TILE(i) (DESC ? NT - 1 - (i) : (i))
#define ATT_ISSUE(i) do { const int i_ = (i); const int t_ = ATT_TILE(i_); const unsigned so_ = (unsigned)((i_ % NSLOT) * SLOT); \
        if (SMP && t_ != 32) break;                                                 \
        const unsigned char* src_ = (SMP ? imgn : img0 + (size_t)t_ * 32768) + poff; \
        glds16(src_, (unsigned)__builtin_amdgcn_readfirstlane(pdst + so_)); \
        glds16(src_ + 8192, (unsigned)__builtin_amdgcn_readfirstlane(pdst + so_ + 8192)); \
        glds16(src_ + 16384, (unsigned)__builtin_amdgcn_readfirstlane(pdst + so_ + 16384)); \
        glds16(src_ + 24576, (unsigned)__builtin_amdgcn_readfirstlane(pdst + so_ + 24576)); } while (0)
    ATT_ISSUE(0); if (NT > 1) ATT_ISSUE(1);
    bf16x8 qr[4];
    { const bf16* Qw = Qb + (size_t)(qrow0 + 32 * gq + r32) * 512 + h * 128 + comp * 64;
#pragma unroll
      for (int d0 = 0; d0 < 4; ++d0) qr[d0] = *(const GAS bf16x8*)(Qw + d0 * 16 + hi * 8); }
    VM_WAIT();
    asm volatile("" : "+v"(qr[0]), "+v"(qr[1]), "+v"(qr[2]), "+v"(qr[3]));
#ifdef ATT_PRIO
    if (comp == ATT_PRIO - 1) __builtin_amdgcn_s_setprio(1);
#endif
    const bool loader = SMP && !active;
    const int wl = wid & 3;
#define ATT_LOAD_TILE(tt, slot_) do { const int t_ = (tt); LAS unsigned char* sl_ = lds + A_RING + (slot_) * SLOT; \
        const float* ck_ = fin(F, 2) + ((size_t)(sidx * PAST + t_ * 64 + wl * 16) * 4 + h) * 128; const float* cv_ = fin(F, 3) + ((size_t)(sidx * PAST + t_ * 64 + wl * 16) * 4 + h) * 128; \
        f32x4 ka_[4][2], va_[4][2]; \
        _Pragma("unroll") for (int u = 0; u < 4; ++u) { const int cj = u * 4 + (lane >> 4); const float* s_ = ck_ + (size_t)(lane & 15) * 512 + cj * 8; \
            ka_[u][0] = __builtin_nontemporal_load((const f32x4*)s_); ka_[u][1] = __builtin_nontemporal_load((const f32x4*)s_ + 1); } \
        _Pragma("unroll") for (int u = 0; u < 4; ++u) { const float* s_ = cv_ + (size_t)(lane >> 2) * 512 + u * 32 + (lane & 3) * 8; \
            va_[u][0] = __builtin_nontemporal_load((const f32x4*)s_); va_[u][1] = __builtin_nontemporal_load((const f32x4*)s_ + 1); } \
        _Pragma("unroll") for (int u = 0; u < 4; ++u) { const int cj = u * 4 + (lane >> 4); v4u o_; o_.x = pk2(ka_[u][0].x, ka_[u][0].y); o_.y = pk2(ka_[u][0].z, ka_[u][0].w); o_.z = pk2(ka_[u][1].x, ka_[u][1].y); o_.w = pk2(ka_[u][1].z, ka_[u][1].w); \
            *(LAS v4u*)(sl_ + (cj >> 3) * 8192 + (cj & 7) * 1024 + (wl * 16 + (lane & 15)) * 16) = o_; } \
        _Pragma("unroll") for (int u = 0; u < 4; ++u) { v4u o_; o_.x = pk2(va_[u][0].x, va_[u][0].y); o_.y = pk2(va_[u][0].z, va_[u][0].w); o_.z = pk2(va_[u][1].x, va_[u][1].y); o_.w = pk2(va_[u][1].z, va_[u][1].w); \
            *(LAS v4u*)(sl_ + 16384 + u * 4096 + (wl * 16 + (lane >> 2)) * 64 + (lane & 3) * 16) = o_; } } while (0)
    if (loader) { ATT_LOAD_TILE(0, 0); ATT_LOAD_TILE(1, 1); VM_WAIT(); }
    f32x16 o[4]; o[0] = f32x16{}; o[1] = f32x16{}; o[2] = f32x16{}; o[3] = f32x16{};
    float lsum = 0.f;
    const lds_cptr l3 = (lds_cptr)lds;
    const int kfo = A_RING + comp * 8192 + hi * 1024 + r32 * 16;
    const int vfo = A_RING + 16384 + ((lane >> 4) & 1) * 32 + (lane & 3) * 8 + (4 * hi + ((lane & 15) >> 2)) * 64;
    const int qposl = qw + r32;
    v4u pw[4]; bool have_p = false;
    int so_prev = 0;
#define ATT_VRD(j) do { vlo[j] = vtr(vp + ((j) >> 2) * 4096 + ((j) & 3) * 1024); vhi[j] = vtr(vp + ((j) >> 2) * 4096 + ((j) & 3) * 1024 + 512); } while (0)
#define ATT_VFR(j) (bf16x8){vlo[j][0], vlo[j][1], vlo[j][2], vlo[j][3], vhi[j][0], vhi[j][1], vhi[j][2], vhi[j][3]}
#define ATT_G2(j) do { if ((j) + 3 < 16) ATT_VRD((j) + 3); \
        o[(j) >> 2] = __builtin_amdgcn_mfma_f32_32x32x16_bf16(__builtin_bit_cast(bf16x8, pw[(j) & 3]), ATT_VFR(j), o[(j) >> 2], 0, 0, 0); __builtin_amdgcn_sched_barrier(0); } while (0)
#define ATT_QKEXP(t_, so_) do { f32x16 p0, p1; \
        const lds_cptr kp = l3 + kfo + (so_); \
        bf16x8 kf[8];                                                               \
        _Pragma("unroll") for (int d0 = 0; d0 < 4; ++d0) { kf[2 * d0] = *(const __attribute__((address_space(3))) bf16x8*)(kp + d0 * 2048); kf[2 * d0 + 1] = *(const __attribute__((address_space(3))) bf16x8*)(kp + d0 * 2048 + 512); } \
        __builtin_amdgcn_sched_barrier(0); ATT_PRIO_QK_ON(); \
        if ((t_) >= t_near0) { const LAS float* tb = (const LAS float*)(lds + A_TAB) + (64 * (t_) + 4 * hi - qposl + 187);     \
            _Pragma("unroll") for (int r = 0; r < 16; ++r) { p0[r] = tb[(r & 3) + 8 * (r >> 2)]; p1[r] = tb[(r & 3) + 8 * (r >> 2) + 32]; } \
            p0 = __builtin_amdgcn_mfma_f32_32x32x16_bf16(kf[0], qr[0], p0, 0, 0, 0); p1 = __builtin_amdgcn_mfma_f32_32x32x16_bf16(kf[1], qr[0], p1, 0, 0, 0); } \
        else { p0 = __builtin_amdgcn_mfma_f32_32x32x16_bf16(kf[0], qr[0], f32x16{}, 0, 0, 0); p1 = __builtin_amdgcn_mfma_f32_32x32x16_bf16(kf[1], qr[0], f32x16{}, 0, 0, 0); }     \
        _Pragma("unroll") for (int d0 = 1; d0 < 4; ++d0) { \
            p0 = __builtin_amdgcn_mfma_f32_32x32x16_bf16(kf[2 * d0], qr[d0], p0, 0, 0, 0); \
            p1 = __builtin_amdgcn_mfma_f32_32x32x16_bf16(kf[2 * d0 + 1], qr[d0], p1, 0, 0, 0); } ATT_PRIO_QK_OFF(); \
        ATT_PROBE_CODE(kp) \
        float sacc = 0.f; \
        _Pragma("unroll") for (int r = 0; r < 16; ++r) { p0[r] = __builtin_amdgcn_exp2f(p0[r]); p1[r] = __builtin_amdgcn_exp2f(p1[r]); sacc += p0[r] + p1[r]; } \
        lsum += sacc; \
        _Pragma("unroll") for (int k = 0; k < 2; ++k) { pw[k] = (v4u){cvtpk(p0[8 * k], p0[8 * k + 1]), cvtpk(p0[8 * k + 2], p0[8 * k + 3]), cvtpk(p0[8 * k + 4], p0[8 * k + 5]), cvtpk(p0[8 * k + 6], p0[8 * k + 7])}; \
                                      pw[2 + k] = (v4u){cvtpk(p1[8 * k], p1[8 * k + 1]), cvtpk(p1[8 * k + 2], p1[8 * k + 3]), cvtpk(p1[8 * k + 4], p1[8 * k + 5]), cvtpk(p1[8 * k + 6], p1[8 * k + 7])}; } } while (0)
#define ATT_PV(so_) do { const lds_cptr vp = l3 + vfo + (so_); s16x4 vlo[16], vhi[16]; ATT_VRD(0); ATT_VRD(1); ATT_VRD(2); __builtin_amdgcn_sched_barrier(0); ATT_PRIO_ON(); \
        ATT_G2(0); ATT_G2(1); ATT_G2(2); ATT_G2(3); ATT_G2(4); ATT_G2(5); ATT_G2(6); ATT_G2(7); ATT_G2(8); ATT_G2(9); ATT_G2(10); ATT_G2(11); ATT_G2(12); ATT_G2(13); ATT_G2(14); ATT_G2(15); ATT_PRIO_OFF(); } while (0)
#define ATT_SYNC(it_) do { if ((it_) + 1 < NT) ATT_WAIT_BAR(4); else ATT_WAIT_BAR(0);     \
        if ((it_) + 2 < NT) ATT_ISSUE((it_) + 2); } while (0)
    if (!SMP && ATT_RSTAGE) {
        asm volatile("s_waitcnt vmcnt(0)" ::: "memory");
        const unsigned char* gsrc = img0 + poff;
        LAS unsigned char* ldst = lds + A_RING + wid * 1024 + lane * 16;
        v4u st[8];
#define ATT_RLOAD(i_, k_) do { const unsigned char* s_ = gsrc + (size_t)ATT_TILE(i_) * 32768; \
        st[4 * (k_)] = *(const GAS v4u*)(s_); st[4 * (k_) + 1] = *(const GAS v4u*)(s_ + 8192); st[4 * (k_) + 2] = *(const GAS v4u*)(s_ + 16384); st[4 * (k_) + 3] = *(const GAS v4u*)(s_ + 24576); } while (0)
#define ATT_RWRITE(i_, k_) do { LAS unsigned char* d_ = ldst + ((i_) % NSLOT) * SLOT; \
        *(LAS v4u*)(d_) = st[4 * (k_)]; *(LAS v4u*)(d_ + 8192) = st[4 * (k_) + 1]; *(LAS v4u*)(d_ + 16384) = st[4 * (k_) + 2]; *(LAS v4u*)(d_ + 24576) = st[4 * (k_) + 3]; } while (0)
        if (NT > 2) { ATT_RLOAD(2, 0); ATT_RLOAD(3, 1); }
        asm volatile("s_waitcnt lgkmcnt(0)\n\ts_barrier" ::: "memory");
        for (int it = 0; it < NT; it += 2) {
            if (it + 2 < NT) { ATT_RWRITE(it + 2, 0); ATT_RWRITE(it + 3, 1); }
            if (it + 4 < NT) { ATT_RLOAD(it + 4, 0); ATT_RLOAD(it + 5, 1); }
#pragma unroll
            for (int k = 0; k < 2; ++k) { const int t = ATT_TILE(it + k); const int so = ((it + k) % NSLOT) * SLOT;
                if (t <= t_last) { ATT_QKEXP(t, so); __builtin_amdgcn_sched_barrier(0); ATT_PV(so); } }
            asm volatile("s_waitcnt lgkmcnt(0)\n\ts_barrier" ::: "memory");
        }
#undef ATT_RLOAD
#undef ATT_RWRITE
    } else {
    const bool skew = comp == 1;
    for (int it = 0; it < NT; ++it) {
        const int t = ATT_TILE(it);
        if (skew) ATT_SYNC(it);
        if (have_p) { ATT_PV(so_prev); __builtin_amdgcn_sched_barrier(0); }
        if (!skew) ATT_SYNC(it);
        const int so = (it % NSLOT) * SLOT;
        have_p = (t <= t_last);
        if (have_p) { ATT_QKEXP(t, so); so_prev = so; }
        if (loader && it + 2 < 32) { ATT_LOAD_TILE(it + 2, (it + 2) % NSLOT); VM_WAIT(); }
    }
    if (have_p) { ATT_PV(so_prev); }
    }
#undef ATT_SYNC
#undef ATT_VRD
#undef ATT_VFR
#undef ATT_G2
#undef ATT_QKEXP
#undef ATT_PV
#ifdef ATT_PRIO
    __builtin_amdgcn_s_setprio(0);
#endif
    int lane_e = lane; asm volatile("" : "+v"(lane_e));
    const int r32e = lane_e & 31, hie = lane_e >> 5;
    { auto rr = __builtin_amdgcn_permlane32_swap(__float_as_uint(lsum), __float_as_uint(lsum), false, false); lsum = __uint_as_float(rr[0]) + __uint_as_float(rr[1]); }
    LAS float* wsf = (LAS float*)(lds + A_WSF) + wid * 32;
    if (hie == 0) wsf[r32e] = lsum;
    ATT_WAIT_BAR(0);
    float rli[16];
#pragma unroll
    for (int r = 0; r < 16; ++r) rli[r] = __builtin_amdgcn_rcpf(wsf[crow(r, hie)]);
    LAS float* ex = (LAS float*)(lds + A_EX) + g * 4096;
    if (comp == 1) {
#pragma unroll
        for (int db = 0; db < 4; ++db)
#pragma unroll
            for (int r = 0; r < 16; ++r) ex[crow(r, hie) * 128 + db * 32 + r32e] = o[db][r] * (rli[r] * lam);
    }
    LDS_WAIT(); __syncthreads();
    if (comp == 0 && active) {
        float ss[16];
#pragma unroll
        for (int r = 0; r < 16; ++r) ss[r] = 0.f;
#pragma unroll
        for (int db = 0; db < 4; ++db)
#pragma unroll
            for (int r = 0; r < 16; ++r) { const float v = o[db][r] * rli[r] - ex[crow(r, hie) * 128 + db * 32 + r32e]; o[db][r] = v; ss[r] += v * v; }
#pragma unroll
        for (int r = 0; r < 16; ++r) { float s = ss[r];
#pragma unroll
            for (int m = 1; m < 32; m <<= 1) s += __shfl_xor(s, m);
            ss[r] = __builtin_amdgcn_rsqf(s * (1.0f / 128.0f) + EPS) * 0.8f; }
        LDS_WAIT();
        LAS unsigned short* stg = (LAS unsigned short*)ex;
#pragma unroll
        for (int db = 0; db < 4; ++db) { const float gn = fin(F, 19)[db * 32 + r32e];
#pragma unroll
            for (int r = 0; r < 16; ++r) stg[crow(r, hie) * 128 + db * 32 + r32e] = (unsigned short)f2bf(o[db][r] * ss[r] * gn); }
        LDS_WAIT();
        bf16* CAT = (bf16*)(F.ws + WS_CAT);
#pragma unroll
        for (int i = 0; i < 8; ++i) { const int row = i * 4 + (lane_e >> 4), ch = lane_e & 15;
            const v4u v = *(const LAS v4u*)(stg + row * 128 + ch * 8);
#ifdef NT_CAT
            __builtin_nontemporal_store(v, (GAS v4u*)(CAT + (size_t)(qrow0 + 32 * g + row) * 1024 + h * 128 + ch * 8)); }
#else
            *(GAS v4u*)(CAT + (size_t)(qrow0 + 32 * g + row) * 1024 + h * 128 + ch * 8) = v; }
#endif
    }
    LDS_WAIT(); __syncthreads();
#undef ATT_ISSUE
#undef ATT_LOAD_TILE
#undef ATT_TILE
}
#undef ATT_WAIT_BAR
}

#ifndef PG8_ALIGN
#define PG8_ALIGN true
#endif
#ifndef PG8_SP2
#define PG8_SP2 true
#endif
#ifndef SKM_G1
#define SKM_G1 0
#endif
#ifndef SKM_G2
#define SKM_G2 0
#endif
#ifndef SKM_G3
#define SKM_G3 0
#endif
#ifndef SKM_G5
#define SKM_G5 0
#endif
#ifndef SKM_G6
#define SKM_G6 0
#endif
#ifndef SKM_G7
#define SKM_G7 0
#endif
__device__ __forceinline__ void phase_p0(Frame& F) {
    unsigned char* ws = F.ws; (void)ws;
#ifndef NO_P0
    p0_prologue(F);
#endif
}

#ifdef DEP_OFF
#define DEPM(k) 0
#else
#ifndef DEP_MASK
#define DEP_MASK 3
#endif
#define DEPM(k) ((k) & DEP_MASK)
#endif
constexpr int UPX(int N) { return (TT / 256 / 8) * (N / 256); }
#define DEPC(k) ((unsigned*)(ws + WS_CTL) + CW_DEP + ((k) + cs) * 136 * 4)
__device__ __forceinline__ void phase_g1(Frame& F, int cs = 0  ) {
    unsigned char* ws = F.ws; (void)ws;
#ifndef NO_G1
    {   pg8::Gemm g{(const pg8::bf16_t*)(ws + WS_XB), (const pg8::bf16_t*)(ws + WS_W1GU), TT, 2 * FF, DM}; typedef pg8::StreamK<0, DEPM(2)> SK; SK S; S.init(TT, 2 * FF, DM, F.G, F.bx, nullptr, nullptr, 0, 0);
        S.dep_in = nullptr; S.dep_target = 0u; S.dep_out = DEPC(0);
        pg8::EpiSwiGLU<0> E{(pg8::bf16_t*)(ws + WS_H), (const float*)(ws + WS_RSTD0)};
        pg8::gemm_phase<pg8::EpiSwiGLU<0>, SK, PG8_ALIGN, PG8_SP2>(F.lds, g, S, E, F.tid); }
#endif
}

__device__ __forceinline__ void phase_g2(Frame& F, int cs = 0  ) {
    unsigned char* ws = F.ws; (void)ws;
#ifndef NO_G2
    {   pg8::Gemm g{(const pg8::bf16_t*)(ws + WS_H), (const pg8::bf16_t*)(ws + WS_W1D), TT, DM, FF}; typedef pg8::StreamK<0, DEPM(3)> SK; SK S; S.init(TT, DM, FF, F.G, F.bx, nullptr, nullptr, 0, UPX(2 * FF));
        S.dep_in = DEPC(0); S.dep_target = 8u * (2 * FF / 256); S.dep_out = DEPC(1);
        pg8::EpiResid<0> E{(pg8::bf16_t*)(ws + WS_XB), F.out, (float*)(ws + WS_SSQ1), (pg8::bf16_t*)(ws + WS_XB1)};
        pg8::gemm_phase<pg8::EpiResid<0>, SK, PG8_ALIGN, PG8_SP2>(F.lds, g, S, E, F.tid); }
#endif
}

__device__ __forceinline__ void phase_g3(Frame& F, int cs = 0  ) {
    unsigned char* ws = F.ws; (void)ws;
#ifndef NO_G3
    {   pg8::Gemm g{(const pg8::bf16_t*)(ws + WS_XB1), (const pg8::bf16_t*)(ws + WS_WIN), TT, INW, DM}; typedef pg8::StreamK<0, DEPM(1)> SK; SK S; S.init(TT, INW, DM, F.G, F.bx, nullptr, nullptr, 0, UPX(2 * FF) + UPX(DM));
        S.dep_in = DEPC(1); S.dep_target = 8u * (DM / 256); S.dep_out = nullptr;
        pg8::EpiWin E{ws, F.out, fin(F, 13), fin(F, 14)};
        pg8::gemm_phase<pg8::EpiWin, SK, PG8_ALIGN, PG8_SP2>(F.lds, g, S, E, F.tid); }
#ifndef CONV_IN_ATT
    if (cs == 0) convert_queue(F, (unsigned*)(ws + WS_CTL) + CW_CONVQ, (LAS int*)(F.lds + att::A_MISC) + 1);
#endif
#endif
}

__device__ __forceinline__ void phase_l1(Frame& F) {
    unsigned char* ws = F.ws; (void)ws;
#ifndef NO_L1
#ifdef L1_DYN
    {   unsigned* ctl = (unsigned*)(F.ws + WS_CTL); const int grp = F.bx & 7; unsigned* head1 = ctl + CW_QUEUE + 64 * grp + 2048;
        LAS int* qi = (LAS int*)(F.lds + att::A_MISC) + 1;
        for (;;) {
            if (F.tid == 0) *qi = (int)atomicAdd(head1, 1u);
            __syncthreads();
            const int it = *qi;
            __syncthreads();
            if (it >= 68) break;
            lru::lru_unit<1>(F, grp * 68 + it);
#if L1_DYN >= 2
            if (F.tid == 0) { asm volatile("s_waitcnt vmcnt(0)" ::: "memory");
#if L1_DYN >= 3
                __builtin_amdgcn_fence(__ATOMIC_RELEASE, "agent"); asm volatile("s_waitcnt vmcnt(0)" ::: "memory");
#endif
                __hip_atomic_fetch_add(ctl + 100, 1u, __ATOMIC_RELAXED, __HIP_MEMORY_SCOPE_AGENT); }
#endif
        }
    }
#else
    for (int u = F.bx; u < 512; u += F.G) if ((u & 127) != 127) lru::lru_unit<1>(F, u);
#endif
#endif
}

__device__ __forceinline__ void phase_g5(Frame& F, int cs = 0  ) {
    unsigned char* ws = F.ws; (void)ws;
#ifndef NO_G5
    {   pg8::Gemm g{(const pg8::bf16_t*)(ws + WS_CAT), (const pg8::bf16_t*)(ws + WS_WOUT), TT, DM, DM}; typedef pg8::StreamK<0, DEPM(2)> SK; SK S; S.init(TT, DM, DM, F.G, F.bx, nullptr, nullptr, 0, 0);
        S.dep_in = nullptr; S.dep_target = 0u; S.dep_out = DEPC(2);
        pg8::EpiResid<1> E{(pg8::bf16_t*)(ws + WS_XB1), F.out, (float*)(ws + WS_SSQ2), (pg8::bf16_t*)(ws + WS_XB)};
        pg8::gemm_phase<pg8::EpiResid<1>, SK, PG8_ALIGN, PG8_SP2>(F.lds, g, S, E, F.tid); }
#endif
}

__device__ __forceinline__ void phase_g6(Frame& F, int cs = 0  ) {
    unsigned char* ws = F.ws; (void)ws;
#ifndef NO_G6
    {   pg8::Gemm g{(const pg8::bf16_t*)(ws + WS_XB), (const pg8::bf16_t*)(ws + WS_W2GU), TT, 2 * FF, DM}; typedef pg8::StreamK<0, DEPM(3)> SK; SK S; S.init(TT, 2 * FF, DM, F.G, F.bx, nullptr, nullptr, 0, UPX(DM));
        S.dep_in = DEPC(2); S.dep_target = 8u * (DM / 256); S.dep_out = DEPC(3);
        pg8::EpiSwiGLU<1> E{(pg8::bf16_t*)(ws + WS_H), (const float*)(ws + WS_SSQ2)};
        pg8::gemm_phase<pg8::EpiSwiGLU<1>, SK, PG8_ALIGN, PG8_SP2>(F.lds, g, S, E, F.tid); }
#endif
}

__device__ __forceinline__ void phase_g7(Frame& F, int cs = 0  ) {
    unsigned char* ws = F.ws; (void)ws;
#ifndef NO_G7
    {   pg8::Gemm g{(const pg8::bf16_t*)(ws + WS_H), (const pg8::bf16_t*)(ws + WS_W2D), TT, DM, FF}; typedef pg8::StreamK<0, DEPM(1)> SK; SK S; S.init(TT, DM, FF, F.G, F.bx, nullptr, nullptr, 0, UPX(DM) + UPX(2 * FF));
        S.dep_in = DEPC(3); S.dep_target = 8u * (2 * FF / 256); S.dep_out = nullptr;
        pg8::EpiResid<2> E{(pg8::bf16_t*)(ws + WS_XB), F.out, nullptr, nullptr};
        pg8::gemm_phase<pg8::EpiResid<2>, SK, PG8_ALIGN, PG8_SP2>(F.lds, g, S, E, F.tid); }
#endif
}

struct Args { const float* in[33]; float* out; unsigned char* ws; int pad0, pad1; };
__global__ void __launch_bounds__(512, 2) hymba_fwd(Args args) {
    extern __shared__ __attribute__((aligned(16))) unsigned char lds_raw[];
    cg::grid_group grid = cg::this_grid();
    Frame F;
    F.lds = (LAS unsigned char*)lds_raw;
    F.tid = threadIdx.x; F.lane = F.tid & 63; F.wave = __builtin_amdgcn_readfirstlane(F.tid >> 6);
    F.G = gridDim.x; F.bx = blockIdx.x;
    F.ka = (kptr_t)__builtin_amdgcn_kernarg_segment_ptr(); F.z = 0;
    F.out = args.out; F.ws = args.ws;
    unsigned char* ws = F.ws;
    unsigned* ctl = (unsigned*)(ws + WS_CTL);
    volatile LAS unsigned* MISCW = (volatile LAS unsigned*)(F.lds + 144384);
    if (F.tid < 16) MISCW[F.tid] = 0u;
    __syncthreads();
    XcdBarrier bar = xcd_barrier_post(ctl + CW_BAR, MISCW + 8, F.wave);
#define GRID_BAR() do { xcd_barrier(bar); NEW_PHASE(); } while (0)
#define GRID_BAR_CG() do { __threadfence(); grid.sync(); NEW_PHASE(); } while (0)

    phase_p0(F);
#if defined(REP_P0)
    GRID_BAR(); phase_p0(F);
#endif
#ifdef USE_CG_SYNC
    GRID_BAR_CG();
#else
    GRID_BAR();
#endif
    phase_g1(F);
#ifdef CHAIN_BARS
    GRID_BAR();
#endif
    phase_g2(F);
#ifdef CHAIN_BARS
    GRID_BAR();
#endif
    phase_g3(F);
    GRID_BAR();
#ifdef REP_C1
    phase_g1(F, 4); phase_g2(F, 4); phase_g3(F, 4); GRID_BAR();
#endif
    phase_l1(F);
#if defined(REP_L1)
    GRID_BAR(); phase_l1(F);
#endif
    GRID_BAR();
    {
        LAS float* misc = (LAS float*)(F.lds + att::A_MISC);
        if (F.wave == 0) { const float a = wave_sum(fin(F, 15)[F.lane] * fin(F, 16)[F.lane]), b = wave_sum(fin(F, 17)[F.lane] * fin(F, 18)[F.lane]);
            if (F.lane == 0) misc[0] = __expf(a) - __expf(b) + 0.2f; }
        __syncthreads();
        const float lam = misc[0];
        const int grp = F.bx & 7;
#ifdef ATT_TWICE
        for (int rep = 0; rep < 2; ++rep) {
        unsigned* head = ctl + CW_QUEUE + 64 * grp + 1024 * rep;
#else
        unsigned* head = ctl + CW_QUEUE + 64 * grp;
#endif
        const int wq = F.bx >> 3;
        if (F.G == 256) {
#ifndef NO_ATT
#pragma unroll 1
            for (int k = 0; k < 2; ++k) { const int st = grp + 8 * k;
                att::attn_unit<false, false>(F, st >> 2, st & 3, wq, lam);
                att::attn_unit<false, true>(F, st >> 2, st & 3, 63 - wq, lam); }
#endif
        }
        const int qbase = (F.G == 256) ? 128 : 0;
        for (;;) {
            if (F.tid == 0) ((LAS int*)misc)[1] = qbase + (int)atomicAdd(head, 1u);
            __syncthreads();
            const int it = ((LAS int*)misc)[1];
            __syncthreads();
            if (it >= 212) break;
#ifndef NO_ATT
            if (it < 128) { const int st = grp + 8 * (it >> 6), qb = 63 - (it & 63); att::attn_unit<false, false>(F, st >> 2, st & 3, qb, lam); }
            else if (it < 144) { const int su = grp * 16 + (it - 128); att::attn_unit<true, false>(F, su >> 2, su & 3, 0, lam); }
            else
#endif
#ifndef NO_L2
            { lru::lru_unit<2>(F, grp * 68 + (it - 144));
#ifdef L2_TWICE
              lru::lru_unit<2>(F, grp * 68 + (it - 144));
#endif
            }
#else
            {}
#endif
        }
#ifdef ATT_TWICE
        __syncthreads(); }
#endif
#ifdef CONV_IN_ATT
        convert_queue(F, ctl + CW_CONVQ, (LAS int*)misc + 1);
#endif
    }
    GRID_BAR();
#ifdef REP_C2
    phase_g5(F, 2); phase_g6(F, 2); phase_g7(F, 2); GRID_BAR();
#endif
    phase_g5(F);
#ifdef CHAIN_BARS
    GRID_BAR();
#endif
    phase_g6(F);
#ifdef CHAIN_BARS
    GRID_BAR();
#endif
    phase_g7(F);
}

extern "C" void kernel_launch(void* const* d_in, const int* in_sizes, int n_in, void* d_out, int out_size, void* d_ws, size_t ws_size, hipStream_t stream) {
    static int grid = 0;
    if (grid == 0) {
        if (n_in != 33 || out_size != (int)O_END || ws_size < WS_END) { fprintf(stderr, "kernel_launch: unexpected shapes: n_in %d out %d ws %zu (need %zu)\n", n_in, out_size, ws_size, (size_t)WS_END); grid = -1; return; }
        int dev = 0, cus = 0, per_cu = 0;
        hipGetDevice(&dev); hipDeviceGetAttribute(&cus, hipDeviceAttributeMultiprocessorCount, dev);
        if (hipFuncSetAttribute((const void*)hymba_fwd, hipFuncAttributeMaxDynamicSharedMemorySize, LDS_BYTES) != hipSuccess) { fprintf(stderr, "kernel_launch: hipFuncSetAttribute failed\n"); grid = -1; return; }
        if (hipOccupancyMaxActiveBlocksPerMultiprocessor(&per_cu, (const void*)hymba_fwd, 512, LDS_BYTES) != hipSuccess || per_cu < 1) { fprintf(stderr, "kernel_launch: occupancy query says %d\n", per_cu); per_cu = 1; }
        (void)hipGetLastError();
        grid = cus * 1;
        if (grid % 8 != 0 || grid < 8) { fprintf(stderr, "kernel_launch: grid %d not a multiple of 8\n", grid); }
    }
    if (grid < 0) return;
    (void)hipMemsetAsync((char*)d_ws + WS_CTL, 0, CTL_ZERO_BYTES, stream);
    Args a{};
    for (int i = 0; i < 33; ++i) a.in[i] = (const float*)d_in[i];
    a.out = (float*)d_out; a.ws = (unsigned char*)d_ws;
    void* kargs[] = {&a};
    hipError_t e = hipLaunchCooperativeKernel((const void*)hymba_fwd, dim3(grid), dim3(512), kargs, LDS_BYTES, stream);
    if (e != hipSuccess) fprintf(stderr, "kernel_launch: cooperative launch failed: %s (grid %d)\n", hipGetErrorString(e), grid);
}
```
